# Optimizing an MI355X kernel written in HIP

```python
import jax, jax.numpy as jnp
from jax import lax
import numpy as np

D_MODEL = 2048
BATCH = 2
SEQ = 4096
DEPTH = 4

HEAD_DIM = 128
MIX_WIDTH = D_MODEL
MOBA_HEADS = MIX_WIDTH // 2 // HEAD_DIM
MOBA_WIDTH = MOBA_HEADS * HEAD_DIM
MOBA_BLOCK = 256
MOBA_TOPK = 3
MOBA_Q_CHUNK = 32
DN_HEADS = MIX_WIDTH // 2 // HEAD_DIM
DN_DK = HEAD_DIM
DN_DV = HEAD_DIM
DN_QK_WIDTH = DN_HEADS * DN_DK
DN_WIDTH = DN_HEADS * DN_DV
DN_CONV_CH = 2 * DN_QK_WIDTH + DN_WIDTH
CONV_W = 4
DN_CHUNK = 64
AB_WIDTH = MOBA_WIDTH + DN_WIDTH
AB_IN = 3 * MOBA_WIDTH + DN_CONV_CH + DN_WIDTH + 2 * DN_HEADS
AB_SPLITS = (3 * MOBA_WIDTH, 3 * MOBA_WIDTH + DN_CONV_CH, 3 * MOBA_WIDTH + DN_CONV_CH + DN_WIDTH, 3 * MOBA_WIDTH + DN_CONV_CH + DN_WIDTH + DN_HEADS)
C_DK = 128
C_HEADS = MIX_WIDTH // C_DK
C_DV = MIX_WIDTH // C_HEADS
C_WIDTH = MIX_WIDTH
C_CHUNK = 64
MEM_TOKENS = 256
X_HEADS = 4
X_DIM = 128
X_WIDTH = X_HEADS * X_DIM
D_FF = 5504
N_EVEN = (DEPTH + 1) // 2
N_ODD = DEPTH // 2
EPS = 1e-6
F32 = jnp.float32

kernel_name = 'hybrid_moba_gdn_hgrn2_macaron'


def rmsnorm(x, g):
    xf = x.astype(F32)
    y = xf * lax.rsqrt(jnp.mean(xf * xf, axis=-1, keepdims=True) + EPS)
    return (y * g.astype(F32)).astype(x.dtype)


def l2norm(x):
    return x * lax.rsqrt(jnp.sum(x * x, axis=-1, keepdims=True) + EPS)


def swiglu(h, w_in, w_out):
    a, b = jnp.split(h @ w_in, 2, axis=-1)
    return (jax.nn.silu(a) * b) @ w_out


def causal_dwconv(x, w):
    width, ch = w.shape
    return lax.conv_general_dilated(x, w.astype(x.dtype)[:, None, :], window_strides=(1,), padding=[(width - 1, 0)], dimension_numbers=('NWC', 'WIO', 'NWC'), feature_group_count=ch)


def moba_attention(q, k, v):
    B, T, H, dh = q.shape
    nb = -(-T // MOBA_BLOCK)
    t_pad = nb * MOBA_BLOCK
    pad = ((0, 0), (0, t_pad - T), (0, 0), (0, 0))
    kh = jnp.pad(k, pad).transpose(0, 2, 1, 3).reshape(B, H, nb, MOBA_BLOCK, dh)
    vh = jnp.pad(v, pad).transpose(0, 2, 1, 3).reshape(B, H, nb, MOBA_BLOCK, dh)
    qh = q.transpose(0, 2, 1, 3)
    k_mean = jnp.mean(kh.astype(F32), axis=3)
    gate = jnp.einsum('bhtd,bhnd->bhtn', qh.astype(F32), k_mean)
    pos = jnp.arange(T)
    q_blk = pos // MOBA_BLOCK
    past = jnp.arange(nb)[None, :] < q_blk[:, None]
    gate = jnp.where(past, gate, -jnp.inf)
    kk = min(MOBA_TOPK, nb)
    _, top = lax.top_k(gate, kk)
    own = jnp.broadcast_to(q_blk[:, None], (B, H, T, 1)).astype(top.dtype)
    idx = jnp.concatenate([top, own], axis=-1)
    slot_ok = jnp.concatenate([top < q_blk[:, None], jnp.ones((B, H, T, 1), bool)], axis=-1)
    nq = T // MOBA_Q_CHUNK

    def to_q_chunks(a):
        a = a.reshape(B, H, nq, MOBA_Q_CHUNK, *a.shape[3:])
        return jnp.moveaxis(a, 2, 0)

    b_ix = jnp.arange(B)[:, None, None, None]
    h_ix = jnp.arange(H)[None, :, None, None]
    blk_off = jnp.arange(MOBA_BLOCK)
    scale = dh ** -0.5

    def attend(args):
        qc, ic, okc, pc = args
        ks = kh[b_ix, h_ix, ic]
        vs = vh[b_ix, h_ix, ic]
        s = jnp.einsum('bhqd,bhqnkd->bhqnk', qc, ks).astype(F32) * scale
        key_pos = ic[..., None] * MOBA_BLOCK + blk_off
        mask = okc[..., None] & (key_pos <= pc[:, None, None])
        s = jnp.where(mask, s, -jnp.inf)
        p = jax.nn.softmax(s.reshape(*s.shape[:3], -1), axis=-1).reshape(s.shape)
        return jnp.einsum('bhqnk,bhqnkd->bhqd', p.astype(vs.dtype), vs)

    out = lax.map(attend, (to_q_chunks(qh), to_q_chunks(idx), to_q_chunks(slot_ok), pos.reshape(nq, MOBA_Q_CHUNK)))
    out = jnp.moveaxis(out, 0, 2).reshape(B, H, T, dh).transpose(0, 2, 1, 3)
    return out.reshape(B, T, H * dh)


def gated_delta_rule(q, k, v, g, beta):
    B, T, H, dk = q.shape
    dv = v.shape[-1]
    C = DN_CHUNK
    n = T // C

    def chunks(a):
        a = a.reshape(B, n, C, H, *a.shape[3:])
        return jnp.moveaxis(a, 3, 1)

    q, k, v, g, beta = chunks(q), chunks(k), chunks(v), chunks(g), chunks(beta)
    G = jnp.cumsum(g, axis=-1)
    tril = jnp.tril(jnp.ones((C, C), bool))
    eye = jnp.eye(C, dtype=F32)
    gamma = jnp.exp(jnp.where(tril, G[..., :, None] - G[..., None, :], -jnp.inf))
    kb = k * beta[..., None]
    m = jnp.where(tril & (eye == 0), jnp.einsum('bhncd,bhnsd->bhncs', kb, k) * gamma, 0.0)
    t_inv = lax.linalg.triangular_solve(m + eye, jnp.broadcast_to(eye, m.shape), left_side=True, lower=True, unit_diagonal=True)
    u = t_inv @ (v * beta[..., None])
    w = t_inv @ (kb * jnp.exp(G)[..., None])
    a_qk = jnp.einsum('bhncd,bhnsd->bhncs', q, k) * gamma
    q_dec = q * jnp.exp(G)[..., None]
    k_dec = k * jnp.exp(G[..., -1:] - G)[..., None]
    g_last = jnp.exp(G[..., -1])
    xs = tuple(jnp.moveaxis(a, 2, 0) for a in (u, w, a_qk, q_dec, k_dec, g_last))

    def step(S, inp):
        u_c, w_c, a_c, qd, kd, gl = inp
        v_new = u_c - w_c @ S
        o = qd @ S + a_c @ v_new
        S = gl[..., None, None] * S + jnp.einsum('bhcd,bhcv->bhdv', kd, v_new)
        return S, o

    _, o = lax.scan(step, jnp.zeros((B, H, dk, dv), F32), xs)
    return o.transpose(1, 0, 3, 2, 4).reshape(B, T, H, dv)


def gla_chunked(q, k, v, log_f):
    B, T, H, dk = q.shape
    dv = v.shape[-1]
    C = C_CHUNK
    n = T // C

    def chunks(a):
        a = a.reshape(B, n, C, H, a.shape[-1])
        return a.transpose(1, 0, 3, 2, 4)

    qc, kc, vc = chunks(q), chunks(k), chunks(v)
    bc = jnp.cumsum(chunks(log_f), axis=3)
    tril = jnp.tril(jnp.ones((C, C), bool))[:, :, None]

    def step(S, inp):
        qi, ki, vi, bi = inp
        decay = jnp.exp(jnp.where(tril, bi[:, :, :, None, :] - bi[:, :, None, :, :], -jnp.inf))
        a = jnp.einsum('bhtd,bhsd,bhtsd->bhts', qi, ki, decay)
        o = a @ vi + (qi * jnp.exp(bi)) @ S
        b_last = bi[:, :, -1:, :]
        S = jnp.exp(b_last[:, :, 0, :])[..., None] * S + jnp.einsum('bhsd,bhsv->bhdv', ki * jnp.exp(b_last - bi), vi)
        return S, o

    _, o = lax.scan(step, jnp.zeros((B, H, dk, dv), F32), (qc, kc, vc, bc))
    return o.transpose(1, 0, 3, 2, 4).reshape(B, T, H, dv)


def moba_deltanet_mixer(h, w_in, conv_w, a_log, dt_bias, o_norm_g, w_out):
    B, T, _ = h.shape
    moba_qkv, dn_qkv, dn_gate, beta_raw, alpha_raw = jnp.split(h @ w_in, AB_SPLITS, axis=-1)
    mq, mk, mv = (a.reshape(B, T, MOBA_HEADS, HEAD_DIM) for a in jnp.split(moba_qkv, 3, axis=-1))
    y_a = moba_attention(mq, mk, mv)
    dn = jax.nn.silu(causal_dwconv(dn_qkv, conv_w)).astype(F32)
    dq, dk, dv = jnp.split(dn, (DN_QK_WIDTH, 2 * DN_QK_WIDTH), axis=-1)
    dq = l2norm(dq.reshape(B, T, DN_HEADS, DN_DK)) * DN_DK ** -0.5
    dk = l2norm(dk.reshape(B, T, DN_HEADS, DN_DK))
    dv = dv.reshape(B, T, DN_HEADS, DN_DV)
    beta = jax.nn.sigmoid(beta_raw.astype(F32))
    g = -jnp.exp(a_log.astype(F32)) * jax.nn.softplus(alpha_raw.astype(F32) + dt_bias.astype(F32))
    o = gated_delta_rule(dq, dk, dv, g, beta)
    y_b = rmsnorm(o, o_norm_g) * jax.nn.silu(dn_gate.astype(F32).reshape(B, T, DN_HEADS, DN_DV))
    y = jnp.concatenate([y_a, y_b.reshape(B, T, DN_WIDTH).astype(h.dtype)], axis=-1)
    return y @ w_out


def hgrn2_mixer(h, w_in, lb, o_norm_g, w_out):
    B, T, _ = h.shape
    q_raw, f_raw, i_raw, g_raw = jnp.split(h @ w_in, 4, axis=-1)
    f_raw = f_raw.astype(F32)
    lb = lb.astype(F32)
    log_f = jnp.log(lb + (1.0 - lb) * jax.nn.sigmoid(f_raw))
    k = (1.0 - lb) * jax.nn.sigmoid(-f_raw)
    q = jax.nn.silu(q_raw.astype(F32)) * C_DK ** -0.5
    heads = lambda a, d: a.reshape(B, T, C_HEADS, d)
    o = gla_chunked(heads(q, C_DK), heads(k, C_DK), heads(i_raw.astype(F32), C_DV), heads(log_f, C_DK))
    o = rmsnorm(o, o_norm_g) * jax.nn.silu(heads(g_raw.astype(F32), C_DV))
    return o.reshape(B, T, C_WIDTH).astype(h.dtype) @ w_out


def mem_cross_attention(h, mem_n, w_q, w_kv, w_o):
    B, T, _ = h.shape
    M = mem_n.shape[1]
    q = (h @ w_q).reshape(B, T, X_HEADS, X_DIM)
    k, v = jnp.split(mem_n @ w_kv, 2, axis=-1)
    k = k.reshape(B, M, X_HEADS, X_DIM)
    v = v.reshape(B, M, X_HEADS, X_DIM)
    s = jnp.einsum('bthd,bmhd->bhtm', q, k).astype(F32) * X_DIM ** -0.5
    p = jax.nn.softmax(s, axis=-1).astype(v.dtype)
    o = jnp.einsum('bhtm,bmhd->bthd', p, v).reshape(B, T, X_WIDTH)
    return o @ w_o


def setup_inputs(seed: int = 0) -> dict:
    key = jax.random.key(seed)
    ks = jax.random.split(key, 20)

    def nrm(k, shape, fan_in, mult=1.0):
        return jax.random.normal(k, shape, F32) * (mult * fan_in ** -0.5)

    def gain(k, shape):
        return 1.0 + 0.02 * jax.random.normal(k, shape, F32)

    dt = jnp.exp(jax.random.uniform(ks[9], (N_EVEN, DN_HEADS), F32, float(np.log(1e-3)), float(np.log(1e-1))))
    return {
        'x': jax.random.normal(ks[0], (BATCH, SEQ, D_MODEL), F32),
        'mem': jax.random.normal(ks[1], (BATCH, MEM_TOKENS, D_MODEL), F32),
        'norm_g': gain(ks[2], (DEPTH, 4, D_MODEL)),
        'mem_norm_g': gain(ks[3], (D_MODEL,)),
        'final_norm_g': gain(ks[4], (D_MODEL,)),
        'ffn_w_in': nrm(ks[5], (DEPTH, 2, D_MODEL, 2 * D_FF), D_MODEL),
        'ffn_w_out': nrm(ks[6], (DEPTH, 2, D_FF, D_MODEL), D_FF, 0.5),
        'ab_w_in': nrm(ks[7], (N_EVEN, D_MODEL, AB_IN), D_MODEL),
        'ab_conv_w': nrm(ks[8], (N_EVEN, CONV_W, DN_CONV_CH), CONV_W),
        'ab_a_log': jnp.log(jax.random.uniform(ks[10], (N_EVEN, DN_HEADS), F32, 1.0, 16.0)),
        'ab_dt_bias': dt + jnp.log(-jnp.expm1(-dt)),
        'ab_o_norm_g': gain(ks[11], (N_EVEN, DN_DV)),
        'ab_w_out': nrm(ks[12], (N_EVEN, AB_WIDTH, D_MODEL), AB_WIDTH, 0.5),
        'c_w_in': nrm(ks[13], (N_ODD, D_MODEL, 4 * C_WIDTH), D_MODEL),
        'c_lb_logits': 0.1 * jax.random.normal(ks[14], (DEPTH, C_WIDTH), F32),
        'c_o_norm_g': gain(ks[15], (N_ODD, C_DV)),
        'c_w_out': nrm(ks[16], (N_ODD, C_WIDTH, D_MODEL), C_WIDTH, 0.5),
        'x_w_q': nrm(ks[17], (DEPTH, D_MODEL, X_WIDTH), D_MODEL),
        'x_w_kv': nrm(ks[18], (DEPTH, D_MODEL, 2 * X_WIDTH), D_MODEL),
        'x_w_o': nrm(ks[19], (DEPTH, X_WIDTH, D_MODEL), X_WIDTH, 0.5),
    }


def reference(x, mem, norm_g, mem_norm_g, final_norm_g, ffn_w_in, ffn_w_out, ab_w_in, ab_conv_w, ab_a_log, ab_dt_bias, ab_o_norm_g, ab_w_out, c_w_in, c_lb_logits, c_o_norm_g, c_w_out, x_w_q, x_w_kv, x_w_o):
    p_lb = jax.nn.softmax(c_lb_logits.astype(F32), axis=0)
    lb_all = jnp.cumsum(p_lb, axis=0) - p_lb[0]
    mem_n = rmsnorm(mem, mem_norm_g)
    for l in range(DEPTH):
        x = x + 0.5 * swiglu(rmsnorm(x, norm_g[l, 0]), ffn_w_in[l, 0], ffn_w_out[l, 0])
        h = rmsnorm(x, norm_g[l, 1])
        if l % 2 == 0:
            e = l // 2
            x = x + moba_deltanet_mixer(h, ab_w_in[e], ab_conv_w[e], ab_a_log[e], ab_dt_bias[e], ab_o_norm_g[e], ab_w_out[e])
        else:
            o = l // 2
            x = x + hgrn2_mixer(h, c_w_in[o], lb_all[l], c_o_norm_g[o], c_w_out[o])
        x = x + mem_cross_attention(rmsnorm(x, norm_g[l, 2]), mem_n, x_w_q[l], x_w_kv[l], x_w_o[l])
        x = x + 0.5 * swiglu(rmsnorm(x, norm_g[l, 3]), ffn_w_in[l, 1], ffn_w_out[l, 1])
    return rmsnorm(x, final_norm_g)
```

```cpp
#include <hip/hip_runtime.h>
#include <cstdio>
#include <cstdint>
namespace pg8 {
#define PG8_LAS __attribute__((address_space(3)))
typedef unsigned short bf16_t;
typedef short bf16x8 __attribute__((ext_vector_type(8)));
typedef float f32x4 __attribute__((ext_vector_type(4)));
typedef unsigned u32x4 __attribute__((ext_vector_type(4)));
constexpr int BM = 256, BK = 64, HALF = 128, HTB = HALF * BK * 2  , STAGE_BYTES = 8 * HTB, NXCD = 8, WGM = 8;

__host__ __device__ __forceinline__ int lds_byte(int r, int c) { const int st = (r >> 4) * 2 + (c >> 5), rr = r & 15, cc = c & 31, ob = rr * 64 + cc * 2; return st * 1024 + (ob ^ (((ob >> 9) & 1) << 5)); }
__host__ __device__ __forceinline__ void stage_rc(int b, int& R, int& C) { const int st = b / 1024, sb = b % 1024, swz = sb ^ (((sb >> 9) & 1) << 5); R = (st >> 1) * 16 + swz / 64; C = (st & 1) * 32 + (swz % 64) / 2; }
__host__ __device__ __forceinline__ int perm32(int rho) { const int n = rho >> 4, i = rho & 15; return 8 * (i >> 2) + 4 * n + (i & 3); }

struct Unit { int pm, pn; };
struct Gemm { const bf16_t* A; const bf16_t* Bt; int M, N, K; };

struct StaticOrder {
    int nM, nN, nwg, G, c;
    __host__ __device__ void init(int M, int N, int G_, int c_) { nM = M / BM; nN = N / BM; nwg = nM * nN; G = G_; c = c_; }
    __host__ __device__ bool next(int i, Unit& u) const {
        const long L = (long)i * G + c; if (L >= nwg) return false;
        int wgid = (int)L; { const int q = nwg / NXCD, r = nwg % NXCD, xcd = wgid % NXCD, off = wgid / NXCD; wgid = (xcd < r ? xcd * (q + 1) : r * (q + 1) + (xcd - r) * q) + off; }
        const int nig = WGM * nN, gid = wgid / nig, fm = gid * WGM, gsz = (nM - fm) < WGM ? (nM - fm) : WGM;
        u.pm = fm + ((wgid % nig) % gsz); u.pn = (wgid % nig) / gsz; return true;
    }
    __device__ __forceinline__ void a_ready(const Unit&) const {}
    __device__ __forceinline__ void done(const Unit&) const {}
};

__device__ __forceinline__ unsigned cvt_pk_bf16(float lo, float hi) { unsigned r; asm volatile("v_cvt_pk_bf16_f32 %0, %1, %2" : "=v"(r) : "v"(lo), "v"(hi)); return r; }
typedef float f32x2 __attribute__((ext_vector_type(2)));
typedef unsigned u32x2 __attribute__((ext_vector_type(2)));
__device__ __forceinline__ float fast_exp2(float x) { return __builtin_amdgcn_exp2f(x); }
__device__ __forceinline__ float fast_rcp(float x) { return __builtin_amdgcn_rcpf(x); }
__device__ __forceinline__ float silu_f(float a) { return a * fast_rcp(1.0f + fast_exp2(a * -1.44269504089f)); }
__device__ __forceinline__ u32x4 pack8(const f32x4& v0, const f32x4& v1) { u32x4 w; w.x = cvt_pk_bf16(v0[0], v0[1]); w.y = cvt_pk_bf16(v0[2], v0[3]); w.z = cvt_pk_bf16(v1[0], v1[1]); w.w = cvt_pk_bf16(v1[2], v1[3]); return w; }


struct EpiSwiGLU {
    static constexpr bool PERM = true, AFTER_DRAIN = false;
    bf16_t* O; int ldc; const PG8_LAS float* rtab;
    __device__ __forceinline__ void operator()(const f32x4 (&acc)[2][2][4][2], const Unit& u, int ui, int wr, int wc, int fr, int fq) const {
        const PG8_LAS float* rt = rtab + ui * 256;
#pragma unroll
        for (int ai = 0; ai < 2; ++ai)
#pragma unroll
            for (int m = 0; m < 4; ++m) {
                const int rl = ai * HALF + wr * 64 + m * 16 + fr; const float rs = rt[rl];
                bf16_t* rowp = O + (size_t)(u.pm * BM + rl) * ldc + u.pn * HALF + wc * 32 + 8 * fq;
                f32x4 h[2];
#pragma unroll
                for (int n = 0; n < 2; ++n)
#pragma unroll
                    for (int e = 0; e < 4; ++e) { const float a = acc[ai][0][m][n][e] * rs, b = acc[ai][1][m][n][e] * rs; h[n][e] = silu_f(a) * b; }
                *(u32x4*)rowp = pack8(h[0], h[1]);
            }
    }
};

struct EpiResidual {
    static constexpr bool PERM = true, AFTER_DRAIN = false;
    const float* xin; float* xout; bf16_t* xb; float* rowss; float scale; int ldx;
    __device__ __forceinline__ void operator()(const f32x4 (&acc)[2][2][4][2], const Unit& u, int ui, int wr, int wc, int fr, int fq) const {
#pragma unroll
        for (int ai = 0; ai < 2; ++ai)
#pragma unroll
            for (int m = 0; m < 4; ++m) {
                const int row = u.pm * BM + ai * HALF + wr * 64 + m * 16 + fr; float ss = 0.f;
#pragma unroll
                for (int bj = 0; bj < 2; ++bj) {
                    const size_t off = (size_t)row * ldx + u.pn * BM + bj * HALF + wc * 32 + 8 * fq;
                    const f32x4 o0 = *(const f32x4*)(xin + off) + acc[ai][bj][m][0] * scale, o1 = *(const f32x4*)(xin + off + 4) + acc[ai][bj][m][1] * scale;
                    *(f32x4*)(xout + off) = o0; *(f32x4*)(xout + off + 4) = o1;
                    *(u32x4*)(xb + off) = pack8(o0, o1);
                    ss += (o0[0] * o0[0] + o0[1] * o0[1]) + (o0[2] * o0[2] + o0[3] * o0[3]) + (o1[0] * o1[0] + o1[1] * o1[1]) + (o1[2] * o1[2] + o1[3] * o1[3]);
                }
                ss += __shfl_xor(ss, 16); ss += __shfl_xor(ss, 32);
                if (fq == 0) rowss[(size_t)row * 32 + u.pn * 4 + wc] = ss;
            }
    }
};

struct EpiBf16Route {
    static constexpr bool PERM = true, AFTER_DRAIN = false;
    bf16_t* O; int ldc; const PG8_LAS float* rtab; float scale;
    __device__ __forceinline__ void operator()(const f32x4 (&acc)[2][2][4][2], const Unit& u, int ui, int wr, int wc, int fr, int fq) const {
#pragma unroll
        for (int ai = 0; ai < 2; ++ai)
#pragma unroll
            for (int m = 0; m < 4; ++m) {
                const int rl = ai * HALF + wr * 64 + m * 16 + fr; const float rs = (rtab ? rtab[ui * 256 + rl] : 1.0f) * scale;
                bf16_t* rowp = O + (size_t)(u.pm * BM + rl) * ldc + u.pn * BM + wc * 32 + 8 * fq;
#pragma unroll
                for (int bj = 0; bj < 2; ++bj) *(u32x4*)(rowp + bj * HALF) = pack8(acc[ai][bj][m][0] * rs, acc[ai][bj][m][1] * rs);
            }
    }
};

struct EpiABin {
    static constexpr bool PERM = true, AFTER_DRAIN = false;
    bf16_t *Qm, *Km, *Vm, *DNpre, *DNgate; float* ba; float* kms; const PG8_LAS float* rtab; float qscale;
    __device__ __forceinline__ void operator()(const f32x4 (&acc)[2][2][4][2], const Unit& u, int ui, int wr, int wc, int fr, int fq) const {
        const int pn = u.pn; const PG8_LAS float* rt = rtab + ui * 256;
        if (pn < 28) {
            bf16_t* base; int ld = 1024, ct; float sc = 1.0f;
            if (pn < 4) { base = Qm; ct = pn; sc = qscale; } else if (pn < 8) { base = Km; ct = pn - 4; } else if (pn < 12) { base = Vm; ct = pn - 8; }
            else if (pn < 24) { base = DNpre; ld = 3072; ct = pn - 12; } else { base = DNgate; ct = pn - 24; }
            f32x4 cs[2][2];
#pragma unroll
            for (int bj = 0; bj < 2; ++bj)
#pragma unroll
                for (int n = 0; n < 2; ++n) cs[bj][n] = (f32x4){0.f, 0.f, 0.f, 0.f};
#pragma unroll
            for (int ai = 0; ai < 2; ++ai)
#pragma unroll
                for (int m = 0; m < 4; ++m) {
                    const int rl = ai * HALF + wr * 64 + m * 16 + fr; const float rs = rt[rl] * sc;
                    bf16_t* rowp = base + (size_t)(u.pm * BM + rl) * ld + ct * BM + wc * 32 + 8 * fq;
#pragma unroll
                    for (int bj = 0; bj < 2; ++bj) { const f32x4 v0 = acc[ai][bj][m][0] * rs, v1 = acc[ai][bj][m][1] * rs; *(u32x4*)(rowp + bj * HALF) = pack8(v0, v1); cs[bj][0] += v0; cs[bj][1] += v1; }
                }
            if (pn >= 4 && pn < 8) {
#pragma unroll
                for (int bj = 0; bj < 2; ++bj)
#pragma unroll
                    for (int n = 0; n < 2; ++n) {
                        f32x4 s = cs[bj][n];
#pragma unroll
                        for (int o = 1; o < 16; o <<= 1) { s[0] += __shfl_xor(s[0], o); s[1] += __shfl_xor(s[1], o); s[2] += __shfl_xor(s[2], o); s[3] += __shfl_xor(s[3], o); }
                        if (fr == 0) *(f32x4*)(kms + (size_t)(u.pm * 2 + wr) * 1024 + (pn - 4) * BM + bj * HALF + wc * 32 + 8 * fq + 4 * n) = s;
                    }
            }
        } else {
            if (wc == 0 && fq < 2) {
#pragma unroll
                for (int ai = 0; ai < 2; ++ai)
#pragma unroll
                    for (int m = 0; m < 4; ++m) {
                        const int rl = ai * HALF + wr * 64 + m * 16 + fr; const float rs = rt[rl];
                        float* p = ba + (size_t)(u.pm * BM + rl) * 16 + 8 * fq;
                        *(f32x4*)p = acc[ai][0][m][0] * rs; *(f32x4*)(p + 4) = acc[ai][0][m][1] * rs;
                    }
            }
        }
    }
};

struct EpiCin {
    static constexpr bool PERM = true, AFTER_DRAIN = false;
    bf16_t *Cq, *Ck, *Cv, *Cg; float* Clf; const float* lb; const PG8_LAS float* rtab;
    __device__ __forceinline__ void operator()(const f32x4 (&acc)[2][2][4][2], const Unit& u, int ui, int wr, int wc, int fr, int fq) const {
        const int pn = u.pn, sec = pn >> 3, ct = pn & 7; const PG8_LAS float* rt = rtab + ui * 256;
        bf16_t* base = sec == 0 ? Cq : (sec == 1 ? Ck : (sec == 2 ? Cv : Cg));
        const int cl = ct * BM + wc * 32 + 8 * fq;
        f32x4 lbv[2][2];
        if (sec == 1) {
#pragma unroll
            for (int bj = 0; bj < 2; ++bj) { lbv[bj][0] = *(const f32x4*)(lb + cl + bj * HALF); lbv[bj][1] = *(const f32x4*)(lb + cl + bj * HALF + 4); }
        }
#pragma unroll
        for (int ai = 0; ai < 2; ++ai)
#pragma unroll
            for (int m = 0; m < 4; ++m) {
                const int rl = ai * HALF + wr * 64 + m * 16 + fr; const float rs = rt[rl];
                const size_t off = (size_t)(u.pm * BM + rl) * 2048 + cl;
#pragma unroll
                for (int bj = 0; bj < 2; ++bj) {
                    f32x4 v[2] = {acc[ai][bj][m][0] * rs, acc[ai][bj][m][1] * rs};
                    if (sec == 0) {
#pragma unroll
                        for (int n = 0; n < 2; ++n)
#pragma unroll
                            for (int e = 0; e < 4; ++e) v[n][e] = silu_f(v[n][e]) * 0.08838834764831845f;
                    } else if (sec == 1) {
                        f32x4 lf[2];
#pragma unroll
                        for (int n = 0; n < 2; ++n)
#pragma unroll
                            for (int e = 0; e < 4; ++e) {
                                const float ex = fast_exp2(v[n][e] * -1.44269504089f), r = fast_rcp(1.0f + ex), l = lbv[bj][n][e];
                                lf[n][e] = __logf(l + (1.0f - l) * r); v[n][e] = (1.0f - l) * ex * r;
                            }
                        *(f32x4*)(Clf + off + bj * HALF) = lf[0]; *(f32x4*)(Clf + off + bj * HALF + 4) = lf[1];
                    }
                    *(u32x4*)(base + off + bj * HALF) = pack8(v[0], v[1]);
                }
            }
    }
};
template <class Epi, class Sched, bool ALIGN_EPI = false, bool SP2 = false>
__device__ __forceinline__ void gemm_phase(PG8_LAS unsigned char* lds, const Gemm g, const Sched& S, const Epi& E) {
    int tid_ = threadIdx.x; asm volatile("" : "+v"(tid_));
    const int tid = tid_, wid = __builtin_amdgcn_readfirstlane(tid >> 6), lane = tid & 63, wr = wid >> 2, wc = wid & 3, fr = lane & 15, fq = lane >> 4;
    const int K = g.K, nt = K / BK;
    unsigned voffA[2], voffB[2];
#pragma unroll
    for (int i = 0; i < 2; ++i) { int R, C; stage_rc(tid * 16 + i * 8192, R, C); const int Rb = Epi::PERM ? ((R & ~31) + perm32(R & 31)) : R;
        voffA[i] = (unsigned)(R * K + C) * 2u; voffB[i] = (unsigned)(Rb * K + C) * 2u; }
    const size_t kstep = (size_t)(BK * 2);
    const size_t hstep = (size_t)HALF * K * 2;
    const size_t tstep = 2 * hstep;
    const unsigned ldsw = (unsigned)wid * 1024u;
    const int aoff = lds_byte(wr * 64 + fr, fq * 8), boff = lds_byte(wc * 32 + fr, fq * 8);
#define PG8_SA(b, h) (((b) * 2 + (h)) * HTB)
#define PG8_SB(b, h) ((4 + (b) * 2 + (h)) * HTB)
#define PG8_STAGE(bufoff, gbase, voff) do { _Pragma("unroll") for (int _i = 0; _i < 2; ++_i) \
        __builtin_amdgcn_global_load_lds((const unsigned*)((const char*)(gbase) + (voff)[_i]), (PG8_LAS unsigned*)(lds + (bufoff) + ldsw + _i * 8192), 16, 0, 0); } while (0)
#define PG8_LDA(dst, b, h) do { _Pragma("unroll") for (int m = 0; m < 4; ++m) _Pragma("unroll") for (int k = 0; k < 2; ++k) dst[m][k] = *(const PG8_LAS bf16x8*)(lds + PG8_SA(b, h) + aoff + m * 2048 + k * 1024); } while (0)
#define PG8_LDB(dst, b, h) do { _Pragma("unroll") for (int n = 0; n < 2; ++n) _Pragma("unroll") for (int k = 0; k < 2; ++k) dst[n][k] = *(const PG8_LAS bf16x8*)(lds + PG8_SB(b, h) + boff + n * 2048 + k * 1024); } while (0)
#define PG8_MMA(ai, bj, At, Bt) do { __builtin_amdgcn_s_setprio(1); _Pragma("unroll") for (int m = 0; m < 4; ++m) _Pragma("unroll") for (int n = 0; n < 2; ++n) _Pragma("unroll") for (int k = 0; k < 2; ++k) \
        acc[ai][bj][m][n] = __builtin_amdgcn_mfma_f32_16x16x32_bf16(Bt[n][k], At[m][k], acc[ai][bj][m][n], 0, 0, 0); __builtin_amdgcn_s_setprio(0); } while (0)
#define PG8_WAIT_V(n) asm volatile("s_waitcnt vmcnt(" #n ")" ::: "memory")
#define PG8_WAIT_L(n) asm volatile("s_waitcnt lgkmcnt(" #n ")" ::: "memory")
#define PG8_BAR __builtin_amdgcn_s_barrier()
#define PG8_SCHED __builtin_amdgcn_sched_barrier(0)
    Unit cur, nxt; int ui = 0;
    if (!S.next(0, cur)) return;
    f32x4 acc[2][2][4][2];
#pragma unroll
    for (int a = 0; a < 2; ++a)
#pragma unroll
        for (int b = 0; b < 2; ++b)
#pragma unroll
            for (int m = 0; m < 4; ++m)
#pragma unroll
                for (int n = 0; n < 2; ++n) acc[a][b][m][n] = (f32x4){0.f, 0.f, 0.f, 0.f};
    bf16x8 At[4][2], B0[2][2], B1[2][2];
    const char* cA = (const char*)g.A + (size_t)cur.pm * tstep; const char* cB = (const char*)g.Bt + (size_t)cur.pn * tstep;
    S.a_ready(cur);
    if constexpr (SP2) {
        PG8_STAGE(PG8_SB(0, 0), cB, voffB); PG8_STAGE(PG8_SB(0, 1), cB + hstep, voffB); PG8_STAGE(PG8_SA(0, 0), cA, voffA); PG8_STAGE(PG8_SA(0, 1), cA + hstep, voffA);
        if (wr == 1) PG8_BAR;
        PG8_WAIT_V(2); PG8_BAR;
        PG8_STAGE(PG8_SB(1, 0), cB + kstep, voffB); PG8_STAGE(PG8_SA(1, 0), cA + kstep, voffA); PG8_STAGE(PG8_SB(1, 1), cB + hstep + kstep, voffB);
        PG8_WAIT_V(6); PG8_BAR;
    } else {
        PG8_STAGE(PG8_SB(0, 0), cB, voffB); PG8_STAGE(PG8_SA(0, 0), cA, voffA); PG8_STAGE(PG8_SB(0, 1), cB + hstep, voffB); PG8_STAGE(PG8_SA(0, 1), cA + hstep, voffA);
        if (wr == 1) PG8_BAR;
        PG8_WAIT_V(4); PG8_BAR;
        PG8_STAGE(PG8_SB(1, 0), cB + kstep, voffB); PG8_STAGE(PG8_SA(1, 0), cA + kstep, voffA); PG8_STAGE(PG8_SB(1, 1), cB + hstep + kstep, voffB);
        PG8_WAIT_V(6); PG8_BAR;
    }
    for (;;) {
        const bool has_next = S.next(ui + 1, nxt);
        const char* nA = has_next ? (const char*)g.A + (size_t)nxt.pm * tstep : cA; const char* nB = has_next ? (const char*)g.Bt + (size_t)nxt.pn * tstep : cB;
        for (int t = 0; t < nt; t += 2) {
            const bool last = (t == nt - 2);
            const char* a1 = cA + (size_t)(t + 1) * kstep;
            const char* a2 = last ? nA : cA + (size_t)(t + 2) * kstep; const char* b2 = last ? nB : cB + (size_t)(t + 2) * kstep;
            const char* a3 = a2 + kstep; const char* b3 = b2 + kstep;
            if (last && has_next) S.a_ready(nxt);
            if constexpr (SP2) {
            PG8_LDB(B0, 0, 0); PG8_LDB(B1, 0, 1); PG8_SCHED; PG8_LDA(At, 0, 0); PG8_STAGE(PG8_SA(1, 1), a1 + hstep, voffA);
            PG8_WAIT_V(8); PG8_WAIT_L(0); PG8_BAR; PG8_MMA(0, 0, At, B0); PG8_MMA(0, 1, At, B1); PG8_BAR; PG8_SCHED;
            PG8_LDA(At, 0, 1); PG8_STAGE(PG8_SB(0, 0), b2, voffB); PG8_STAGE(PG8_SB(0, 1), b2 + hstep, voffB); PG8_STAGE(PG8_SA(0, 0), a2, voffA);
            PG8_WAIT_V(8); PG8_WAIT_L(0); PG8_BAR; PG8_MMA(1, 0, At, B0); PG8_MMA(1, 1, At, B1); PG8_BAR; PG8_SCHED;
            PG8_LDB(B0, 1, 0); PG8_LDB(B1, 1, 1); PG8_SCHED; PG8_LDA(At, 1, 0); PG8_STAGE(PG8_SA(0, 1), a2 + hstep, voffA);
            PG8_WAIT_V(8); PG8_WAIT_L(0); PG8_BAR; PG8_MMA(0, 0, At, B0); PG8_MMA(0, 1, At, B1); PG8_BAR; PG8_SCHED;
            PG8_LDA(At, 1, 1); PG8_STAGE(PG8_SB(1, 0), b3, voffB); PG8_STAGE(PG8_SB(1, 1), b3 + hstep, voffB); PG8_STAGE(PG8_SA(1, 0), a3, voffA);
            PG8_WAIT_V(8); PG8_WAIT_L(0); PG8_BAR; PG8_MMA(1, 0, At, B0); PG8_MMA(1, 1, At, B1); PG8_BAR; PG8_SCHED;
            } else {
            PG8_LDB(B0, 0, 0); PG8_SCHED; PG8_LDA(At, 0, 0); PG8_STAGE(PG8_SA(1, 1), a1 + hstep, voffA);
            PG8_WAIT_L(8); PG8_BAR; PG8_WAIT_L(0); PG8_MMA(0, 0, At, B0); PG8_BAR; PG8_SCHED;
            PG8_LDB(B1, 0, 1); PG8_STAGE(PG8_SB(0, 0), b2, voffB);
            PG8_BAR; PG8_WAIT_L(0); PG8_MMA(0, 1, At, B1); PG8_BAR;
            PG8_LDA(At, 0, 1); PG8_STAGE(PG8_SA(0, 0), a2, voffA);
            PG8_BAR; PG8_WAIT_L(0); PG8_MMA(1, 0, At, B0); PG8_BAR; PG8_SCHED;
            PG8_STAGE(PG8_SB(0, 1), b2 + hstep, voffB);
            PG8_WAIT_V(6); PG8_BAR; PG8_MMA(1, 1, At, B1); PG8_BAR;
            PG8_LDB(B0, 1, 0); PG8_SCHED; PG8_LDA(At, 1, 0); PG8_STAGE(PG8_SA(0, 1), a2 + hstep, voffA);
            PG8_WAIT_L(8); PG8_BAR; PG8_WAIT_L(0); PG8_MMA(0, 0, At, B0); PG8_BAR; PG8_SCHED;
            PG8_LDB(B1, 1, 1); PG8_STAGE(PG8_SB(1, 0), b3, voffB);
            PG8_BAR; PG8_WAIT_L(0); PG8_MMA(0, 1, At, B1); PG8_BAR;
            PG8_LDA(At, 1, 1); PG8_STAGE(PG8_SA(1, 0), a3, voffA);
            PG8_BAR; PG8_WAIT_L(0); PG8_MMA(1, 0, At, B0); PG8_BAR; PG8_SCHED;
            PG8_STAGE(PG8_SB(1, 1), b3 + hstep, voffB);
            PG8_WAIT_V(6); PG8_BAR; PG8_MMA(1, 1, At, B1); PG8_BAR;
            }
        }
        if constexpr (ALIGN_EPI) { if (wr == 0) PG8_BAR; }
        if constexpr (!Epi::AFTER_DRAIN) { E(acc, cur, ui, wr, wc, fr, fq); S.done(cur); }
        if (!has_next) break;
#pragma unroll
        for (int a = 0; a < 2; ++a)
#pragma unroll
            for (int b = 0; b < 2; ++b)
#pragma unroll
                for (int m = 0; m < 4; ++m)
#pragma unroll
                    for (int n = 0; n < 2; ++n) acc[a][b][m][n] = (f32x4){0.f, 0.f, 0.f, 0.f};
        cur = nxt; cA = nA; cB = nB; ++ui;
        if constexpr (ALIGN_EPI) { if (wr == 1) PG8_BAR; }
    }
    PG8_WAIT_V(0);
    if constexpr (!ALIGN_EPI) { if (wr == 0) PG8_BAR; }
    PG8_BAR;
    if constexpr (Epi::AFTER_DRAIN) { E.fused(acc, cur, wr, wc, fr, fq, lds, wid, lane); S.done(cur); }
#undef PG8_SA
#undef PG8_SB
#undef PG8_STAGE
#undef PG8_LDA
#undef PG8_LDB
#undef PG8_MMA
#undef PG8_WAIT_V
#undef PG8_WAIT_L
#undef PG8_BAR
#undef PG8_SCHED
}
}

constexpr int BATCH = 2, SEQ = 4096, D = 2048, DEPTH = 4, M = BATCH * SEQ;
constexpr int DFF = 5504, NFF = 2 * DFF;
constexpr int AB_IN = 7184, AB_PAD = 7424;
constexpr int HD = 128, NH_AB = 8, NH_C = 16, MEMT = 256, XW = 512, NBLK = SEQ / 256;
constexpr float EPS = 1e-6f;
constexpr float QK_SCALE_LOG2E = 0.08838834764831845f * 1.4426950408889634f;
constexpr int NWAVES = 8;

constexpr size_t MiB = 1u << 20;
constexpr size_t WS_CTL = 0, CTL_ZERO_BYTES = 1 * MiB;
constexpr size_t WS_X = 1 * MiB, WS_XB = 65 * MiB, WS_ROWSS = 97 * MiB, WS_ACT = 98 * MiB;
constexpr size_t WS_W1T = 184 * MiB, WS_W2T = 528 * MiB, WS_WABT = 700 * MiB, WS_WABOT = 758 * MiB, WS_WCT = 774 * MiB, WS_WCOT = 838 * MiB, WS_WXQT = 854 * MiB, WS_WXKVT = 862 * MiB, WS_WXOT = 878 * MiB;
constexpr size_t WS_MIX = 886 * MiB;
constexpr size_t WS_QM = WS_MIX, WS_KM = WS_MIX + 16 * MiB, WS_VM = WS_MIX + 32 * MiB, WS_DNPRE = WS_MIX + 48 * MiB, WS_DNGATE = WS_MIX + 96 * MiB, WS_BA = WS_MIX + 112 * MiB, WS_KMS = WS_MIX + 113 * MiB,
                 WS_DQ = WS_MIX + 114 * MiB, WS_DK = WS_MIX + 146 * MiB, WS_DV = WS_MIX + 178 * MiB, WS_BG = WS_MIX + 210 * MiB, WS_DNO = WS_MIX + 211 * MiB;
constexpr size_t WS_CQ = WS_MIX, WS_CK = WS_MIX + 32 * MiB, WS_CV = WS_MIX + 64 * MiB, WS_CG = WS_MIX + 96 * MiB, WS_CLF = WS_MIX + 128 * MiB, WS_CO = WS_MIX + 192 * MiB;
constexpr size_t WS_Y = WS_MIX + 256 * MiB, WS_XQ = WS_Y + 32 * MiB, WS_XO = WS_XQ + 8 * MiB, WS_MEMN = WS_XO + 8 * MiB, WS_KV = WS_MEMN + 2 * MiB, WS_LB = WS_KV + 4 * MiB, WS_END = WS_LB + 1 * MiB;
static_assert(WS_W1T + (size_t)8 * NFF * D * 2 <= WS_W2T && WS_W2T + (size_t)8 * D * DFF * 2 <= WS_WABT && WS_WABT + (size_t)2 * AB_PAD * D * 2 <= WS_WABOT && WS_ACT + (size_t)M * DFF * 2 <= WS_W1T, "ws map");
constexpr int CW_TMO = 0, CW_CODE = 1, CW_BAR = 4096;

constexpr int RING_OFF = 0, RING_BYTES = 131072;
constexpr int RTAB_OFF = RING_BYTES, RTAB_BYTES = 8 * 1024;
constexpr int LDSCTL_OFF = RTAB_OFF + RTAB_BYTES, MISC_OFF = LDSCTL_OFF + 320;
constexpr int LDS_BYTES = 147456;
static_assert(MISC_OFF + 128 <= LDS_BYTES, "LDS map");
#define GAS __attribute__((address_space(1)))
#define LAS __attribute__((address_space(3)))
typedef unsigned short bf16;
typedef unsigned v4u __attribute__((ext_vector_type(4)));
typedef float f32x4 __attribute__((ext_vector_type(4)));
typedef short bf16x8 __attribute__((ext_vector_type(8)));
typedef GAS unsigned gu32;
typedef GAS unsigned long long gu64;
#define RLX_AGENT __ATOMIC_RELAXED, __HIP_MEMORY_SCOPE_AGENT
#define LDS_WAIT() asm volatile("s_waitcnt lgkmcnt(0)" ::: "memory")
#define VM_WAIT() asm volatile("s_waitcnt vmcnt(0)" ::: "memory")
__device__ __forceinline__ unsigned long long rt() { return __builtin_amdgcn_s_memrealtime(); }
__device__ __forceinline__ unsigned f2bf(float f) { unsigned u = __builtin_bit_cast(unsigned, f); return (u + 0x7fffu + ((u >> 16) & 1u)) >> 16; }
__device__ __forceinline__ unsigned pk2(float lo, float hi) { return f2bf(lo) | (f2bf(hi) << 16); }
#define XB_TMO      128
#define XB_XCNT(j)  (256  + 64 * (j))
#define XB_XSUB(j)  (1280 + 64 * (j))
#define XB_XGEN(j)  (2304 + 64 * (j))
#define XB_TOP      3328
#define XB_TOPGEN   3392
#define XCD_BAR_WORDS 3456
#define XB_SPIN_CAP (1u << 18)

__device__ __forceinline__ unsigned xb_ld(unsigned* p)              { return __hip_atomic_load(p, __ATOMIC_RELAXED, __HIP_MEMORY_SCOPE_AGENT); }
__device__ __forceinline__ unsigned xb_add(unsigned* p, unsigned v) { return __hip_atomic_fetch_add(p, v, __ATOMIC_RELAXED, __HIP_MEMORY_SCOPE_AGENT); }
__device__ __forceinline__ unsigned xb_xcc_id() { return (unsigned)__builtin_amdgcn_s_getreg((3 << 11) | 20) & 0xFu; }
#define XB_SPIN(cond, bar) do { unsigned _sp = 0; while (cond) { __builtin_amdgcn_s_sleep(1); \
    if ((++_sp & 255u) == 0u) { if (xb_ld(&(bar)[XB_TMO])) break; if (_sp > XB_SPIN_CAP) { atomicAdd(&(bar)[XB_TMO], 1u); break; } } } } while (0)

struct XcdBarrier {
    unsigned* bar; unsigned x;
    volatile LAS unsigned* st;
};

__device__ __forceinline__ XcdBarrier xcd_barrier_post(unsigned* bar, volatile LAS unsigned* st) {
    XcdBarrier b; b.bar = bar; b.x = xb_xcc_id(); b.st = st;
    if (threadIdx.x == 0) (void)xb_add(&bar[XB_XCNT(b.x)], 1u);
    return b;
}
__device__ __forceinline__ void xcd_barrier_complete(unsigned* bar, unsigned x, unsigned& nloc, unsigned& nx) {
    const unsigned G = gridDim.x * gridDim.y * gridDim.z;
    unsigned sum, cnt, mine, sp = 0u;
    for (;;) {
        sum = 0u; cnt = 0u; mine = 0u;
#pragma unroll
        for (unsigned j = 0; j < 16; ++j) { const unsigned c = xb_ld(&bar[XB_XCNT(j)]); sum += c; cnt += (c > 0u) ? 1u : 0u; mine = (j == x) ? c : mine; }
        if (sum == G) break;
        __builtin_amdgcn_s_sleep(1);
        if ((++sp & 255u) == 0u) { if (xb_ld(&bar[XB_TMO])) break; if (sp > XB_SPIN_CAP) { atomicAdd(&bar[XB_TMO], 1u); break; } }
    }
    nloc = mine > 0u ? mine : 1u; nx = cnt > 0u ? cnt : 1u;
}

__device__ __forceinline__ void xcd_barrier(const XcdBarrier& b) {
    asm volatile("s_waitcnt vmcnt(0)" ::: "memory");
    __syncthreads();
    if (threadIdx.x == 0) {
        unsigned* bar = b.bar;
        __builtin_amdgcn_s_waitcnt(0);
        unsigned nloc = b.st[0], nx = b.st[1];
        if (nloc == 0u) { xcd_barrier_complete(bar, b.x, nloc, nx); b.st[0] = nloc; b.st[1] = nx; }
        const unsigned old = xb_add(&bar[XB_XSUB(b.x)], 1u);
        const unsigned gen = old / nloc;
        if (old + 1u == (gen + 1u) * nloc) {
            __builtin_amdgcn_fence(__ATOMIC_RELEASE, "agent");
            asm volatile("s_waitcnt vmcnt(0)" ::: "memory");
            const unsigned og = xb_add(&bar[XB_TOP], 1u);
            const unsigned tg = og / nx;
            if (og + 1u == (tg + 1u) * nx) xb_add(&bar[XB_TOPGEN], 1u);
            else XB_SPIN(xb_ld(&bar[XB_TOPGEN]) == tg, bar);
            __builtin_amdgcn_fence(__ATOMIC_ACQUIRE, "agent");
            xb_add(&bar[XB_XGEN(b.x)], 1u);
            asm volatile("s_waitcnt vmcnt(0)" ::: "memory");
        } else {
            XB_SPIN(xb_ld(&bar[XB_XGEN(b.x)]) == gen, bar);
            __builtin_amdgcn_fence(__ATOMIC_ACQUIRE, "agent");
            asm volatile("s_waitcnt vmcnt(0)" ::: "memory");
        }
    }
    __syncthreads();
}

struct Frame {
    LAS unsigned char* lds;
    volatile LAS unsigned* MISC;
    gu32* ctl;
    int tid, lane, wave, G;
    const float* in[20];
    float* out; unsigned char* ws;
};
enum { I_X = 0, I_MEM, I_NORMG, I_MEMG, I_FINALG, I_FFN_WIN, I_FFN_WOUT, I_AB_WIN, I_AB_CONVW, I_AB_ALOG, I_AB_DTB, I_AB_ONG, I_AB_WOUT, I_C_WIN, I_C_LBL, I_C_ONG, I_C_WOUT, I_X_WQ, I_X_WKV, I_X_WO };

__device__ __forceinline__ int opaque_i(int v) { asm volatile("" : "+v"(v)); return v; }
#define PHASE_IDS() const int tid = opaque_i(F.tid), lane = tid & 63, wave = __builtin_amdgcn_readfirstlane(tid >> 6); (void)lane; (void)wave
__device__ __forceinline__ float wave_sum(float v) {
#pragma unroll
    for (int o = 1; o < 64; o <<= 1) v += __shfl_xor(v, o);
    return v;
}
__device__ __forceinline__ float wave_max(float v) {
#pragma unroll
    for (int o = 1; o < 64; o <<= 1) v = fmaxf(v, __shfl_xor(v, o));
    return v;
}
__device__ __forceinline__ float bflo(unsigned w) { return __uint_as_float(w << 16); }
__device__ __forceinline__ float bfhi(unsigned w) { return __uint_as_float(w & 0xffff0000u); }
__device__ __forceinline__ float sigmoid_f(float a) { return 1.0f / (1.0f + __expf(-a)); }
__device__ __forceinline__ float silu_acc(float a) { return a / (1.0f + __expf(-a)); }

__device__ __forceinline__ void conv_tile(const float* src, bf16* dst, int K, int N, int mode, const float* gain, int kb, int nb, int wave, int lane) {
    const int k0 = kb * 128 + wave * 16, n = nb * 256 + lane * 4;
    if (n >= N) return;
    f32x4 v[16];
#pragma unroll
    for (int r = 0; r < 16; ++r) v[r] = *(const GAS f32x4*)(src + (size_t)(k0 + r) * N + n);
    if (gain) {
#pragma unroll
        for (int r = 0; r < 16; ++r) v[r] = v[r] * gain[k0 + r];
    }
#pragma unroll
    for (int e = 0; e < 4; ++e) {
        const int col = n + e; int drow = col;
        if (mode == 1) { const int half = col >= DFF ? 1 : 0, j = col - half * DFF; drow = (j >> 7) * 256 + half * 128 + (j & 127); }
        v4u w0, w1;
        w0.x = pg8::cvt_pk_bf16(v[0][e], v[1][e]); w0.y = pg8::cvt_pk_bf16(v[2][e], v[3][e]); w0.z = pg8::cvt_pk_bf16(v[4][e], v[5][e]); w0.w = pg8::cvt_pk_bf16(v[6][e], v[7][e]);
        w1.x = pg8::cvt_pk_bf16(v[8][e], v[9][e]); w1.y = pg8::cvt_pk_bf16(v[10][e], v[11][e]); w1.z = pg8::cvt_pk_bf16(v[12][e], v[13][e]); w1.w = pg8::cvt_pk_bf16(v[14][e], v[15][e]);
        GAS v4u* o = (GAS v4u*)(dst + (size_t)drow * K + k0);
        o[0] = w0; o[1] = w1;
    }
}
constexpr int IT_W1 = 8 * 16 * 43, IT_W2 = 8 * 43 * 8, IT_AB = 2 * 16 * 29, IT_ABO = 2 * 16 * 8, IT_C = 2 * 16 * 32, IT_CO = 2 * 16 * 8, IT_XQ = 4 * 16 * 2, IT_XKV = 4 * 16 * 4, IT_XO = 4 * 4 * 8;
constexpr int IT_TOTAL = IT_W1 + IT_W2 + IT_AB + IT_ABO + IT_C + IT_CO + IT_XQ + IT_XKV + IT_XO;

__device__ __forceinline__ void p0_prologue(Frame& F) {
    PHASE_IDS();
    const float* normg = F.in[I_NORMG];
    for (int it = blockIdx.x; it < IT_TOTAL; it += F.G) {
        int r = it; const float* src; bf16* dst; int K, N, Npad, mode = 0, gsel = 0;
        if (r < IT_W1) { src = F.in[I_FFN_WIN]; dst = (bf16*)(F.ws + WS_W1T); K = D; N = NFF; Npad = NFF; mode = 1; gsel = 1; }
        else if ((r -= IT_W1) < IT_W2) { src = F.in[I_FFN_WOUT]; dst = (bf16*)(F.ws + WS_W2T); K = DFF; N = D; Npad = D; }
        else if ((r -= IT_W2) < IT_AB) { src = F.in[I_AB_WIN]; dst = (bf16*)(F.ws + WS_WABT); K = D; N = AB_IN; Npad = AB_PAD; gsel = 2; }
        else if ((r -= IT_AB) < IT_ABO) { src = F.in[I_AB_WOUT]; dst = (bf16*)(F.ws + WS_WABOT); K = D; N = D; Npad = D; }
        else if ((r -= IT_ABO) < IT_C) { src = F.in[I_C_WIN]; dst = (bf16*)(F.ws + WS_WCT); K = D; N = 4 * D; Npad = 4 * D; gsel = 3; }
        else if ((r -= IT_C) < IT_CO) { src = F.in[I_C_WOUT]; dst = (bf16*)(F.ws + WS_WCOT); K = D; N = D; Npad = D; }
        else if ((r -= IT_CO) < IT_XQ) { src = F.in[I_X_WQ]; dst = (bf16*)(F.ws + WS_WXQT); K = D; N = XW; Npad = XW; gsel = 4; }
        else if ((r -= IT_XQ) < IT_XKV) { src = F.in[I_X_WKV]; dst = (bf16*)(F.ws + WS_WXKVT); K = D; N = 2 * XW; Npad = 2 * XW; }
        else { r -= IT_XKV; src = F.in[I_X_WO]; dst = (bf16*)(F.ws + WS_WXOT); K = XW; N = D; Npad = D; }
        const int kbs = K / 128, nbs = (N + 255) / 256, per = kbs * nbs, mat = r / per; r -= mat * per;
        const int kb = r / nbs, nb = r - kb * nbs;
        const float* gain = nullptr;
        if (gsel == 1) gain = normg + (size_t)((mat >> 1) * 4 + ((mat & 1) ? 3 : 0)) * D;
        else if (gsel == 2) gain = normg + (size_t)((2 * mat) * 4 + 1) * D;
        else if (gsel == 3) gain = normg + (size_t)((2 * mat + 1) * 4 + 1) * D;
        else if (gsel == 4) gain = normg + (size_t)(mat * 4 + 2) * D;
        conv_tile(src + (size_t)mat * K * N, dst + (size_t)mat * Npad * K, K, N, mode, gain, kb, nb, wave, lane);
    }
    {
        constexpr int PADV = (AB_PAD - AB_IN) * D * 2 / 16;
        for (int i = blockIdx.x * 512 + tid; i < 2 * PADV; i += F.G * 512) { const int mat = i / PADV, j = i - mat * PADV;
            ((GAS v4u*)(F.ws + WS_WABT + ((size_t)mat * AB_PAD + AB_IN) * D * 2))[j] = (v4u){0u, 0u, 0u, 0u}; }
    }
    const int gw = blockIdx.x * NWAVES + wave, NGW = F.G * NWAVES;
    {
        const float* x = F.in[I_X]; bf16* xb = (bf16*)(F.ws + WS_XB); float* rowss = (float*)(F.ws + WS_ROWSS);
        for (int m = gw; m < M; m += NGW) {
            const GAS f32x4* xr = (const GAS f32x4*)(x + (size_t)m * D) + lane; f32x4 v[8]; float ss = 0.f;
#pragma unroll
            for (int j = 0; j < 8; ++j) { v[j] = xr[64 * j]; ss += (v[j][0] * v[j][0] + v[j][1] * v[j][1]) + (v[j][2] * v[j][2] + v[j][3] * v[j][3]); }
            ss = wave_sum(ss);
            GAS pg8::u32x2* o = (GAS pg8::u32x2*)(xb + (size_t)m * D) + lane;
#pragma unroll
            for (int j = 0; j < 8; ++j) { pg8::u32x2 w; w.x = pg8::cvt_pk_bf16(v[j][0], v[j][1]); w.y = pg8::cvt_pk_bf16(v[j][2], v[j][3]); o[64 * j] = w; }
            if (lane < 32) rowss[(size_t)m * 32 + lane] = lane == 0 ? ss : 0.f;
        }
    }
    {
        const float* mem = F.in[I_MEM]; const float* mg = F.in[I_MEMG]; bf16* mn = (bf16*)(F.ws + WS_MEMN);
        for (int m = gw; m < BATCH * MEMT; m += NGW) {
            const GAS f32x4* xr = (const GAS f32x4*)(mem + (size_t)m * D) + lane; f32x4 v[8]; float ss = 0.f;
#pragma unroll
            for (int j = 0; j < 8; ++j) { v[j] = xr[64 * j]; ss += (v[j][0] * v[j][0] + v[j][1] * v[j][1]) + (v[j][2] * v[j][2] + v[j][3] * v[j][3]); }
            const float rs = 1.0f / sqrtf(wave_sum(ss) * (1.0f / D) + EPS);
            GAS pg8::u32x2* o = (GAS pg8::u32x2*)(mn + (size_t)m * D) + lane;
#pragma unroll
            for (int j = 0; j < 8; ++j) { const f32x4 g = ((const GAS f32x4*)mg)[lane + 64 * j]; pg8::u32x2 w; w.x = pg8::cvt_pk_bf16(v[j][0] * rs * g[0], v[j][1] * rs * g[1]); w.y = pg8::cvt_pk_bf16(v[j][2] * rs * g[2], v[j][3] * rs * g[3]); o[64 * j] = w; }
        }
    }
    {
        const float* lg = F.in[I_C_LBL]; float* lb = (float*)(F.ws + WS_LB);
        for (int c = blockIdx.x * 512 + tid; c < D; c += F.G * 512) {
            const float a0 = lg[c], a1 = lg[D + c], a2 = lg[2 * D + c], a3 = lg[3 * D + c];
            const float mx = fmaxf(fmaxf(a0, a1), fmaxf(a2, a3));
            const float e0 = expf(a0 - mx), e1 = expf(a1 - mx), e2 = expf(a2 - mx), e3 = expf(a3 - mx), inv = 1.0f / (e0 + e1 + e2 + e3);
            const float p1 = e1 * inv, p2 = e2 * inv, p3 = e3 * inv;
            lb[c] = 0.f; lb[D + c] = p1; lb[2 * D + c] = p1 + p2; lb[3 * D + c] = p1 + p2 + p3;
        }
    }
}

__device__ __forceinline__ void build_rtab(Frame& F, const pg8::StaticOrder& S) {
    PHASE_IDS();
    const float* rowss = (const float*)(F.ws + WS_ROWSS); LAS float* rt = (LAS float*)(F.lds + RTAB_OFF);
    for (int idx = tid; idx < 8 * 256; idx += NWAVES * 64) {
        const int i = idx >> 8, r = idx & 255; pg8::Unit u;
        if (!S.next(i, u)) break;
        const GAS f32x4* p = (const GAS f32x4*)(rowss + (size_t)(u.pm * 256 + r) * 32); float s = 0.f;
#pragma unroll
        for (int j = 0; j < 8; ++j) { const f32x4 v = p[j]; s += (v[0] + v[1]) + (v[2] + v[3]); }
        rt[idx] = 1.0f / sqrtf(s * (1.0f / D) + EPS);
    }
    LDS_WAIT(); __syncthreads();
}
template <class Epi> __device__ __forceinline__ void run_gemm(Frame& F, const bf16* A, const bf16* Bt, int Mrows, int N, int K, const Epi& E, bool need_rtab) {
    pg8::Gemm g{A, Bt, Mrows, N, K}; pg8::StaticOrder S; S.init(Mrows, N, F.G, (int)blockIdx.x);
    if (need_rtab) build_rtab(F, S);
    pg8::gemm_phase<Epi, pg8::StaticOrder, true, true>(F.lds + RING_OFF, g, S, E);
}

__device__ __forceinline__ float nv_scores(const bf16* Kp, size_t pitch, const LAS float* qf, LAS float* sc, int limit, int lane) {
    float mx = -INFINITY;
    for (int kk = 0; kk < 4; ++kk) {
        const int key = kk * 64 + lane; const GAS v4u* kr = (const GAS v4u*)(Kp + (size_t)key * pitch); float s0 = 0.f, s1 = 0.f;
#pragma unroll 4
        for (int c = 0; c < 16; ++c) {
            const v4u w = kr[c]; const f32x4 q0 = *(const LAS f32x4*)(qf + 8 * c), q1 = *(const LAS f32x4*)(qf + 8 * c + 4);
            s0 += q0[0] * bflo(w.x) + q0[1] * bfhi(w.x) + q0[2] * bflo(w.y) + q0[3] * bfhi(w.y);
            s1 += q1[0] * bflo(w.z) + q1[1] * bfhi(w.z) + q1[2] * bflo(w.w) + q1[3] * bfhi(w.w);
        }
        float s = s0 + s1; if (key > limit) s = -INFINITY;
        sc[key] = s; mx = fmaxf(mx, s);
    }
    return mx;
}
__device__ __forceinline__ float nv_exp(LAS float* sc, float mx, int lane) {
    float sum = 0.f;
    for (int kk = 0; kk < 4; ++kk) { const int key = kk * 64 + lane; const float p = exp2f(sc[key] - mx); sc[key] = p; sum += p; }
    return sum;
}
__device__ __forceinline__ void nv_pv(const bf16* Vp, size_t pitch, const LAS float* sc, float& o0, float& o1, int lane) {
#pragma unroll 8
    for (int key = 0; key < 256; ++key) { const float p = sc[key]; const unsigned w = *(const GAS unsigned*)(Vp + (size_t)key * pitch + 2 * lane); o0 += p * bflo(w); o1 += p * bfhi(w); }
}

__device__ __forceinline__ void moba_naive(Frame& F, int blk0) {
    PHASE_IDS();
    if ((int)blockIdx.x < blk0) return;
    const bf16* Qm = (const bf16*)(F.ws + WS_QM); const bf16* Km = (const bf16*)(F.ws + WS_KM); const bf16* Vm = (const bf16*)(F.ws + WS_VM); const float* kms = (const float*)(F.ws + WS_KMS);
    bf16* Y = (bf16*)(F.ws + WS_Y);
    LAS float* qf = (LAS float*)(F.lds + RING_OFF + wave * 8192); LAS float* sc = qf + 128;
    const int gw = ((int)blockIdx.x - blk0) * NWAVES + wave, NGW = (F.G - blk0) * NWAVES;
    for (int un = gw; un < M * NH_AB; un += NGW) {
        const int row = un >> 3, h = un & 7, b = row / SEQ, t = row - b * SEQ, qb = t >> 8;
        const unsigned qw = *(const GAS unsigned*)(Qm + (size_t)row * 1024 + h * HD + 2 * lane); const float q0 = bflo(qw), q1 = bfhi(qw);
        __builtin_amdgcn_wave_barrier();
        qf[2 * lane] = q0; qf[2 * lane + 1] = q1;
        float v1 = -INFINITY, v2 = -INFINITY, v3 = -INFINITY; int i1 = -1, i2 = -1, i3 = -1;
        for (int j = 0; j < qb; ++j) {
            const float* k0 = kms + (size_t)((b * NBLK + j) * 2) * 1024 + h * HD + 2 * lane;
            const pg8::f32x2 a = *(const GAS pg8::f32x2*)k0, c = *(const GAS pg8::f32x2*)(k0 + 1024);
            const float gj = wave_sum(q0 * (a.x + c.x) + q1 * (a.y + c.y));
            if (gj > v1) { v3 = v2; i3 = i2; v2 = v1; i2 = i1; v1 = gj; i1 = j; } else if (gj > v2) { v3 = v2; i3 = i2; v2 = gj; i2 = j; } else if (gj > v3) { v3 = gj; i3 = j; }
        }
        LDS_WAIT(); __builtin_amdgcn_wave_barrier();
        int blk[4]; blk[0] = qb; blk[1] = i1; blk[2] = i2; blk[3] = i3;
        float mx = -INFINITY;
#pragma unroll
        for (int sidx = 0; sidx < 4; ++sidx) { const int jb = blk[sidx]; if (jb >= 0) mx = fmaxf(mx, nv_scores(Km + ((size_t)(b * SEQ + jb * 256)) * 1024 + h * HD, 1024, qf, sc + sidx * 256, sidx == 0 ? (t & 255) : 255, lane)); }
        mx = wave_max(mx);
        float sum = 0.f;
#pragma unroll
        for (int sidx = 0; sidx < 4; ++sidx) if (blk[sidx] >= 0) sum += nv_exp(sc + sidx * 256, mx, lane);
        sum = wave_sum(sum);
        LDS_WAIT(); __builtin_amdgcn_wave_barrier();
        float o0 = 0.f, o1 = 0.f;
#pragma unroll
        for (int sidx = 0; sidx < 4; ++sidx) { const int jb = blk[sidx]; if (jb >= 0) nv_pv(Vm + ((size_t)(b * SEQ + jb * 256)) * 1024 + h * HD, 1024, sc + sidx * 256, o0, o1, lane); }
        const float inv = 1.0f / sum;
        *(GAS unsigned*)(Y + (size_t)row * D + h * HD + 2 * lane) = pg8::cvt_pk_bf16(o0 * inv, o1 * inv);
    }
}
__device__ __forceinline__ void xattn_naive(Frame& F, int l) {
    PHASE_IDS();
    const bf16* Xq = (const bf16*)(F.ws + WS_XQ); const bf16* KV = (const bf16*)(F.ws + WS_KV); bf16* Xo = (bf16*)(F.ws + WS_XO);
    LAS float* qf = (LAS float*)(F.lds + RING_OFF + wave * 8192); LAS float* sc = qf + 128;
    const int gw = blockIdx.x * NWAVES + wave, NGW = F.G * NWAVES;
    for (int un = gw; un < M * 4; un += NGW) {
        const int row = un >> 2, h = un & 3, b = row / SEQ;
        const unsigned qw = *(const GAS unsigned*)(Xq + (size_t)row * XW + h * HD + 2 * lane);
        __builtin_amdgcn_wave_barrier();
        qf[2 * lane] = bflo(qw); qf[2 * lane + 1] = bfhi(qw);
        LDS_WAIT(); __builtin_amdgcn_wave_barrier();
        const bf16* Kp = KV + (size_t)(b * MEMT) * 4096 + l * 1024 + h * HD;
        float mx = wave_max(nv_scores(Kp, 4096, qf, sc, 255, lane));
        const float sum = wave_sum(nv_exp(sc, mx, lane));
        LDS_WAIT(); __builtin_amdgcn_wave_barrier();
        float o0 = 0.f, o1 = 0.f; nv_pv(Kp + 512, 4096, sc, o0, o1, lane);
        const float inv = 1.0f / sum;
        *(GAS unsigned*)(Xo + (size_t)row * XW + h * HD + 2 * lane) = pg8::cvt_pk_bf16(o0 * inv, o1 * inv);
    }
}
__device__ __forceinline__ void dn_prep(Frame& F, int e) {
    PHASE_IDS();
    const bf16* pre = (const bf16*)(F.ws + WS_DNPRE); const float* ba = (const float*)(F.ws + WS_BA); const float* cw = F.in[I_AB_CONVW] + (size_t)e * 4 * 3072;
    float* dq = (float*)(F.ws + WS_DQ); float* dk = (float*)(F.ws + WS_DK); float* dv = (float*)(F.ws + WS_DV); float* bg = (float*)(F.ws + WS_BG);
    const int gw = blockIdx.x * NWAVES + wave, NGW = F.G * NWAVES;
    for (int un = gw; un < M * NH_AB; un += NGW) {
        const int row = un >> 3, h = un & 7, t = row & (SEQ - 1);
#pragma unroll
        for (int sec = 0; sec < 3; ++sec) {
            const int ch = sec * 1024 + h * HD + 2 * lane; float a0 = 0.f, a1 = 0.f;
#pragma unroll
            for (int i = 0; i < 4; ++i) { if (t - 3 + i >= 0) { const unsigned w = *(const GAS unsigned*)(pre + (size_t)(row - 3 + i) * 3072 + ch); const pg8::f32x2 c = *(const GAS pg8::f32x2*)(cw + i * 3072 + ch); a0 += c.x * bflo(w); a1 += c.y * bfhi(w); } }
            a0 = silu_acc(a0); a1 = silu_acc(a1);
            float* dst = sec == 0 ? dq : (sec == 1 ? dk : dv);
            if (sec < 2) { const float ss = wave_sum(a0 * a0 + a1 * a1); const float r = (1.0f / sqrtf(ss + EPS)) * (sec == 0 ? 0.08838834764831845f : 1.0f); a0 *= r; a1 *= r; }
            *(GAS pg8::f32x2*)(dst + (size_t)row * 1024 + h * HD + 2 * lane) = (pg8::f32x2){a0, a1};
        }
        if (lane == 0) {
            const float braw = ba[(size_t)row * 16 + h], araw = ba[(size_t)row * 16 + 8 + h] + F.in[I_AB_DTB][e * 8 + h];
            const float sp = araw > 20.f ? araw : log1pf(expf(araw));
            bg[(size_t)row * 16 + h] = sigmoid_f(braw); bg[(size_t)row * 16 + 8 + h] = -expf(F.in[I_AB_ALOG][e * 8 + h]) * sp;
        }
    }
}
__device__ __forceinline__ void dn_scan_naive(Frame& F) {
    PHASE_IDS();
    if (blockIdx.x >= BATCH * NH_AB) return;
    const int b = blockIdx.x >> 3, h = blockIdx.x & 7;
    const float* dq = (const float*)(F.ws + WS_DQ); const float* dk = (const float*)(F.ws + WS_DK); const float* dv = (const float*)(F.ws + WS_DV); const float* bg = (const float*)(F.ws + WS_BG);
    float* dno = (float*)(F.ws + WS_DNO);
    constexpr int CH = 32;
    LAS float* sq = (LAS float*)(F.lds + RING_OFF); LAS float* sk = sq + CH * 128; LAS float* sv = sk + CH * 128; LAS float* sbg = sv + CH * 128;
    float S[128];
#pragma unroll
    for (int d = 0; d < 128; ++d) S[d] = 0.f;
    for (int t0 = 0; t0 < SEQ; t0 += CH) {
        __syncthreads();
        const size_t rbase = (size_t)(b * SEQ + t0);
        for (int i = tid; i < CH * 32; i += NWAVES * 64) { const int r = i >> 5, c = i & 31; const size_t off = (rbase + r) * 1024 + h * HD + 4 * c;
            *(LAS f32x4*)(sq + r * 128 + 4 * c) = *(const GAS f32x4*)(dq + off); *(LAS f32x4*)(sk + r * 128 + 4 * c) = *(const GAS f32x4*)(dk + off); *(LAS f32x4*)(sv + r * 128 + 4 * c) = *(const GAS f32x4*)(dv + off); }
        if (tid < CH * 2) { const int r = tid >> 1, w = tid & 1; sbg[tid] = bg[(rbase + r) * 16 + w * 8 + h]; }
        LDS_WAIT(); __syncthreads();
        if (tid < 128) {
            for (int tt = 0; tt < CH; ++tt) {
                const float beta = sbg[2 * tt], a = __expf(sbg[2 * tt + 1]), vj = sv[tt * 128 + tid];
                float ks0 = 0.f, ks1 = 0.f, ks2 = 0.f, ks3 = 0.f;
#pragma unroll
                for (int d4 = 0; d4 < 32; ++d4) { if ((d4 & 3) == 0) asm volatile("" ::: "memory"); const f32x4 kk = *(const LAS f32x4*)(sk + tt * 128 + 4 * d4); ks0 += kk[0] * S[4 * d4]; ks1 += kk[1] * S[4 * d4 + 1]; ks2 += kk[2] * S[4 * d4 + 2]; ks3 += kk[3] * S[4 * d4 + 3]; }
                const float coef = beta * (vj - a * ((ks0 + ks1) + (ks2 + ks3)));
                float o0 = 0.f, o1 = 0.f, o2 = 0.f, o3 = 0.f;
#pragma unroll
                for (int d4 = 0; d4 < 32; ++d4) { if ((d4 & 3) == 0) asm volatile("" ::: "memory"); const f32x4 kk = *(const LAS f32x4*)(sk + tt * 128 + 4 * d4), qq = *(const LAS f32x4*)(sq + tt * 128 + 4 * d4);
                    S[4 * d4] = a * S[4 * d4] + kk[0] * coef; S[4 * d4 + 1] = a * S[4 * d4 + 1] + kk[1] * coef; S[4 * d4 + 2] = a * S[4 * d4 + 2] + kk[2] * coef; S[4 * d4 + 3] = a * S[4 * d4 + 3] + kk[3] * coef;
                    o0 += qq[0] * S[4 * d4]; o1 += qq[1] * S[4 * d4 + 1]; o2 += qq[2] * S[4 * d4 + 2]; o3 += qq[3] * S[4 * d4 + 3]; }
                dno[(rbase + tt) * 1024 + h * HD + tid] = (o0 + o1) + (o2 + o3);
            }
        }
    }
    __syncthreads();
}
__device__ __forceinline__ void gla_scan_naive(Frame& F) {
    PHASE_IDS();
    if (blockIdx.x >= BATCH * NH_C) return;
    const int b = blockIdx.x >> 4, h = blockIdx.x & 15;
    const bf16* Cq = (const bf16*)(F.ws + WS_CQ); const bf16* Ck = (const bf16*)(F.ws + WS_CK); const bf16* Cv = (const bf16*)(F.ws + WS_CV); const float* Clf = (const float*)(F.ws + WS_CLF);
    float* Co = (float*)(F.ws + WS_CO);
    constexpr int CH = 32;
    LAS float* sq = (LAS float*)(F.lds + RING_OFF); LAS float* sk = sq + CH * 128; LAS float* sv = sk + CH * 128; LAS float* sf = sv + CH * 128;
    float S[128];
#pragma unroll
    for (int d = 0; d < 128; ++d) S[d] = 0.f;
    for (int t0 = 0; t0 < SEQ; t0 += CH) {
        __syncthreads();
        const size_t rbase = (size_t)(b * SEQ + t0);
        for (int i = tid; i < CH * 32; i += NWAVES * 64) { const int r = i >> 5, c = i & 31; const size_t off = (rbase + r) * D + h * HD + 4 * c;
            const pg8::u32x2 wq = *(const GAS pg8::u32x2*)(Cq + off), wk = *(const GAS pg8::u32x2*)(Ck + off), wv = *(const GAS pg8::u32x2*)(Cv + off); const f32x4 lf = *(const GAS f32x4*)(Clf + off);
            *(LAS f32x4*)(sq + r * 128 + 4 * c) = (f32x4){bflo(wq.x), bfhi(wq.x), bflo(wq.y), bfhi(wq.y)};
            *(LAS f32x4*)(sk + r * 128 + 4 * c) = (f32x4){bflo(wk.x), bfhi(wk.x), bflo(wk.y), bfhi(wk.y)};
            *(LAS f32x4*)(sv + r * 128 + 4 * c) = (f32x4){bflo(wv.x), bfhi(wv.x), bflo(wv.y), bfhi(wv.y)};
            *(LAS f32x4*)(sf + r * 128 + 4 * c) = (f32x4){__expf(lf[0]), __expf(lf[1]), __expf(lf[2]), __expf(lf[3])}; }
        LDS_WAIT(); __syncthreads();
        if (tid < 128) {
            for (int tt = 0; tt < CH; ++tt) {
                const float vj = sv[tt * 128 + tid];
                float o0 = 0.f, o1 = 0.f, o2 = 0.f, o3 = 0.f;
#pragma unroll
                for (int d4 = 0; d4 < 32; ++d4) { if ((d4 & 3) == 0) asm volatile("" ::: "memory"); const f32x4 kk = *(const LAS f32x4*)(sk + tt * 128 + 4 * d4), qq = *(const LAS f32x4*)(sq + tt * 128 + 4 * d4), ff = *(const LAS f32x4*)(sf + tt * 128 + 4 * d4);
                    S[4 * d4] = ff[0] * S[4 * d4] + kk[0] * vj; S[4 * d4 + 1] = ff[1] * S[4 * d4 + 1] + kk[1] * vj; S[4 * d4 + 2] = ff[2] * S[4 * d4 + 2] + kk[2] * vj; S[4 * d4 + 3] = ff[3] * S[4 * d4 + 3] + kk[3] * vj;
                    o0 += qq[0] * S[4 * d4]; o1 += qq[1] * S[4 * d4 + 1]; o2 += qq[2] * S[4 * d4 + 2]; o3 += qq[3] * S[4 * d4 + 3]; }
                Co[(rbase + tt) * D + h * HD + tid] = (o0 + o1) + (o2 + o3);
            }
        }
    }
    __syncthreads();
}
__device__ __forceinline__ void normgate(Frame& F, const float* o, const bf16* gate, int nheads, const float* gw_, int ycol) {
    PHASE_IDS();
    bf16* Y = (bf16*)(F.ws + WS_Y);
    const int gw = blockIdx.x * NWAVES + wave, NGW = F.G * NWAVES, ld = nheads * HD;
    const pg8::f32x2 g2 = *(const GAS pg8::f32x2*)(gw_ + 2 * lane);
    for (int un = gw; un < M * nheads; un += NGW) {
        const int row = un / nheads, h = un - row * nheads;
        const pg8::f32x2 v = *(const GAS pg8::f32x2*)(o + (size_t)row * ld + h * HD + 2 * lane);
        const float rs = 1.0f / sqrtf(wave_sum(v.x * v.x + v.y * v.y) * (1.0f / HD) + EPS);
        const unsigned gt = *(const GAS unsigned*)(gate + (size_t)row * ld + h * HD + 2 * lane);
        *(GAS unsigned*)(Y + (size_t)row * D + ycol + h * HD + 2 * lane) = pg8::cvt_pk_bf16(v.x * rs * g2.x * silu_acc(bflo(gt)), v.y * rs * g2.y * silu_acc(bfhi(gt)));
    }
}
__device__ __forceinline__ void final_norm(Frame& F) {
    PHASE_IDS();
    const float* x = (const float*)(F.ws + WS_X); const float* rowss = (const float*)(F.ws + WS_ROWSS); const float* fg = F.in[I_FINALG];
    const int gw = blockIdx.x * NWAVES + wave, NGW = F.G * NWAVES;
    for (int m = gw; m < M; m += NGW) {
        float s = lane < 32 ? rowss[(size_t)m * 32 + lane] : 0.f;
        float tot = 0.f;
#pragma unroll
        for (int j = 0; j < 32; ++j) tot += __shfl(s, j);
        const float rs = 1.0f / sqrtf(tot * (1.0f / D) + EPS);
        const GAS f32x4* xr = (const GAS f32x4*)(x + (size_t)m * D) + lane; GAS f32x4* orow = (GAS f32x4*)(F.out + (size_t)m * D) + lane;
#pragma unroll
        for (int j = 0; j < 8; ++j) { const f32x4 g = ((const GAS f32x4*)fg)[lane + 64 * j]; orow[64 * j] = xr[64 * j] * rs * g; }
    }
}

struct Args { const float* in[20]; float* out; unsigned char* ws; };
__global__ void __launch_bounds__(NWAVES * 64, 2) fwd(Args args) {
    extern __shared__ __attribute__((aligned(16))) unsigned char lds[];
    Frame F;
    F.lds = (LAS unsigned char*)lds;
    F.MISC = (volatile LAS unsigned*)(F.lds + MISC_OFF);
    F.tid = threadIdx.x; F.lane = F.tid & 63; F.wave = __builtin_amdgcn_readfirstlane(F.tid >> 6);
    F.G = gridDim.x;
    unsigned char* ws = args.ws; F.ws = ws; F.out = args.out;
    F.ctl = (gu32*)(ws + WS_CTL);
#pragma unroll
    for (int i = 0; i < 20; ++i) F.in[i] = args.in[i];
    for (int u = F.tid; u < (LDS_BYTES - LDSCTL_OFF) / 4; u += NWAVES * 64) ((LAS unsigned*)(F.lds + LDSCTL_OFF))[u] = 0u;
    __syncthreads();
    XcdBarrier bar = xcd_barrier_post((unsigned*)(F.ctl + CW_BAR), F.MISC + 8);
#define GRID_BAR() xcd_barrier(bar)
    const LAS float* rtab = (const LAS float*)(F.lds + RTAB_OFF);
    bf16* XB = (bf16*)(ws + WS_XB); float* X = (float*)(ws + WS_X); float* ROWSS = (float*)(ws + WS_ROWSS); bf16* ACT = (bf16*)(ws + WS_ACT); bf16* Y = (bf16*)(ws + WS_Y);

    p0_prologue(F);
    GRID_BAR();
    { pg8::EpiBf16Route E{(bf16*)(ws + WS_KV), 4096, nullptr, 1.0f}; run_gemm(F, (const bf16*)(ws + WS_MEMN), (const bf16*)(ws + WS_WXKVT), BATCH * MEMT, 4096, D, E, false); }

    for (int s = 0; s < 2 * DEPTH; ++s) {
        { pg8::EpiSwiGLU E{ACT, DFF, rtab}; run_gemm(F, XB, (const bf16*)(ws + WS_W1T) + (size_t)s * NFF * D, M, NFF, D, E, true); }
        GRID_BAR();
        { pg8::EpiResidual E{s == 0 ? F.in[I_X] : (const float*)X, X, XB, ROWSS, 0.5f, D}; run_gemm(F, ACT, (const bf16*)(ws + WS_W2T) + (size_t)s * D * DFF, M, D, DFF, E, false); }
        GRID_BAR();
        if (!(s & 1)) {
            const int l = s >> 1;
            if (!(l & 1)) {
                const int e = l >> 1;
                { pg8::EpiABin E{(bf16*)(ws + WS_QM), (bf16*)(ws + WS_KM), (bf16*)(ws + WS_VM), (bf16*)(ws + WS_DNPRE), (bf16*)(ws + WS_DNGATE), (float*)(ws + WS_BA), (float*)(ws + WS_KMS), rtab, QK_SCALE_LOG2E};
                  run_gemm(F, XB, (const bf16*)(ws + WS_WABT) + (size_t)e * AB_PAD * D, M, AB_PAD, D, E, true); }
                GRID_BAR();
                dn_prep(F, e);
                GRID_BAR();
                dn_scan_naive(F);
                moba_naive(F, BATCH * NH_AB);
                GRID_BAR();
                normgate(F, (const float*)(ws + WS_DNO), (const bf16*)(ws + WS_DNGATE), NH_AB, F.in[I_AB_ONG] + e * HD, 1024);
                GRID_BAR();
                { pg8::EpiResidual E{X, X, XB, ROWSS, 1.0f, D}; run_gemm(F, Y, (const bf16*)(ws + WS_WABOT) + (size_t)e * D * D, M, D, D, E, false); }
                GRID_BAR();
            } else {
                const int o = l >> 1;
                { pg8::EpiCin E{(bf16*)(ws + WS_CQ), (bf16*)(ws + WS_CK), (bf16*)(ws + WS_CV), (bf16*)(ws + WS_CG), (float*)(ws + WS_CLF), (const float*)(ws + WS_LB) + (size_t)l * D, rtab};
                  run_gemm(F, XB, (const bf16*)(ws + WS_WCT) + (size_t)o * 4 * D * D, M, 4 * D, D, E, true); }
                GRID_BAR();
                gla_scan_naive(F);
                GRID_BAR();
                normgate(F, (const float*)(ws + WS_CO), (const bf16*)(ws + WS_CG), NH_C, F.in[I_C_ONG] + o * HD, 0);
                GRID_BAR();
                { pg8::EpiResidual E{X, X, XB, ROWSS, 1.0f, D}; run_gemm(F, Y, (const bf16*)(ws + WS_WCOT) + (size_t)o * D * D, M, D, D, E, false); }
                GRID_BAR();
            }
            { pg8::EpiBf16Route E{(bf16*)(ws + WS_XQ), XW, rtab, QK_SCALE_LOG2E}; run_gemm(F, XB, (const bf16*)(ws + WS_WXQT) + (size_t)l * XW * D, M, XW, D, E, true); }
            GRID_BAR();
            xattn_naive(F, l);
            GRID_BAR();
            { pg8::EpiResidual E{X, X, XB, ROWSS, 1.0f, D}; run_gemm(F, (const bf16*)(ws + WS_XO), (const bf16*)(ws + WS_WXOT) + (size_t)l * D * XW, M, D, XW, E, false); }
            GRID_BAR();
        }
    }
    final_norm(F);
#undef GRID_BAR
}

extern "C" void kernel_launch(void* const* d_in, const int* in_sizes, int n_in, void* d_out, int out_size, void* d_ws, size_t ws_size, hipStream_t stream) {
    static int grid = 0;
    if (grid == 0) {
        if (n_in != 20 || in_sizes[0] != M * D || out_size != M * D || ws_size < WS_END) { fprintf(stderr, "kernel_launch: unexpected shapes: n_in %d in0 %d out %d ws %zu (need %zu); nothing launched\n", n_in, n_in > 0 ? in_sizes[0] : -1, out_size, ws_size, (size_t)WS_END); grid = -1; return; }
        int dev = 0, cus = 0, per_cu = 0;
        if (hipGetDevice(&dev) != hipSuccess || hipDeviceGetAttribute(&cus, hipDeviceAttributeMultiprocessorCount, dev) != hipSuccess) { fprintf(stderr, "kernel_launch: device query failed\n"); grid = -1; return; }
        if (hipFuncSetAttribute((const void*)fwd, hipFuncAttributeMaxDynamicSharedMemorySize, LDS_BYTES) != hipSuccess) { fprintf(stderr, "kernel_launch: hipFuncSetAttribute failed\n"); grid = -1; return; }
        if (hipOccupancyMaxActiveBlocksPerMultiprocessor(&per_cu, (const void*)fwd, NWAVES * 64, LDS_BYTES) != hipSuccess || per_cu < 1) fprintf(stderr, "kernel_launch: note: occupancy query reports %d workgroups per CU\n", per_cu);
        (void)hipGetLastError();
        grid = cus;
    }
    if (grid < 0) return;
    if (hipMemsetAsync((char*)d_ws + WS_CTL, 0, CTL_ZERO_BYTES, stream) != hipSuccess) { fprintf(stderr, "kernel_launch: memset failed\n"); return; }
    Args a{};
    for (int i = 0; i < 20; ++i) a.in[i] = (const float*)d_in[i];
    a.out = (float*)d_out; a.ws = (unsigned char*)d_ws;
    hipLaunchKernelGGL(fwd, dim3(grid), dim3(NWAVES * 64), LDS_BYTES, stream, a);
    const hipError_t le = hipPeekAtLastError();
    if (le != hipSuccess) fprintf(stderr, "kernel_launch: launch failed: %s\n", hipGetErrorName(le));
}
```

```cpp
#include <hip/hip_runtime.h>
#include <cstdio>
#include <cstdint>
namespace pg8 {
#define PG8_LAS __attribute__((address_space(3)))
typedef unsigned short bf16_t;
typedef short bf16x8 __attribute__((ext_vector_type(8)));
typedef float f32x4 __attribute__((ext_vector_type(4)));
typedef unsigned u32x4 __attribute__((ext_vector_type(4)));
constexpr int BM = 256, BK = 64, HALF = 128, HTB = HALF * BK * 2  , STAGE_BYTES = 8 * HTB, NXCD = 8, WGM = 4;

__host__ __device__ __forceinline__ int lds_byte(int r, int c) { const int st = (r >> 4) * 2 + (c >> 5), rr = r & 15, cc = c & 31, ob = rr * 64 + cc * 2; return st * 1024 + (ob ^ (((ob >> 9) & 1) << 5)); }
__host__ __device__ __forceinline__ void stage_rc(int b, int& R, int& C) { const int st = b / 1024, sb = b % 1024, swz = sb ^ (((sb >> 9) & 1) << 5); R = (st >> 1) * 16 + swz / 64; C = (st & 1) * 32 + (swz % 64) / 2; }
__host__ __device__ __forceinline__ int perm32(int rho) { const int n = rho >> 4, i = rho & 15; return 8 * (i >> 2) + 4 * n + (i & 3); }

#ifndef BIMG
#define BIMG 1
#endif
__host__ __device__ __forceinline__ int slot32(int c) { const int q = c & 31; return (c & ~31) + 16 * ((q >> 2) & 1) + 4 * (q >> 3) + (q & 3); }
__host__ __device__ __forceinline__ size_t img_off(int r, int k, int K) { return ((size_t)(r >> 4) * (K >> 5) + (k >> 5)) * 1024 + lds_byte(r & 15, k & 31); }
struct Unit { int pm, pn, half; };
struct Gemm { const bf16_t* A; const bf16_t* Bt; int M, N, K, ld, ks; };

struct StaticOrder {
    int nM, nN, nwg, G, c;
    __host__ __device__ void init(int M, int N, int G_, int c_) { nM = M / BM; nN = N / BM; nwg = nM * nN; G = G_; c = c_; }
    __host__ __device__ bool next(int i, Unit& u) const {
        const long L = (long)i * G + c; if (L >= nwg) return false;
        int wgid = (int)L; { const int q = nwg / NXCD, r = nwg % NXCD, xcd = wgid % NXCD, off = wgid / NXCD; wgid = (xcd < r ? xcd * (q + 1) : r * (q + 1) + (xcd - r) * q) + off; }
        const int nig = WGM * nN, gid = wgid / nig, fm = gid * WGM, gsz = (nM - fm) < WGM ? (nM - fm) : WGM;
        u.pm = fm + ((wgid % nig) % gsz); u.pn = (wgid % nig) / gsz; u.half = 0; return true;
    }
    __device__ __forceinline__ void a_ready(const Unit&) const {}
    __device__ __forceinline__ void done(const Unit&) const {}
};

struct HalfOrder {
    int nM, pn0, nhalf, G, c;
    __host__ __device__ void init(int M, int pn0_, int ntile, int G_, int c_) { nM = M / BM; pn0 = pn0_; nhalf = 2 * nM * ntile; G = G_; c = c_; }
    __host__ __device__ bool next(int i, Unit& u) const { const int L = i * G + c; if (L >= nhalf) return false; const int T = L >> 1; u.pm = T % nM; u.pn = pn0 + T / nM; u.half = L & 1; return true; }
    __device__ __forceinline__ void a_ready(const Unit&) const {}
    __device__ __forceinline__ void done(const Unit&) const {}
};

typedef float f32x2_cv __attribute__((ext_vector_type(2))); typedef __bf16 bf16x2_cv __attribute__((ext_vector_type(2)));
__device__ __forceinline__ unsigned cvt_pk_bf16(float lo, float hi) { const f32x2_cv v = {lo, hi}; const bf16x2_cv b = __builtin_convertvector(v, bf16x2_cv); return __builtin_bit_cast(unsigned, b); }
#ifndef X_F16
#define X_F16 2
#endif
typedef _Float16 f16x2_cv __attribute__((ext_vector_type(2))); typedef _Float16 f16x8 __attribute__((ext_vector_type(8)));
__device__ __forceinline__ unsigned cvt_pk_f16(float lo, float hi) { const f32x2_cv v = {lo, hi}; const f16x2_cv b = __builtin_convertvector(v, f16x2_cv); return __builtin_bit_cast(unsigned, b); }
__device__ __forceinline__ float f16_lo(unsigned w) { return (float)__builtin_bit_cast(f16x2_cv, w)[0]; }
__device__ __forceinline__ float f16_hi(unsigned w) { return (float)__builtin_bit_cast(f16x2_cv, w)[1]; }
__device__ __forceinline__ unsigned cvt_pk_x(float lo, float hi) { return X_F16 == 1 ? cvt_pk_f16(lo, hi) : cvt_pk_bf16(lo, hi); }
typedef float f32x2 __attribute__((ext_vector_type(2)));
typedef unsigned u32x2 __attribute__((ext_vector_type(2)));
__device__ __forceinline__ float fast_exp2(float x) { return __builtin_amdgcn_exp2f(x); }
__device__ __forceinline__ float fast_rcp(float x) { return __builtin_amdgcn_rcpf(x); }
__device__ __forceinline__ float silu_f(float a) { return a * fast_rcp(1.0f + fast_exp2(a * -1.44269504089f)); }
__device__ __forceinline__ u32x4 pack8(const f32x4& v0, const f32x4& v1) { u32x4 w; w.x = cvt_pk_bf16(v0[0], v0[1]); w.y = cvt_pk_bf16(v0[2], v0[3]); w.z = cvt_pk_bf16(v1[0], v1[1]); w.w = cvt_pk_bf16(v1[2], v1[3]); return w; }


#ifndef AIMG_ACT
#define AIMG_ACT 1
#endif
#ifndef AIMG_XB
#define AIMG_XB 1
#endif
struct EpiSwiGLU {
    static constexpr bool PERM = true, AFTER_DRAIN = false;
    bf16_t* O; int ldc; const PG8_LAS float* rtab; int hm;
    __device__ __forceinline__ void init(f32x4 (&acc)[2][2][4][2], const Unit&, int, int, int, int) const {
#pragma unroll
        for (int a = 0; a < 2; ++a)
#pragma unroll
            for (int b = 0; b < 2; ++b)
#pragma unroll
                for (int m = 0; m < 4; ++m)
#pragma unroll
                    for (int n = 0; n < 2; ++n) acc[a][b][m][n] = (f32x4){0.f, 0.f, 0.f, 0.f};
    }
    __device__ __forceinline__ void operator()(const f32x4 (&acc)[2][2][4][2], const Unit& u, int ui, int wr, int wc, int fr, int fq) const {
        const PG8_LAS float* rt = rtab + ui * 256;
#pragma unroll
        for (int ai = 0; ai < 2; ++ai)
#pragma unroll
            for (int m = 0; m < 4; ++m) {
                if (hm && ai == 1) continue;
                const int rl = (hm ? u.half : ai) * HALF + wr * 64 + m * 16 + fr; const float rs = rt[rl];
                bf16_t* rowp = AIMG_ACT ? (bf16_t*)((char*)O + img_off(u.pm * BM + rl, u.pn * HALF + wc * 32 + 8 * fq, ldc)) : O + (size_t)(u.pm * BM + rl) * ldc + u.pn * HALF + wc * 32 + 8 * fq;
                f32x4 h[2];
#pragma unroll
                for (int n = 0; n < 2; ++n)
#pragma unroll
                    for (int e = 0; e < 4; ++e) { const float a = acc[ai][0][m][n][e] * rs, b = acc[ai][1][m][n][e] * rs; h[n][e] = silu_f(a) * b; }
                *(u32x4*)rowp = pack8(h[0], h[1]);
            }
    }
};

#ifndef RES_LO
#define RES_LO 1
#endif
constexpr float LO_SCALE = 2048.0f;
__device__ __forceinline__ float bf_lo(unsigned w) { return __builtin_bit_cast(float, w << 16); }
__device__ __forceinline__ float bf_hi(unsigned w) { return __builtin_bit_cast(float, w & 0xffff0000u); }
__device__ __forceinline__ float lo_clamp(float v) { return __builtin_amdgcn_fmed3f(v * LO_SCALE, -448.0f, 448.0f); }
__device__ __forceinline__ unsigned lo_pack4(float a, float b, float c, float d) { int w = __builtin_amdgcn_cvt_pk_fp8_f32(lo_clamp(a), lo_clamp(b), 0, false); return (unsigned)__builtin_amdgcn_cvt_pk_fp8_f32(lo_clamp(c), lo_clamp(d), w, true); }
__device__ __forceinline__ f32x4 hilo4(unsigned h0, unsigned h1, unsigned l) {
    const auto a = __builtin_amdgcn_cvt_pk_f32_fp8((int)l, false), b = __builtin_amdgcn_cvt_pk_f32_fp8((int)l, true); constexpr float r = 1.0f / LO_SCALE;
    return (f32x4){__builtin_fmaf(a[0], r, bf_lo(h0)), __builtin_fmaf(a[1], r, bf_hi(h0)), __builtin_fmaf(b[0], r, bf_lo(h1)), __builtin_fmaf(b[1], r, bf_hi(h1))};
}
__device__ __forceinline__ size_t res_chunk(const Unit& u, int ldx, int wr, int wc, int ai, int m, int bj, int fr, int fq) {
    return (((((size_t)(u.pm * (ldx / BM) + u.pn) * 8 + (wr * 4 + wc)) * 8 + (ai * 4 + m)) * 2 + bj) * 64) + (fq * 16 + fr);
}
struct EpiResidual {
    static constexpr bool PERM = true, AFTER_DRAIN = false;
    const float* xf32; bf16_t* xhi; void* xlo; float* rowss; float scale; int ldx, rsld;
    __device__ __forceinline__ void init(f32x4 (&acc)[2][2][4][2], const Unit& u, int wr, int wc, int fr, int fq) const {
        const float inv = 1.0f / scale;
#pragma unroll
        for (int ai = 0; ai < 2; ++ai)
#pragma unroll
            for (int m = 0; m < 4; ++m) {
                const int row = u.pm * BM + ai * HALF + wr * 64 + m * 16 + fr;
#pragma unroll
                for (int bj = 0; bj < 2; ++bj) { const size_t off = (size_t)row * ldx + u.pn * BM + bj * HALF + wc * 32 + 8 * fq;
                    if (xf32) { acc[ai][bj][m][0] = *(const f32x4*)(xf32 + off) * inv; acc[ai][bj][m][1] = *(const f32x4*)(xf32 + off + 4) * inv; }
                    else { const u32x4 h = X_F16 == 2 ? ((const u32x4*)xlo)[res_chunk(u, ldx, wr, wc, ai, m, bj, fr, fq)] : *(const u32x4*)(xhi + off);
#if X_F16
                        acc[ai][bj][m][0] = (f32x4){f16_lo(h.x), f16_hi(h.x), f16_lo(h.y), f16_hi(h.y)} * inv; acc[ai][bj][m][1] = (f32x4){f16_lo(h.z), f16_hi(h.z), f16_lo(h.w), f16_hi(h.w)} * inv;
#elif RES_LO == 2
                        const u32x2 l = *(const u32x2*)((const unsigned char*)xlo + off);
                        acc[ai][bj][m][0] = hilo4(h.x, h.y, l.x) * inv; acc[ai][bj][m][1] = hilo4(h.z, h.w, l.y) * inv;
#elif RES_LO == 1
                        const u32x4 l = *(const u32x4*)((const bf16_t*)xlo + off);
                        acc[ai][bj][m][0] = (f32x4){bf_lo(h.x) + bf_lo(l.x), bf_hi(h.x) + bf_hi(l.x), bf_lo(h.y) + bf_lo(l.y), bf_hi(h.y) + bf_hi(l.y)} * inv;
                        acc[ai][bj][m][1] = (f32x4){bf_lo(h.z) + bf_lo(l.z), bf_hi(h.z) + bf_hi(l.z), bf_lo(h.w) + bf_lo(l.w), bf_hi(h.w) + bf_hi(l.w)} * inv;
#else
                        acc[ai][bj][m][0] = (f32x4){bf_lo(h.x), bf_hi(h.x), bf_lo(h.y), bf_hi(h.y)} * inv; acc[ai][bj][m][1] = (f32x4){bf_lo(h.z), bf_hi(h.z), bf_lo(h.w), bf_hi(h.w)} * inv;
#endif
                    }
                }
            }
    }
    __device__ __forceinline__ void operator()(const f32x4 (&acc)[2][2][4][2], const Unit& u, int ui, int wr, int wc, int fr, int fq) const {
#pragma unroll
        for (int ai = 0; ai < 2; ++ai)
#pragma unroll
            for (int m = 0; m < 4; ++m) {
                const int row = u.pm * BM + ai * HALF + wr * 64 + m * 16 + fr; float ss = 0.f;
#pragma unroll
                for (int bj = 0; bj < 2; ++bj) {
                    const size_t off = (size_t)row * ldx + u.pn * BM + bj * HALF + wc * 32 + 8 * fq;
                    const f32x4 o0 = acc[ai][bj][m][0] * scale, o1 = acc[ai][bj][m][1] * scale;
#if X_F16
                    *(X_F16 == 2 ? (u32x4*)xlo + res_chunk(u, ldx, wr, wc, ai, m, bj, fr, fq) : (u32x4*)(xhi + off)) = (u32x4){cvt_pk_f16(o0[0], o0[1]), cvt_pk_f16(o0[2], o0[3]), cvt_pk_f16(o1[0], o1[1]), cvt_pk_f16(o1[2], o1[3])};
                    if constexpr (X_F16 == 2) *(u32x4*)(AIMG_XB ? (bf16_t*)((char*)xhi + img_off(row, u.pn * BM + bj * HALF + wc * 32 + 8 * fq, ldx)) : xhi + off) = pack8(o0, o1);
#else
                    const u32x4 h = pack8(o0, o1);
                    *(u32x4*)(xhi + off) = h;
#endif
#if RES_LO && !X_F16
                    const f32x4 r0 = o0 - (f32x4){bf_lo(h.x), bf_hi(h.x), bf_lo(h.y), bf_hi(h.y)}, r1 = o1 - (f32x4){bf_lo(h.z), bf_hi(h.z), bf_lo(h.w), bf_hi(h.w)};
#if RES_LO == 2
                    *(u32x2*)((unsigned char*)xlo + off) = (u32x2){lo_pack4(r0[0], r0[1], r0[2], r0[3]), lo_pack4(r1[0], r1[1], r1[2], r1[3])};
#else
                    *(u32x4*)((bf16_t*)xlo + off) = pack8(r0, r1);
#endif
#endif
                    ss += (o0[0] * o0[0] + o0[1] * o0[1]) + (o0[2] * o0[2] + o0[3] * o0[3]) + (o1[0] * o1[0] + o1[1] * o1[1]) + (o1[2] * o1[2] + o1[3] * o1[3]);
                }
                ss += __shfl_xor(ss, 16); ss += __shfl_xor(ss, 32);
                if (fq == 0) rowss[(size_t)(u.pn * 4 + wc) * rsld + row] = ss;
            }
    }
};

struct EpiBf16Route {
    static constexpr bool PERM = true, AFTER_DRAIN = false;
    bf16_t* O; int ldc; const PG8_LAS float* rtab; float scale; int hm;
    __device__ __forceinline__ void init(f32x4 (&acc)[2][2][4][2], const Unit&, int, int, int, int) const {
#pragma unroll
        for (int a = 0; a < 2; ++a)
#pragma unroll
            for (int b = 0; b < 2; ++b)
#pragma unroll
                for (int m = 0; m < 4; ++m)
#pragma unroll
                    for (int n = 0; n < 2; ++n) acc[a][b][m][n] = (f32x4){0.f, 0.f, 0.f, 0.f};
    }
    __device__ __forceinline__ void operator()(const f32x4 (&acc)[2][2][4][2], const Unit& u, int ui, int wr, int wc, int fr, int fq) const {
#pragma unroll
        for (int ai = 0; ai < 2; ++ai)
#pragma unroll
            for (int m = 0; m < 4; ++m) {
                if (hm && ai == 1) continue;
                const int rl = (hm ? u.half : ai) * HALF + wr * 64 + m * 16 + fr; const float rs = (rtab ? rtab[ui * 256 + rl] : 1.0f) * scale;
                bf16_t* rowp = O + (size_t)(u.pm * BM + rl) * ldc + u.pn * BM + wc * 32 + 8 * fq;
#pragma unroll
                for (int bj = 0; bj < 2; ++bj) *(u32x4*)(rowp + bj * HALF) = pack8(acc[ai][bj][m][0] * rs, acc[ai][bj][m][1] * rs);
            }
    }
};

struct EpiF32Part {
    static constexpr bool PERM = true, AFTER_DRAIN = false;
    float* P; int ldc; int ks; size_t part_stride;
    __device__ __forceinline__ void init(f32x4 (&acc)[2][2][4][2], const Unit&, int, int, int, int) const {
#pragma unroll
        for (int a = 0; a < 2; ++a)
#pragma unroll
            for (int b = 0; b < 2; ++b)
#pragma unroll
                for (int m = 0; m < 4; ++m)
#pragma unroll
                    for (int n = 0; n < 2; ++n) acc[a][b][m][n] = (f32x4){0.f, 0.f, 0.f, 0.f};
    }
    __device__ __forceinline__ void operator()(const f32x4 (&acc)[2][2][4][2], const Unit& u, int ui, int wr, int wc, int fr, int fq) const {
        float* base = P + (size_t)(u.pn % ks) * part_stride + (size_t)(u.pn / ks) * BM + wc * 32 + 8 * fq;
#pragma unroll
        for (int ai = 0; ai < 2; ++ai)
#pragma unroll
            for (int m = 0; m < 4; ++m) {
                float* rowp = base + (size_t)(u.pm * BM + ai * HALF + wr * 64 + m * 16 + fr) * ldc;
#pragma unroll
                for (int bj = 0; bj < 2; ++bj) { *(f32x4*)(rowp + bj * HALF) = acc[ai][bj][m][0]; *(f32x4*)(rowp + bj * HALF + 4) = acc[ai][bj][m][1]; }
            }
    }
};

struct EpiABin {
    static constexpr bool PERM = true, AFTER_DRAIN = false;
    bf16_t *Qm, *Km, *Vm, *DNpre, *DNgate; float* ba; float* kms; const PG8_LAS float* rtab; float qscale;
    __device__ __forceinline__ void init(f32x4 (&acc)[2][2][4][2], const Unit&, int, int, int, int) const {
#pragma unroll
        for (int a = 0; a < 2; ++a)
#pragma unroll
            for (int b = 0; b < 2; ++b)
#pragma unroll
                for (int m = 0; m < 4; ++m)
#pragma unroll
                    for (int n = 0; n < 2; ++n) acc[a][b][m][n] = (f32x4){0.f, 0.f, 0.f, 0.f};
    }
    __device__ __forceinline__ void operator()(const f32x4 (&acc)[2][2][4][2], const Unit& u, int ui, int wr, int wc, int fr, int fq) const {
        const int pn = u.pn; const PG8_LAS float* rt = rtab + ui * 256;
        if (pn < 28) {
            bf16_t* base; int ld = 1024, ct; float sc = 1.0f;
            if (pn < 4) { base = Qm; ct = pn; sc = qscale; } else if (pn < 8) { base = Km; ct = pn - 4; } else if (pn < 12) { base = Vm; ct = pn - 8; }
            else if (pn < 24) { base = DNpre; ld = 3072; ct = pn - 12; } else { base = DNgate; ct = pn - 24; }
            f32x4 cs[2][2];
#pragma unroll
            for (int bj = 0; bj < 2; ++bj)
#pragma unroll
                for (int n = 0; n < 2; ++n) cs[bj][n] = (f32x4){0.f, 0.f, 0.f, 0.f};
#pragma unroll
            for (int ai = 0; ai < 2; ++ai)
#pragma unroll
                for (int m = 0; m < 4; ++m) {
                    const int rl = ai * HALF + wr * 64 + m * 16 + fr; const float rs = rt[rl] * sc;
                    bf16_t* rowp = base + (size_t)(u.pm * BM + rl) * ld + ct * BM + wc * 32 + 8 * fq;
#pragma unroll
                    for (int bj = 0; bj < 2; ++bj) { const f32x4 v0 = acc[ai][bj][m][0] * rs, v1 = acc[ai][bj][m][1] * rs; *(u32x4*)(rowp + bj * HALF) = pack8(v0, v1); cs[bj][0] += v0; cs[bj][1] += v1; }
                }
            if (pn >= 4 && pn < 8) {
#pragma unroll
                for (int bj = 0; bj < 2; ++bj)
#pragma unroll
                    for (int n = 0; n < 2; ++n) {
                        f32x4 s = cs[bj][n];
#pragma unroll
                        for (int o = 1; o < 16; o <<= 1) { s[0] += __shfl_xor(s[0], o); s[1] += __shfl_xor(s[1], o); s[2] += __shfl_xor(s[2], o); s[3] += __shfl_xor(s[3], o); }
                        if (fr == 0) *(f32x4*)(kms + (size_t)(u.pm * 2 + wr) * 1024 + (pn - 4) * BM + bj * HALF + wc * 32 + 8 * fq + 4 * n) = s;
                    }
            }
        } else {
            if (wc == 0 && fq < 2) {
#pragma unroll
                for (int ai = 0; ai < 2; ++ai)
#pragma unroll
                    for (int m = 0; m < 4; ++m) {
                        const int rl = ai * HALF + wr * 64 + m * 16 + fr; const float rs = rt[rl];
                        float* p = ba + (size_t)(u.pm * BM + rl) * 16 + 8 * fq;
                        *(f32x4*)p = acc[ai][0][m][0] * rs; *(f32x4*)(p + 4) = acc[ai][0][m][1] * rs;
                    }
            }
        }
    }
};

struct EpiCin {
    static constexpr bool PERM = true, AFTER_DRAIN = false;
    bf16_t *Cq, *Ck, *Cv, *Cg; float* Clf; const float* lb; const PG8_LAS float* rtab;
    __device__ __forceinline__ void init(f32x4 (&acc)[2][2][4][2], const Unit&, int, int, int, int) const {
#pragma unroll
        for (int a = 0; a < 2; ++a)
#pragma unroll
            for (int b = 0; b < 2; ++b)
#pragma unroll
                for (int m = 0; m < 4; ++m)
#pragma unroll
                    for (int n = 0; n < 2; ++n) acc[a][b][m][n] = (f32x4){0.f, 0.f, 0.f, 0.f};
    }
    __device__ __forceinline__ void operator()(const f32x4 (&acc)[2][2][4][2], const Unit& u, int ui, int wr, int wc, int fr, int fq) const {
        const int pn = u.pn, sec = pn >> 3, ct = pn & 7; const PG8_LAS float* rt = rtab + ui * 256;
        bf16_t* base = sec == 0 ? Cq : (sec == 1 ? Ck : (sec == 2 ? Cv : Cg));
        const int cl = ct * BM + wc * 32 + 8 * fq;
        f32x4 lbv[2][2];
        if (sec == 1) {
#pragma unroll
            for (int bj = 0; bj < 2; ++bj) { lbv[bj][0] = *(const f32x4*)(lb + cl + bj * HALF); lbv[bj][1] = *(const f32x4*)(lb + cl + bj * HALF + 4); }
        }
#pragma unroll
        for (int ai = 0; ai < 2; ++ai)
#pragma unroll
            for (int m = 0; m < 4; ++m) {
                const int rl = ai * HALF + wr * 64 + m * 16 + fr; const float rs = rt[rl];
                const size_t off = (size_t)(u.pm * BM + rl) * 2048 + cl;
#pragma unroll
                for (int bj = 0; bj < 2; ++bj) {
                    f32x4 v[2] = {acc[ai][bj][m][0] * rs, acc[ai][bj][m][1] * rs};
                    if (sec == 0) {
#pragma unroll
                        for (int n = 0; n < 2; ++n)
#pragma unroll
                            for (int e = 0; e < 4; ++e) v[n][e] = silu_f(v[n][e]) * 0.08838834764831845f;
                    } else if (sec == 1) {
                        f32x4 lf[2];
#pragma unroll
                        for (int n = 0; n < 2; ++n)
#pragma unroll
                            for (int e = 0; e < 4; ++e) {
                                const float ex = fast_exp2(v[n][e] * -1.44269504089f), r = fast_rcp(1.0f + ex), l = lbv[bj][n][e];
                                lf[n][e] = __logf(l + (1.0f - l) * r); v[n][e] = (1.0f - l) * ex * r;
                            }
                        *(f32x4*)(Clf + off + bj * HALF) = lf[0]; *(f32x4*)(Clf + off + bj * HALF + 4) = lf[1];
                    }
                    *(u32x4*)(base + off + bj * HALF) = pack8(v[0], v[1]);
                }
            }
    }
};
#ifndef PG8_KROT
#define PG8_KROT 0
#endif
template <class Epi, class Sched, bool ALIGN_EPI = false, bool SP2 = false, int PM = 0, bool HM = false, bool F16 = false, bool AIMG = false>
__device__ __forceinline__ void gemm_phase(PG8_LAS unsigned char* lds, const Gemm g, const Sched& S, const Epi& E) {
    int tid_ = threadIdx.x; asm volatile("" : "+v"(tid_));
    const int tid = tid_, wid = __builtin_amdgcn_readfirstlane(tid >> 6), lane = tid & 63, wr = wid >> 2, wc = wid & 3, fr = lane & 15, fq = lane >> 4;
    const int K = g.K, nt = K / BK, ld = g.ld, ks = g.ks;
    unsigned voffA[2], voffB[2];
#pragma unroll
    for (int i = 0; i < 2; ++i) { int R, C; stage_rc(tid * 16 + i * 8192, R, C); const int Rb = Epi::PERM ? ((R & ~31) + perm32(R & 31)) : R;
        voffA[i] = AIMG ? (unsigned)(((R >> 4) * (ld >> 5) + (C >> 5)) * 1024 + (lds_byte(R, C) & 1023)) : (unsigned)(R * ld + C) * 2u; voffB[i] = BIMG ? (unsigned)(((R >> 4) * (ld >> 5) + (C >> 5)) * 1024 + (lds_byte(R, C) & 1023)) : (unsigned)(Rb * ld + C) * 2u; }
    const size_t kstep = AIMG ? (size_t)2048 : (size_t)(BK * 2), kstepB = BIMG ? (size_t)2048 : (size_t)(BK * 2);
    const size_t hstep = (size_t)HALF * ld * 2;
    const size_t tstep = 2 * hstep;
    const unsigned ldsw = (unsigned)wid * 1024u;
    const int aoff = lds_byte(wr * 64 + fr, fq * 8), boff = lds_byte(wc * 32 + fr, fq * 8);
#define PG8_SA(b, h) (((b) * 2 + (h)) * HTB)
#define PG8_SB(b, h) ((4 + (b) * 2 + (h)) * HTB)
#define PG8_STAGE(bufoff, gbase, voff) do { _Pragma("unroll") for (int _i = 0; _i < 2; ++_i) \
        __builtin_amdgcn_global_load_lds((const unsigned*)((const char*)(gbase) + (voff)[_i]), (PG8_LAS unsigned*)(lds + (bufoff) + ldsw + _i * 8192), 16, 0, 0); } while (0)
#define PG8_LDA(dst, b, h) do { _Pragma("unroll") for (int m = 0; m < 4; ++m) _Pragma("unroll") for (int k = 0; k < 2; ++k) dst[m][k] = *(const PG8_LAS bf16x8*)(lds + PG8_SA(b, h) + aoff + m * 2048 + k * 1024); } while (0)
#define PG8_LDB(dst, b, h) do { _Pragma("unroll") for (int n = 0; n < 2; ++n) _Pragma("unroll") for (int k = 0; k < 2; ++k) dst[n][k] = *(const PG8_LAS bf16x8*)(lds + PG8_SB(b, h) + boff + n * 2048 + k * 1024); } while (0)
#define PG8_MMA(ai, bj, At, Bt) do { __builtin_amdgcn_s_setprio(1); _Pragma("unroll") for (int m = 0; m < 4; ++m) _Pragma("unroll") for (int n = 0; n < 2; ++n) _Pragma("unroll") for (int k = 0; k < 2; ++k) \
        { if constexpr (F16) acc[ai][bj][m][n] = __builtin_amdgcn_mfma_f32_16x16x32_f16(__builtin_bit_cast(f16x8, Bt[n][k]), __builtin_bit_cast(f16x8, At[m][k]), acc[ai][bj][m][n], 0, 0, 0); \
          else acc[ai][bj][m][n] = __builtin_amdgcn_mfma_f32_16x16x32_bf16(Bt[n][k], At[m][k], acc[ai][bj][m][n], 0, 0, 0); } __builtin_amdgcn_s_setprio(0); } while (0)
#define PG8_STAGE_L(bufoff, gbase, voff) do { if constexpr (PM != 1) PG8_STAGE(bufoff, gbase, voff); } while (0)
#define PG8_MMA_L(ai, bj, At, Bt) do { if constexpr (PM != 2) PG8_MMA(ai, bj, At, Bt); } while (0)
#define PG8_WAIT_V(n) asm volatile("s_waitcnt vmcnt(" #n ")" ::: "memory")
#define PG8_WAIT_L(n) asm volatile("s_waitcnt lgkmcnt(" #n ")" ::: "memory")
#define PG8_BAR __builtin_amdgcn_s_barrier()
#define PG8_SCHED __builtin_amdgcn_sched_barrier(0)
    Unit cur, nxt; int ui = 0;
    if (!S.next(0, cur)) return;
    f32x4 acc[2][2][4][2];
    E.init(acc, cur, wr, wc, fr, fq);
    bf16x8 At[4][2], B0[2][2], B1[2][2];
    const char* cA = (const char*)g.A + (size_t)cur.pm * tstep + (size_t)(cur.pn % ks) * K * 2 + (HM ? (size_t)cur.half * hstep : 0); const char* cB = (const char*)g.Bt + (size_t)(cur.pn / ks) * tstep + (size_t)(cur.pn % ks) * K * 2;
    int koff = PG8_KROT ? (PG8_KROT * (cur.pm + cur.pn)) % nt : 0;
    S.a_ready(cur);
    const char* cA0 = cA + (size_t)koff * kstep; const char* cB0 = cB + (size_t)koff * kstepB; const long k1d = (koff + 1 >= nt) ? -(long)koff * (long)kstep : (long)kstep, k1dB = (koff + 1 >= nt) ? -(long)koff * (long)kstepB : (long)kstepB;
    if constexpr (SP2) {
        static_assert(!HM || SP2, "HM needs the SP2 loop");
        PG8_STAGE(PG8_SB(0, 0), cB0, voffB); PG8_STAGE(PG8_SB(0, 1), cB0 + hstep, voffB); PG8_STAGE(PG8_SA(0, 0), cA0, voffA); if constexpr (!HM) PG8_STAGE(PG8_SA(0, 1), cA0 + hstep, voffA);
        if (wr == 1) PG8_BAR;
        if constexpr (HM) PG8_WAIT_V(0); else PG8_WAIT_V(2);
        PG8_BAR;
        PG8_STAGE(PG8_SB(1, 0), cB0 + k1dB, voffB); PG8_STAGE(PG8_SA(1, 0), cA0 + k1d, voffA); PG8_STAGE(PG8_SB(1, 1), cB0 + hstep + k1dB, voffB);
        PG8_WAIT_V(6); PG8_BAR;
    } else {
        PG8_STAGE(PG8_SB(0, 0), cB0, voffB); PG8_STAGE(PG8_SA(0, 0), cA0, voffA); PG8_STAGE(PG8_SB(0, 1), cB0 + hstep, voffB); PG8_STAGE(PG8_SA(0, 1), cA0 + hstep, voffA);
        if (wr == 1) PG8_BAR;
        PG8_WAIT_V(4); PG8_BAR;
        PG8_STAGE(PG8_SB(1, 0), cB0 + k1dB, voffB); PG8_STAGE(PG8_SA(1, 0), cA0 + k1d, voffA); PG8_STAGE(PG8_SB(1, 1), cB0 + hstep + k1dB, voffB);
        PG8_WAIT_V(6); PG8_BAR;
    }
    for (;;) {
        const bool has_next = S.next(ui + 1, nxt);
        const char* nA = has_next ? (const char*)g.A + (size_t)nxt.pm * tstep + (size_t)(nxt.pn % ks) * K * 2 + (HM ? (size_t)nxt.half * hstep : 0) : cA; const char* nB = has_next ? (const char*)g.Bt + (size_t)(nxt.pn / ks) * tstep + (size_t)(nxt.pn % ks) * K * 2 : cB;
        const int koffN = (PG8_KROT && has_next) ? (PG8_KROT * (nxt.pm + nxt.pn)) % nt : koff;
        int e0 = koff;
        for (int t = 0; t < nt; t += 2) {
            const bool last = (t == nt - 2);
            const int e1 = (e0 + 1 >= nt) ? e0 + 1 - nt : e0 + 1, e2 = (e0 + 2 >= nt) ? e0 + 2 - nt : e0 + 2, e3 = (e2 + 1 >= nt) ? 0 : e2 + 1, n1 = (koffN + 1 >= nt) ? 0 : koffN + 1;
            const char* a1 = cA + (size_t)e1 * kstep;
            const char* a2 = last ? nA + (size_t)koffN * kstep : cA + (size_t)e2 * kstep; const char* b2 = last ? nB + (size_t)koffN * kstepB : cB + (size_t)e2 * kstepB;
            const char* a3 = last ? nA + (size_t)n1 * kstep : cA + (size_t)e3 * kstep; const char* b3 = last ? nB + (size_t)n1 * kstepB : cB + (size_t)e3 * kstepB;
            e0 = e2;
            if (last && has_next) S.a_ready(nxt);
            if constexpr (SP2) {
#define PG8_WAIT_VL() do { if constexpr (HM) PG8_WAIT_V(6); else PG8_WAIT_V(8); } while (0)
            PG8_LDB(B0, 0, 0); PG8_LDB(B1, 0, 1); PG8_SCHED; PG8_LDA(At, 0, 0); if constexpr (!HM) PG8_STAGE_L(PG8_SA(1, 1), a1 + hstep, voffA);
            PG8_WAIT_VL(); PG8_WAIT_L(0); PG8_BAR; PG8_MMA_L(0, 0, At, B0); PG8_MMA_L(0, 1, At, B1); PG8_BAR; PG8_SCHED;
            if constexpr (!HM) PG8_LDA(At, 0, 1); PG8_STAGE_L(PG8_SB(0, 0), b2, voffB); PG8_STAGE_L(PG8_SB(0, 1), b2 + hstep, voffB); PG8_STAGE_L(PG8_SA(0, 0), a2, voffA);
            PG8_WAIT_VL(); PG8_WAIT_L(0); PG8_BAR; if constexpr (!HM) { PG8_MMA_L(1, 0, At, B0); PG8_MMA_L(1, 1, At, B1); } PG8_BAR; PG8_SCHED;
            PG8_LDB(B0, 1, 0); PG8_LDB(B1, 1, 1); PG8_SCHED; PG8_LDA(At, 1, 0); if constexpr (!HM) PG8_STAGE_L(PG8_SA(0, 1), a2 + hstep, voffA);
            PG8_WAIT_VL(); PG8_WAIT_L(0); PG8_BAR; PG8_MMA_L(0, 0, At, B0); PG8_MMA_L(0, 1, At, B1); PG8_BAR; PG8_SCHED;
            if constexpr (!HM) PG8_LDA(At, 1, 1); PG8_STAGE_L(PG8_SB(1, 0), b3, voffB); PG8_STAGE_L(PG8_SB(1, 1), b3 + hstep, voffB); PG8_STAGE_L(PG8_SA(1, 0), a3, voffA);
            PG8_WAIT_VL(); PG8_WAIT_L(0); PG8_BAR; if constexpr (!HM) { PG8_MMA_L(1, 0, At, B0); PG8_MMA_L(1, 1, At, B1); } PG8_BAR; PG8_SCHED;
#undef PG8_WAIT_VL
            } else {
            PG8_LDB(B0, 0, 0); PG8_SCHED; PG8_LDA(At, 0, 0); PG8_STAGE_L(PG8_SA(1, 1), a1 + hstep, voffA);
            PG8_WAIT_L(8); PG8_BAR; PG8_WAIT_L(0); PG8_MMA_L(0, 0, At, B0); PG8_BAR; PG8_SCHED;
            PG8_LDB(B1, 0, 1); PG8_STAGE_L(PG8_SB(0, 0), b2, voffB);
            PG8_BAR; PG8_WAIT_L(0); PG8_MMA_L(0, 1, At, B1); PG8_BAR;
            PG8_LDA(At, 0, 1); PG8_STAGE_L(PG8_SA(0, 0), a2, voffA);
            PG8_BAR; PG8_WAIT_L(0); PG8_MMA_L(1, 0, At, B0); PG8_BAR; PG8_SCHED;
            PG8_STAGE_L(PG8_SB(0, 1), b2 + hstep, voffB);
            PG8_WAIT_V(6); PG8_BAR; PG8_MMA_L(1, 1, At, B1); PG8_BAR;
            PG8_LDB(B0, 1, 0); PG8_SCHED; PG8_LDA(At, 1, 0); PG8_STAGE_L(PG8_SA(0, 1), a2 + hstep, voffA);
            PG8_WAIT_L(8); PG8_BAR; PG8_WAIT_L(0); PG8_MMA_L(0, 0, At, B0); PG8_BAR; PG8_SCHED;
            PG8_LDB(B1, 1, 1); PG8_STAGE_L(PG8_SB(1, 0), b3, voffB);
            PG8_BAR; PG8_WAIT_L(0); PG8_MMA_L(0, 1, At, B1); PG8_BAR;
            PG8_LDA(At, 1, 1); PG8_STAGE_L(PG8_SA(1, 0), a3, voffA);
            PG8_BAR; PG8_WAIT_L(0); PG8_MMA_L(1, 0, At, B0); PG8_BAR; PG8_SCHED;
            PG8_STAGE_L(PG8_SB(1, 1), b3 + hstep, voffB);
            PG8_WAIT_V(6); PG8_BAR; PG8_MMA_L(1, 1, At, B1); PG8_BAR;
            }
        }
        if constexpr (ALIGN_EPI) { if (wr == 0) PG8_BAR; }
        if constexpr (!Epi::AFTER_DRAIN) { E(acc, cur, ui, wr, wc, fr, fq); S.done(cur); }
        if (!has_next) break;
        cur = nxt; cA = nA; cB = nB; koff = koffN; ++ui;
        E.init(acc, cur, wr, wc, fr, fq);
        if constexpr (ALIGN_EPI) { if (wr == 1) PG8_BAR; }
    }
    PG8_WAIT_V(0);
    if constexpr (!ALIGN_EPI) { if (wr == 0) PG8_BAR; }
    PG8_BAR;
    if constexpr (Epi::AFTER_DRAIN) { E.fused(acc, cur, wr, wc, fr, fq, lds, wid, lane); S.done(cur); }
#undef PG8_SA
#undef PG8_SB
#undef PG8_STAGE
#undef PG8_STAGE_L
#undef PG8_MMA_L
#undef PG8_LDA
#undef PG8_LDB
#undef PG8_MMA
#undef PG8_WAIT_V
#undef PG8_WAIT_L
#undef PG8_BAR
#undef PG8_SCHED
}
}

constexpr int BATCH = 2, SEQ = 4096, D = 2048, DEPTH = 4, M = BATCH * SEQ;
constexpr int DFF = 5504, NFF = 2 * DFF;
constexpr int AB_IN = 7184, AB_PAD = 7424;
constexpr int HD = 128, NH_AB = 8, NH_C = 16, MEMT = 256, XW = 512, NBLK = SEQ / 256;
constexpr float EPS = 1e-6f;
constexpr float QK_SCALE_LOG2E = 0.08838834764831845f * 1.4426950408889634f;
constexpr int NWAVES = 8;

constexpr size_t MiB = 1u << 20;
constexpr size_t WS_CTL = 0, CTL_ZERO_BYTES = 1 * MiB;
constexpr size_t WS_X = 1 * MiB, WS_XB = 65 * MiB, WS_ROWSS = 97 * MiB, WS_ACT = 98 * MiB;
constexpr size_t WS_W1T = 184 * MiB, WS_W2T = 528 * MiB, WS_WABT = 700 * MiB, WS_WABOT = 758 * MiB, WS_WCT = 774 * MiB, WS_WCOT = 838 * MiB, WS_WXQT = 854 * MiB, WS_WXKVT = 862 * MiB, WS_WXOT = 878 * MiB;
constexpr size_t WS_MIX = 886 * MiB;
constexpr size_t WS_QM = WS_MIX, WS_KM = WS_MIX + 16 * MiB, WS_VM = WS_MIX + 32 * MiB, WS_DNPRE = WS_MIX + 48 * MiB, WS_DNGATE = WS_MIX + 96 * MiB, WS_BA = WS_MIX + 112 * MiB, WS_KMS = WS_MIX + 113 * MiB,
                 WS_DQ = WS_MIX + 114 * MiB, WS_DK = WS_MIX + 146 * MiB, WS_DV = WS_MIX + 178 * MiB, WS_BG = WS_MIX + 210 * MiB, WS_DNO = WS_MIX + 211 * MiB;
constexpr size_t WS_CQ = WS_MIX, WS_CK = WS_MIX + 32 * MiB, WS_CV = WS_MIX + 64 * MiB, WS_CG = WS_MIX + 96 * MiB, WS_CLF = WS_MIX + 128 * MiB, WS_CO = WS_MIX + 192 * MiB;
constexpr size_t WS_Y = WS_MIX + 256 * MiB, WS_XQ = WS_Y + 32 * MiB, WS_XO = WS_XQ + 8 * MiB, WS_MEMN = WS_XO + 8 * MiB, WS_KV = WS_MEMN + 2 * MiB, WS_LB = WS_KV + 4 * MiB, WS_END = WS_LB + 1 * MiB;
static_assert(WS_W1T + (size_t)8 * NFF * D * 2 <= WS_W2T && WS_W2T + (size_t)8 * D * DFF * 2 <= WS_WABT && WS_WABT + (size_t)2 * AB_PAD * D * 2 <= WS_WABOT && WS_ACT + (size_t)M * DFF * 2 <= WS_W1T, "ws map");
constexpr int CW_TMO = 0, CW_CODE = 1, CW_BAR = 4096;

constexpr int RING_OFF = 0, RING_BYTES = 131072;
constexpr int RTAB_OFF = RING_BYTES, RTAB_BYTES = 8 * 1024;
constexpr int LDSCTL_OFF = RTAB_OFF + RTAB_BYTES, MISC_OFF = LDSCTL_OFF + 320;
constexpr int LDS_BYTES = 147456;
static_assert(MISC_OFF + 128 <= LDS_BYTES, "LDS map");
#define GAS __attribute__((address_space(1)))
#define LAS __attribute__((address_space(3)))
typedef unsigned short bf16;
typedef unsigned v4u __attribute__((ext_vector_type(4)));
typedef float f32x4 __attribute__((ext_vector_type(4)));
typedef short bf16x8 __attribute__((ext_vector_type(8)));
typedef GAS unsigned gu32;
typedef GAS unsigned long long gu64;
#define RLX_AGENT __ATOMIC_RELAXED, __HIP_MEMORY_SCOPE_AGENT
#define LDS_WAIT() asm volatile("s_waitcnt lgkmcnt(0)" ::: "memory")
#define VM_WAIT() asm volatile("s_waitcnt vmcnt(0)" ::: "memory")
__device__ __forceinline__ unsigned long long rt() { return __builtin_amdgcn_s_memrealtime(); }
__device__ __forceinline__ unsigned f2bf(float f) { unsigned u = __builtin_bit_cast(unsigned, f); return (u + 0x7fffu + ((u >> 16) & 1u)) >> 16; }
__device__ __forceinline__ unsigned pk2(float lo, float hi) { return f2bf(lo) | (f2bf(hi) << 16); }
#define XB_TMO      128
#define XB_XCNT(j)  (256  + 64 * (j))
#define XB_XSUB(j)  (1280 + 64 * (j))
#define XB_XGEN(j)  (2304 + 64 * (j))
#define XB_TOP      3328
#define XB_TOPGEN   3392
#define XCD_BAR_WORDS 3456
#define XB_SPIN_CAP (1u << 18)

__device__ __forceinline__ unsigned xb_ld(unsigned* p)              { return __hip_atomic_load(p, __ATOMIC_RELAXED, __HIP_MEMORY_SCOPE_AGENT); }
__device__ __forceinline__ unsigned xb_add(unsigned* p, unsigned v) { return __hip_atomic_fetch_add(p, v, __ATOMIC_RELAXED, __HIP_MEMORY_SCOPE_AGENT); }
__device__ __forceinline__ unsigned xb_xcc_id() { return (unsigned)__builtin_amdgcn_s_getreg((3 << 11) | 20) & 0xFu; }
#define XB_SPIN(cond, bar) do { unsigned _sp = 0; while (cond) { __builtin_amdgcn_s_sleep(1); \
    if ((++_sp & 255u) == 0u) { if (xb_ld(&(bar)[XB_TMO])) break; if (_sp > XB_SPIN_CAP) { atomicAdd(&(bar)[XB_TMO], 1u); break; } } } } while (0)

struct XcdBarrier {
    unsigned* bar; unsigned x;
    volatile LAS unsigned* st;
};

__device__ __forceinline__ XcdBarrier xcd_barrier_post(unsigned* bar, volatile LAS unsigned* st) {
    XcdBarrier b; b.bar = bar; b.x = xb_xcc_id(); b.st = st;
    if (threadIdx.x == 0) (void)xb_add(&bar[XB_XCNT(b.x)], 1u);
    return b;
}
__device__ __forceinline__ void xcd_barrier_complete(unsigned* bar, unsigned x, unsigned& nloc, unsigned& nx) {
    const unsigned G = gridDim.x * gridDim.y * gridDim.z;
    unsigned sum, cnt, mine, sp = 0u;
    for (;;) {
        sum = 0u; cnt = 0u; mine = 0u;
#pragma unroll
        for (unsigned j = 0; j < 16; ++j) { const unsigned c = xb_ld(&bar[XB_XCNT(j)]); sum += c; cnt += (c > 0u) ? 1u : 0u; mine = (j == x) ? c : mine; }
        if (sum == G) break;
        __builtin_amdgcn_s_sleep(1);
        if ((++sp & 255u) == 0u) { if (xb_ld(&bar[XB_TMO])) break; if (sp > XB_SPIN_CAP) { atomicAdd(&bar[XB_TMO], 1u); break; } }
    }
    nloc = mine > 0u ? mine : 1u; nx = cnt > 0u ? cnt : 1u;
}

__device__ __forceinline__ void xcd_barrier(const XcdBarrier& b) {
    asm volatile("s_waitcnt vmcnt(0)" ::: "memory");
    __syncthreads();
    if (threadIdx.x == 0) {
        GAS unsigned* bar_g = (GAS unsigned*)b.bar; asm volatile("" : "+s"(bar_g)); unsigned* bar = (unsigned*)bar_g;
        __builtin_amdgcn_s_waitcnt(0);
        unsigned nloc = b.st[0], nx = b.st[1];
        if (nloc == 0u) { xcd_barrier_complete(bar, b.x, nloc, nx); b.st[0] = nloc; b.st[1] = nx; }
        const unsigned old = xb_add(&bar[XB_XSUB(b.x)], 1u);
        const unsigned gen = old / nloc;
        if (old + 1u == (gen + 1u) * nloc) {
            __builtin_amdgcn_fence(__ATOMIC_RELEASE, "agent");
            asm volatile("s_waitcnt vmcnt(0)" ::: "memory");
            const unsigned og = xb_add(&bar[XB_TOP], 1u);
            const unsigned tg = og / nx;
            if (og + 1u == (tg + 1u) * nx) xb_add(&bar[XB_TOPGEN], 1u);
            else XB_SPIN(xb_ld(&bar[XB_TOPGEN]) == tg, bar);
            __builtin_amdgcn_fence(__ATOMIC_ACQUIRE, "agent");
            xb_add(&bar[XB_XGEN(b.x)], 1u);
            asm volatile("s_waitcnt vmcnt(0)" ::: "memory");
        } else {
            XB_SPIN(xb_ld(&bar[XB_XGEN(b.x)]) == gen, bar);
            __builtin_amdgcn_fence(__ATOMIC_ACQUIRE, "agent");
            asm volatile("s_waitcnt vmcnt(0)" ::: "memory");
        }
    }
    __syncthreads();
}

struct Frame {
    LAS unsigned char* lds;
    volatile LAS unsigned* MISC;
    gu32* ctl;
    int tid, lane, wave, G, bx;
    const __attribute__((address_space(4))) unsigned long long* ka;
    float* out; GAS unsigned char* ws;
};
#define FIN(i) ((const float*)(const GAS float*)F.ka[i])
enum { I_X = 0, I_MEM, I_NORMG, I_MEMG, I_FINALG, I_FFN_WIN, I_FFN_WOUT, I_AB_WIN, I_AB_CONVW, I_AB_ALOG, I_AB_DTB, I_AB_ONG, I_AB_WOUT, I_C_WIN, I_C_LBL, I_C_ONG, I_C_WOUT, I_X_WQ, I_X_WKV, I_X_WO };

__device__ __forceinline__ int opaque_i(int v) { asm volatile("" : "+v"(v)); return v; }
#define PHASE_IDS() const int tid = opaque_i(F.tid), lane = tid & 63, wave = __builtin_amdgcn_readfirstlane(tid >> 6); (void)lane; (void)wave
__device__ __forceinline__ float wave_sum(float v) {
#pragma unroll
    for (int o = 1; o < 64; o <<= 1) v += __shfl_xor(v, o);
    return v;
}
__device__ __forceinline__ float wave_max(float v) {
#pragma unroll
    for (int o = 1; o < 64; o <<= 1) v = fmaxf(v, __shfl_xor(v, o));
    return v;
}
__device__ __forceinline__ float bflo(unsigned w) { return __uint_as_float(w << 16); }
__device__ __forceinline__ float bfhi(unsigned w) { return __uint_as_float(w & 0xffff0000u); }
__device__ __forceinline__ float sigmoid_f(float a) { return 1.0f / (1.0f + __expf(-a)); }
__device__ __forceinline__ float silu_acc(float a) { return a / (1.0f + __expf(-a)); }

__device__ __forceinline__ void conv_tile(const float* src, bf16* dst, int K, int N, int mode, const float* gain, int kb, int nb, int wave, int lane) {
    const int k0 = kb * 128 + wave * 16, n = nb * 256 + lane * 4;
    if (n >= N) return;
    const bool xw = X_F16 == 1 && gain != nullptr;
    f32x4 v[16];
#pragma unroll
    for (int r = 0; r < 16; ++r) v[r] = *(const GAS f32x4*)(src + (size_t)(k0 + r) * N + n);
    if (gain) {
#pragma unroll
        for (int r = 0; r < 16; ++r) v[r] = v[r] * gain[k0 + r];
    }
#pragma unroll
    for (int e = 0; e < 4; ++e) {
        const int col = n + e; int drow = col;
        if (mode == 1) { const int half = col >= DFF ? 1 : 0, j = col - half * DFF; drow = (j >> 7) * 256 + half * 128 + (j & 127); }
        v4u w0, w1;
#define CV2(a_, b_) (xw ? pg8::cvt_pk_f16(a_, b_) : pg8::cvt_pk_bf16(a_, b_))
        w0.x = CV2(v[0][e], v[1][e]); w0.y = CV2(v[2][e], v[3][e]); w0.z = CV2(v[4][e], v[5][e]); w0.w = CV2(v[6][e], v[7][e]);
        w1.x = CV2(v[8][e], v[9][e]); w1.y = CV2(v[10][e], v[11][e]); w1.z = CV2(v[12][e], v[13][e]); w1.w = CV2(v[14][e], v[15][e]);
#undef CV2
        GAS v4u* o = BIMG ? (GAS v4u*)((GAS char*)dst + pg8::img_off(pg8::slot32(drow), k0, K)) : (GAS v4u*)(dst + (size_t)drow * K + k0);
        o[0] = w0; o[1] = w1;
    }
}
constexpr int IT_W1M = 16 * 43, IT_W2M = 43 * 8;
__device__ __forceinline__ int conv_family_tiles(int fam) { return fam == 0 ? IT_W1M + IT_W2M : (fam == 1 ? 16 * 29 + 16 * 8 : (fam == 2 ? 16 * 32 + 16 * 8 : (fam == 3 ? 64 : 256))); }
__device__ __forceinline__ void conv_family_item(Frame& F, int fam, int m, int r, int wave, int lane) {
    const float* normg = FIN(I_NORMG); const float* src; bf16* dst; const float* gain = nullptr; int K = D, N = D, mode = 0, kb, nb;
    if (fam == 0) {
        if (r < IT_W1M) { kb = r / 43; nb = r - kb * 43; src = FIN(I_FFN_WIN) + (size_t)m * D * NFF; dst = (bf16*)(F.ws + WS_W1T) + (size_t)m * NFF * D; N = NFF; mode = 1; gain = normg + (size_t)((m >> 1) * 4 + ((m & 1) ? 3 : 0)) * D; }
        else { r -= IT_W1M; kb = r >> 3; nb = r & 7; src = FIN(I_FFN_WOUT) + (size_t)m * DFF * D; dst = (bf16*)(F.ws + WS_W2T) + (size_t)m * D * DFF; K = DFF; }
    } else if (fam == 1) {
        if (r < 16 * 29) { kb = r / 29; nb = r - kb * 29; src = FIN(I_AB_WIN) + (size_t)m * D * AB_IN; dst = (bf16*)(F.ws + WS_WABT) + (size_t)m * AB_PAD * D; N = AB_IN; gain = normg + (size_t)((2 * m) * 4 + 1) * D; }
        else { r -= 16 * 29; kb = r >> 3; nb = r & 7; src = FIN(I_AB_WOUT) + (size_t)m * D * D; dst = (bf16*)(F.ws + WS_WABOT) + (size_t)m * D * D; }
    } else if (fam == 2) {
        if (r < 16 * 32) { kb = r >> 5; nb = r & 31; src = FIN(I_C_WIN) + (size_t)m * D * 4 * D; dst = (bf16*)(F.ws + WS_WCT) + (size_t)m * 4 * D * D; N = 4 * D; gain = normg + (size_t)((2 * m + 1) * 4 + 1) * D; }
        else { r -= 16 * 32; kb = r >> 3; nb = r & 7; src = FIN(I_C_WOUT) + (size_t)m * D * D; dst = (bf16*)(F.ws + WS_WCOT) + (size_t)m * D * D; }
    } else if (fam == 3) {
        if (r < 32) { kb = r >> 1; nb = r & 1; src = FIN(I_X_WQ) + (size_t)m * D * XW; dst = (bf16*)(F.ws + WS_WXQT) + (size_t)m * XW * D; N = XW; gain = normg + (size_t)(m * 4 + 2) * D; }
        else { r -= 32; kb = r >> 3; nb = r & 7; src = FIN(I_X_WO) + (size_t)m * XW * D; dst = (bf16*)(F.ws + WS_WXOT) + (size_t)m * D * XW; K = XW; }
    } else { const int mat = r >> 6, q = r & 63; kb = q >> 2; nb = q & 3; src = FIN(I_X_WKV) + (size_t)mat * D * 2 * XW; dst = (bf16*)(F.ws + WS_WXKVT) + (size_t)mat * 2 * XW * D; N = 2 * XW; }
    conv_tile(src, dst, K, N, mode, gain, kb, nb, wave, lane);
}
__device__ __forceinline__ void conv_family(Frame& F, int fam, int m, int first, int skip_lo = 0, int skip_hi = 0, int part = 0) {
    if (F.bx < first || (F.bx >= skip_lo && F.bx < skip_hi)) return;
    PHASE_IDS();
    const int nall = conv_family_tiles(fam), r0 = part == 2 ? nall / 2 : 0, nt = part == 1 ? nall / 2 : nall, vb = F.bx - first - (F.bx >= skip_hi ? skip_hi - skip_lo : 0), nb = F.G - first - (skip_hi - skip_lo);
    for (int r = r0 + vb; r < nt; r += nb) conv_family_item(F, fam, m, r, wave, lane);
    if (part == 2) return;
    if (fam == 1) {
        constexpr int PADV = (AB_PAD - AB_IN) * (D / 16);
        for (int i = vb * 512 + tid; i < PADV; i += nb * 512) { const int c = AB_IN + i / (D / 16), k0 = (i % (D / 16)) * 16;
            GAS v4u* o = BIMG ? (GAS v4u*)(F.ws + WS_WABT + (size_t)m * AB_PAD * D * 2 + pg8::img_off(pg8::slot32(c), k0, D)) : (GAS v4u*)(F.ws + WS_WABT + ((size_t)m * AB_PAD + c) * D * 2 + k0 * 2); o[0] = (v4u){0u, 0u, 0u, 0u}; o[1] = (v4u){0u, 0u, 0u, 0u}; }
    }
}

constexpr int CQ_NSEG = 17;
__device__ __forceinline__ void conv_queue_tile(Frame& F, int t, int wave, int lane, int tid) {
    int fam = 0, m = 0, base = 0;
#define CQ_SEG(f_, m_, n_) if (t >= base + (n_)) base += (n_); else { fam = (f_); m = (m_); goto found; }
    CQ_SEG(0, 0, 1032) CQ_SEG(1, 0, 592) CQ_SEG(4, 0, 256) CQ_SEG(3, 0, 64) CQ_SEG(0, 1, 1032) CQ_SEG(0, 2, 1032) CQ_SEG(2, 0, 640) CQ_SEG(3, 1, 64) CQ_SEG(0, 3, 1032)
    CQ_SEG(0, 4, 1032) CQ_SEG(1, 1, 592) CQ_SEG(3, 2, 64) CQ_SEG(0, 5, 1032) CQ_SEG(0, 6, 1032) CQ_SEG(2, 1, 640) CQ_SEG(3, 3, 64) CQ_SEG(0, 7, 1032)
    return;
#undef CQ_SEG
found:
    const int r = t - base;
    conv_family_item(F, fam, m, r, wave, lane);
    if (fam == 1 && r == 0) {
        constexpr int PADV = (AB_PAD - AB_IN) * (D / 16);
        for (int i2 = tid; i2 < PADV; i2 += NWAVES * 64) { const int c = AB_IN + i2 / (D / 16), k0 = (i2 % (D / 16)) * 16;
            GAS v4u* o = BIMG ? (GAS v4u*)(F.ws + WS_WABT + (size_t)m * AB_PAD * D * 2 + pg8::img_off(pg8::slot32(c), k0, D)) : (GAS v4u*)(F.ws + WS_WABT + ((size_t)m * AB_PAD + c) * D * 2 + k0 * 2); o[0] = (v4u){0u, 0u, 0u, 0u}; o[1] = (v4u){0u, 0u, 0u, 0u}; }
    }
}
constexpr int CQ_TOTAL = 11232, CW_CONVQ = 2048;
__device__ __forceinline__ int cq_n_ffn(int s) { return s == 0 ? 1032 : s == 1 ? 2976 : s == 2 ? 4008 : s == 3 ? 5744 : s == 4 ? 6776 : s == 5 ? 8464 : s == 6 ? 9496 : 11232; }
__device__ __forceinline__ int cq_n_mix(int l) { return l == 0 ? 1624 : l == 1 ? 4648 : l == 2 ? 7368 : 10136; }
__device__ __forceinline__ int cq_n_x(int l) { return l == 0 ? 1944 : l == 1 ? 4712 : l == 2 ? 7432 : 10200; }
__device__ __forceinline__ unsigned cq_bcast(Frame& F, unsigned v, int tid) { __syncthreads(); if (tid == 0) F.MISC[20] = v; __syncthreads(); return F.MISC[20]; }
__device__ __forceinline__ void conv_slot(Frame& F, int first, int quota, int skip_lo = 0, int skip_hi = 0) {
    if (F.bx < first || (F.bx >= skip_lo && F.bx < skip_hi)) return;
    PHASE_IDS();
    gu32* q = F.ctl + CW_CONVQ;
    unsigned tk = 0u; if (tid == 0) tk = __hip_atomic_fetch_add(q, 1u, RLX_AGENT);
    for (int i = 0; i < quota; ++i) {
        const unsigned t = cq_bcast(F, tk, tid);
        if (t >= (unsigned)CQ_TOTAL) break;
        if (tid == 0 && i + 1 < quota) tk = __hip_atomic_fetch_add(q, 1u, RLX_AGENT);
        conv_queue_tile(F, (int)t, wave, lane, tid);
    }
}
__device__ __forceinline__ void conv_deadline(Frame& F, int need) {
    PHASE_IDS();
    gu32* q = F.ctl + CW_CONVQ;
    for (;;) {
        unsigned cur = 0u; if (tid == 0) cur = __hip_atomic_load(q, RLX_AGENT);
        if (cq_bcast(F, cur, tid) >= (unsigned)need) break;
        unsigned tk = 0u; if (tid == 0) tk = __hip_atomic_fetch_add(q, 1u, RLX_AGENT);
        const unsigned t = cq_bcast(F, tk, tid);
        if (t < (unsigned)CQ_TOTAL) conv_queue_tile(F, (int)t, wave, lane, tid);
    }
}

__device__ __forceinline__ void p0_prologue(Frame& F) {
    PHASE_IDS();
    conv_deadline(F, cq_n_ffn(0));
    const int gw = F.bx * NWAVES + wave, NGW = F.G * NWAVES;
    {
        const float* x = FIN(I_X); bf16* xb = (bf16*)(F.ws + WS_XB); float* rowss = (float*)(F.ws + WS_ROWSS);
        for (int m = gw; m < M; m += NGW) {
            const GAS f32x4* xr = (const GAS f32x4*)(x + (size_t)m * D) + lane; f32x4 v[8]; float ss = 0.f;
#pragma unroll
            for (int j = 0; j < 8; ++j) { v[j] = xr[64 * j]; ss += (v[j][0] * v[j][0] + v[j][1] * v[j][1]) + (v[j][2] * v[j][2] + v[j][3] * v[j][3]); }
            ss = wave_sum(ss);
            GAS pg8::u32x2* o = (GAS pg8::u32x2*)(xb + (size_t)m * D) + lane;
#pragma unroll
            for (int j = 0; j < 8; ++j) { pg8::u32x2 w; w.x = pg8::cvt_pk_x(v[j][0], v[j][1]); w.y = pg8::cvt_pk_x(v[j][2], v[j][3]);
                if (AIMG_XB) *(GAS pg8::u32x2*)((GAS char*)xb + pg8::img_off(m, 4 * lane + 256 * j, D)) = w; else o[64 * j] = w; }
            if (lane < 32) rowss[(size_t)lane * M + m] = lane == 0 ? ss : 0.f;
        }
    }
    {
        const float* mem = FIN(I_MEM); const float* mg = FIN(I_MEMG); bf16* mn = (bf16*)(F.ws + WS_MEMN);
        for (int m = gw; m < BATCH * MEMT; m += NGW) {
            const GAS f32x4* xr = (const GAS f32x4*)(mem + (size_t)m * D) + lane; f32x4 v[8]; float ss = 0.f;
#pragma unroll
            for (int j = 0; j < 8; ++j) { v[j] = xr[64 * j]; ss += (v[j][0] * v[j][0] + v[j][1] * v[j][1]) + (v[j][2] * v[j][2] + v[j][3] * v[j][3]); }
            const float rs = 1.0f / sqrtf(wave_sum(ss) * (1.0f / D) + EPS);
            GAS pg8::u32x2* o = (GAS pg8::u32x2*)(mn + (size_t)m * D) + lane;
#pragma unroll
            for (int j = 0; j < 8; ++j) { const f32x4 g = ((const GAS f32x4*)mg)[lane + 64 * j]; pg8::u32x2 w; w.x = pg8::cvt_pk_bf16(v[j][0] * rs * g[0], v[j][1] * rs * g[1]); w.y = pg8::cvt_pk_bf16(v[j][2] * rs * g[2], v[j][3] * rs * g[3]); o[64 * j] = w; }
        }
    }
    {
        const float* lg = FIN(I_C_LBL); float* lb = (float*)(F.ws + WS_LB);
        for (int c = F.bx * 512 + tid; c < D; c += F.G * 512) {
            const float a0 = lg[c], a1 = lg[D + c], a2 = lg[2 * D + c], a3 = lg[3 * D + c];
            const float mx = fmaxf(fmaxf(a0, a1), fmaxf(a2, a3));
            const float e0 = expf(a0 - mx), e1 = expf(a1 - mx), e2 = expf(a2 - mx), e3 = expf(a3 - mx), inv = 1.0f / (e0 + e1 + e2 + e3);
            const float p1 = e1 * inv, p2 = e2 * inv, p3 = e3 * inv;
            lb[c] = 0.f; lb[D + c] = p1; lb[2 * D + c] = p1 + p2; lb[3 * D + c] = p1 + p2 + p3;
        }
    }
}

template <class Sched> __device__ __forceinline__ void build_rtab(Frame& F, const Sched& S, int xi = -1, int xpn0 = 0, int xnt = 0) {
    PHASE_IDS();
    const float* rowss = (const float*)(F.ws + WS_ROWSS); LAS float* rt = (LAS float*)(F.lds + RTAB_OFF);
    int xpm = -1; if (xi >= 0) { pg8::HalfOrder H; H.init(M, xpn0, xnt, F.G, F.bx); pg8::Unit hu; if (H.next(0, hu)) xpm = hu.pm; xpm = __builtin_amdgcn_readfirstlane(xpm); }
    float v[4][32]; bool ok[4];
#pragma unroll
    for (int it = 0; it < 4; ++it) {
        const int idx = tid + it * NWAVES * 64, i = idx >> 8, r = idx & 255; pg8::Unit u; ok[it] = S.next(i, u);
        if (!ok[it] && i == xi && xpm >= 0) { ok[it] = true; u.pm = xpm; }
        const GAS float* p = (const GAS float*)rowss + (size_t)((ok[it] ? u.pm : 0) * 256 + r);
        if (ok[it]) {
#pragma unroll
            for (int j = 0; j < 32; ++j) v[it][j] = p[(size_t)j * M];
        } else {
#pragma unroll
            for (int j = 0; j < 32; ++j) v[it][j] = 0.f;
        }
    }
#pragma unroll
    for (int it = 0; it < 4; ++it) {
        float s = 0.f;
#pragma unroll
        for (int j = 0; j < 8; ++j) s += (v[it][4 * j] + v[it][4 * j + 1]) + (v[it][4 * j + 2] + v[it][4 * j + 3]);
        if (ok[it]) rt[tid + it * NWAVES * 64] = 1.0f / sqrtf(s * (1.0f / D) + EPS);
    }
    LDS_WAIT(); __syncthreads();
}
template <class Epi, int PM = 0, bool F16 = false, bool AIMG = false> __device__ __forceinline__ void run_gemm(Frame& F, const bf16* A, const bf16* Bt, int Mrows, int N, int K, const Epi& E, bool need_rtab, int rot = 0, int ld = 0, int ks = 1, int xi = -1, int xpn0 = 0, int xnt = 0) {
    pg8::Gemm g{A, Bt, Mrows, N, K, ld ? ld : K, ks}; pg8::StaticOrder S; S.init(Mrows, N, F.G, (int)(((unsigned)F.bx + (unsigned)rot) % (unsigned)F.G));
    if (need_rtab) build_rtab(F, S, xi, xpn0, xnt);
    pg8::gemm_phase<Epi, pg8::StaticOrder, true, true, PM, false, F16, AIMG>(F.lds + RING_OFF, g, S, E);
}

template <class Epi, bool F16 = false, bool AIMG = false> __device__ __forceinline__ void run_gemm_half(Frame& F, const bf16* A, const bf16* Bt, int Mrows, int N, int K, int pn0, int ntile, const Epi& E, bool need_rtab = true, int rot = 0) {
    pg8::Gemm g{A, Bt, Mrows, N, K, K, 1}; pg8::HalfOrder S; S.init(Mrows, pn0, ntile, F.G, (int)(((unsigned)F.bx + (unsigned)rot) % (unsigned)F.G));
    if (need_rtab) build_rtab(F, S);
    pg8::gemm_phase<Epi, pg8::HalfOrder, true, true, 0, true, F16, AIMG>(F.lds + RING_OFF, g, S, E);
}
__device__ __forceinline__ void normgate(Frame& F, const float* o, const bf16* gate, int nheads, const float* gw_, int ycol) {
    PHASE_IDS();
    bf16* Y = (bf16*)(F.ws + WS_Y);
    const int hw = lane >> 5, l32 = lane & 31, ld = nheads * HD, total = M * nheads;
    const int gw = (F.bx * NWAVES + wave) * 2 + hw, NGW = F.G * NWAVES * 2;
    const f32x4 g4 = *(const GAS f32x4*)(gw_ + 4 * l32);
    for (int u0 = gw; u0 < total; u0 += 4 * NGW) {
        f32x4 v[4]; pg8::u32x2 gt[4];
#pragma unroll
        for (int j = 0; j < 4; ++j) { const int un = u0 + j * NGW; if (un < total) { const int row = un / nheads, h = un - row * nheads;
            v[j] = *(const GAS f32x4*)(o + (size_t)row * ld + h * HD + 4 * l32); gt[j] = *(const GAS pg8::u32x2*)(gate + (size_t)row * ld + h * HD + 4 * l32); } else { v[j] = (f32x4){0.f, 0.f, 0.f, 0.f}; gt[j] = (pg8::u32x2){0u, 0u}; } }
#pragma unroll
        for (int j = 0; j < 4; ++j) { const int un = u0 + j * NGW;
            float ss = (v[j][0] * v[j][0] + v[j][1] * v[j][1]) + (v[j][2] * v[j][2] + v[j][3] * v[j][3]);
#pragma unroll
            for (int of = 1; of < 32; of <<= 1) ss += __shfl_xor(ss, of);
            const float rs = 1.0f / sqrtf(ss * (1.0f / HD) + EPS);
            if (un < total) { const int row = un / nheads, h = un - row * nheads; pg8::u32x2 w;
                w.x = pg8::cvt_pk_bf16(v[j][0] * rs * g4[0] * silu_acc(bflo(gt[j].x)), v[j][1] * rs * g4[1] * silu_acc(bfhi(gt[j].x))); w.y = pg8::cvt_pk_bf16(v[j][2] * rs * g4[2] * silu_acc(bflo(gt[j].y)), v[j][3] * rs * g4[3] * silu_acc(bfhi(gt[j].y)));
                *(GAS pg8::u32x2*)(Y + (size_t)row * D + ycol + h * HD + 4 * l32) = w; }
        }
    }
}
__device__ __forceinline__ void final_norm(Frame& F) {
    PHASE_IDS();
    static_assert(X_F16 == 2, "final_norm reads the fragment-ordered f16 residual plane");
    const GAS pg8::u32x4* xn = (const GAS pg8::u32x4*)(F.ws + WS_X); const GAS float* rowss = (const GAS float*)(F.ws + WS_ROWSS); const float* fg = FIN(I_FINALG);
    const int gw = F.bx * NWAVES + wave, NGW = F.G * NWAVES, fr = lane & 15, fq = lane >> 4;
    for (int t = gw; t < (M / 256) * (D / 256) * 64; t += NGW) {
        const int am = t & 7, wid = (t >> 3) & 7, U = t >> 6, pm = U / (D / 256), pn = U % (D / 256), wr = wid >> 2, wc = wid & 3;
        const int row = pm * 256 + (am >> 2) * 128 + wr * 64 + (am & 3) * 16 + fr;
        const pg8::u32x4 c0 = xn[((size_t)t * 2 + 0) * 64 + lane], c1 = xn[((size_t)t * 2 + 1) * 64 + lane];
        float s = 0.f;
#pragma unroll
        for (int k = 0; k < 8; ++k) s += rowss[(size_t)(fq * 8 + k) * M + row];
        s += __shfl_xor(s, 16); s += __shfl_xor(s, 32);
        const float rs = 1.0f / sqrtf(s * (1.0f / D) + EPS);
#pragma unroll
        for (int bj = 0; bj < 2; ++bj) { const pg8::u32x4 c = bj ? c1 : c0; const int col = pn * 256 + bj * 128 + wc * 32 + 8 * fq;
            const f32x4 g0 = *(const GAS f32x4*)(fg + col), g1 = *(const GAS f32x4*)(fg + col + 4);
            const f32x4 x0 = {pg8::f16_lo(c.x), pg8::f16_hi(c.x), pg8::f16_lo(c.y), pg8::f16_hi(c.y)}, x1 = {pg8::f16_lo(c.z), pg8::f16_hi(c.z), pg8::f16_lo(c.w), pg8::f16_hi(c.w)};
            GAS f32x4* o = (GAS f32x4*)(F.out + (size_t)row * D + col); o[0] = x0 * rs * g0; o[1] = x1 * rs * g1; }
    }
}

namespace att {
typedef short s16x4 __attribute__((ext_vector_type(4)));
typedef short v4i16_t __attribute__((ext_vector_type(4)));
__device__ __forceinline__ unsigned swz(unsigned row) { return ((row & 3u) << 2) | ((row >> 2) & 3u); }
__device__ __forceinline__ void glds16(const void* gsrc, unsigned lds_dst) { unsigned keep;
    asm volatile("s_mov_b32 %0, m0\n\ts_mov_b32 m0, %2\n\ts_nop 0\n\tglobal_load_lds_dwordx4 %1, off\n\ts_mov_b32 m0, %0" : "=&s"(keep) : "v"(gsrc), "s"(lds_dst) : "memory"); }
__device__ __forceinline__ s16x4 vtr(const LAS char* p) { return __builtin_bit_cast(s16x4, __builtin_amdgcn_ds_read_tr16_b64_v4i16((LAS v4i16_t*)p)); }
__device__ __forceinline__ void stage_half(const char* g, size_t pitch, LAS char* img, int wave, int lane) {
#pragma unroll
    for (int p = 0; p < 4; ++p) {
        const int piece = 4 * wave + p; const unsigned row = 4u * piece + ((unsigned)lane >> 4), ch = ((unsigned)lane & 15u) ^ swz(row);
        glds16(g + (size_t)row * pitch + ch * 16u, (unsigned)__builtin_amdgcn_readfirstlane((unsigned)(size_t)(img + piece * 1024)));
    }
}
struct State { f32x4 o[2][8]; float m[2], l[2]; };
__device__ __forceinline__ void half_step(State& st, const bf16x8 (&qf)[2][4], const LAS char* Kimg, const LAS char* Vimg, int lane, int maskmode, int kbase, const int (&qidx)[2], const bool (&valid)[2]) {
    const unsigned fr = lane & 15, g = lane >> 4, q4 = fr >> 2, p = lane & 3;
    const unsigned fk = swz(fr);
    f32x4 s[2][8];
#pragma unroll
    for (int qt = 0; qt < 2; ++qt)
#pragma unroll
        for (int kt = 0; kt < 8; ++kt) s[qt][kt] = (f32x4){0.f, 0.f, 0.f, 0.f};
#define SB() __builtin_amdgcn_sched_barrier(0)
#define ATT_LDK(kt_, K_) do { _Pragma("unroll") for (int ks_ = 0; ks_ < 4; ++ks_) K_[ks_] = *(const LAS bf16x8*)(Kimg + 256u * (16u * (kt_) + fr) + 16u * ((4u * ks_ + g) ^ fk)); } while (0)
#define ATT_MMK(kt_, K_) do { _Pragma("unroll") for (int ks_ = 0; ks_ < 4; ++ks_) { s[0][kt_] = __builtin_amdgcn_mfma_f32_16x16x32_bf16(K_[ks_], qf[0][ks_], s[0][kt_], 0, 0, 0); s[1][kt_] = __builtin_amdgcn_mfma_f32_16x16x32_bf16(K_[ks_], qf[1][ks_], s[1][kt_], 0, 0, 0); } } while (0)
    {
        bf16x8 kA[4], kB[4];
        ATT_LDK(0, kA); SB();
        ATT_LDK(1, kB); SB(); ATT_MMK(0, kA); SB();
        ATT_LDK(2, kA); SB(); ATT_MMK(1, kB); SB();
        ATT_LDK(3, kB); SB(); ATT_MMK(2, kA); SB();
        ATT_LDK(4, kA); SB(); ATT_MMK(3, kB); SB();
        ATT_LDK(5, kB); SB(); ATT_MMK(4, kA); SB();
        ATT_LDK(6, kA); SB(); ATT_MMK(5, kB); SB();
        ATT_LDK(7, kB); SB(); ATT_MMK(6, kA); SB();
        ATT_MMK(7, kB); SB();
    }
#undef ATT_LDK
#undef ATT_MMK
    bf16x8 pf[2][4];
    if (maskmode == 1) {
#pragma unroll
        for (int qt = 0; qt < 2; ++qt)
#pragma unroll
            for (int kt = 0; kt < 8; ++kt)
#pragma unroll
                for (int r = 0; r < 4; ++r) if (kbase + 16 * kt + 4 * (int)g + r > qidx[qt]) s[qt][kt][r] = -INFINITY;
    }
#pragma unroll
    for (int qt = 0; qt < 2; ++qt) {
        float mx = -INFINITY;
#pragma unroll
        for (int kt = 0; kt < 8; ++kt)
#pragma unroll
            for (int r = 0; r < 4; ++r) mx = fmaxf(mx, s[qt][kt][r]);
        mx = fmaxf(mx, __shfl_xor(mx, 16)); mx = fmaxf(mx, __shfl_xor(mx, 32));
        if (!valid[qt]) mx = -INFINITY;
        const float mn = fmaxf(st.m[qt], mx);
        const float alpha = (st.m[qt] == -INFINITY) ? 0.f : __builtin_amdgcn_exp2f(st.m[qt] - mn);
        const float msub = (!valid[qt] || mn == -INFINITY) ? INFINITY : mn;
        st.m[qt] = mn;
        float sum = 0.f;
#pragma unroll
        for (int kt = 0; kt < 8; ++kt)
#pragma unroll
            for (int r = 0; r < 4; ++r) { const float pv = __builtin_amdgcn_exp2f(s[qt][kt][r] - msub); s[qt][kt][r] = pv; sum += pv; }
        st.l[qt] = st.l[qt] * alpha + sum;
        if (__any(alpha != 1.0f)) {
#pragma unroll
            for (int dt = 0; dt < 8; ++dt) st.o[qt][dt] = st.o[qt][dt] * alpha;
        }
#pragma unroll
        for (int ks = 0; ks < 4; ++ks) {
            pg8::u32x4 w; w.x = pg8::cvt_pk_bf16(s[qt][2 * ks][0], s[qt][2 * ks][1]); w.y = pg8::cvt_pk_bf16(s[qt][2 * ks][2], s[qt][2 * ks][3]);
            w.z = pg8::cvt_pk_bf16(s[qt][2 * ks + 1][0], s[qt][2 * ks + 1][1]); w.w = pg8::cvt_pk_bf16(s[qt][2 * ks + 1][2], s[qt][2 * ks + 1][3]);
            pf[qt][ks] = __builtin_bit_cast(bf16x8, w);
        }
    }
    const unsigned fv = (q4 << 2) | g;
#define ATT_LDV(dt_, V_) do { const unsigned vb_ = 256u * (4u * g + q4) + 16u * ((2u * (dt_) + (p >> 1)) ^ fv) + 8u * (p & 1u); _Pragma("unroll") for (int ks_ = 0; ks_ < 4; ++ks_) { \
        const s16x4 v0_ = vtr(Vimg + vb_ + 256u * (32u * ks_)), v1_ = vtr(Vimg + vb_ + 256u * (32u * ks_ + 16u)); bf16x8 t_; t_[0] = v0_[0]; t_[1] = v0_[1]; t_[2] = v0_[2]; t_[3] = v0_[3]; t_[4] = v1_[0]; t_[5] = v1_[1]; t_[6] = v1_[2]; t_[7] = v1_[3]; V_[ks_] = t_; } } while (0)
#define ATT_MMV(dt_, V_) do { _Pragma("unroll") for (int ks_ = 0; ks_ < 4; ++ks_) { st.o[0][dt_] = __builtin_amdgcn_mfma_f32_16x16x32_bf16(V_[ks_], pf[0][ks_], st.o[0][dt_], 0, 0, 0); st.o[1][dt_] = __builtin_amdgcn_mfma_f32_16x16x32_bf16(V_[ks_], pf[1][ks_], st.o[1][dt_], 0, 0, 0); } } while (0)
    {
        bf16x8 vA[4], vB[4];
        ATT_LDV(0, vA); SB();
        ATT_LDV(1, vB); SB(); ATT_MMV(0, vA); SB();
        ATT_LDV(2, vA); SB(); ATT_MMV(1, vB); SB();
        ATT_LDV(3, vB); SB(); ATT_MMV(2, vA); SB();
        ATT_LDV(4, vA); SB(); ATT_MMV(3, vB); SB();
        ATT_LDV(5, vB); SB(); ATT_MMV(4, vA); SB();
        ATT_LDV(6, vA); SB(); ATT_MMV(5, vB); SB();
        ATT_LDV(7, vB); SB(); ATT_MMV(6, vA); SB();
        ATT_MMV(7, vB); SB();
    }
#undef ATT_LDV
#undef ATT_MMV
#undef SB
}
}

template <int MODE>
__device__ __forceinline__ void attn_unit(Frame& F, int tid_in, int wave, int b, int h, int qblk, int l) {
    const int tid = opaque_i(tid_in), lane = tid & 63;
    LAS char* ring = (LAS char*)(F.lds + RING_OFF);
    LAS unsigned* sel = (LAS unsigned*)(F.lds + RTAB_OFF);
    const bf16* Qp; int ldq; bf16* Op; int ldo;
    if (MODE == 0) { Qp = (const bf16*)(F.ws + WS_XQ); ldq = XW; Op = (bf16*)(F.ws + WS_XO); ldo = XW; }
    else { Qp = (const bf16*)(F.ws + WS_QM); ldq = 1024; Op = (bf16*)(F.ws + WS_Y); ldo = D; }
    const int row0 = b * SEQ + qblk * 256;
    const unsigned fr = lane & 15, g = lane >> 4;
    int nsteps = 2;
    if (MODE == 1) {
        const float* kms = (const float*)(F.ws + WS_KMS);
        LAS float* km = (LAS float*)ring; LAS float* gl = (LAS float*)(ring + 8192);
        __syncthreads();
        const int q = tid >> 1, par = tid & 1;
        const GAS v4u* qr = (const GAS v4u*)(Qp + (size_t)(row0 + q) * ldq + h * HD);
        float kmv[4][2]; v4u qv[16];
#pragma unroll
        for (int it = 0; it < 4; ++it) { const int i = tid + it * NWAVES * 64, j = i >> 7, d = i & 127;
            if (i < qblk * 128) { const GAS float* p0 = (const GAS float*)kms + (size_t)((b * NBLK + j) * 2) * 1024 + h * HD + d; kmv[it][0] = p0[0]; kmv[it][1] = p0[1024]; } else { kmv[it][0] = 0.f; kmv[it][1] = 0.f; } }
#pragma unroll
        for (int c = 0; c < 16; ++c) qv[c] = qr[c];
#pragma unroll
        for (int it = 0; it < 4; ++it) { const int i = tid + it * NWAVES * 64; if (i < qblk * 128) km[i] = kmv[it][0] + kmv[it][1]; }
        LDS_WAIT(); __syncthreads();
        {
            float ga[8];
#pragma unroll
            for (int jj = 0; jj < 8; ++jj) ga[jj] = 0.f;
#pragma unroll
            for (int c = 0; c < 16; ++c) {
                const v4u w = qv[c]; const float q0 = bflo(w.x), q1 = bfhi(w.x), q2 = bflo(w.y), q3 = bfhi(w.y), q4 = bflo(w.z), q5 = bfhi(w.z), q6 = bflo(w.w), q7 = bfhi(w.w);
#pragma unroll
                for (int jj = 0; jj < 8; ++jj) { const int j = 2 * jj + par; if (j < qblk) { const f32x4 k0 = *(const LAS f32x4*)(km + j * 128 + 8 * c), k1 = *(const LAS f32x4*)(km + j * 128 + 8 * c + 4);
                    ga[jj] += (q0 * k0[0] + q1 * k0[1]) + (q2 * k0[2] + q3 * k0[3]) + (q4 * k1[0] + q5 * k1[1]) + (q6 * k1[2] + q7 * k1[3]); } }
            }
#pragma unroll
            for (int jj = 0; jj < 8; ++jj) gl[q * 16 + 2 * jj + par] = ga[jj];
        }
        LDS_WAIT(); __syncthreads();
        if (tid < 256) {
            float v1 = -INFINITY, v2 = -INFINITY, v3 = -INFINITY; int i1 = -1, i2 = -1, i3 = -1;
            for (int j = 0; j < qblk; ++j) { const float gj = gl[tid * 16 + j];
                if (gj > v1) { v3 = v2; i3 = i2; v2 = v1; i2 = i1; v1 = gj; i1 = j; } else if (gj > v2) { v3 = v2; i3 = i2; v2 = gj; i2 = j; } else if (gj > v3) { v3 = gj; i3 = j; } }
            unsigned mbits = 1u << qblk; if (i1 >= 0) mbits |= 1u << i1; if (i2 >= 0) mbits |= 1u << i2; if (i3 >= 0) mbits |= 1u << i3;
            sel[tid] = mbits;
        }
        LDS_WAIT(); __syncthreads();
        nsteps = 2 * (qblk + 1);
    } else { __syncthreads(); }
    bf16x8 qf[2][4]; int qidx[2]; unsigned selq[2];
#pragma unroll
    for (int qt = 0; qt < 2; ++qt) {
        qidx[qt] = 32 * wave + 16 * qt + (int)fr; selq[qt] = MODE == 1 ? sel[qidx[qt]] : 0u;
        const bf16* qrow = Qp + (size_t)(row0 + qidx[qt]) * ldq + h * HD;
#pragma unroll
        for (int ks = 0; ks < 4; ++ks) qf[qt][ks] = *(const GAS bf16x8*)(qrow + 32 * ks + 8 * g);
    }
    att::State st;
#pragma unroll
    for (int qt = 0; qt < 2; ++qt) { st.m[qt] = -INFINITY; st.l[qt] = 0.f;
#pragma unroll
        for (int dt = 0; dt < 8; ++dt) st.o[qt][dt] = (f32x4){0.f, 0.f, 0.f, 0.f}; }
    const size_t pitch = MODE == 0 ? (size_t)4096 * 2 : (size_t)1024 * 2;
#define KBASE_OF(i) (MODE == 0 ? (const char*)((const bf16*)(F.ws + WS_KV) + (size_t)(b * MEMT + (i) * 128) * 4096 + l * 1024 + h * HD) \
                               : (const char*)((const bf16*)(F.ws + WS_KM) + (size_t)(b * SEQ + ((i) < 2 ? qblk : (((i) - 2) >> 1)) * 256 + ((i) & 1) * 128) * 1024 + h * HD))
#define VBASE_OF(i) (MODE == 0 ? (const char*)((const bf16*)(F.ws + WS_KV) + (size_t)(b * MEMT + (i) * 128) * 4096 + l * 1024 + 512 + h * HD) \
                               : (const char*)((const bf16*)(F.ws + WS_VM) + (size_t)(b * SEQ + ((i) < 2 ? qblk : (((i) - 2) >> 1)) * 256 + ((i) & 1) * 128) * 1024 + h * HD))
    att::stage_half(KBASE_OF(0), pitch, ring, wave, lane); att::stage_half(VBASE_OF(0), pitch, ring + 32768, wave, lane);
    VM_WAIT(); __syncthreads();
    for (int i = 0; i < nsteps; ++i) {
        LAS char* cur = ring + (i & 1) * 65536; LAS char* nxt = ring + ((i + 1) & 1) * 65536;
        const int ln = opaque_i(lane);
        if (i + 1 < nsteps) { att::stage_half(KBASE_OF(i + 1), pitch, nxt, wave, ln); att::stage_half(VBASE_OF(i + 1), pitch, nxt + 32768, wave, ln); }
        bool valid[2] = {true, true}; int maskmode = 0; bool run = true;
        if (MODE == 1) {
            if (i < 2) { maskmode = 1; if (i == 1 && wave < 4) run = false; }
            else { const int blk = (i - 2) >> 1; valid[0] = (selq[0] >> blk) & 1u; valid[1] = (selq[1] >> blk) & 1u; run = __any((int)(valid[0] || valid[1])) != 0; }
        }
        if (run) att::half_step(st, qf, cur, cur + 32768, opaque_i(ln), maskmode, (i & 1) * 128, qidx, valid);
        VM_WAIT(); __syncthreads();
    }
#pragma unroll
    for (int qt = 0; qt < 2; ++qt) {
        float lt = st.l[qt]; lt += __shfl_xor(lt, 16); lt += __shfl_xor(lt, 32);
        const float inv = 1.0f / lt;
        bf16* orow = Op + (size_t)(row0 + qidx[qt]) * ldo + h * HD + 4 * g;
#pragma unroll
        for (int dt = 0; dt < 8; ++dt) { pg8::u32x2 w; w.x = pg8::cvt_pk_bf16(st.o[qt][dt][0] * inv, st.o[qt][dt][1] * inv); w.y = pg8::cvt_pk_bf16(st.o[qt][dt][2] * inv, st.o[qt][dt][3] * inv); *(GAS pg8::u32x2*)(orow + 16 * dt) = w; }
    }
}
#undef KBASE_OF
#undef VBASE_OF
__device__ __forceinline__ void moba_phase(Frame& F, int blk0) {
    if (F.bx < blk0) return;
    PHASE_IDS();
    const int nb = F.G - blk0;
    for (int pr = F.bx - blk0; pr < BATCH * NH_AB * 8; pr += nb) {
        const int bh = pr >> 3, k = pr & 7, b = bh >> 3, h = bh & 7;
        for (int rep = 0; rep < 2; ++rep) attn_unit<1>(F, tid, wave, b, h, rep ? k : 15 - k, 0);
    }
}
__device__ __forceinline__ void xattn_phase(Frame& F, int l) {
    PHASE_IDS();
    for (int un = F.bx; un < BATCH * 4 * (SEQ / 256); un += F.G) {
        const int qblk = un & 15, bh = un >> 4, b = bh >> 2, h = bh & 3;
        attn_unit<0>(F, tid, wave, b, h, qblk, l);
    }
}

constexpr size_t WS_UT = WS_MIX + 114 * MiB, WS_WT = WS_MIX + 146 * MiB, WS_QDT = WS_MIX + 162 * MiB, WS_KD = WS_MIX + 178 * MiB, WS_AQK = WS_MIX + 194 * MiB, WS_GL = WS_MIX + 202 * MiB;
namespace dn {
typedef short s16x4 __attribute__((ext_vector_type(4)));
__device__ __forceinline__ unsigned swz8(unsigned row) { return (row >> 1) & 7u; }
__device__ __forceinline__ s16x4 pack4(const f32x4& v) { pg8::u32x2 w; w.x = pg8::cvt_pk_bf16(v[0], v[1]); w.y = pg8::cvt_pk_bf16(v[2], v[3]); return __builtin_bit_cast(s16x4, w); }
__device__ __forceinline__ f32x4 unpack4(const s16x4& v) { const pg8::u32x2 w = __builtin_bit_cast(pg8::u32x2, v); return (f32x4){bflo(w.x), bfhi(w.x), bflo(w.y), bfhi(w.y)}; }
__device__ __forceinline__ bf16x8 join8(const s16x4& a, const s16x4& b) { bf16x8 r; r[0] = a[0]; r[1] = a[1]; r[2] = a[2]; r[3] = a[3]; r[4] = b[0]; r[5] = b[1]; r[6] = b[2]; r[7] = b[3]; return r; }
constexpr int MPITCH = 68, DPITCH = 20;
}

__device__ __forceinline__ void dn_chunk_phase(Frame& F, int e) {
    PHASE_IDS();
    LAS char* ring = (LAS char*)(F.lds + RING_OFF);
    LAS char* QI = ring; LAS char* KI = ring + 16384; LAS char* VI = ring + 32768;
    LAS float* MI = (LAS float*)(ring + 49152);
    LAS float* DI = (LAS float*)(ring + 49152 + 64 * dn::MPITCH * 4);
    LAS float* TG = DI + 4 * 16 * dn::DPITCH; LAS float* TB = TG + 64; LAS float* SSQ = TB + 64;
    const bf16* pre = (const bf16*)(F.ws + WS_DNPRE); const float* ba = (const float*)(F.ws + WS_BA); const float* cw = FIN(I_AB_CONVW) + (size_t)e * 4 * 3072;
    const unsigned fr = lane & 15, g = lane >> 4, q4 = fr >> 2, p = lane & 3;
    for (int ci = F.bx; ci < BATCH * NH_AB * (SEQ / 64); ci += F.G) {
        const int n = ci & 63, bh = ci >> 6, h = bh & 7, b = bh >> 3; const size_t rbase = (size_t)b * SEQ + n * 64;
        float* uT = (float*)(F.ws + WS_UT) + (size_t)ci * 8192; bf16* wT = (bf16*)(F.ws + WS_WT) + (size_t)ci * 8192; bf16* qdT = (bf16*)(F.ws + WS_QDT) + (size_t)ci * 8192;
        bf16* kd = (bf16*)(F.ws + WS_KD) + (size_t)ci * 8192; bf16* aqk = (bf16*)(F.ws + WS_AQK) + (size_t)ci * 4096;
        __syncthreads();
        float val[6][8];
        v4u wpre[6][4];
#pragma unroll
        for (int it = 0; it < 6; ++it) {
            const int sec = it >> 1, c = (tid >> 4) + 32 * (it & 1), gq = tid & 15, ch = sec * 1024 + h * HD + 8 * gq, t = n * 64 + c;
#pragma unroll
            for (int i = 0; i < 4; ++i) { const bool okt = t - 3 + i >= 0; wpre[it][i] = *(const GAS v4u*)(pre + (rbase + (okt ? c - 3 + i : c)) * 3072 + ch); }
        }
#pragma unroll
        for (int it = 0; it < 6; ++it) {
            const int sec = it >> 1, c = (tid >> 4) + 32 * (it & 1), gq = tid & 15, ch = sec * 1024 + h * HD + 8 * gq, t = n * 64 + c;
#pragma unroll
            for (int j = 0; j < 8; ++j) val[it][j] = 0.f;
#pragma unroll
            for (int i = 0; i < 4; ++i) {
                const f32x4 c0 = *(const GAS f32x4*)(cw + i * 3072 + ch), c1 = *(const GAS f32x4*)(cw + i * 3072 + ch + 4);
                if (t - 3 + i >= 0) {
                    const v4u w = wpre[it][i];
                    val[it][0] += c0[0] * bflo(w.x); val[it][1] += c0[1] * bfhi(w.x); val[it][2] += c0[2] * bflo(w.y); val[it][3] += c0[3] * bfhi(w.y);
                    val[it][4] += c1[0] * bflo(w.z); val[it][5] += c1[1] * bfhi(w.z); val[it][6] += c1[2] * bflo(w.w); val[it][7] += c1[3] * bfhi(w.w);
                }
            }
            float ss = 0.f;
#pragma unroll
            for (int j = 0; j < 8; ++j) { val[it][j] = silu_acc(val[it][j]); ss += val[it][j] * val[it][j]; }
            if (sec < 2) SSQ[(c * 2 + sec) * 16 + gq] = ss;
        }
        if (tid < 64) {
            const float braw = ba[(rbase + tid) * 16 + h], araw = ba[(rbase + tid) * 16 + 8 + h] + FIN(I_AB_DTB)[e * 8 + h];
            const float ea = __expf(araw); const float sp = araw > 20.f ? araw : (ea < 1e-3f ? ea * (1.0f - 0.5f * ea) : __logf(1.0f + ea));
            float gg = -__expf(FIN(I_AB_ALOG)[e * 8 + h]) * sp;
#pragma unroll
            for (int o = 1; o < 64; o <<= 1) { const float t2 = __shfl_up(gg, o); if (lane >= o) gg += t2; }
            TG[tid] = gg; TB[tid] = sigmoid_f(braw);
        }
        LDS_WAIT(); __syncthreads();
#pragma unroll
        for (int it = 0; it < 6; ++it) {
            const int sec = it >> 1, c = (tid >> 4) + 32 * (it & 1), gq = tid & 15; float sc = 1.0f;
            if (sec < 2) { float s = 0.f;
#pragma unroll
                for (int j = 0; j < 4; ++j) { const f32x4 q = *(const LAS f32x4*)(SSQ + (c * 2 + sec) * 16 + 4 * j); s += (q[0] + q[1]) + (q[2] + q[3]); }
                sc = (1.0f / sqrtf(s + EPS)) * (sec == 0 ? 0.08838834764831845f : 1.0f); }
            LAS char* img = sec == 0 ? QI : (sec == 1 ? KI : VI);
            v4u w; w.x = pg8::cvt_pk_bf16(val[it][0] * sc, val[it][1] * sc); w.y = pg8::cvt_pk_bf16(val[it][2] * sc, val[it][3] * sc); w.z = pg8::cvt_pk_bf16(val[it][4] * sc, val[it][5] * sc); w.w = pg8::cvt_pk_bf16(val[it][6] * sc, val[it][7] * sc);
            *(LAS v4u*)(img + 256 * c + 16 * ((unsigned)gq ^ att::swz((unsigned)c))) = w;
        }
        if (tid < 384) { const int pr = tid >> 6, ctz = pr < 3 ? 0 : (pr < 5 ? 1 : 2), stz = pr < 3 ? pr + 1 : (pr < 5 ? pr - 1 : 3), cz = 16 * ctz + ((tid & 63) >> 2), gz = tid & 3;
            *(GAS pg8::u32x2*)(aqk + cz * 64 + 32 * (stz >> 1) + 8 * gz + 4 * (stz & 1)) = (pg8::u32x2){0u, 0u}; }
        LDS_WAIT(); __syncthreads();
        for (int jb = wave; jb < 20; jb += NWAVES) {
            const int ty = jb >= 10 ? 1 : 0, ti = jb - 10 * ty; int ct = 0, st = ti;
            if (ti >= 6) { ct = 3; st = ti - 6; } else if (ti >= 3) { ct = 2; st = ti - 3; } else if (ti >= 1) { ct = 1; st = ti - 1; }
            f32x4 acc = {0.f, 0.f, 0.f, 0.f};
            if (ty == 0) {
#pragma unroll
                for (int ks = 0; ks < 4; ++ks) { const bf16x8 a = *(const LAS bf16x8*)(KI + 256u * (16u * ct + fr) + 16u * ((4u * ks + g) ^ att::swz(fr))), bb = *(const LAS bf16x8*)(KI + 256u * (16u * st + fr) + 16u * ((4u * ks + g) ^ att::swz(fr)));
                    acc = __builtin_amdgcn_mfma_f32_16x16x32_bf16(a, bb, acc, 0, 0, 0); }
                const int s = 16 * st + (int)fr; const float gs = TG[s];
#pragma unroll
                for (int r = 0; r < 4; ++r) { const int c = 16 * ct + 4 * (int)g + r; MI[c * dn::MPITCH + s] = s < c ? acc[r] * TB[c] * __expf(TG[c] - gs) : 0.f; }
            } else {
#pragma unroll
                for (int ks = 0; ks < 4; ++ks) { const bf16x8 a = *(const LAS bf16x8*)(KI + 256u * (16u * st + fr) + 16u * ((4u * ks + g) ^ att::swz(fr))), bb = *(const LAS bf16x8*)(QI + 256u * (16u * ct + fr) + 16u * ((4u * ks + g) ^ att::swz(fr)));
                    acc = __builtin_amdgcn_mfma_f32_16x16x32_bf16(a, bb, acc, 0, 0, 0); }
                const int c = 16 * ct + (int)fr; const float gc = TG[c]; f32x4 o;
#pragma unroll
                for (int r = 0; r < 4; ++r) { const int s = 16 * st + 4 * (int)g + r; o[r] = s <= c ? acc[r] * __expf(gc - TG[s]) : 0.f; }
                *(GAS dn::s16x4*)(aqk + c * 64 + 32 * (st >> 1) + 8 * g + 4 * (st & 1)) = dn::pack4(o);
            }
        }
        LDS_WAIT(); __syncthreads();
        if (wave == 0) {
            const int i = g, j = fr; float dc[16]; f32x4 mr[16][4];
#pragma unroll
            for (int r = 1; r < 16; ++r)
#pragma unroll
                for (int q = 0; q < 4; ++q) if (4 * q < r) mr[r][q] = *(const LAS f32x4*)(MI + (16 * i + r) * dn::MPITCH + 16 * i + 4 * q);
#pragma unroll
            for (int r = 0; r < 16; ++r) { float a = (r == j) ? 1.f : 0.f;
#pragma unroll
                for (int s = 0; s < r; ++s) a -= mr[r][s >> 2][s & 3] * dc[s];
                dc[r] = a; }
#pragma unroll
            for (int r = 0; r < 16; ++r) DI[(i * 16 + r) * dn::DPITCH + j] = dc[r];
        }
        LDS_WAIT(); __syncthreads();
#pragma unroll
        for (int job = 0; job < 2; ++job) {
            const LAS char* img = job ? KI : VI; dn::s16x4 xb[4];
#pragma unroll
            for (int i = 0; i < 4; ++i) {
                const unsigned row = 16u * i + 4u * g + q4;
                const dn::s16x4 raw = att::vtr(img + 256u * row + 16u * ((2u * wave + (p >> 1)) ^ att::swz(row)) + 8u * (p & 1u));
                f32x4 acc = dn::unpack4(raw);
#pragma unroll
                for (int r = 0; r < 4; ++r) { const int c = 16 * i + 4 * (int)g + r; acc[r] *= job ? TB[c] * __expf(TG[c]) : TB[c]; }
#pragma unroll
                for (int j = 0; j < 4; ++j) { if (j < i) { const f32x4 mm = *(const LAS f32x4*)(MI + (16 * i + (int)fr) * dn::MPITCH + 16 * j + 4 * (int)g);
                    acc = __builtin_amdgcn_mfma_f32_16x16x16bf16_1k(dn::pack4(-mm), xb[j], acc, 0, 0, 0); } }
                const f32x4 dd = *(const LAS f32x4*)(DI + (16 * i + (int)fr) * dn::DPITCH + 4 * (int)g);
                const f32x4 x = __builtin_amdgcn_mfma_f32_16x16x16bf16_1k(dn::pack4(dd), dn::pack4(acc), (f32x4){0.f, 0.f, 0.f, 0.f}, 0, 0, 0);
                xb[i] = dn::pack4(x);
                if (job == 0) *(GAS f32x4*)(uT + (16 * wave + (int)fr) * 64 + 16 * i + 4 * (int)g) = x;
                else *(GAS dn::s16x4*)(wT + (16 * wave + (int)fr) * 64 + 16 * i + 4 * (int)g) = dn::pack4(-x);
            }
        }
#pragma unroll
        for (int i = 0; i < 4; ++i) {
            const unsigned row = 16u * i + 4u * g + q4;
            f32x4 qv = dn::unpack4(att::vtr(QI + 256u * row + 16u * ((2u * wave + (p >> 1)) ^ att::swz(row)) + 8u * (p & 1u)));
#pragma unroll
            for (int r = 0; r < 4; ++r) qv[r] *= __expf(TG[16 * i + 4 * (int)g + r]);
            *(GAS dn::s16x4*)(qdT + (16 * wave + (int)fr) * 64 + 16 * i + 4 * (int)g) = dn::pack4(qv);
        }
        {
            const float glast = TG[63];
#pragma unroll
            for (int it = 0; it < 2; ++it) { const int item = tid + 512 * it, s = item >> 4, ch = item & 15; const float sc = __expf(glast - TG[s]);
                const v4u w = *(const LAS v4u*)(KI + 256 * s + 16 * ((unsigned)ch ^ att::swz((unsigned)s)));
                v4u o; o.x = pg8::cvt_pk_bf16(bflo(w.x) * sc, bfhi(w.x) * sc); o.y = pg8::cvt_pk_bf16(bflo(w.y) * sc, bfhi(w.y) * sc); o.z = pg8::cvt_pk_bf16(bflo(w.z) * sc, bfhi(w.z) * sc); o.w = pg8::cvt_pk_bf16(bflo(w.w) * sc, bfhi(w.w) * sc);
                *(GAS v4u*)(kd + s * 128 + 8 * ch) = o; }
            if (tid == 0) ((float*)(F.ws + WS_GL))[ci] = __expf(glast);
        }
    }
    __syncthreads();
}

#ifndef DN_TAIL_NORMGATE
#define DN_TAIL_NORMGATE 1
#endif
constexpr int CW_CHAIN = 8192;
__device__ __forceinline__ void chain_sync(Frame& F, gu32* word, unsigned want) {
    asm volatile("s_waitcnt vmcnt(0)" ::: "memory");
    __syncthreads();
    if (threadIdx.x == 0) {
        __builtin_amdgcn_fence(__ATOMIC_RELEASE, "agent"); asm volatile("s_waitcnt vmcnt(0)" ::: "memory");
        __hip_atomic_fetch_add(word, 1u, RLX_AGENT);
        unsigned sp = 0u;
        while (__hip_atomic_load(word, RLX_AGENT) < want) { __builtin_amdgcn_s_sleep(1); if (++sp > (1u << 22)) break; }
        __builtin_amdgcn_fence(__ATOMIC_ACQUIRE, "agent"); asm volatile("s_waitcnt vmcnt(0)" ::: "memory");
    }
    __syncthreads();
}
constexpr int NG_ = 8;
__device__ __forceinline__ void normgate_rows(Frame& F, const float* o, const bf16* gate, int nheads, const float* gw_, int ycol, int r0, int nr, int h) {
    PHASE_IDS();
    bf16* Y = (bf16*)(F.ws + WS_Y);
    const int hw = lane >> 5, l32 = lane & 31, ld = nheads * HD, hid = wave * 2 + hw;
    const f32x4 g4 = *(const GAS f32x4*)(gw_ + 4 * l32);
    for (int u0 = hid; u0 < nr; u0 += NG_ * 2 * NWAVES) {
        f32x4 v[NG_]; pg8::u32x2 gt[NG_];
#pragma unroll
        for (int j = 0; j < NG_; ++j) { const int un = u0 + j * 2 * NWAVES; if (un < nr) { const size_t row = (size_t)(r0 + un);
            v[j] = *(const GAS f32x4*)(o + row * ld + h * HD + 4 * l32); gt[j] = *(const GAS pg8::u32x2*)(gate + row * ld + h * HD + 4 * l32); } else { v[j] = (f32x4){0.f, 0.f, 0.f, 0.f}; gt[j] = (pg8::u32x2){0u, 0u}; } }
#pragma unroll
        for (int j = 0; j < NG_; ++j) { const int un = u0 + j * 2 * NWAVES;
            float ss = (v[j][0] * v[j][0] + v[j][1] * v[j][1]) + (v[j][2] * v[j][2] + v[j][3] * v[j][3]);
#pragma unroll
            for (int of = 1; of < 32; of <<= 1) ss += __shfl_xor(ss, of);
            const float rs = 1.0f / sqrtf(ss * (1.0f / HD) + EPS);
            if (un < nr) { const size_t row = (size_t)(r0 + un); pg8::u32x2 w;
                w.x = pg8::cvt_pk_bf16(v[j][0] * rs * g4[0] * silu_acc(bflo(gt[j].x)), v[j][1] * rs * g4[1] * silu_acc(bfhi(gt[j].x))); w.y = pg8::cvt_pk_bf16(v[j][2] * rs * g4[2] * silu_acc(bflo(gt[j].y)), v[j][3] * rs * g4[3] * silu_acc(bfhi(gt[j].y)));
                *(GAS pg8::u32x2*)(Y + row * D + ycol + h * HD + 4 * l32) = w; }
        }
    }
}
template <int PM>
__device__ __forceinline__ void dn_scan_phase(Frame& F, int e) {
    constexpr int SPL = 4, NCH = BATCH * NH_AB;
    if (F.bx >= SPL * NCH) return;
    PHASE_IDS();
    const int bh = F.bx % NCH, part = F.bx / NCH, h = bh & 7, b = bh >> 3;
    const int dvt = (8 / SPL) * part + (wave & (8 / SPL - 1)); const bool active = wave < 8 / SPL;
    const int rot = part * (56 / SPL);
    LAS char* ring = (LAS char*)(F.lds + RING_OFF);
    constexpr int STG = 57344;
    const char* gWT = (const char*)(F.ws + WS_WT) + (size_t)bh * 64 * 16384; const char* gQD = (const char*)(F.ws + WS_QDT) + (size_t)bh * 64 * 16384;
    const char* gKD = (const char*)(F.ws + WS_KD) + (size_t)bh * 64 * 16384; const char* gAQ = (const char*)(F.ws + WS_AQK) + (size_t)bh * 64 * 8192;
    const float* gUT = (const float*)(F.ws + WS_UT) + (size_t)bh * 64 * 8192; const float* gGL = (const float*)(F.ws + WS_GL) + bh * 64;
    float* dno = (float*)(F.ws + (PM == 0 ? WS_DNO : WS_ACT));
#define DN_STAGE(n_, stg_) do { _Pragma("unroll") for (int pi_ = 0; pi_ < 7; ++pi_) { int pc_ = 7 * wave + pi_ + rot; pc_ -= pc_ >= 56 ? 56 : 0; const char* src_; \
        if (pc_ < 32 || pc_ >= 48) { const int q_ = pc_ < 16 ? pc_ : (pc_ < 32 ? pc_ - 16 : pc_ - 48); const unsigned row_ = 8u * q_ + ((unsigned)ln >> 3), ch_ = ((unsigned)ln & 7u) ^ dn::swz8(row_); \
            src_ = (pc_ < 16 ? gWT + (size_t)(n_) * 16384 : (pc_ < 32 ? gQD + (size_t)(n_) * 16384 : gAQ + (size_t)(n_) * 8192)) + row_ * 128u + ch_ * 16u; } \
        else { const int q_ = pc_ - 32; const unsigned row_ = 4u * q_ + ((unsigned)ln >> 4), ch_ = ((unsigned)ln & 15u) ^ att::swz(row_); src_ = gKD + (size_t)(n_) * 16384 + row_ * 256u + ch_ * 16u; } \
        att::glds16(src_, (unsigned)__builtin_amdgcn_readfirstlane((unsigned)(size_t)((stg_) + pc_ * 1024))); } } while (0)
    f32x4 S[8]; bf16x8 Sb[4];
#pragma unroll
    for (int dt = 0; dt < 8; ++dt) S[dt] = (f32x4){0.f, 0.f, 0.f, 0.f};
#pragma unroll
    for (int ks = 0; ks < 4; ++ks) Sb[ks] = (bf16x8){0, 0, 0, 0, 0, 0, 0, 0};
    { const int ln = lane; DN_STAGE(0, ring); }
    f32x4 un[4]; const int glbits = __float_as_int(gGL[lane]);
#pragma unroll
    for (int mt = 0; mt < 4; ++mt) un[mt] = *(const GAS f32x4*)(gUT + (16 * dvt + (lane & 15)) * 64 + 16 * mt + 4 * (lane >> 4));
    VM_WAIT(); __syncthreads();
    for (int n = 0; n < SEQ / 64; ++n) {
        LAS char* cur = ring + (n & 1) * STG; LAS char* nxt = ring + ((n + 1) & 1) * STG;
        const int ln = opaque_i(lane);
        asm volatile("" : "+v"(un[0]), "+v"(un[1]), "+v"(un[2]), "+v"(un[3]));
        f32x4 vn[4];
#pragma unroll
        for (int mt = 0; mt < 4; ++mt) vn[mt] = un[mt];
        if (PM != 1 && n + 1 < SEQ / 64) DN_STAGE(n + 1, nxt);
        const unsigned fr = ln & 15, g = (unsigned)ln >> 4, q4 = fr >> 2, p = ln & 3;
        const LAS char* WI = cur; const LAS char* QDI = cur + 16384; const LAS char* KDI = cur + 32768; const LAS char* AQI = cur + 49152;
        if (active && PM != 2) {
        const float gl = __int_as_float(__builtin_amdgcn_readlane(glbits, n));
        f32x4 oo[4];
#pragma unroll
        for (int mt = 0; mt < 4; ++mt) oo[mt] = (f32x4){0.f, 0.f, 0.f, 0.f};
        if (n + 1 < SEQ / 64) {
#pragma unroll
            for (int mt = 0; mt < 4; ++mt) un[mt] = *(const GAS f32x4*)(gUT + (size_t)(n + 1) * 8192 + (16 * dvt + (int)fr) * 64 + 16 * mt + 4 * (int)g);
        }
#define SB() __builtin_amdgcn_sched_barrier(0)
        const unsigned sw8 = (2u * g + (q4 >> 1)) & 7u, fv = (q4 << 2) | g;
#define DN_LD_WQ(mt_, W_, Q_) do { _Pragma("unroll") for (int ks_ = 0; ks_ < 4; ++ks_) { const unsigned r0_ = 32u * ks_ + 4u * g + q4, cb_ = 16u * ((2u * (mt_) + (p >> 1)) ^ sw8) + 8u * (p & 1u); \
            W_[ks_] = dn::join8(att::vtr(WI + 128u * r0_ + cb_), att::vtr(WI + 128u * (r0_ + 16u) + cb_)); Q_[ks_] = dn::join8(att::vtr(QDI + 128u * r0_ + cb_), att::vtr(QDI + 128u * (r0_ + 16u) + cb_)); } } while (0)
#define DN_MM_WQ(mt_, W_, Q_) do { _Pragma("unroll") for (int ks_ = 0; ks_ < 4; ++ks_) { vn[mt_] = __builtin_amdgcn_mfma_f32_16x16x32_bf16(W_[ks_], Sb[ks_], vn[mt_], 0, 0, 0); oo[mt_] = __builtin_amdgcn_mfma_f32_16x16x32_bf16(Q_[ks_], Sb[ks_], oo[mt_], 0, 0, 0); } } while (0)
#define DN_LD_KD(d0_, K_) do { _Pragma("unroll") for (int dd_ = 0; dd_ < 4; ++dd_) _Pragma("unroll") for (int k2_ = 0; k2_ < 2; ++k2_) { const unsigned r0_ = 32u * k2_ + 4u * g + q4, cb_ = 16u * ((2u * ((d0_) + dd_) + (p >> 1)) ^ fv) + 8u * (p & 1u); \
            K_[dd_][k2_] = dn::join8(att::vtr(KDI + 256u * r0_ + cb_), att::vtr(KDI + 256u * (r0_ + 16u) + cb_)); } } while (0)
        bf16x8 wA[4], qA[4], wB[4], qB[4], af[4][2], kA[4][2], kB[4][2];
        DN_LD_WQ(0, wA, qA); SB();
        DN_LD_WQ(1, wB, qB); SB(); DN_MM_WQ(0, wA, qA); SB();
        DN_LD_WQ(2, wA, qA); SB(); DN_MM_WQ(1, wB, qB); SB();
        DN_LD_WQ(3, wB, qB); SB(); DN_MM_WQ(2, wA, qA); SB();
#pragma unroll
        for (int mt = 0; mt < 4; ++mt)
#pragma unroll
            for (int k2 = 0; k2 < 2; ++k2) { const unsigned row = 16u * mt + fr; af[mt][k2] = *(const LAS bf16x8*)(AQI + 128u * row + 16u * ((4u * k2 + g) ^ dn::swz8(row))); }
        SB(); DN_MM_WQ(3, wB, qB); SB();
        DN_LD_KD(0, kA); SB();
        bf16x8 vb[2];
#pragma unroll
        for (int k2 = 0; k2 < 2; ++k2) vb[k2] = dn::join8(dn::pack4(vn[2 * k2]), dn::pack4(vn[2 * k2 + 1]));
#pragma unroll
        for (int mt = 0; mt < 4; ++mt)
#pragma unroll
            for (int k2 = 0; k2 < 2; ++k2) oo[mt] = __builtin_amdgcn_mfma_f32_16x16x32_bf16(af[mt][k2], vb[k2], oo[mt], 0, 0, 0);
        SB(); DN_LD_KD(4, kB); SB();
#pragma unroll
        for (int dt = 0; dt < 4; ++dt) { S[dt] = S[dt] * gl;
#pragma unroll
            for (int k2 = 0; k2 < 2; ++k2) S[dt] = __builtin_amdgcn_mfma_f32_16x16x32_bf16(kA[dt][k2], vb[k2], S[dt], 0, 0, 0); }
        SB();
#pragma unroll
        for (int dt = 4; dt < 8; ++dt) { S[dt] = S[dt] * gl;
#pragma unroll
            for (int k2 = 0; k2 < 2; ++k2) S[dt] = __builtin_amdgcn_mfma_f32_16x16x32_bf16(kB[dt - 4][k2], vb[k2], S[dt], 0, 0, 0); }
#pragma unroll
        for (int ks = 0; ks < 4; ++ks) Sb[ks] = dn::join8(dn::pack4(S[2 * ks]), dn::pack4(S[2 * ks + 1]));
#undef DN_LD_WQ
#undef DN_MM_WQ
#undef DN_LD_KD
#undef SB
        const size_t rbase = (size_t)b * SEQ + n * 64;
#pragma unroll
        for (int mt = 0; mt < 4; ++mt)
#pragma unroll
            for (int r = 0; r < 4; ++r) dno[(rbase + 16 * mt + 4 * g + r) * 1024 + h * HD + 16 * dvt + fr] = oo[mt][r];
        }
        VM_WAIT();
        __syncthreads();
    }
#undef DN_STAGE
    if constexpr (PM == 0 && DN_TAIL_NORMGATE) {
        chain_sync(F, F.ctl + CW_CHAIN + (e * NCH + bh) * 16, SPL);
        normgate_rows(F, (const float*)(F.ws + WS_DNO), (const bf16*)(F.ws + WS_DNGATE), NH_AB, FIN(I_AB_ONG) + e * HD, 1024, b * SEQ + part * (SEQ / SPL), SEQ / SPL, h);
    }
}

constexpr size_t WS_QEP = WS_END, WS_KE = WS_END + 32 * MiB, WS_AINT = WS_END + 64 * MiB, WS_GD = WS_END + 80 * MiB, WS_END2 = WS_END + 82 * MiB;
namespace gla { constexpr int BP = 132; }

__device__ __forceinline__ void gla_chunk_phase(Frame& F) {
    PHASE_IDS();
    LAS char* ring = (LAS char*)(F.lds + RING_OFF);
    LAS float* BI = (LAS float*)ring;
    LAS char* QS = ring + 34816;
    LAS char* KS = ring + 34816 + 16384;
    LAS float* PART = (LAS float*)(ring + 34816 + 16384 + 40960);
    const bf16* Cq = (const bf16*)(F.ws + WS_CQ); const bf16* Ck = (const bf16*)(F.ws + WS_CK); const float* Clf = (const float*)(F.ws + WS_CLF);
    const unsigned fr = lane & 15, g = lane >> 4;
    for (int ci = F.bx; ci < BATCH * NH_C * (SEQ / 64); ci += F.G) {
        const int n = ci & 63, bh = ci >> 6, h = bh & 15, b = bh >> 4; const size_t rbase = (size_t)b * SEQ + n * 64;
        bf16* qep = (bf16*)(F.ws + WS_QEP) + (size_t)ci * 8192; bf16* ke = (bf16*)(F.ws + WS_KE) + (size_t)ci * 8192; bf16* aint = (bf16*)(F.ws + WS_AINT) + (size_t)ci * 4096; float* gd = (float*)(F.ws + WS_GD) + (size_t)ci * 256;
        __syncthreads();
        float lfv[16];
        { const int d = tid & 127, qr = tid >> 7;
#pragma unroll
          for (int r = 0; r < 16; ++r) lfv[r] = Clf[(rbase + 16 * qr + r) * D + h * HD + d]; }
        v4u qwA[2], kwA[2], kwB[5]; pg8::u32x2 q0C[2], q1C[2];
#pragma unroll
        for (int it = 0; it < 2; ++it) { const int item = tid + 512 * it, c = item >> 4, gq = item & 15;
            qwA[it] = *(const GAS v4u*)(Cq + (rbase + c) * D + h * HD + 8 * gq); kwA[it] = *(const GAS v4u*)(Ck + (rbase + c) * D + h * HD + 8 * gq); }
#pragma unroll
        for (int it = 0; it < 5; ++it) { const int item = tid + 512 * it, ri = item >> 4, gq = item & 15; const int s = ri < 16 ? ri : (ri < 48 ? ri - 16 : (ri < 96 ? ri - 48 : ri - 96));
            kwB[it] = *(const GAS v4u*)(Ck + (rbase + s) * D + h * HD + 8 * gq); }
#pragma unroll
        for (int it = 0; it < 2; ++it) { const int item = tid + 512 * it, c = item >> 4, pc = item & 15, dk0 = 32 * (pc >> 2) + 4 * (pc & 3);
            q0C[it] = *(const GAS pg8::u32x2*)(Cq + (rbase + c) * D + h * HD + dk0); q1C[it] = *(const GAS pg8::u32x2*)(Cq + (rbase + c) * D + h * HD + dk0 + 16); }
        if (tid < 192) { const int pr = tid >> 5, ctz = pr < 3 ? 0 : (pr < 5 ? 1 : 2), stz = pr < 3 ? pr + 1 : (pr < 5 ? pr - 1 : 3), cz = 16 * ctz + ((tid & 31) >> 1);
            *(GAS v4u*)(aint + cz * 64 + 16 * stz + 8 * (tid & 1)) = (v4u){0u, 0u, 0u, 0u}; }
        {
            const int d = tid & 127, qr = tid >> 7; float loc[16]; float run = 0.f;
#pragma unroll
            for (int r = 0; r < 16; ++r) { run += lfv[r]; loc[r] = run; }
            PART[qr * 128 + d] = run;
            LDS_WAIT(); __syncthreads();
            float off = 0.f;
#pragma unroll
            for (int q2 = 0; q2 < 3; ++q2) if (q2 < qr) off += PART[q2 * 128 + d];
#pragma unroll
            for (int r = 0; r < 16; ++r) BI[(16 * qr + r) * gla::BP + d] = off + loc[r];
        }
        LDS_WAIT(); __syncthreads();
#pragma unroll
        for (int it = 0; it < 2; ++it) {
            const int item = tid + 512 * it, c = item >> 4, gq = item & 15;
            const v4u qw = qwA[it], kw = kwA[it];
            const LAS float* bc = BI + c * gla::BP + 8 * gq; const LAS float* br = BI + (c & ~15) * gla::BP + 8 * gq; const LAS float* bl = BI + 63 * gla::BP + 8 * gq;
            const f32x4 b0 = *(const LAS f32x4*)bc, b1 = *(const LAS f32x4*)(bc + 4), r0 = *(const LAS f32x4*)br, r1 = *(const LAS f32x4*)(br + 4), l0 = *(const LAS f32x4*)bl, l1 = *(const LAS f32x4*)(bl + 4);
            v4u o;
            o.x = pg8::cvt_pk_bf16(bflo(qw.x) * __expf(b0[0] - r0[0]), bfhi(qw.x) * __expf(b0[1] - r0[1])); o.y = pg8::cvt_pk_bf16(bflo(qw.y) * __expf(b0[2] - r0[2]), bfhi(qw.y) * __expf(b0[3] - r0[3]));
            o.z = pg8::cvt_pk_bf16(bflo(qw.z) * __expf(b1[0] - r1[0]), bfhi(qw.z) * __expf(b1[1] - r1[1])); o.w = pg8::cvt_pk_bf16(bflo(qw.w) * __expf(b1[2] - r1[2]), bfhi(qw.w) * __expf(b1[3] - r1[3]));
            *(LAS v4u*)(QS + 256 * c + 16 * ((unsigned)gq ^ att::swz((unsigned)c))) = o;
            o.x = pg8::cvt_pk_bf16(bflo(kw.x) * __expf(l0[0] - b0[0]), bfhi(kw.x) * __expf(l0[1] - b0[1])); o.y = pg8::cvt_pk_bf16(bflo(kw.y) * __expf(l0[2] - b0[2]), bfhi(kw.y) * __expf(l0[3] - b0[3]));
            o.z = pg8::cvt_pk_bf16(bflo(kw.z) * __expf(l1[0] - b1[0]), bfhi(kw.z) * __expf(l1[1] - b1[1])); o.w = pg8::cvt_pk_bf16(bflo(kw.w) * __expf(l1[2] - b1[2]), bfhi(kw.w) * __expf(l1[3] - b1[3]));
            *(GAS v4u*)(ke + c * 128 + 8 * gq) = o;
        }
#pragma unroll
        for (int it = 0; it < 5; ++it) {
            const int item = tid + 512 * it, ri = item >> 4, gq = item & 15;
            int i, s, base; if (ri < 16) { i = 0; s = ri; base = 0; } else if (ri < 48) { i = 1; s = ri - 16; base = 4096; } else if (ri < 96) { i = 2; s = ri - 48; base = 12288; } else { i = 3; s = ri - 96; base = 24576; }
            const v4u kw = kwB[it];
            const LAS float* bs = BI + s * gla::BP + 8 * gq; const LAS float* br = BI + 16 * i * gla::BP + 8 * gq;
            const f32x4 b0 = *(const LAS f32x4*)bs, b1 = *(const LAS f32x4*)(bs + 4), r0 = *(const LAS f32x4*)br, r1 = *(const LAS f32x4*)(br + 4);
            v4u o;
            o.x = pg8::cvt_pk_bf16(bflo(kw.x) * __expf(r0[0] - b0[0]), bfhi(kw.x) * __expf(r0[1] - b0[1])); o.y = pg8::cvt_pk_bf16(bflo(kw.y) * __expf(r0[2] - b0[2]), bfhi(kw.y) * __expf(r0[3] - b0[3]));
            o.z = pg8::cvt_pk_bf16(bflo(kw.z) * __expf(r1[0] - b1[0]), bfhi(kw.z) * __expf(r1[1] - b1[1])); o.w = pg8::cvt_pk_bf16(bflo(kw.w) * __expf(r1[2] - b1[2]), bfhi(kw.w) * __expf(r1[3] - b1[3]));
            *(LAS v4u*)(KS + base + 256 * s + 16 * ((unsigned)gq ^ att::swz((unsigned)s))) = o;
        }
#pragma unroll
        for (int it = 0; it < 2; ++it) {
            const int item = tid + 512 * it, c = item >> 4, pc = item & 15, ks = pc >> 2, gp = pc & 3, dk0 = 32 * ks + 4 * gp;
            const pg8::u32x2 q0 = q0C[it], q1 = q1C[it];
            const f32x4 b0 = *(const LAS f32x4*)(BI + c * gla::BP + dk0), b1 = *(const LAS f32x4*)(BI + c * gla::BP + dk0 + 16);
            v4u o;
            o.x = pg8::cvt_pk_bf16(bflo(q0.x) * __expf(b0[0]), bfhi(q0.x) * __expf(b0[1])); o.y = pg8::cvt_pk_bf16(bflo(q0.y) * __expf(b0[2]), bfhi(q0.y) * __expf(b0[3]));
            o.z = pg8::cvt_pk_bf16(bflo(q1.x) * __expf(b1[0]), bfhi(q1.x) * __expf(b1[1])); o.w = pg8::cvt_pk_bf16(bflo(q1.y) * __expf(b1[2]), bfhi(q1.y) * __expf(b1[3]));
            *(GAS v4u*)(qep + c * 128 + 8 * pc) = o;
        }
        if (tid < 256) gd[tid] = tid < 128 ? __expf(BI[63 * gla::BP + tid]) : 0.f;
        LDS_WAIT(); __syncthreads();
        for (int jb = wave; jb < 10; jb += NWAVES) {
            int ct = 0, st = jb; if (jb >= 6) { ct = 3; st = jb - 6; } else if (jb >= 3) { ct = 2; st = jb - 3; } else if (jb >= 1) { ct = 1; st = jb - 1; }
            const int base = ct == 0 ? 0 : (ct == 1 ? 4096 : (ct == 2 ? 12288 : 24576));
            f32x4 acc = {0.f, 0.f, 0.f, 0.f};
#pragma unroll
            for (int ks = 0; ks < 4; ++ks) { const bf16x8 a = *(const LAS bf16x8*)(KS + base + 256u * (16u * st + fr) + 16u * ((4u * ks + g) ^ att::swz(fr))), bb = *(const LAS bf16x8*)(QS + 256u * (16u * ct + fr) + 16u * ((4u * ks + g) ^ att::swz(fr)));
                acc = __builtin_amdgcn_mfma_f32_16x16x32_bf16(a, bb, acc, 0, 0, 0); }
            const int c = 16 * ct + (int)fr; f32x4 o;
#pragma unroll
            for (int r = 0; r < 4; ++r) { const int s = 16 * st + 4 * (int)g + r; o[r] = s <= c ? acc[r] : 0.f; }
            *(GAS dn::s16x4*)(aint + c * 64 + 16 * st + 4 * g) = dn::pack4(o);
        }
    }
    __syncthreads();
}

template <int PM>
__device__ __forceinline__ void gla_scan_phase(Frame& F) {
    constexpr int SPL = 4, NCH = BATCH * NH_C;
    if (F.bx >= SPL * NCH) return;
    PHASE_IDS();
    const int bh = F.bx % NCH, part = F.bx / NCH, h = bh & 15, b = bh >> 4;
    const int dvt = (8 / SPL) * part + (wave & (8 / SPL - 1)); const bool active = wave < 8 / SPL;
    const int rot = part * (56 / SPL);
    LAS char* ring = (LAS char*)(F.lds + RING_OFF);
    constexpr int STG = 58368;
    const char* gQE = (const char*)(F.ws + WS_QEP) + (size_t)bh * 64 * 16384; const char* gKE = (const char*)(F.ws + WS_KE) + (size_t)bh * 64 * 16384;
    const char* gA = (const char*)(F.ws + WS_AINT) + (size_t)bh * 64 * 8192; const char* gD = (const char*)(F.ws + WS_GD) + (size_t)bh * 64 * 1024;
    const char* gV = (const char*)((const bf16*)(F.ws + WS_CV) + (size_t)b * SEQ * D + h * HD);
    float* co = (float*)(F.ws + (PM == 0 ? WS_CO : WS_ACT));
#define GLA_PIECE(n_, stg_, pc_) do { const char* src_; \
        if ((pc_) < 48) { const int q_ = (pc_) & 15; const unsigned row_ = 4u * q_ + ((unsigned)ln >> 4), ch_ = ((unsigned)ln & 15u) ^ att::swz(row_); \
            src_ = (pc_) < 16 ? gQE + (size_t)(n_) * 16384 + row_ * 256u + ch_ * 16u : ((pc_) < 32 ? gKE + (size_t)(n_) * 16384 + row_ * 256u + ch_ * 16u : gV + ((size_t)(n_) * 64 + row_) * 4096 + ch_ * 16u); } \
        else if ((pc_) < 56) { const int q_ = (pc_) - 48; const unsigned row_ = 8u * q_ + ((unsigned)ln >> 3), ch_ = ((unsigned)ln & 7u) ^ dn::swz8(row_); src_ = gA + (size_t)(n_) * 8192 + row_ * 128u + ch_ * 16u; } \
        else src_ = gD + (size_t)(n_) * 1024 + (unsigned)ln * 16u; \
        att::glds16(src_, (unsigned)__builtin_amdgcn_readfirstlane((unsigned)(size_t)((stg_) + (pc_) * 1024))); } while (0)
#define GLA_STAGE(n_, stg_) do { _Pragma("unroll") for (int pi_ = 0; pi_ < 7; ++pi_) { int pcc_ = 7 * wave + pi_ + rot; pcc_ -= pcc_ >= 56 ? 56 : 0; GLA_PIECE(n_, stg_, pcc_); } if (wave == 0) { GLA_PIECE(n_, stg_, 56); } } while (0)
    f32x4 S[8]; bf16x8 Sb[4];
#pragma unroll
    for (int dt = 0; dt < 8; ++dt) S[dt] = (f32x4){0.f, 0.f, 0.f, 0.f};
#pragma unroll
    for (int ks = 0; ks < 4; ++ks) Sb[ks] = (bf16x8){0, 0, 0, 0, 0, 0, 0, 0};
    { const int ln = lane; GLA_STAGE(0, ring); }
    VM_WAIT(); __syncthreads();
    for (int n = 0; n < SEQ / 64; ++n) {
        LAS char* cur = ring + (n & 1) * STG; LAS char* nxt = ring + ((n + 1) & 1) * STG;
        const int ln = opaque_i(lane);
        if (PM != 1 && n + 1 < SEQ / 64) GLA_STAGE(n + 1, nxt);
        const unsigned fr = ln & 15, g = (unsigned)ln >> 4, q4 = fr >> 2, p = ln & 3;
        const LAS char* QEI = cur; const LAS char* KEI = cur + 16384; const LAS char* VI = cur + 32768; const LAS char* AI = cur + 49152; const LAS float* DV = (const LAS float*)(cur + 57344);
        if (active && PM != 2) {
        f32x4 oo[4];
#pragma unroll
        for (int mt = 0; mt < 4; ++mt) oo[mt] = (f32x4){0.f, 0.f, 0.f, 0.f};
#define SB() __builtin_amdgcn_sched_barrier(0)
#define GLA_LD_Q(mt_, Q_) do { _Pragma("unroll") for (int ks_ = 0; ks_ < 4; ++ks_) Q_[ks_] = *(const LAS bf16x8*)(QEI + 256u * (16u * (mt_) + fr) + 16u * ((4u * ks_ + g) ^ att::swz(fr))); } while (0)
#define GLA_MM_Q(mt_, Q_) do { _Pragma("unroll") for (int ks_ = 0; ks_ < 4; ++ks_) oo[mt_] = __builtin_amdgcn_mfma_f32_16x16x32_bf16(Q_[ks_], Sb[ks_], oo[mt_], 0, 0, 0); } while (0)
#define GLA_LD_KE(d0_, K_) do { _Pragma("unroll") for (int dd_ = 0; dd_ < 4; ++dd_) _Pragma("unroll") for (int k2_ = 0; k2_ < 2; ++k2_) { const unsigned r0_ = 32u * k2_ + 8u * g + q4, r1_ = r0_ + 4u; \
            K_[dd_][k2_] = dn::join8(att::vtr(KEI + 256u * r0_ + 16u * ((2u * ((d0_) + dd_) + (p >> 1)) ^ att::swz(r0_)) + 8u * (p & 1u)), att::vtr(KEI + 256u * r1_ + 16u * ((2u * ((d0_) + dd_) + (p >> 1)) ^ att::swz(r1_)) + 8u * (p & 1u))); } } while (0)
        bf16x8 qA[4], qB[4], af[4][2], kA[4][2], kB[4][2], vb[2];
        GLA_LD_Q(0, qA);
#pragma unroll
        for (int k2 = 0; k2 < 2; ++k2) {
            const unsigned r0 = 32u * k2 + 8u * g + q4, r1 = r0 + 4u;
            vb[k2] = dn::join8(att::vtr(VI + 256u * r0 + 16u * ((2u * dvt + (p >> 1)) ^ att::swz(r0)) + 8u * (p & 1u)), att::vtr(VI + 256u * r1 + 16u * ((2u * dvt + (p >> 1)) ^ att::swz(r1)) + 8u * (p & 1u)));
        }
        GLA_LD_Q(1, qB); SB(); GLA_MM_Q(0, qA); SB();
        GLA_LD_Q(2, qA);
#pragma unroll
        for (int mt = 0; mt < 4; ++mt)
#pragma unroll
            for (int k2 = 0; k2 < 2; ++k2) { const unsigned row = 16u * mt + fr; af[mt][k2] = *(const LAS bf16x8*)(AI + 128u * row + 16u * ((4u * k2 + g) ^ dn::swz8(row))); }
        SB(); GLA_MM_Q(1, qB); SB();
        GLA_LD_Q(3, qB); SB(); GLA_MM_Q(2, qA); SB();
        GLA_LD_KE(0, kA); SB(); GLA_MM_Q(3, qB);
#pragma unroll
        for (int mt = 0; mt < 4; ++mt)
#pragma unroll
            for (int k2 = 0; k2 < 2; ++k2) oo[mt] = __builtin_amdgcn_mfma_f32_16x16x32_bf16(af[mt][k2], vb[k2], oo[mt], 0, 0, 0);
        SB(); GLA_LD_KE(4, kB); SB();
#pragma unroll
        for (int dt = 0; dt < 4; ++dt) { const f32x4 dd = *(const LAS f32x4*)(DV + 16 * dt + 4 * g); S[dt] = S[dt] * dd;
#pragma unroll
            for (int k2 = 0; k2 < 2; ++k2) S[dt] = __builtin_amdgcn_mfma_f32_16x16x32_bf16(kA[dt][k2], vb[k2], S[dt], 0, 0, 0); }
        SB();
#pragma unroll
        for (int dt = 4; dt < 8; ++dt) { const f32x4 dd = *(const LAS f32x4*)(DV + 16 * dt + 4 * g); S[dt] = S[dt] * dd;
#pragma unroll
            for (int k2 = 0; k2 < 2; ++k2) S[dt] = __builtin_amdgcn_mfma_f32_16x16x32_bf16(kB[dt - 4][k2], vb[k2], S[dt], 0, 0, 0); }
#pragma unroll
        for (int ks = 0; ks < 4; ++ks) Sb[ks] = dn::join8(dn::pack4(S[2 * ks]), dn::pack4(S[2 * ks + 1]));
#undef GLA_LD_Q
#undef GLA_MM_Q
#undef GLA_LD_KE
#undef SB
        const size_t rbase = (size_t)b * SEQ + n * 64;
#pragma unroll
        for (int mt = 0; mt < 4; ++mt)
#pragma unroll
            for (int r = 0; r < 4; ++r) co[(rbase + 16 * mt + 4 * g + r) * D + h * HD + 16 * dvt + fr] = oo[mt][r];
        }
        VM_WAIT();
        __syncthreads();
    }
#undef GLA_STAGE
#undef GLA_PIECE
}

struct Args { const float* in[20]; float* out; unsigned char* ws; };
__global__ void __launch_bounds__(NWAVES * 64, 2) fwd(Args args) {
    extern __shared__ __attribute__((aligned(16))) unsigned char lds[];
    Frame F;
    F.lds = (LAS unsigned char*)lds;
    F.MISC = (volatile LAS unsigned*)(F.lds + MISC_OFF);
    F.tid = threadIdx.x; F.lane = F.tid & 63; F.wave = __builtin_amdgcn_readfirstlane(F.tid >> 6);
    F.G = gridDim.x; F.bx = (int)blockIdx.x;
    GAS unsigned char* ws = (GAS unsigned char*)args.ws; F.ws = ws; F.out = args.out;
    F.ctl = (gu32*)(ws + WS_CTL);
    F.ka = (const __attribute__((address_space(4))) unsigned long long*)__builtin_amdgcn_kernarg_segment_ptr();
    for (int u = F.tid; u < (LDS_BYTES - LDSCTL_OFF) / 4; u += NWAVES * 64) ((LAS unsigned*)(F.lds + LDSCTL_OFF))[u] = 0u;
    __syncthreads();
    XcdBarrier bar = xcd_barrier_post((unsigned*)(F.ctl + CW_BAR), F.MISC + 8);
#define GRID_BAR() xcd_barrier(bar)
    const LAS float* rtab = (const LAS float*)(F.lds + RTAB_OFF);
    bf16* XB; void* XLO; float* ROWSS; bf16* ACT; bf16* Y;
    constexpr bool XF = X_F16 == 1;

    p0_prologue(F);
    GRID_BAR();

    for (int s = 0; s < 2 * DEPTH; ++s) {
        { GAS unsigned char* w_ = F.ws; asm volatile("" : "+s"(w_)); F.ws = w_; ws = w_; auto k_ = F.ka; asm volatile("" : "+s"(k_)); F.ka = k_; int b_ = (int)blockIdx.x; asm volatile("" : "+s"(b_)); F.bx = b_; }
        XB = (bf16*)(ws + WS_XB); XLO = (void*)(ws + WS_X); ROWSS = (float*)(ws + WS_ROWSS); ACT = (bf16*)(ws + WS_ACT); Y = (bf16*)(ws + WS_Y);
        { pg8::EpiSwiGLU E{ACT, DFF, rtab, 0}; run_gemm<pg8::EpiSwiGLU, 0, XF, AIMG_XB != 0>(F, XB, (const bf16*)(ws + WS_W1T) + (size_t)s * NFF * D, M, F.G == 256 ? 40 * 256 : NFF, D, E, true, 0, 0, 1, F.G == 256 ? 5 : -1, 40, 3); }
        if (F.G == 256) { pg8::EpiSwiGLU E{ACT, DFF, rtab + 5 * 256, 1}; run_gemm_half<pg8::EpiSwiGLU, XF, AIMG_XB != 0>(F, XB, (const bf16*)(ws + WS_W1T) + (size_t)s * NFF * D, M, NFF, D, 40, 3, E, false); }
        conv_slot(F, F.G == 256 ? 192 : 0, 3);
        GRID_BAR();
        { pg8::EpiResidual E{s == 0 ? FIN(I_X) : (const float*)nullptr, XB, XLO, ROWSS, 0.5f, D, M}; run_gemm<pg8::EpiResidual, 0, false, AIMG_ACT != 0>(F, ACT, (const bf16*)(ws + WS_W2T) + (size_t)s * D * DFF, M, D, DFF, E, false); }
        if (!(s & 1)) conv_deadline(F, cq_n_mix(s >> 1)); else if (s + 1 < 2 * DEPTH) conv_deadline(F, cq_n_ffn(s + 1));
        GRID_BAR();
        if (!(s & 1)) {
            const int l = s >> 1;
            if (!(l & 1)) {
                const int e = l >> 1;
                { pg8::EpiABin E{(bf16*)(ws + WS_QM), (bf16*)(ws + WS_KM), (bf16*)(ws + WS_VM), (bf16*)(ws + WS_DNPRE), (bf16*)(ws + WS_DNGATE), (float*)(ws + WS_BA), (float*)(ws + WS_KMS), rtab, QK_SCALE_LOG2E};
                  run_gemm<pg8::EpiABin, 0, XF, AIMG_XB != 0>(F, XB, (const bf16*)(ws + WS_WABT) + (size_t)e * AB_PAD * D, M, AB_PAD, D, E, true); }
                conv_slot(F, F.G == 256 ? 160 : F.G, 6);
                GRID_BAR();
                dn_chunk_phase(F, e);
                GRID_BAR();
                dn_scan_phase<0>(F, e);
                moba_phase(F, 4 * BATCH * NH_AB);
                conv_slot(F, 4 * BATCH * NH_AB + BATCH * NH_AB * 8, 18);
                GRID_BAR();
                if (!DN_TAIL_NORMGATE) { normgate(F, (const float*)(ws + WS_DNO), (const bf16*)(ws + WS_DNGATE), NH_AB, FIN(I_AB_ONG) + e * HD, 1024); GRID_BAR(); }
                { pg8::EpiResidual E{nullptr, XB, XLO, ROWSS, 1.0f, D, M}; run_gemm(F, Y, (const bf16*)(ws + WS_WABOT) + (size_t)e * D * D, M, D, D, E, false); }
                conv_deadline(F, cq_n_x(l));
                GRID_BAR();
            } else {
                const int o = l >> 1;
                { pg8::EpiCin E{(bf16*)(ws + WS_CQ), (bf16*)(ws + WS_CK), (bf16*)(ws + WS_CV), (bf16*)(ws + WS_CG), (float*)(ws + WS_CLF), (const float*)(ws + WS_LB) + (size_t)l * D, rtab};
                  run_gemm<pg8::EpiCin, 0, XF, AIMG_XB != 0>(F, XB, (const bf16*)(ws + WS_WCT) + (size_t)o * 4 * D * D, M, 4 * D, D, E, true); }
                GRID_BAR();
                gla_chunk_phase(F);
                GRID_BAR();
                gla_scan_phase<0>(F);
                conv_slot(F, 4 * BATCH * NH_C, 14);
                GRID_BAR();
                normgate(F, (const float*)(ws + WS_CO), (const bf16*)(ws + WS_CG), NH_C, FIN(I_C_ONG) + o * HD, 0);
                GRID_BAR();
                { pg8::EpiResidual E{nullptr, XB, XLO, ROWSS, 1.0f, D, M}; run_gemm(F, Y, (const bf16*)(ws + WS_WCOT) + (size_t)o * D * D, M, D, D, E, false); }
                conv_deadline(F, cq_n_x(l));
                GRID_BAR();
            }
            { pg8::EpiBf16Route E{(bf16*)(ws + WS_XQ), XW, rtab, QK_SCALE_LOG2E, 1}; run_gemm_half<pg8::EpiBf16Route, XF, AIMG_XB != 0>(F, XB, (const bf16*)(ws + WS_WXQT) + (size_t)l * XW * D, M, XW, D, 0, XW / 256, E, true, 0); }
            if (l == 0) { pg8::EpiBf16Route E{(bf16*)(ws + WS_KV), 4096, nullptr, 1.0f, 1}; run_gemm_half(F, (const bf16*)(ws + WS_MEMN), (const bf16*)(ws + WS_WXKVT), BATCH * MEMT, 4096, D, 0, 16, E, false, F.G - 128); }
            conv_slot(F, l == 0 ? 192 : 128, 3);
            GRID_BAR();
            xattn_phase(F, l);
            conv_slot(F, 128, 2);
            GRID_BAR();
            { pg8::EpiResidual E{nullptr, XB, XLO, ROWSS, 1.0f, D, M}; run_gemm(F, (const bf16*)(ws + WS_XO), (const bf16*)(ws + WS_WXOT) + (size_t)l * D * XW, M, D, XW, E, false); }
            conv_deadline(F, cq_n_ffn(s + 1));
            GRID_BAR();
        }
    }
    final_norm(F);
#undef GRID_BAR
}

extern "C" void kernel_launch(void* const* d_in, const int* in_sizes, int n_in, void* d_out, int out_size, void* d_ws, size_t ws_size, hipStream_t stream) {
    static int grid = 0;
    if (grid == 0) {
        if (n_in != 20 || in_sizes[0] != M * D || out_size != M * D || ws_size < WS_END2) { fprintf(stderr, "kernel_launch: unexpected shapes: n_in %d in0 %d out %d ws %zu (need %zu); nothing launched\n", n_in, n_in > 0 ? in_sizes[0] : -1, out_size, ws_size, (size_t)WS_END2); grid = -1; return; }
        int dev = 0, cus = 0, per_cu = 0;
        if (hipGetDevice(&dev) != hipSuccess || hipDeviceGetAttribute(&cus, hipDeviceAttributeMultiprocessorCount, dev) != hipSuccess) { fprintf(stderr, "kernel_launch: device query failed\n"); grid = -1; return; }
        if (hipFuncSetAttribute((const void*)fwd, hipFuncAttributeMaxDynamicSharedMemorySize, LDS_BYTES) != hipSuccess) { fprintf(stderr, "kernel_launch: hipFuncSetAttribute failed\n"); grid = -1; return; }
        if (hipOccupancyMaxActiveBlocksPerMultiprocessor(&per_cu, (const void*)fwd, NWAVES * 64, LDS_BYTES) != hipSuccess || per_cu < 1) fprintf(stderr, "kernel_launch: note: occupancy query reports %d workgroups per CU\n", per_cu);
        (void)hipGetLastError();
        grid = cus;
    }
    if (grid < 0) return;
    if (hipMemsetAsync((char*)d_ws + WS_CTL, 0, CTL_ZERO_BYTES, stream) != hipSuccess) { fprintf(stderr, "kernel_launch: memset failed\n"); return; }
    Args a{};
    for (int i = 0; i < 20; ++i) a.in[i] = (const float*)d_in[i];
    a.out = (float*)d_out; a.ws = (unsigned char*)d_ws;
    hipLaunchKernelGGL(fwd, dim3(grid), dim3(NWAVES * 64), LDS_BYTES, stream, a);
    const hipError_t le = hipPeekAtLastError();
    if (le != hipSuccess) fprintf(stderr, "kernel_launch: launch failed: %s\n", hipGetErrorName(le));
}
```

```cpp
#include <hip/hip_runtime.h>
#include <cstdio>
#include <cstdint>
namespace pg8 {
#define PG8_LAS __attribute__((address_space(3)))
typedef unsigned short bf16_t;
typedef short bf16x8 __attribute__((ext_vector_type(8)));
typedef float f32x4 __attribute__((ext_vector_type(4)));
typedef unsigned u32x4 __attribute__((ext_vector_type(4)));
constexpr int BM = 256, BK = 64, HALF = 128, HTB = HALF * BK * 2  , STAGE_BYTES = 8 * HTB, NXCD = 8, WGM = 4;

__host__ __device__ __forceinline__ int lds_byte(int r, int c) { const int st = (r >> 4) * 2 + (c >> 5), rr = r & 15, cc = c & 31, ob = rr * 64 + cc * 2; return st * 1024 + (ob ^ (((ob >> 9) & 1) << 5)); }
__host__ __device__ __forceinline__ void stage_rc(int b, int& R, int& C) { const int st = b / 1024, sb = b % 1024, swz = sb ^ (((sb >> 9) & 1) << 5); R = (st >> 1) * 16 + swz / 64; C = (st & 1) * 32 + (swz % 64) / 2; }
__host__ __device__ __forceinline__ int perm32(int rho) { const int n = rho >> 4, i = rho & 15; return 8 * (i >> 2) + 4 * n + (i & 3); }

#ifndef BIMG
#define BIMG 1
#endif
__host__ __device__ __forceinline__ int slot32(int c) { const int q = c & 31; return (c & ~31) + 16 * ((q >> 2) & 1) + 4 * (q >> 3) + (q & 3); }
__host__ __device__ __forceinline__ size_t img_off(int r, int k, int K) { return ((size_t)(r >> 4) * (K >> 5) + (k >> 5)) * 1024 + lds_byte(r & 15, k & 31); }
struct Unit { int pm, pn, half; };
struct Gemm { const bf16_t* A; const bf16_t* Bt; int M, N, K, ld, ks; };

struct StaticOrder {
    int nM, nN, nwg, G, c;
    __host__ __device__ void init(int M, int N, int G_, int c_) { nM = M / BM; nN = N / BM; nwg = nM * nN; G = G_; c = c_; }
    __host__ __device__ bool next(int i, Unit& u) const {
        const long L = (long)i * G + c; if (L >= nwg) return false;
        int wgid = (int)L; { const int q = nwg / NXCD, r = nwg % NXCD, xcd = wgid % NXCD, off = wgid / NXCD; wgid = (xcd < r ? xcd * (q + 1) : r * (q + 1) + (xcd - r) * q) + off; }
        const int nig = WGM * nN, gid = wgid / nig, fm = gid * WGM, gsz = (nM - fm) < WGM ? (nM - fm) : WGM;
        u.pm = fm + ((wgid % nig) % gsz); u.pn = (wgid % nig) / gsz; u.half = 0; return true;
    }
    __device__ __forceinline__ void a_ready(const Unit&) const {}
    __device__ __forceinline__ void done(const Unit&) const {}
};

struct HalfOrder {
    int nM, pn0, nhalf, G, c;
    __host__ __device__ void init(int M, int pn0_, int ntile, int G_, int c_) { nM = M / BM; pn0 = pn0_; nhalf = 2 * nM * ntile; G = G_; c = c_; }
    __host__ __device__ bool next(int i, Unit& u) const { const int L = i * G + c; if (L >= nhalf) return false; const int T = L >> 1; u.pm = T % nM; u.pn = pn0 + T / nM; u.half = L & 1; return true; }
    __device__ __forceinline__ void a_ready(const Unit&) const {}
    __device__ __forceinline__ void done(const Unit&) const {}
};

typedef float f32x2_cv __attribute__((ext_vector_type(2))); typedef __bf16 bf16x2_cv __attribute__((ext_vector_type(2)));
__device__ __forceinline__ unsigned cvt_pk_bf16(float lo, float hi) { const f32x2_cv v = {lo, hi}; const bf16x2_cv b = __builtin_convertvector(v, bf16x2_cv); return __builtin_bit_cast(unsigned, b); }
#ifndef X_F16
#define X_F16 2
#endif
typedef _Float16 f16x2_cv __attribute__((ext_vector_type(2))); typedef _Float16 f16x8 __attribute__((ext_vector_type(8)));
__device__ __forceinline__ unsigned cvt_pk_f16(float lo, float hi) { const f32x2_cv v = {lo, hi}; const f16x2_cv b = __builtin_convertvector(v, f16x2_cv); return __builtin_bit_cast(unsigned, b); }
__device__ __forceinline__ float f16_lo(unsigned w) { return (float)__builtin_bit_cast(f16x2_cv, w)[0]; }
__device__ __forceinline__ float f16_hi(unsigned w) { return (float)__builtin_bit_cast(f16x2_cv, w)[1]; }
__device__ __forceinline__ unsigned cvt_pk_x(float lo, float hi) { return X_F16 == 1 ? cvt_pk_f16(lo, hi) : cvt_pk_bf16(lo, hi); }
typedef float f32x2 __attribute__((ext_vector_type(2)));
typedef unsigned u32x2 __attribute__((ext_vector_type(2)));
__device__ __forceinline__ float fast_exp2(float x) { return __builtin_amdgcn_exp2f(x); }
__device__ __forceinline__ float fast_rcp(float x) { return __builtin_amdgcn_rcpf(x); }
__device__ __forceinline__ float silu_f(float a) { return a * fast_rcp(1.0f + fast_exp2(a * -1.44269504089f)); }
__device__ __forceinline__ u32x4 pack8(const f32x4& v0, const f32x4& v1) { u32x4 w; w.x = cvt_pk_bf16(v0[0], v0[1]); w.y = cvt_pk_bf16(v0[2], v0[3]); w.z = cvt_pk_bf16(v1[0], v1[1]); w.w = cvt_pk_bf16(v1[2], v1[3]); return w; }


#ifndef AIMG_ACT
#define AIMG_ACT 1
#endif
#ifndef AIMG_XB
#define AIMG_XB 1
#endif
struct EpiSwiGLU {
    static constexpr bool PERM = true, AFTER_DRAIN = false;
    bf16_t* O; int ldc; const PG8_LAS float* rtab; int hm;
    __device__ __forceinline__ void init(f32x4 (&acc)[2][2][4][2], const Unit&, int, int, int, int) const {
#pragma unroll
        for (int a = 0; a < 2; ++a)
#pragma unroll
            for (int b = 0; b < 2; ++b)
#pragma unroll
                for (int m = 0; m < 4; ++m)
#pragma unroll
                    for (int n = 0; n < 2; ++n) acc[a][b][m][n] = (f32x4){0.f, 0.f, 0.f, 0.f};
    }
    __device__ __forceinline__ void operator()(const f32x4 (&acc)[2][2][4][2], const Unit& u, int ui, int wr, int wc, int fr, int fq) const {
        const PG8_LAS float* rt = rtab + ui * 256;
#pragma unroll
        for (int ai = 0; ai < 2; ++ai)
#pragma unroll
            for (int m = 0; m < 4; ++m) {
                if (hm && ai == 1) continue;
                const int rl = (hm ? u.half : ai) * HALF + wr * 64 + m * 16 + fr; const float rs = rt[rl];
                bf16_t* rowp = AIMG_ACT ? (bf16_t*)((char*)O + img_off(u.pm * BM + rl, u.pn * HALF + wc * 32 + 8 * fq, ldc)) : O + (size_t)(u.pm * BM + rl) * ldc + u.pn * HALF + wc * 32 + 8 * fq;
                f32x4 h[2];
#pragma unroll
                for (int n = 0; n < 2; ++n)
#pragma unroll
                    for (int e = 0; e < 4; ++e) { const float a = acc[ai][0][m][n][e] * rs, b = acc[ai][1][m][n][e] * rs; h[n][e] = silu_f(a) * b; }
                *(u32x4*)rowp = pack8(h[0], h[1]);
            }
    }
};

#ifndef RES_LO
#define RES_LO 1
#endif
constexpr float LO_SCALE = 2048.0f;
__device__ __forceinline__ float bf_lo(unsigned w) { return __builtin_bit_cast(float, w << 16); }
__device__ __forceinline__ float bf_hi(unsigned w) { return __builtin_bit_cast(float, w & 0xffff0000u); }
__device__ __forceinline__ float lo_clamp(float v) { return __builtin_amdgcn_fmed3f(v * LO_SCALE, -448.0f, 448.0f); }
__device__ __forceinline__ unsigned lo_pack4(float a, float b, float c, float d) { int w = __builtin_amdgcn_cvt_pk_fp8_f32(lo_clamp(a), lo_clamp(b), 0, false); return (unsigned)__builtin_amdgcn_cvt_pk_fp8_f32(lo_clamp(c), lo_clamp(d), w, true); }
__device__ __forceinline__ f32x4 hilo4(unsigned h0, unsigned h1, unsigned l) {
    const auto a = __builtin_amdgcn_cvt_pk_f32_fp8((int)l, false), b = __builtin_amdgcn_cvt_pk_f32_fp8((int)l, true); constexpr float r = 1.0f / LO_SCALE;
    return (f32x4){__builtin_fmaf(a[0], r, bf_lo(h0)), __builtin_fmaf(a[1], r, bf_hi(h0)), __builtin_fmaf(b[0], r, bf_lo(h1)), __builtin_fmaf(b[1], r, bf_hi(h1))};
}
__device__ __forceinline__ size_t res_chunk(const Unit& u, int ldx, int wr, int wc, int ai, int m, int bj, int fr, int fq) {
    return (((((size_t)(u.pm * (ldx / BM) + u.pn) * 8 + (wr * 4 + wc)) * 8 + (ai * 4 + m)) * 2 + bj) * 64) + (fq * 16 + fr);
}
struct EpiResidual {
    static constexpr bool PERM = true, AFTER_DRAIN = false;
    const float* xf32; bf16_t* xhi; void* xlo; float* rowss; float scale; int ldx, rsld;
    __device__ __forceinline__ void init(f32x4 (&acc)[2][2][4][2], const Unit& u, int wr, int wc, int fr, int fq) const {
        const float inv = 1.0f / scale;
#pragma unroll
        for (int ai = 0; ai < 2; ++ai)
#pragma unroll
            for (int m = 0; m < 4; ++m) {
                const int row = u.pm * BM + ai * HALF + wr * 64 + m * 16 + fr;
#pragma unroll
                for (int bj = 0; bj < 2; ++bj) { const size_t off = (size_t)row * ldx + u.pn * BM + bj * HALF + wc * 32 + 8 * fq;
                    if (xf32) { acc[ai][bj][m][0] = *(const f32x4*)(xf32 + off) * inv; acc[ai][bj][m][1] = *(const f32x4*)(xf32 + off + 4) * inv; }
                    else { const u32x4 h = X_F16 == 2 ? ((const u32x4*)xlo)[res_chunk(u, ldx, wr, wc, ai, m, bj, fr, fq)] : *(const u32x4*)(xhi + off);
#if X_F16
                        acc[ai][bj][m][0] = (f32x4){f16_lo(h.x), f16_hi(h.x), f16_lo(h.y), f16_hi(h.y)} * inv; acc[ai][bj][m][1] = (f32x4){f16_lo(h.z), f16_hi(h.z), f16_lo(h.w), f16_hi(h.w)} * inv;
#elif RES_LO == 2
                        const u32x2 l = *(const u32x2*)((const unsigned char*)xlo + off);
                        acc[ai][bj][m][0] = hilo4(h.x, h.y, l.x) * inv; acc[ai][bj][m][1] = hilo4(h.z, h.w, l.y) * inv;
#elif RES_LO == 1
                        const u32x4 l = *(const u32x4*)((const bf16_t*)xlo + off);
                        acc[ai][bj][m][0] = (f32x4){bf_lo(h.x) + bf_lo(l.x), bf_hi(h.x) + bf_hi(l.x), bf_lo(h.y) + bf_lo(l.y), bf_hi(h.y) + bf_hi(l.y)} * inv;
                        acc[ai][bj][m][1] = (f32x4){bf_lo(h.z) + bf_lo(l.z), bf_hi(h.z) + bf_hi(l.z), bf_lo(h.w) + bf_lo(l.w), bf_hi(h.w) + bf_hi(l.w)} * inv;
#else
                        acc[ai][bj][m][0] = (f32x4){bf_lo(h.x), bf_hi(h.x), bf_lo(h.y), bf_hi(h.y)} * inv; acc[ai][bj][m][1] = (f32x4){bf_lo(h.z), bf_hi(h.z), bf_lo(h.w), bf_hi(h.w)} * inv;
#endif
                    }
                }
            }
    }
    __device__ __forceinline__ void operator()(const f32x4 (&acc)[2][2][4][2], const Unit& u, int ui, int wr, int wc, int fr, int fq) const {
#pragma unroll
        for (int ai = 0; ai < 2; ++ai)
#pragma unroll
            for (int m = 0; m < 4; ++m) {
                const int row = u.pm * BM + ai * HALF + wr * 64 + m * 16 + fr; float ss = 0.f;
#pragma unroll
                for (int bj = 0; bj < 2; ++bj) {
                    const size_t off = (size_t)row * ldx + u.pn * BM + bj * HALF + wc * 32 + 8 * fq;
                    const f32x4 o0 = acc[ai][bj][m][0] * scale, o1 = acc[ai][bj][m][1] * scale;
#if X_F16
                    *(X_F16 == 2 ? (u32x4*)xlo + res_chunk(u, ldx, wr, wc, ai, m, bj, fr, fq) : (u32x4*)(xhi + off)) = (u32x4){cvt_pk_f16(o0[0], o0[1]), cvt_pk_f16(o0[2], o0[3]), cvt_pk_f16(o1[0], o1[1]), cvt_pk_f16(o1[2], o1[3])};
                    if constexpr (X_F16 == 2) *(u32x4*)(AIMG_XB ? (bf16_t*)((char*)xhi + img_off(row, u.pn * BM + bj * HALF + wc * 32 + 8 * fq, ldx)) : xhi + off) = pack8(o0, o1);
#else
                    const u32x4 h = pack8(o0, o1);
                    *(u32x4*)(xhi + off) = h;
#endif
#if RES_LO && !X_F16
                    const f32x4 r0 = o0 - (f32x4){bf_lo(h.x), bf_hi(h.x), bf_lo(h.y), bf_hi(h.y)}, r1 = o1 - (f32x4){bf_lo(h.z), bf_hi(h.z), bf_lo(h.w), bf_hi(h.w)};
#if RES_LO == 2
                    *(u32x2*)((unsigned char*)xlo + off) = (u32x2){lo_pack4(r0[0], r0[1], r0[2], r0[3]), lo_pack4(r1[0], r1[1], r1[2], r1[3])};
#else
                    *(u32x4*)((bf16_t*)xlo + off) = pack8(r0, r1);
#endif
#endif
                    ss += (o0[0] * o0[0] + o0[1] * o0[1]) + (o0[2] * o0[2] + o0[3] * o0[3]) + (o1[0] * o1[0] + o1[1] * o1[1]) + (o1[2] * o1[2] + o1[3] * o1[3]);
                }
                ss += __shfl_xor(ss, 16); ss += __shfl_xor(ss, 32);
                if (fq == 0) rowss[(size_t)(u.pn * 4 + wc) * rsld + row] = ss;
            }
    }
};

struct EpiBf16Route {
    static constexpr bool PERM = true, AFTER_DRAIN = false;
    bf16_t* O; int ldc; const PG8_LAS float* rtab; float scale; int hm;
    __device__ __forceinline__ void init(f32x4 (&acc)[2][2][4][2], const Unit&, int, int, int, int) const {
#pragma unroll
        for (int a = 0; a < 2; ++a)
#pragma unroll
            for (int b = 0; b < 2; ++b)
#pragma unroll
                for (int m = 0; m < 4; ++m)
#pragma unroll
                    for (int n = 0; n < 2; ++n) acc[a][b][m][n] = (f32x4){0.f, 0.f, 0.f, 0.f};
    }
    __device__ __forceinline__ void operator()(const f32x4 (&acc)[2][2][4][2], const Unit& u, int ui, int wr, int wc, int fr, int fq) const {
#pragma unroll
        for (int ai = 0; ai < 2; ++ai)
#pragma unroll
            for (int m = 0; m < 4; ++m) {
                if (hm && ai == 1) continue;
                const int rl = (hm ? u.half : ai) * HALF + wr * 64 + m * 16 + fr; const float rs = (rtab ? rtab[ui * 256 + rl] : 1.0f) * scale;
                bf16_t* rowp = O + (size_t)(u.pm * BM + rl) * ldc + u.pn * BM + wc * 32 + 8 * fq;
#pragma unroll
                for (int bj = 0; bj < 2; ++bj) *(u32x4*)(rowp + bj * HALF) = pack8(acc[ai][bj][m][0] * rs, acc[ai][bj][m][1] * rs);
            }
    }
};

struct EpiF32Part {
    static constexpr bool PERM = true, AFTER_DRAIN = false;
    float* P; int ldc; int ks; size_t part_stride;
    __device__ __forceinline__ void init(f32x4 (&acc)[2][2][4][2], const Unit&, int, int, int, int) const {
#pragma unroll
        for (int a = 0; a < 2; ++a)
#pragma unroll
            for (int b = 0; b < 2; ++b)
#pragma unroll
                for (int m = 0; m < 4; ++m)
#pragma unroll
                    for (int n = 0; n < 2; ++n) acc[a][b][m][n] = (f32x4){0.f, 0.f, 0.f, 0.f};
    }
    __device__ __forceinline__ void operator()(const f32x4 (&acc)[2][2][4][2], const Unit& u, int ui, int wr, int wc, int fr, int fq) const {
        float* base = P + (size_t)(u.pn % ks) * part_stride + (size_t)(u.pn / ks) * BM + wc * 32 + 8 * fq;
#pragma unroll
        for (int ai = 0; ai < 2; ++ai)
#pragma unroll
            for (int m = 0; m < 4; ++m) {
                float* rowp = base + (size_t)(u.pm * BM + ai * HALF + wr * 64 + m * 16 + fr) * ldc;
#pragma unroll
                for (int bj = 0; bj < 2; ++bj) { *(f32x4*)(rowp + bj * HALF) = acc[ai][bj][m][0]; *(f32x4*)(rowp + bj * HALF + 4) = acc[ai][bj][m][1]; }
            }
    }
};

struct EpiABin {
    static constexpr bool PERM = true, AFTER_DRAIN = false;
    bf16_t *Qm, *Km, *Vm, *DNpre, *DNgate; float* ba; float* kms; const PG8_LAS float* rtab; float qscale;
    __device__ __forceinline__ void init(f32x4 (&acc)[2][2][4][2], const Unit&, int, int, int, int) const {
#pragma unroll
        for (int a = 0; a < 2; ++a)
#pragma unroll
            for (int b = 0; b < 2; ++b)
#pragma unroll
                for (int m = 0; m < 4; ++m)
#pragma unroll
                    for (int n = 0; n < 2; ++n) acc[a][b][m][n] = (f32x4){0.f, 0.f, 0.f, 0.f};
    }
    __device__ __forceinline__ void operator()(const f32x4 (&acc)[2][2][4][2], const Unit& u, int ui, int wr, int wc, int fr, int fq) const {
        const int pn = u.pn; const PG8_LAS float* rt = rtab + ui * 256;
        if (pn < 28) {
            bf16_t* base; int ld = 1024, ct; float sc = 1.0f;
            if (pn < 4) { base = Qm; ct = pn; sc = qscale; } else if (pn < 8) { base = Km; ct = pn - 4; } else if (pn < 12) { base = Vm; ct = pn - 8; }
            else if (pn < 24) { base = DNpre; ld = 3072; ct = pn - 12; } else { base = DNgate; ct = pn - 24; }
            f32x4 cs[2][2];
#pragma unroll
            for (int bj = 0; bj < 2; ++bj)
#pragma unroll
                for (int n = 0; n < 2; ++n) cs[bj][n] = (f32x4){0.f, 0.f, 0.f, 0.f};
#pragma unroll
            for (int ai = 0; ai < 2; ++ai)
#pragma unroll
                for (int m = 0; m < 4; ++m) {
                    const int rl = ai * HALF + wr * 64 + m * 16 + fr; const float rs = rt[rl] * sc;
                    bf16_t* rowp = base + (size_t)(u.pm * BM + rl) * ld + ct * BM + wc * 32 + 8 * fq;
#pragma unroll
                    for (int bj = 0; bj < 2; ++bj) { const f32x4 v0 = acc[ai][bj][m][0] * rs, v1 = acc[ai][bj][m][1] * rs; *(u32x4*)(rowp + bj * HALF) = pack8(v0, v1); cs[bj][0] += v0; cs[bj][1] += v1; }
                }
            if (pn >= 4 && pn < 8) {
#pragma unroll
                for (int bj = 0; bj < 2; ++bj)
#pragma unroll
                    for (int n = 0; n < 2; ++n) {
                        f32x4 s = cs[bj][n];
#pragma unroll
                        for (int o = 1; o < 16; o <<= 1) { s[0] += __shfl_xor(s[0], o); s[1] += __shfl_xor(s[1], o); s[2] += __shfl_xor(s[2], o); s[3] += __shfl_xor(s[3], o); }
                        if (fr == 0) *(f32x4*)(kms + (size_t)(u.pm * 2 + wr) * 1024 + (pn - 4) * BM + bj * HALF + wc * 32 + 8 * fq + 4 * n) = s;
                    }
            }
        } else {
            if (wc == 0 && fq < 2) {
#pragma unroll
                for (int ai = 0; ai < 2; ++ai)
#pragma unroll
                    for (int m = 0; m < 4; ++m) {
                        const int rl = ai * HALF + wr * 64 + m * 16 + fr; const float rs = rt[rl];
                        float* p = ba + (size_t)(u.pm * BM + rl) * 16 + 8 * fq;
                        *(f32x4*)p = acc[ai][0][m][0] * rs; *(f32x4*)(p + 4) = acc[ai][0][m][1] * rs;
                    }
            }
        }
    }
};

struct EpiCin {
    static constexpr bool PERM = true, AFTER_DRAIN = false;
    bf16_t *Cq, *Ck, *Cv, *Cg; float* Clf; const float* lb; const PG8_LAS float* rtab;
    __device__ __forceinline__ void init(f32x4 (&acc)[2][2][4][2], const Unit&, int, int, int, int) const {
#pragma unroll
        for (int a = 0; a < 2; ++a)
#pragma unroll
            for (int b = 0; b < 2; ++b)
#pragma unroll
                for (int m = 0; m < 4; ++m)
#pragma unroll
                    for (int n = 0; n < 2; ++n) acc[a][b][m][n] = (f32x4){0.f, 0.f, 0.f, 0.f};
    }
    __device__ __forceinline__ void operator()(const f32x4 (&acc)[2][2][4][2], const Unit& u, int ui, int wr, int wc, int fr, int fq) const {
        const int pn = u.pn, sec = pn >> 3, ct = pn & 7; const PG8_LAS float* rt = rtab + ui * 256;
        bf16_t* base = sec == 0 ? Cq : (sec == 1 ? Ck : (sec == 2 ? Cv : Cg));
        const int cl = ct * BM + wc * 32 + 8 * fq;
        f32x4 lbv[2][2];
        if (sec == 1) {
#pragma unroll
            for (int bj = 0; bj < 2; ++bj) { lbv[bj][0] = *(const f32x4*)(lb + cl + bj * HALF); lbv[bj][1] = *(const f32x4*)(lb + cl + bj * HALF + 4); }
        }
#pragma unroll
        for (int ai = 0; ai < 2; ++ai)
#pragma unroll
            for (int m = 0; m < 4; ++m) {
                const int rl = ai * HALF + wr * 64 + m * 16 + fr; const float rs = rt[rl];
                const size_t off = (size_t)(u.pm * BM + rl) * 2048 + cl;
#pragma unroll
                for (int bj = 0; bj < 2; ++bj) {
                    f32x4 v[2] = {acc[ai][bj][m][0] * rs, acc[ai][bj][m][1] * rs};
                    if (sec == 0) {
#pragma unroll
                        for (int n = 0; n < 2; ++n)
#pragma unroll
                            for (int e = 0; e < 4; ++e) v[n][e] = silu_f(v[n][e]) * 0.08838834764831845f;
                    } else if (sec == 1) {
                        f32x4 lf[2];
#pragma unroll
                        for (int n = 0; n < 2; ++n)
#pragma unroll
                            for (int e = 0; e < 4; ++e) {
                                const float ex = fast_exp2(v[n][e] * -1.44269504089f), r = fast_rcp(1.0f + ex), l = lbv[bj][n][e];
                                lf[n][e] = __logf(l + (1.0f - l) * r); v[n][e] = (1.0f - l) * ex * r;
                            }
                        *(f32x4*)(Clf + off + bj * HALF) = lf[0]; *(f32x4*)(Clf + off + bj * HALF + 4) = lf[1];
                    }
                    *(u32x4*)(base + off + bj * HALF) = pack8(v[0], v[1]);
                }
            }
    }
};
#ifndef PG8_KROT
#define PG8_KROT 0
#endif
template <class Epi, class Sched, bool ALIGN_EPI = false, bool SP2 = false, int PM = 0, bool HM = false, bool F16 = false, bool AIMG = false>
__device__ __forceinline__ void gemm_phase(PG8_LAS unsigned char* lds, const Gemm g, const Sched& S, const Epi& E) {
    int tid_ = threadIdx.x; asm volatile("" : "+v"(tid_));
    const int tid = tid_, wid = __builtin_amdgcn_readfirstlane(tid >> 6), lane = tid & 63, wr = wid >> 2, wc = wid & 3, fr = lane & 15, fq = lane >> 4;
    const int K = g.K, nt = K / BK, ld = g.ld, ks = g.ks;
    unsigned voffA[2], voffB[2];
#pragma unroll
    for (int i = 0; i < 2; ++i) { int R, C; stage_rc(tid * 16 + i * 8192, R, C); const int Rb = Epi::PERM ? ((R & ~31) + perm32(R & 31)) : R;
        voffA[i] = AIMG ? (unsigned)(((R >> 4) * (ld >> 5) + (C >> 5)) * 1024 + (lds_byte(R, C) & 1023)) : (unsigned)(R * ld + C) * 2u; voffB[i] = BIMG ? (unsigned)(((R >> 4) * (ld >> 5) + (C >> 5)) * 1024 + (lds_byte(R, C) & 1023)) : (unsigned)(Rb * ld + C) * 2u; }
    const size_t kstep = AIMG ? (size_t)2048 : (size_t)(BK * 2), kstepB = BIMG ? (size_t)2048 : (size_t)(BK * 2);
    const size_t hstep = (size_t)HALF * ld * 2;
    const size_t tstep = 2 * hstep;
    const unsigned ldsw = (unsigned)wid * 1024u;
    const int aoff = lds_byte(wr * 64 + fr, fq * 8), boff = lds_byte(wc * 32 + fr, fq * 8);
#define PG8_SA(b, h) (((b) * 2 + (h)) * HTB)
#define PG8_SB(b, h) ((4 + (b) * 2 + (h)) * HTB)
#define PG8_STAGE(bufoff, gbase, voff) do { _Pragma("unroll") for (int _i = 0; _i < 2; ++_i) \
        __builtin_amdgcn_global_load_lds((const unsigned*)((const char*)(gbase) + (voff)[_i]), (PG8_LAS unsigned*)(lds + (bufoff) + ldsw + _i * 8192), 16, 0, 0); } while (0)
#define PG8_LDA(dst, b, h) do { _Pragma("unroll") for (int m = 0; m < 4; ++m) _Pragma("unroll") for (int k = 0; k < 2; ++k) dst[m][k] = *(const PG8_LAS bf16x8*)(lds + PG8_SA(b, h) + aoff + m * 2048 + k * 1024); } while (0)
#define PG8_LDB(dst, b, h) do { _Pragma("unroll") for (int n = 0; n < 2; ++n) _Pragma("unroll") for (int k = 0; k < 2; ++k) dst[n][k] = *(const PG8_LAS bf16x8*)(lds + PG8_SB(b, h) + boff + n * 2048 + k * 1024); } while (0)
#define PG8_MMA(ai, bj, At, Bt) do { __builtin_amdgcn_s_setprio(1); _Pragma("unroll") for (int m = 0; m < 4; ++m) _Pragma("unroll") for (int n = 0; n < 2; ++n) _Pragma("unroll") for (int k = 0; k < 2; ++k) \
        { if constexpr (F16) acc[ai][bj][m][n] = __builtin_amdgcn_mfma_f32_16x16x32_f16(__builtin_bit_cast(f16x8, Bt[n][k]), __builtin_bit_cast(f16x8, At[m][k]), acc[ai][bj][m][n], 0, 0, 0); \
          else acc[ai][bj][m][n] = __builtin_amdgcn_mfma_f32_16x16x32_bf16(Bt[n][k], At[m][k], acc[ai][bj][m][n], 0, 0, 0); } __builtin_amdgcn_s_setprio(0); } while (0)
#define PG8_STAGE_L(bufoff, gbase, voff) do { if constexpr (PM != 1) PG8_STAGE(bufoff, gbase, voff); } while (0)
#define PG8_MMA_L(ai, bj, At, Bt) do { if constexpr (PM != 2) PG8_MMA(ai, bj, At, Bt); } while (0)
#define PG8_WAIT_V(n) asm volatile("s_waitcnt vmcnt(" #n ")" ::: "memory")
#define PG8_WAIT_L(n) asm volatile("s_waitcnt lgkmcnt(" #n ")" ::: "memory")
#define PG8_BAR __builtin_amdgcn_s_barrier()
#define PG8_SCHED __builtin_amdgcn_sched_barrier(0)
    Unit cur, nxt; int ui = 0;
    if (!S.next(0, cur)) return;
    f32x4 acc[2][2][4][2];
    E.init(acc, cur, wr, wc, fr, fq);
    bf16x8 At[4][2], B0[2][2], B1[2][2];
    const char* cA = (const char*)g.A + (size_t)cur.pm * tstep + (size_t)(cur.pn % ks) * K * 2 + (HM ? (size_t)cur.half * hstep : 0); const char* cB = (const char*)g.Bt + (size_t)(cur.pn / ks) * tstep + (size_t)(cur.pn % ks) * K * 2;
    int koff = PG8_KROT ? (PG8_KROT * (cur.pm + cur.pn)) % nt : 0;
    S.a_ready(cur);
    const char* cA0 = cA + (size_t)koff * kstep; const char* cB0 = cB + (size_t)koff * kstepB; const long k1d = (koff + 1 >= nt) ? -(long)koff * (long)kstep : (long)kstep, k1dB = (koff + 1 >= nt) ? -(long)koff * (long)kstepB : (long)kstepB;
    if constexpr (SP2) {
        static_assert(!HM || SP2, "HM needs the SP2 loop");
        PG8_STAGE(PG8_SB(0, 0), cB0, voffB); PG8_STAGE(PG8_SB(0, 1), cB0 + hstep, voffB); PG8_STAGE(PG8_SA(0, 0), cA0, voffA); if constexpr (!HM) PG8_STAGE(PG8_SA(0, 1), cA0 + hstep, voffA);
        if (wr == 1) PG8_BAR;
        if constexpr (HM) PG8_WAIT_V(0); else PG8_WAIT_V(2);
        PG8_BAR;
        PG8_STAGE(PG8_SB(1, 0), cB0 + k1dB, voffB); PG8_STAGE(PG8_SA(1, 0), cA0 + k1d, voffA); PG8_STAGE(PG8_SB(1, 1), cB0 + hstep + k1dB, voffB);
        PG8_WAIT_V(6); PG8_BAR;
    } else {
        PG8_STAGE(PG8_SB(0, 0), cB0, voffB); PG8_STAGE(PG8_SA(0, 0), cA0, voffA); PG8_STAGE(PG8_SB(0, 1), cB0 + hstep, voffB); PG8_STAGE(PG8_SA(0, 1), cA0 + hstep, voffA);
        if (wr == 1) PG8_BAR;
        PG8_WAIT_V(4); PG8_BAR;
        PG8_STAGE(PG8_SB(1, 0), cB0 + k1dB, voffB); PG8_STAGE(PG8_SA(1, 0), cA0 + k1d, voffA); PG8_STAGE(PG8_SB(1, 1), cB0 + hstep + k1dB, voffB);
        PG8_WAIT_V(6); PG8_BAR;
    }
    for (;;) {
        const bool has_next = S.next(ui + 1, nxt);
        const char* nA = has_next ? (const char*)g.A + (size_t)nxt.pm * tstep + (size_t)(nxt.pn % ks) * K * 2 + (HM ? (size_t)nxt.half * hstep : 0) : cA; const char* nB = has_next ? (const char*)g.Bt + (size_t)(nxt.pn / ks) * tstep + (size_t)(nxt.pn % ks) * K * 2 : cB;
        const int koffN = (PG8_KROT && has_next) ? (PG8_KROT * (nxt.pm + nxt.pn)) % nt : koff;
        int e0 = koff;
        for (int t = 0; t < nt; t += 2) {
            const bool last = (t == nt - 2);
            const int e1 = (e0 + 1 >= nt) ? e0 + 1 - nt : e0 + 1, e2 = (e0 + 2 >= nt) ? e0 + 2 - nt : e0 + 2, e3 = (e2 + 1 >= nt) ? 0 : e2 + 1, n1 = (koffN + 1 >= nt) ? 0 : koffN + 1;
            const char* a1 = cA + (size_t)e1 * kstep;
            const char* a2 = last ? nA + (size_t)koffN * kstep : cA + (size_t)e2 * kstep; const char* b2 = last ? nB + (size_t)koffN * kstepB : cB + (size_t)e2 * kstepB;
            const char* a3 = last ? nA + (size_t)n1 * kstep : cA + (size_t)e3 * kstep; const char* b3 = last ? nB + (size_t)n1 * kstepB : cB + (size_t)e3 * kstepB;
            e0 = e2;
            if (last && has_next) S.a_ready(nxt);
            if constexpr (SP2) {
#define PG8_WAIT_VL() do { if constexpr (HM) PG8_WAIT_V(6); else PG8_WAIT_V(8); } while (0)
            PG8_LDB(B0, 0, 0); PG8_LDB(B1, 0, 1); PG8_SCHED; PG8_LDA(At, 0, 0); if constexpr (!HM) PG8_STAGE_L(PG8_SA(1, 1), a1 + hstep, voffA);
            PG8_WAIT_VL(); PG8_WAIT_L(0); PG8_BAR; PG8_MMA_L(0, 0, At, B0); PG8_MMA_L(0, 1, At, B1); PG8_BAR; PG8_SCHED;
            if constexpr (!HM) PG8_LDA(At, 0, 1); PG8_STAGE_L(PG8_SB(0, 0), b2, voffB); PG8_STAGE_L(PG8_SB(0, 1), b2 + hstep, voffB); PG8_STAGE_L(PG8_SA(0, 0), a2, voffA);
            PG8_WAIT_VL(); PG8_WAIT_L(0); PG8_BAR; if constexpr (!HM) { PG8_MMA_L(1, 0, At, B0); PG8_MMA_L(1, 1, At, B1); } PG8_BAR; PG8_SCHED;
            PG8_LDB(B0, 1, 0); PG8_LDB(B1, 1, 1); PG8_SCHED; PG8_LDA(At, 1, 0); if constexpr (!HM) PG8_STAGE_L(PG8_SA(0, 1), a2 + hstep, voffA);
            PG8_WAIT_VL(); PG8_WAIT_L(0); PG8_BAR; PG8_MMA_L(0, 0, At, B0); PG8_MMA_L(0, 1, At, B1); PG8_BAR; PG8_SCHED;
            if constexpr (!HM) PG8_LDA(At, 1, 1); PG8_STAGE_L(PG8_SB(1, 0), b3, voffB); PG8_STAGE_L(PG8_SB(1, 1), b3 + hstep, voffB); PG8_STAGE_L(PG8_SA(1, 0), a3, voffA);
            PG8_WAIT_VL(); PG8_WAIT_L(0); PG8_BAR; if constexpr (!HM) { PG8_MMA_L(1, 0, At, B0); PG8_MMA_L(1, 1, At, B1); } PG8_BAR; PG8_SCHED;
#undef PG8_WAIT_VL
            } else {
            PG8_LDB(B0, 0, 0); PG8_SCHED; PG8_LDA(At, 0, 0); PG8_STAGE_L(PG8_SA(1, 1), a1 + hstep, voffA);
            PG8_WAIT_L(8); PG8_BAR; PG8_WAIT_L(0); PG8_MMA_L(0, 0, At, B0); PG8_BAR; PG8_SCHED;
            PG8_LDB(B1, 0, 1); PG8_STAGE_L(PG8_SB(0, 0), b2, voffB);
            PG8_BAR; PG8_WAIT_L(0); PG8_MMA_L(0, 1, At, B1); PG8_BAR;
            PG8_LDA(At, 0, 1); PG8_STAGE_L(PG8_SA(0, 0), a2, voffA);
            PG8_BAR; PG8_WAIT_L(0); PG8_MMA_L(1, 0, At, B0); PG8_BAR; PG8_SCHED;
            PG8_STAGE_L(PG8_SB(0, 1), b2 + hstep, voffB);
            PG8_WAIT_V(6); PG8_BAR; PG8_MMA_L(1, 1, At, B1); PG8_BAR;
            PG8_LDB(B0, 1, 0); PG8_SCHED; PG8_LDA(At, 1, 0); PG8_STAGE_L(PG8_SA(0, 1), a2 + hstep, voffA);
            PG8_WAIT_L(8); PG8_BAR; PG8_WAIT_L(0); PG8_MMA_L(0, 0, At, B0); PG8_BAR; PG8_SCHED;
            PG8_LDB(B1, 1, 1); PG8_STAGE_L(PG8_SB(1, 0), b3, voffB);
            PG8_BAR; PG8_WAIT_L(0); PG8_MMA_L(0, 1, At, B1); PG8_BAR;
            PG8_LDA(At, 1, 1); PG8_STAGE_L(PG8_SA(1, 0), a3, voffA);
            PG8_BAR; PG8_WAIT_L(0); PG8_MMA_L(1, 0, At, B0); PG8_BAR; PG8_SCHED;
            PG8_STAGE_L(PG8_SB(1, 1), b3 + hstep, voffB);
            PG8_WAIT_V(6); PG8_BAR; PG8_MMA_L(1, 1, At, B1); PG8_BAR;
            }
        }
        if constexpr (ALIGN_EPI) { if (wr == 0) PG8_BAR; }
        if constexpr (!Epi::AFTER_DRAIN) { E(acc, cur, ui, wr, wc, fr, fq); S.done(cur); }
        if (!has_next) break;
        cur = nxt; cA = nA; cB = nB; koff = koffN; ++ui;
        E.init(acc, cur, wr, wc, fr, fq);
        if constexpr (ALIGN_EPI) { if (wr == 1) PG8_BAR; }
    }
    PG8_WAIT_V(0);
    if constexpr (!ALIGN_EPI) { if (wr == 0) PG8_BAR; }
    PG8_BAR;
    if constexpr (Epi::AFTER_DRAIN) { E.fused(acc, cur, wr, wc, fr, fq, lds, wid, lane); S.done(cur); }
#undef PG8_SA
#undef PG8_SB
#undef PG8_STAGE
#undef PG8_STAGE_L
#undef PG8_MMA_L
#undef PG8_LDA
#undef PG8_LDB
#undef PG8_MMA
#undef PG8_WAIT_V
#undef PG8_WAIT_L
#undef PG8_BAR
#undef PG8_SCHED
}
}

constexpr int BATCH = 2, SEQ = 4096, D = 2048, DEPTH = 4, M = BATCH * SEQ;
constexpr int DFF = 5504, NFF = 2 * DFF;
constexpr int AB_IN = 7184, AB_PAD = 7424;
constexpr int HD = 128, NH_AB = 8, NH_C = 16, MEMT = 256, XW = 512, NBLK = SEQ / 256;
constexpr float EPS = 1e-6f;
constexpr float QK_SCALE_LOG2E = 0.08838834764831845f * 1.4426950408889634f;
constexpr int NWAVES = 8;

constexpr size_t MiB = 1u << 20;
constexpr size_t WS_CTL = 0, CTL_ZERO_BYTES = 1 * MiB;
constexpr size_t WS_X = 1 * MiB, WS_XB = 65 * MiB, WS_ROWSS = 97 * MiB, WS_ACT = 98 * MiB;
constexpr size_t WS_W1T = 184 * MiB, WS_W2T = 528 * MiB, WS_WABT = 700 * MiB, WS_WABOT = 758 * MiB, WS_WCT = 774 * MiB, WS_WCOT = 838 * MiB, WS_WXQT = 854 * MiB, WS_WXKVT = 862 * MiB, WS_WXOT = 878 * MiB;
constexpr size_t WS_MIX = 886 * MiB;
constexpr size_t WS_QM = WS_MIX, WS_KM = WS_MIX + 16 * MiB, WS_VM = WS_MIX + 32 * MiB, WS_DNPRE = WS_MIX + 48 * MiB, WS_DNGATE = WS_MIX + 96 * MiB, WS_BA = WS_MIX + 112 * MiB, WS_KMS = WS_MIX + 113 * MiB,
                 WS_DQ = WS_MIX + 114 * MiB, WS_DK = WS_MIX + 146 * MiB, WS_DV = WS_MIX + 178 * MiB, WS_BG = WS_MIX + 210 * MiB, WS_DNO = WS_MIX + 211 * MiB;
constexpr size_t WS_CQ = WS_MIX, WS_CK = WS_MIX + 32 * MiB, WS_CV = WS_MIX + 64 * MiB, WS_CG = WS_MIX + 96 * MiB, WS_CLF = WS_MIX + 128 * MiB, WS_CO = WS_MIX + 192 * MiB;
constexpr size_t WS_Y = WS_MIX + 256 * MiB, WS_XQ = WS_Y + 32 * MiB, WS_XO = WS_XQ + 8 * MiB, WS_MEMN = WS_XO + 8 * MiB, WS_KV = WS_MEMN + 2 * MiB, WS_LB = WS_KV + 4 * MiB, WS_END = WS_LB + 1 * MiB;
static_assert(WS_W1T + (size_t)8 * NFF * D * 2 <= WS_W2T && WS_W2T + (size_t)8 * D * DFF * 2 <= WS_WABT && WS_WABT + (size_t)2 * AB_PAD * D * 2 <= WS_WABOT && WS_ACT + (size_t)M * DFF * 2 <= WS_W1T, "ws map");
constexpr int CW_TMO = 0, CW_CODE = 1, CW_BAR = 4096;

constexpr int RING_OFF = 0, RING_BYTES = 131072;
constexpr int RTAB_OFF = RING_BYTES, RTAB_BYTES = 8 * 1024;
constexpr int LDSCTL_OFF = RTAB_OFF + RTAB_BYTES, MISC_OFF = LDSCTL_OFF + 320;
constexpr int LDS_BYTES = 147456;
static_assert(MISC_OFF + 128 <= LDS_BYTES, "LDS map");
#define GAS __attribute__((address_space(1)))
#define LAS __attribute__((address_space(3)))
typedef unsigned short bf16;
typedef unsigned v4u __attribute__((ext_vector_type(4)));
typedef float f32x4 __attribute__((ext_vector_type(4)));
typedef short bf16x8 __attribute__((ext_vector_type(8)));
typedef GAS unsigned gu32;
typedef GAS unsigned long long gu64;
#define RLX_AGENT __ATOMIC_RELAXED, __HIP_MEMORY_SCOPE_AGENT
#define LDS_WAIT() asm volatile("s_waitcnt lgkmcnt(0)" ::: "memory")
#define VM_WAIT() asm volatile("s_waitcnt vmcnt(0)" ::: "memory")
__device__ __forceinline__ unsigned long long rt() { return __builtin_amdgcn_s_memrealtime(); }
__device__ __forceinline__ unsigned f2bf(float f) { unsigned u = __builtin_bit_cast(unsigned, f); return (u + 0x7fffu + ((u >> 16) & 1u)) >> 16; }
__device__ __forceinline__ unsigned pk2(float lo, float hi) { return f2bf(lo) | (f2bf(hi) << 16); }
#define XB_TMO      128
#define XB_XCNT(j)  (256  + 64 * (j))
#define XB_XSUB(j)  (1280 + 64 * (j))
#define XB_XGEN(j)  (2304 + 64 * (j))
#define XB_TOP      3328
#define XB_TOPGEN   3392
#define XCD_BAR_WORDS 3456
#define XB_SPIN_CAP (1u << 18)

__device__ __forceinline__ unsigned xb_ld(unsigned* p)              { return __hip_atomic_load(p, __ATOMIC_RELAXED, __HIP_MEMORY_SCOPE_AGENT); }
__device__ __forceinline__ unsigned xb_add(unsigned* p, unsigned v) { return __hip_atomic_fetch_add(p, v, __ATOMIC_RELAXED, __HIP_MEMORY_SCOPE_AGENT); }
__device__ __forceinline__ unsigned xb_xcc_id() { return (unsigned)__builtin_amdgcn_s_getreg((3 << 11) | 20) & 0xFu; }
#define XB_SPIN(cond, bar) do { unsigned _sp = 0; while (cond) { __builtin_amdgcn_s_sleep(1); \
    if ((++_sp & 255u) == 0u) { if (xb_ld(&(bar)[XB_TMO])) break; if (_sp > XB_SPIN_CAP) { atomicAdd(&(bar)[XB_TMO], 1u); break; } } } } while (0)

struct XcdBarrier {
    unsigned* bar; unsigned x;
    volatile LAS unsigned* st;
};

__device__ __forceinline__ XcdBarrier xcd_barrier_post(unsigned* bar, volatile LAS unsigned* st) {
    XcdBarrier b; b.bar = bar; b.x = xb_xcc_id(); b.st = st;
    if (threadIdx.x == 0) (void)xb_add(&bar[XB_XCNT(b.x)], 1u);
    return b;
}
__device__ __forceinline__ void xcd_barrier_complete(unsigned* bar, unsigned x, unsigned& nloc, unsigned& nx) {
    const unsigned G = gridDim.x * gridDim.y * gridDim.z;
    unsigned sum, cnt, mine, sp = 0u;
    for (;;) {
        sum = 0u; cnt = 0u; mine = 0u;
#pragma unroll
        for (unsigned j = 0; j < 16; ++j) { const unsigned c = xb_ld(&bar[XB_XCNT(j)]); sum += c; cnt += (c > 0u) ? 1u : 0u; mine = (j == x) ? c : mine; }
        if (sum == G) break;
        __builtin_amdgcn_s_sleep(1);
        if ((++sp & 255u) == 0u) { if (xb_ld(&bar[XB_TMO])) break; if (sp > XB_SPIN_CAP) { atomicAdd(&bar[XB_TMO], 1u); break; } }
    }
    nloc = mine > 0u ? mine : 1u; nx = cnt > 0u ? cnt : 1u;
}

__device__ __forceinline__ void xcd_barrier(const XcdBarrier& b) {
    asm volatile("s_waitcnt vmcnt(0)" ::: "memory");
    __syncthreads();
    if (threadIdx.x == 0) {
        GAS unsigned* bar_g = (GAS unsigned*)b.bar; asm volatile("" : "+s"(bar_g)); unsigned* bar = (unsigned*)bar_g;
        __builtin_amdgcn_s_waitcnt(0);
        unsigned nloc = b.st[0], nx = b.st[1];
        if (nloc == 0u) { xcd_barrier_complete(bar, b.x, nloc, nx); b.st[0] = nloc; b.st[1] = nx; }
        const unsigned old = xb_add(&bar[XB_XSUB(b.x)], 1u);
        const unsigned gen = old / nloc;
        if (old + 1u == (gen + 1u) * nloc) {
            __builtin_amdgcn_fence(__ATOMIC_RELEASE, "agent");
            asm volatile("s_waitcnt vmcnt(0)" ::: "memory");
            const unsigned og = xb_add(&bar[XB_TOP], 1u);
            const unsigned tg = og / nx;
            if (og + 1u == (tg + 1u) * nx) xb_add(&bar[XB_TOPGEN], 1u);
            else XB_SPIN(xb_ld(&bar[XB_TOPGEN]) == tg, bar);
            __builtin_amdgcn_fence(__ATOMIC_ACQUIRE, "agent");
            xb_add(&bar[XB_XGEN(b.x)], 1u);
            asm volatile("s_waitcnt vmcnt(0)" ::: "memory");
        } else {
            XB_SPIN(xb_ld(&bar[XB_XGEN(b.x)]) == gen, bar);
            __builtin_amdgcn_fence(__ATOMIC_ACQUIRE, "agent");
            asm volatile("s_waitcnt vmcnt(0)" ::: "memory");
        }
    }
    __syncthreads();
}

struct Frame {
    LAS unsigned char* lds;
    volatile LAS unsigned* MISC;
    gu32* ctl;
    int tid, lane, wave, G, bx;
    const __attribute__((address_space(4))) unsigned long long* ka;
    float* out; GAS unsigned char* ws;
};
#define FIN(i) ((const float*)(const GAS float*)F.ka[i])
enum { I_X = 0, I_MEM, I_NORMG, I_MEMG, I_FINALG, I_FFN_WIN, I_FFN_WOUT, I_AB_WIN, I_AB_CONVW, I_AB_ALOG, I_AB_DTB, I_AB_ONG, I_AB_WOUT, I_C_WIN, I_C_LBL, I_C_ONG, I_C_WOUT, I_X_WQ, I_X_WKV, I_X_WO };

__device__ __forceinline__ int opaque_i(int v) { asm volatile("" : "+v"(v)); return v; }
#define PHASE_IDS() const int tid = opaque_i(F.tid), lane = tid & 63, wave = __builtin_amdgcn_readfirstlane(tid >> 6); (void)lane; (void)wave
__device__ __forceinline__ float wave_sum(float v) {
#pragma unroll
    for (int o = 1; o < 64; o <<= 1) v += __shfl_xor(v, o);
    return v;
}
__device__ __forceinline__ float wave_max(float v) {
#pragma unroll
    for (int o = 1; o < 64; o <<= 1) v = fmaxf(v, __shfl_xor(v, o));
    return v;
}
__device__ __forceinline__ float bflo(unsigned w) { return __uint_as_float(w << 16); }
__device__ __forceinline__ float bfhi(unsigned w) { return __uint_as_float(w & 0xffff0000u); }
__device__ __forceinline__ float sigmoid_f(float a) { return 1.0f / (1.0f + __expf(-a)); }
__device__ __forceinline__ float silu_acc(float a) { return a / (1.0f + __expf(-a)); }

__device__ __forceinline__ void conv_tile(const float* src, bf16* dst, int K, int N, int mode, const float* gain, int kb, int nb, int wave, int lane) {
    const int k0 = kb * 128 + wave * 16, n = nb * 256 + lane * 4;
    if (n >= N) return;
    const bool xw = X_F16 == 1 && gain != nullptr;
    f32x4 v[16];
#pragma unroll
    for (int r = 0; r < 16; ++r) v[r] = *(const GAS f32x4*)(src + (size_t)(k0 + r) * N + n);
    if (gain) {
#pragma unroll
        for (int r = 0; r < 16; ++r) v[r] = v[r] * gain[k0 + r];
    }
#pragma unroll
    for (int e = 0; e < 4; ++e) {
        const int col = n + e; int drow = col;
        if (mode == 1) { const int half = col >= DFF ? 1 : 0, j = col - half * DFF; drow = (j >> 7) * 256 + half * 128 + (j & 127); }
        v4u w0, w1;
#define CV2(a_, b_) (xw ? pg8::cvt_pk_f16(a_, b_) : pg8::cvt_pk_bf16(a_, b_))
        w0.x = CV2(v[0][e], v[1][e]); w0.y = CV2(v[2][e], v[3][e]); w0.z = CV2(v[4][e], v[5][e]); w0.w = CV2(v[6][e], v[7][e]);
        w1.x = CV2(v[8][e], v[9][e]); w1.y = CV2(v[10][e], v[11][e]); w1.z = CV2(v[12][e], v[13][e]); w1.w = CV2(v[14][e], v[15][e]);
#undef CV2
        GAS v4u* o = BIMG ? (GAS v4u*)((GAS char*)dst + pg8::img_off(pg8::slot32(drow), k0, K)) : (GAS v4u*)(dst + (size_t)drow * K + k0);
        o[0] = w0; o[1] = w1;
    }
}
constexpr int IT_W1M = 16 * 43, IT_W2M = 43 * 8;
__device__ __forceinline__ int conv_family_tiles(int fam) { return fam == 0 ? IT_W1M + IT_W2M : (fam == 1 ? 16 * 29 + 16 * 8 : (fam == 2 ? 16 * 32 + 16 * 8 : (fam == 3 ? 64 : 256))); }
__device__ __forceinline__ void conv_family_item(Frame& F, int fam, int m, int r, int wave, int lane) {
    const float* normg = FIN(I_NORMG); const float* src; bf16* dst; const float* gain = nullptr; int K = D, N = D, mode = 0, kb, nb;
    if (fam == 0) {
        if (r < IT_W1M) { kb = r / 43; nb = r - kb * 43; src = FIN(I_FFN_WIN) + (size_t)m * D * NFF; dst = (bf16*)(F.ws + WS_W1T) + (size_t)m * NFF * D; N = NFF; mode = 1; gain = normg + (size_t)((m >> 1) * 4 + ((m & 1) ? 3 : 0)) * D; }
        else { r -= IT_W1M; kb = r >> 3; nb = r & 7; src = FIN(I_FFN_WOUT) + (size_t)m * DFF * D; dst = (bf16*)(F.ws + WS_W2T) + (size_t)m * D * DFF; K = DFF; }
    } else if (fam == 1) {
        if (r < 16 * 29) { kb = r / 29; nb = r - kb * 29; src = FIN(I_AB_WIN) + (size_t)m * D * AB_IN; dst = (bf16*)(F.ws + WS_WABT) + (size_t)m * AB_PAD * D; N = AB_IN; gain = normg + (size_t)((2 * m) * 4 + 1) * D; }
        else { r -= 16 * 29; kb = r >> 3; nb = r & 7; src = FIN(I_AB_WOUT) + (size_t)m * D * D; dst = (bf16*)(F.ws + WS_WABOT) + (size_t)m * D * D; }
    } else if (fam == 2) {
        if (r < 16 * 32) { kb = r >> 5; nb = r & 31; src = FIN(I_C_WIN) + (size_t)m * D * 4 * D; dst = (bf16*)(F.ws + WS_WCT) + (size_t)m * 4 * D * D; N = 4 * D; gain = normg + (size_t)((2 * m + 1) * 4 + 1) * D; }
        else { r -= 16 * 32; kb = r >> 3; nb = r & 7; src = FIN(I_C_WOUT) + (size_t)m * D * D; dst = (bf16*)(F.ws + WS_WCOT) + (size_t)m * D * D; }
    } else if (fam == 3) {
        if (r < 32) { kb = r >> 1; nb = r & 1; src = FIN(I_X_WQ) + (size_t)m * D * XW; dst = (bf16*)(F.ws + WS_WXQT) + (size_t)m * XW * D; N = XW; gain = normg + (size_t)(m * 4 + 2) * D; }
        else { r -= 32; kb = r >> 3; nb = r & 7; src = FIN(I_X_WO) + (size_t)m * XW * D; dst = (bf16*)(F.ws + WS_WXOT) + (size_t)m * D * XW; K = XW; }
    } else { const int mat = r >> 6, q = r & 63; kb = q >> 2; nb = q & 3; src = FIN(I_X_WKV) + (size_t)mat * D * 2 * XW; dst = (bf16*)(F.ws + WS_WXKVT) + (size_t)mat * 2 * XW * D; N = 2 * XW; }
    conv_tile(src, dst, K, N, mode, gain, kb, nb, wave, lane);
}
__device__ __forceinline__ void conv_family(Frame& F, int fam, int m, int first, int skip_lo = 0, int skip_hi = 0, int part = 0) {
    if (F.bx < first || (F.bx >= skip_lo && F.bx < skip_hi)) return;
    PHASE_IDS();
    const int nall = conv_family_tiles(fam), r0 = part == 2 ? nall / 2 : 0, nt = part == 1 ? nall / 2 : nall, vb = F.bx - first - (F.bx >= skip_hi ? skip_hi - skip_lo : 0), nb = F.G - first - (skip_hi - skip_lo);
    for (int r = r0 + vb; r < nt; r += nb) conv_family_item(F, fam, m, r, wave, lane);
    if (part == 2) return;
    if (fam == 1) {
        constexpr int PADV = (AB_PAD - AB_IN) * (D / 16);
        for (int i = vb * 512 + tid; i < PADV; i += nb * 512) { const int c = AB_IN + i / (D / 16), k0 = (i % (D / 16)) * 16;
            GAS v4u* o = BIMG ? (GAS v4u*)(F.ws + WS_WABT + (size_t)m * AB_PAD * D * 2 + pg8::img_off(pg8::slot32(c), k0, D)) : (GAS v4u*)(F.ws + WS_WABT + ((size_t)m * AB_PAD + c) * D * 2 + k0 * 2); o[0] = (v4u){0u, 0u, 0u, 0u}; o[1] = (v4u){0u, 0u, 0u, 0u}; }
    }
}

constexpr int CQ_NSEG = 17;
__device__ __forceinline__ void conv_queue_tile(Frame& F, int t, int wave, int lane, int tid) {
    int fam = 0, m = 0, base = 0;
#define CQ_SEG(f_, m_, n_) if (t >= base + (n_)) base += (n_); else { fam = (f_); m = (m_); goto found; }
    CQ_SEG(0, 0, 1032) CQ_SEG(1, 0, 592) CQ_SEG(4, 0, 256) CQ_SEG(3, 0, 64) CQ_SEG(0, 1, 1032) CQ_SEG(0, 2, 1032) CQ_SEG(2, 0, 640) CQ_SEG(3, 1, 64) CQ_SEG(0, 3, 1032)
    CQ_SEG(0, 4, 1032) CQ_SEG(1, 1, 592) CQ_SEG(3, 2, 64) CQ_SEG(0, 5, 1032) CQ_SEG(0, 6, 1032) CQ_SEG(2, 1, 640) CQ_SEG(3, 3, 64) CQ_SEG(0, 7, 1032)
    return;
#undef CQ_SEG
found:
    const int r = t - base;
    conv_family_item(F, fam, m, r, wave, lane);
    if (fam == 1 && r == 0) {
        constexpr int PADV = (AB_PAD - AB_IN) * (D / 16);
        for (int i2 = tid; i2 < PADV; i2 += NWAVES * 64) { const int c = AB_IN + i2 / (D / 16), k0 = (i2 % (D / 16)) * 16;
            GAS v4u* o = BIMG ? (GAS v4u*)(F.ws + WS_WABT + (size_t)m * AB_PAD * D * 2 + pg8::img_off(pg8::slot32(c), k0, D)) : (GAS v4u*)(F.ws + WS_WABT + ((size_t)m * AB_PAD + c) * D * 2 + k0 * 2); o[0] = (v4u){0u, 0u, 0u, 0u}; o[1] = (v4u){0u, 0u, 0u, 0u}; }
    }
}
constexpr int CQ_TOTAL = 11232, CW_CONVQ = 2048;
__device__ __forceinline__ int cq_n_ffn(int s) { return s == 0 ? 1032 : s == 1 ? 2976 : s == 2 ? 4008 : s == 3 ? 5744 : s == 4 ? 6776 : s == 5 ? 8464 : s == 6 ? 9496 : 11232; }
__device__ __forceinline__ int cq_n_mix(int l) { return l == 0 ? 1624 : l == 1 ? 4648 : l == 2 ? 7368 : 10136; }
__device__ __forceinline__ int cq_n_x(int l) { return l == 0 ? 1944 : l == 1 ? 4712 : l == 2 ? 7432 : 10200; }
__device__ __forceinline__ unsigned cq_bcast(Frame& F, unsigned v, int tid) { __syncthreads(); if (tid == 0) F.MISC[20] = v; __syncthreads(); return F.MISC[20]; }
__device__ __forceinline__ void conv_slot(Frame& F, int first, int quota, int skip_lo = 0, int skip_hi = 0) {
    if (F.bx < first || (F.bx >= skip_lo && F.bx < skip_hi)) return;
    PHASE_IDS();
    gu32* q = F.ctl + CW_CONVQ;
    unsigned tk = 0u; if (tid == 0) tk = __hip_atomic_fetch_add(q, 1u, RLX_AGENT);
    for (int i = 0; i < quota; ++i) {
        const unsigned t = cq_bcast(F, tk, tid);
        if (t >= (unsigned)CQ_TOTAL) break;
        if (tid == 0 && i + 1 < quota) tk = __hip_atomic_fetch_add(q, 1u, RLX_AGENT);
        conv_queue_tile(F, (int)t, wave, lane, tid);
    }
}
__device__ __forceinline__ void conv_deadline(Frame& F, int need) {
    PHASE_IDS();
    gu32* q = F.ctl + CW_CONVQ;
    for (;;) {
        unsigned cur = 0u; if (tid == 0) cur = __hip_atomic_load(q, RLX_AGENT);
        if (cq_bcast(F, cur, tid) >= (unsigned)need) break;
        unsigned tk = 0u; if (tid == 0) tk = __hip_atomic_fetch_add(q, 1u, RLX_AGENT);
        const unsigned t = cq_bcast(F, tk, tid);
        if (t < (unsigned)CQ_TOTAL) conv_queue_tile(F, (int)t, wave, lane, tid);
    }
}

__device__ __forceinline__ void p0_prologue(Frame& F) {
    PHASE_IDS();
    conv_deadline(F, cq_n_ffn(0));
    const int gw = F.bx * NWAVES + wave, NGW = F.G * NWAVES;
    {
        const float* x = FIN(I_X); bf16* xb = (bf16*)(F.ws + WS_XB); float* rowss = (float*)(F.ws + WS_ROWSS);
        for (int m = gw; m < M; m += NGW) {
            const GAS f32x4* xr = (const GAS f32x4*)(x + (size_t)m * D) + lane; f32x4 v[8]; float ss = 0.f;
#pragma unroll
            for (int j = 0; j < 8; ++j) { v[j] = xr[64 * j]; ss += (v[j][0] * v[j][0] + v[j][1] * v[j][1]) + (v[j][2] * v[j][2] + v[j][3] * v[j][3]); }
            ss = wave_sum(ss);
            GAS pg8::u32x2* o = (GAS pg8::u32x2*)(xb + (size_t)m * D) + lane;
#pragma unroll
            for (int j = 0; j < 8; ++j) { pg8::u32x2 w; w.x = pg8::cvt_pk_x(v[j][0], v[j][1]); w.y = pg8::cvt_pk_x(v[j][2], v[j][3]);
                if (AIMG_XB) *(GAS pg8::u32x2*)((GAS char*)xb + pg8::img_off(m, 4 * lane + 256 * j, D)) = w; else o[64 * j] = w; }
            if (lane < 32) rowss[(size_t)lane * M + m] = lane == 0 ? ss : 0.f;
        }
    }
    {
        const float* mem = FIN(I_MEM); const float* mg = FIN(I_MEMG); bf16* mn = (bf16*)(F.ws + WS_MEMN);
        for (int m = gw; m < BATCH * MEMT; m += NGW) {
            const GAS f32x4* xr = (const GAS f32x4*)(mem + (size_t)m * D) + lane; f32x4 v[8]; float ss = 0.f;
#pragma unroll
            for (int j = 0; j < 8; ++j) { v[j] = xr[64 * j]; ss += (v[j][0] * v[j][0] + v[j][1] * v[j][1]) + (v[j][2] * v[j][2] + v[j][3] * v[j][3]); }
            const float rs = 1.0f / sqrtf(wave_sum(ss) * (1.0f / D) + EPS);
            GAS pg8::u32x2* o = (GAS pg8::u32x2*)(mn + (size_t)m * D) + lane;
#pragma unroll
            for (int j = 0; j < 8; ++j) { const f32x4 g = ((const GAS f32x4*)mg)[lane + 64 * j]; pg8::u32x2 w; w.x = pg8::cvt_pk_bf16(v[j][0] * rs * g[0], v[j][1] * rs * g[1]); w.y = pg8::cvt_pk_bf16(v[j][2] * rs * g[2], v[j][3] * rs * g[3]); o[64 * j] = w; }
        }
    }
    {
        const float* lg = FIN(I_C_LBL); float* lb = (float*)(F.ws + WS_LB);
        for (int c = F.bx * 512 + tid; c < D; c += F.G * 512) {
            const float a0 = lg[c], a1 = lg[D + c], a2 = lg[2 * D + c], a3 = lg[3 * D + c];
            const float mx = fmaxf(fmaxf(a0, a1), fmaxf(a2, a3));
            const float e0 = expf(a0 - mx), e1 = expf(a1 - mx), e2 = expf(a2 - mx), e3 = expf(a3 - mx), inv = 1.0f / (e0 + e1 + e2 + e3);
            const float p1 = e1 * inv, p2 = e2 * inv, p3 = e3 * inv;
            lb[c] = 0.f; lb[D + c] = p1; lb[2 * D + c] = p1 + p2; lb[3 * D + c] = p1 + p2 + p3;
        }
    }
}

template <class Sched> __device__ __forceinline__ void build_rtab(Frame& F, const Sched& S, int xi = -1, int xpn0 = 0, int xnt = 0) {
    PHASE_IDS();
    const float* rowss = (const float*)(F.ws + WS_ROWSS); LAS float* rt = (LAS float*)(F.lds + RTAB_OFF);
    int xpm = -1; if (xi >= 0) { pg8::HalfOrder H; H.init(M, xpn0, xnt, F.G, F.bx); pg8::Unit hu; if (H.next(0, hu)) xpm = hu.pm; xpm = __builtin_amdgcn_readfirstlane(xpm); }
    float v[4][32]; bool ok[4];
#pragma unroll
    for (int it = 0; it < 4; ++it) {
        const int idx = tid + it * NWAVES * 64, i = idx >> 8, r = idx & 255; pg8::Unit u; ok[it] = S.next(i, u);
        if (!ok[it] && i == xi && xpm >= 0) { ok[it] = true; u.pm = xpm; }
        const GAS float* p = (const GAS float*)rowss + (size_t)((ok[it] ? u.pm : 0) * 256 + r);
        if (ok[it]) {
#pragma unroll
            for (int j = 0; j < 32; ++j) v[it][j] = p[(size_t)j * M];
        } else {
#pragma unroll
            for (int j = 0; j < 32; ++j) v[it][j] = 0.f;
        }
    }
#pragma unroll
    for (int it = 0; it < 4; ++it) {
        float s = 0.f;
#pragma unroll
        for (int j = 0; j < 8; ++j) s += (v[it][4 * j] + v[it][4 * j + 1]) + (v[it][4 * j + 2] + v[it][4 * j + 3]);
        if (ok[it]) rt[tid + it * NWAVES * 64] = 1.0f / sqrtf(s * (1.0f / D) + EPS);
    }
    LDS_WAIT(); __syncthreads();
}
template <class Epi, int PM = 0, bool F16 = false, bool AIMG = false> __device__ __forceinline__ void run_gemm(Frame& F, const bf16* A, const bf16* Bt, int Mrows, int N, int K, const Epi& E, bool need_rtab, int rot = 0, int ld = 0, int ks = 1, int xi = -1, int xpn0 = 0, int xnt = 0) {
    pg8::Gemm g{A, Bt, Mrows, N, K, ld ? ld : K, ks}; pg8::StaticOrder S; S.init(Mrows, N, F.G, (int)(((unsigned)F.bx + (unsigned)rot) % (unsigned)F.G));
    if (need_rtab) build_rtab(F, S, xi, xpn0, xnt);
    pg8::gemm_phase<Epi, pg8::StaticOrder, true, true, PM, false, F16, AIMG>(F.lds + RING_OFF, g, S, E);
}

template <class Epi, bool F16 = false, bool AIMG = false> __device__ __forceinline__ void run_gemm_half(Frame& F, const bf16* A, const bf16* Bt, int Mrows, int N, int K, int pn0, int ntile, const Epi& E, bool need_rtab = true, int rot = 0) {
    pg8::Gemm g{A, Bt, Mrows, N, K, K, 1}; pg8::HalfOrder S; S.init(Mrows, pn0, ntile, F.G, (int)(((unsigned)F.bx + (unsigned)rot) % (unsigned)F.G));
    if (need_rtab) build_rtab(F, S);
    pg8::gemm_phase<Epi, pg8::HalfOrder, true, true, 0, true, F16, AIMG>(F.lds + RING_OFF, g, S, E);
}
__device__ __forceinline__ void normgate(Frame& F, const float* o, const bf16* gate, int nheads, const float* gw_, int ycol) {
    PHASE_IDS();
    bf16* Y = (bf16*)(F.ws + WS_Y);
    const int hw = lane >> 5, l32 = lane & 31, ld = nheads * HD, total = M * nheads;
    const int gw = (F.bx * NWAVES + wave) * 2 + hw, NGW = F.G * NWAVES * 2;
    const f32x4 g4 = *(const GAS f32x4*)(gw_ + 4 * l32);
    for (int u0 = gw; u0 < total; u0 += 4 * NGW) {
        f32x4 v[4]; pg8::u32x2 gt[4];
#pragma unroll
        for (int j = 0; j < 4; ++j) { const int un = u0 + j * NGW; if (un < total) { const int row = un / nheads, h = un - row * nheads;
            v[j] = *(const GAS f32x4*)(o + (size_t)row * ld + h * HD + 4 * l32); gt[j] = *(const GAS pg8::u32x2*)(gate + (size_t)row * ld + h * HD + 4 * l32); } else { v[j] = (f32x4){0.f, 0.f, 0.f, 0.f}; gt[j] = (pg8::u32x2){0u, 0u}; } }
#pragma unroll
        for (int j = 0; j < 4; ++j) { const int un = u0 + j * NGW;
            float ss = (v[j][0] * v[j][0] + v[j][1] * v[j][1]) + (v[j][2] * v[j][2] + v[j][3] * v[j][3]);
#pragma unroll
            for (int of = 1; of < 32; of <<= 1) ss += __shfl_xor(ss, of);
            const float rs = 1.0f / sqrtf(ss * (1.0f / HD) + EPS);
            if (un < total) { const int row = un / nheads, h = un - row * nheads; pg8::u32x2 w;
                w.x = pg8::cvt_pk_bf16(v[j][0] * rs * g4[0] * silu_acc(bflo(gt[j].x)), v[j][1] * rs * g4[1] * silu_acc(bfhi(gt[j].x))); w.y = pg8::cvt_pk_bf16(v[j][2] * rs * g4[2] * silu_acc(bflo(gt[j].y)), v[j][3] * rs * g4[3] * silu_acc(bfhi(gt[j].y)));
                *(GAS pg8::u32x2*)(Y + (size_t)row * D + ycol + h * HD + 4 * l32) = w; }
        }
    }
}
__device__ __forceinline__ void final_norm(Frame& F) {
    PHASE_IDS();
    static_assert(X_F16 == 2, "final_norm reads the fragment-ordered f16 residual plane");
    const GAS pg8::u32x4* xn = (const GAS pg8::u32x4*)(F.ws + WS_X); const GAS float* rowss = (const GAS float*)(F.ws + WS_ROWSS); const float* fg = FIN(I_FINALG);
    const int gw = F.bx * NWAVES + wave, NGW = F.G * NWAVES, fr = lane & 15, fq = lane >> 4;
    constexpr int NT = (M / 256) * (D / 256) * 64;
    for (int t0 = gw; t0 < NT; t0 += 2 * NGW) {
        pg8::u32x4 c0[2], c1[2]; float s[2]; int row[2], tt[2];
#pragma unroll
        for (int u = 0; u < 2; ++u) { const int t = t0 + u * NGW < NT ? t0 + u * NGW : t0; tt[u] = t;
            const int am = t & 7, wid = (t >> 3) & 7, U = t >> 6, pm = U / (D / 256), wr = wid >> 2;
            row[u] = pm * 256 + (am >> 2) * 128 + wr * 64 + (am & 3) * 16 + fr;
            c0[u] = xn[((size_t)t * 2 + 0) * 64 + lane]; c1[u] = xn[((size_t)t * 2 + 1) * 64 + lane];
            float a = 0.f;
#pragma unroll
            for (int k = 0; k < 8; ++k) a += rowss[(size_t)(fq * 8 + k) * M + row[u]];
            s[u] = a; }
#pragma unroll
        for (int u = 0; u < 2; ++u) { if (u == 1 && t0 + NGW >= NT) break;
            const int t = tt[u], wid = (t >> 3) & 7, U = t >> 6, pn = U % (D / 256), wc = wid & 3;
            float a = s[u]; a += __shfl_xor(a, 16); a += __shfl_xor(a, 32);
            const float rs = 1.0f / sqrtf(a * (1.0f / D) + EPS);
#pragma unroll
            for (int bj = 0; bj < 2; ++bj) { const pg8::u32x4 c = bj ? c1[u] : c0[u]; const int col = pn * 256 + bj * 128 + wc * 32 + 8 * fq;
                const f32x4 g0 = *(const GAS f32x4*)(fg + col), g1 = *(const GAS f32x4*)(fg + col + 4);
                const f32x4 x0 = {pg8::f16_lo(c.x), pg8::f16_hi(c.x), pg8::f16_lo(c.y), pg8::f16_hi(c.y)}, x1 = {pg8::f16_lo(c.z), pg8::f16_hi(c.z), pg8::f16_lo(c.w), pg8::f16_hi(c.w)};
                GAS f32x4* o = (GAS f32x4*)(F.out + (size_t)row[u] * D + col); o[0] = x0 * rs * g0; o[1] = x1 * rs * g1; }
        }
    }
}

namespace att {
typedef short s16x4 __attribute__((ext_vector_type(4)));
typedef short v4i16_t __attribute__((ext_vector_type(4)));
__device__ __forceinline__ unsigned swz(unsigned row) { return ((row & 3u) << 2) | ((row >> 2) & 3u); }
__device__ __forceinline__ void glds16(const void* gsrc, unsigned lds_dst) { unsigned keep;
    asm volatile("s_mov_b32 %0, m0\n\ts_mov_b32 m0, %2\n\ts_nop 0\n\tglobal_load_lds_dwordx4 %1, off\n\ts_mov_b32 m0, %0" : "=&s"(keep) : "v"(gsrc), "s"(lds_dst) : "memory"); }
__device__ __forceinline__ s16x4 vtr(const LAS char* p) { return __builtin_bit_cast(s16x4, __builtin_amdgcn_ds_read_tr16_b64_v4i16((LAS v4i16_t*)p)); }
__device__ __forceinline__ void stage_half(const char* g, size_t pitch, LAS char* img, int wave, int lane) {
#pragma unroll
    for (int p = 0; p < 4; ++p) {
        const int piece = 4 * wave + p; const unsigned row = 4u * piece + ((unsigned)lane >> 4), ch = ((unsigned)lane & 15u) ^ swz(row);
        glds16(g + (size_t)row * pitch + ch * 16u, (unsigned)__builtin_amdgcn_readfirstlane((unsigned)(size_t)(img + piece * 1024)));
    }
}
struct State { f32x4 o[2][8]; float m[2], l[2]; };
__device__ __forceinline__ void half_step(State& st, const bf16x8 (&qf)[2][4], const LAS char* Kimg, const LAS char* Vimg, int lane, int maskmode, int kbase, const int (&qidx)[2], const bool (&valid)[2]) {
    const unsigned fr = lane & 15, g = lane >> 4, q4 = fr >> 2, p = lane & 3;
    const unsigned fk = swz(fr);
    f32x4 s[2][8];
#pragma unroll
    for (int qt = 0; qt < 2; ++qt)
#pragma unroll
        for (int kt = 0; kt < 8; ++kt) s[qt][kt] = (f32x4){0.f, 0.f, 0.f, 0.f};
#define SB() __builtin_amdgcn_sched_barrier(0)
#define ATT_LDK(kt_, K_) do { _Pragma("unroll") for (int ks_ = 0; ks_ < 4; ++ks_) K_[ks_] = *(const LAS bf16x8*)(Kimg + 256u * (16u * (kt_) + fr) + 16u * ((4u * ks_ + g) ^ fk)); } while (0)
#define ATT_MMK(kt_, K_) do { _Pragma("unroll") for (int ks_ = 0; ks_ < 4; ++ks_) { s[0][kt_] = __builtin_amdgcn_mfma_f32_16x16x32_bf16(K_[ks_], qf[0][ks_], s[0][kt_], 0, 0, 0); s[1][kt_] = __builtin_amdgcn_mfma_f32_16x16x32_bf16(K_[ks_], qf[1][ks_], s[1][kt_], 0, 0, 0); } } while (0)
    {
        bf16x8 kA[4], kB[4];
        ATT_LDK(0, kA); SB();
        ATT_LDK(1, kB); SB(); ATT_MMK(0, kA); SB();
        ATT_LDK(2, kA); SB(); ATT_MMK(1, kB); SB();
        ATT_LDK(3, kB); SB(); ATT_MMK(2, kA); SB();
        ATT_LDK(4, kA); SB(); ATT_MMK(3, kB); SB();
        ATT_LDK(5, kB); SB(); ATT_MMK(4, kA); SB();
        ATT_LDK(6, kA); SB(); ATT_MMK(5, kB); SB();
        ATT_LDK(7, kB); SB(); ATT_MMK(6, kA); SB();
        ATT_MMK(7, kB); SB();
    }
#undef ATT_LDK
#undef ATT_MMK
    bf16x8 pf[2][4];
    if (maskmode == 1) {
#pragma unroll
        for (int qt = 0; qt < 2; ++qt)
#pragma unroll
            for (int kt = 0; kt < 8; ++kt)
#pragma unroll
                for (int r = 0; r < 4; ++r) if (kbase + 16 * kt + 4 * (int)g + r > qidx[qt]) s[qt][kt][r] = -INFINITY;
    }
#pragma unroll
    for (int qt = 0; qt < 2; ++qt) {
        float mx = -INFINITY;
#pragma unroll
        for (int kt = 0; kt < 8; ++kt)
#pragma unroll
            for (int r = 0; r < 4; ++r) mx = fmaxf(mx, s[qt][kt][r]);
        mx = fmaxf(mx, __shfl_xor(mx, 16)); mx = fmaxf(mx, __shfl_xor(mx, 32));
        if (!valid[qt]) mx = -INFINITY;
        const float mn = fmaxf(st.m[qt], mx);
        const float alpha = (st.m[qt] == -INFINITY) ? 0.f : __builtin_amdgcn_exp2f(st.m[qt] - mn);
        const float msub = (!valid[qt] || mn == -INFINITY) ? INFINITY : mn;
        st.m[qt] = mn;
        float sum = 0.f;
#pragma unroll
        for (int kt = 0; kt < 8; ++kt)
#pragma unroll
            for (int r = 0; r < 4; ++r) { const float pv = __builtin_amdgcn_exp2f(s[qt][kt][r] - msub); s[qt][kt][r] = pv; sum += pv; }
        st.l[qt] = st.l[qt] * alpha + sum;
        if (__any(alpha != 1.0f)) {
#pragma unroll
            for (int dt = 0; dt < 8; ++dt) st.o[qt][dt] = st.o[qt][dt] * alpha;
        }
#pragma unroll
        for (int ks = 0; ks < 4; ++ks) {
            pg8::u32x4 w; w.x = pg8::cvt_pk_bf16(s[qt][2 * ks][0], s[qt][2 * ks][1]); w.y = pg8::cvt_pk_bf16(s[qt][2 * ks][2], s[qt][2 * ks][3]);
            w.z = pg8::cvt_pk_bf16(s[qt][2 * ks + 1][0], s[qt][2 * ks + 1][1]); w.w = pg8::cvt_pk_bf16(s[qt][2 * ks + 1][2], s[qt][2 * ks + 1][3]);
            pf[qt][ks] = __builtin_bit_cast(bf16x8, w);
        }
    }
    const unsigned fv = (q4 << 2) | g;
#define ATT_LDV(dt_, V_) do { const unsigned vb_ = 256u * (4u * g + q4) + 16u * ((2u * (dt_) + (p >> 1)) ^ fv) + 8u * (p & 1u); _Pragma("unroll") for (int ks_ = 0; ks_ < 4; ++ks_) { \
        const s16x4 v0_ = vtr(Vimg + vb_ + 256u * (32u * ks_)), v1_ = vtr(Vimg + vb_ + 256u * (32u * ks_ + 16u)); bf16x8 t_; t_[0] = v0_[0]; t_[1] = v0_[1]; t_[2] = v0_[2]; t_[3] = v0_[3]; t_[4] = v1_[0]; t_[5] = v1_[1]; t_[6] = v1_[2]; t_[7] = v1_[3]; V_[ks_] = t_; } } while (0)
#define ATT_MMV(dt_, V_) do { _Pragma("unroll") for (int ks_ = 0; ks_ < 4; ++ks_) { st.o[0][dt_] = __builtin_amdgcn_mfma_f32_16x16x32_bf16(V_[ks_], pf[0][ks_], st.o[0][dt_], 0, 0, 0); st.o[1][dt_] = __builtin_amdgcn_mfma_f32_16x16x32_bf16(V_[ks_], pf[1][ks_], st.o[1][dt_], 0, 0, 0); } } while (0)
    {
        bf16x8 vA[4], vB[4];
        ATT_LDV(0, vA); SB();
        ATT_LDV(1, vB); SB(); ATT_MMV(0, vA); SB();
        ATT_LDV(2, vA); SB(); ATT_MMV(1, vB); SB();
        ATT_LDV(3, vB); SB(); ATT_MMV(2, vA); SB();
        ATT_LDV(4, vA); SB(); ATT_MMV(3, vB); SB();
        ATT_LDV(5, vB); SB(); ATT_MMV(4, vA); SB();
        ATT_LDV(6, vA); SB(); ATT_MMV(5, vB); SB();
        ATT_LDV(7, vB); SB(); ATT_MMV(6, vA); SB();
        ATT_MMV(7, vB); SB();
    }
#undef ATT_LDV
#undef ATT_MMV
#undef SB
}
}

template <int MODE>
__device__ __forceinline__ void attn_unit(Frame& F, int tid_in, int wave, int b, int h, int qblk, int l) {
    const int tid = opaque_i(tid_in), lane = tid & 63;
    LAS char* ring = (LAS char*)(F.lds + RING_OFF);
    LAS unsigned* sel = (LAS unsigned*)(F.lds + RTAB_OFF);
    const bf16* Qp; int ldq; bf16* Op; int ldo;
    if (MODE == 0) { Qp = (const bf16*)(F.ws + WS_XQ); ldq = XW; Op = (bf16*)(F.ws + WS_XO); ldo = XW; }
    else { Qp = (const bf16*)(F.ws + WS_QM); ldq = 1024; Op = (bf16*)(F.ws + WS_Y); ldo = D; }
    const int row0 = b * SEQ + qblk * 256;
    const unsigned fr = lane & 15, g = lane >> 4;
    int nsteps = 2;
    if (MODE == 1) {
        const float* kms = (const float*)(F.ws + WS_KMS);
        LAS float* km = (LAS float*)ring; LAS float* gl = (LAS float*)(ring + 8192);
        __syncthreads();
        for (int i = tid; i < qblk * 128; i += NWAVES * 64) { const int j = i >> 7, d = i & 127; const float* p0 = kms + (size_t)((b * NBLK + j) * 2) * 1024 + h * HD + d; km[i] = p0[0] + p0[1024]; }
        LDS_WAIT(); __syncthreads();
        {
            const int q = tid >> 1, par = tid & 1; float ga[8];
#pragma unroll
            for (int jj = 0; jj < 8; ++jj) ga[jj] = 0.f;
            const GAS v4u* qr = (const GAS v4u*)(Qp + (size_t)(row0 + q) * ldq + h * HD);
            for (int c = 0; c < 16; ++c) {
                const v4u w = qr[c]; const float q0 = bflo(w.x), q1 = bfhi(w.x), q2 = bflo(w.y), q3 = bfhi(w.y), q4 = bflo(w.z), q5 = bfhi(w.z), q6 = bflo(w.w), q7 = bfhi(w.w);
#pragma unroll
                for (int jj = 0; jj < 8; ++jj) { const int j = 2 * jj + par; if (j < qblk) { const f32x4 k0 = *(const LAS f32x4*)(km + j * 128 + 8 * c), k1 = *(const LAS f32x4*)(km + j * 128 + 8 * c + 4);
                    ga[jj] += (q0 * k0[0] + q1 * k0[1]) + (q2 * k0[2] + q3 * k0[3]) + (q4 * k1[0] + q5 * k1[1]) + (q6 * k1[2] + q7 * k1[3]); } }
            }
#pragma unroll
            for (int jj = 0; jj < 8; ++jj) gl[q * 16 + 2 * jj + par] = ga[jj];
        }
        LDS_WAIT(); __syncthreads();
        if (tid < 256) {
            float v1 = -INFINITY, v2 = -INFINITY, v3 = -INFINITY; int i1 = -1, i2 = -1, i3 = -1;
            for (int j = 0; j < qblk; ++j) { const float gj = gl[tid * 16 + j];
                if (gj > v1) { v3 = v2; i3 = i2; v2 = v1; i2 = i1; v1 = gj; i1 = j; } else if (gj > v2) { v3 = v2; i3 = i2; v2 = gj; i2 = j; } else if (gj > v3) { v3 = gj; i3 = j; } }
            unsigned mbits = 1u << qblk; if (i1 >= 0) mbits |= 1u << i1; if (i2 >= 0) mbits |= 1u << i2; if (i3 >= 0) mbits |= 1u << i3;
            sel[tid] = mbits;
        }
        LDS_WAIT(); __syncthreads();
        nsteps = 2 * (qblk + 1);
    } else { __syncthreads(); }
    bf16x8 qf[2][4]; int qidx[2]; unsigned selq[2];
#pragma unroll
    for (int qt = 0; qt < 2; ++qt) {
        qidx[qt] = 32 * wave + 16 * qt + (int)fr; selq[qt] = MODE == 1 ? sel[qidx[qt]] : 0u;
        const bf16* qrow = Qp + (size_t)(row0 + qidx[qt]) * ldq + h * HD;
#pragma unroll
        for (int ks = 0; ks < 4; ++ks) qf[qt][ks] = *(const GAS bf16x8*)(qrow + 32 * ks + 8 * g);
    }
    att::State st;
#pragma unroll
    for (int qt = 0; qt < 2; ++qt) { st.m[qt] = -INFINITY; st.l[qt] = 0.f;
#pragma unroll
        for (int dt = 0; dt < 8; ++dt) st.o[qt][dt] = (f32x4){0.f, 0.f, 0.f, 0.f}; }
    const size_t pitch = MODE == 0 ? (size_t)4096 * 2 : (size_t)1024 * 2;
#define KBASE_OF(i) (MODE == 0 ? (const char*)((const bf16*)(F.ws + WS_KV) + (size_t)(b * MEMT + (i) * 128) * 4096 + l * 1024 + h * HD) \
                               : (const char*)((const bf16*)(F.ws + WS_KM) + (size_t)(b * SEQ + ((i) < 2 ? qblk : (((i) - 2) >> 1)) * 256 + ((i) & 1) * 128) * 1024 + h * HD))
#define VBASE_OF(i) (MODE == 0 ? (const char*)((const bf16*)(F.ws + WS_KV) + (size_t)(b * MEMT + (i) * 128) * 4096 + l * 1024 + 512 + h * HD) \
                               : (const char*)((const bf16*)(F.ws + WS_VM) + (size_t)(b * SEQ + ((i) < 2 ? qblk : (((i) - 2) >> 1)) * 256 + ((i) & 1) * 128) * 1024 + h * HD))
    att::stage_half(KBASE_OF(0), pitch, ring, wave, lane); att::stage_half(VBASE_OF(0), pitch, ring + 32768, wave, lane);
    VM_WAIT(); __syncthreads();
    for (int i = 0; i < nsteps; ++i) {
        LAS char* cur = ring + (i & 1) * 65536; LAS char* nxt = ring + ((i + 1) & 1) * 65536;
        const int ln = opaque_i(lane);
        if (i + 1 < nsteps) { att::stage_half(KBASE_OF(i + 1), pitch, nxt, wave, ln); att::stage_half(VBASE_OF(i + 1), pitch, nxt + 32768, wave, ln); }
        bool valid[2] = {true, true}; int maskmode = 0; bool run = true;
        if (MODE == 1) {
            if (i < 2) { maskmode = 1; if (i == 1 && wave < 4) run = false; }
            else { const int blk = (i - 2) >> 1; valid[0] = (selq[0] >> blk) & 1u; valid[1] = (selq[1] >> blk) & 1u; run = __any((int)(valid[0] || valid[1])) != 0; }
        }
        if (run) att::half_step(st, qf, cur, cur + 32768, opaque_i(ln), maskmode, (i & 1) * 128, qidx, valid);
        VM_WAIT(); __syncthreads();
    }
#pragma unroll
    for (int qt = 0; qt < 2; ++qt) {
        float lt = st.l[qt]; lt += __shfl_xor(lt, 16); lt += __shfl_xor(lt, 32);
        const float inv = 1.0f / lt;
        bf16* orow = Op + (size_t)(row0 + qidx[qt]) * ldo + h * HD + 4 * g;
#pragma unroll
        for (int dt = 0; dt < 8; ++dt) { pg8::u32x2 w; w.x = pg8::cvt_pk_bf16(st.o[qt][dt][0] * inv, st.o[qt][dt][1] * inv); w.y = pg8::cvt_pk_bf16(st.o[qt][dt][2] * inv, st.o[qt][dt][3] * inv); *(GAS pg8::u32x2*)(orow + 16 * dt) = w; }
    }
}
#undef KBASE_OF
#undef VBASE_OF
__device__ __forceinline__ void moba_phase(Frame& F, int blk0) {
    if (F.bx < blk0) return;
    PHASE_IDS();
    const int nb = F.G - blk0;
    for (int pr = F.bx - blk0; pr < BATCH * NH_AB * 8; pr += nb) {
        const int bh = pr >> 3, k = pr & 7, b = bh >> 3, h = bh & 7;
        for (int rep = 0; rep < 2; ++rep) attn_unit<1>(F, tid, wave, b, h, rep ? k : 15 - k, 0);
    }
}
__device__ __forceinline__ void xattn_phase(Frame& F, int l) {
    PHASE_IDS();
    for (int un = F.bx; un < BATCH * 4 * (SEQ / 256); un += F.G) {
        const int qblk = un & 15, bh = un >> 4, b = bh >> 2, h = bh & 3;
        attn_unit<0>(F, tid, wave, b, h, qblk, l);
    }
}

constexpr size_t WS_UT = WS_MIX + 114 * MiB, WS_WT = WS_MIX + 146 * MiB, WS_QDT = WS_MIX + 162 * MiB, WS_KD = WS_MIX + 178 * MiB, WS_AQK = WS_MIX + 194 * MiB, WS_GL = WS_MIX + 202 * MiB;
namespace dn {
typedef short s16x4 __attribute__((ext_vector_type(4)));
__device__ __forceinline__ unsigned swz8(unsigned row) { return (row >> 1) & 7u; }
__device__ __forceinline__ s16x4 pack4(const f32x4& v) { pg8::u32x2 w; w.x = pg8::cvt_pk_bf16(v[0], v[1]); w.y = pg8::cvt_pk_bf16(v[2], v[3]); return __builtin_bit_cast(s16x4, w); }
__device__ __forceinline__ f32x4 unpack4(const s16x4& v) { const pg8::u32x2 w = __builtin_bit_cast(pg8::u32x2, v); return (f32x4){bflo(w.x), bfhi(w.x), bflo(w.y), bfhi(w.y)}; }
__device__ __forceinline__ bf16x8 join8(const s16x4& a, const s16x4& b) { bf16x8 r; r[0] = a[0]; r[1] = a[1]; r[2] = a[2]; r[3] = a[3]; r[4] = b[0]; r[5] = b[1]; r[6] = b[2]; r[7] = b[3]; return r; }
constexpr int MPITCH = 68, DPITCH = 20;
}

__device__ __forceinline__ void dn_chunk_phase(Frame& F, int e) {
    PHASE_IDS();
    LAS char* ring = (LAS char*)(F.lds + RING_OFF);
    LAS char* QI = ring; LAS char* KI = ring + 16384; LAS char* VI = ring + 32768;
    LAS float* MI = (LAS float*)(ring + 49152);
    LAS float* DI = (LAS float*)(ring + 49152 + 64 * dn::MPITCH * 4);
    LAS float* TG = DI + 4 * 16 * dn::DPITCH; LAS float* TB = TG + 64; LAS float* SSQ = TB + 64;
    const bf16* pre = (const bf16*)(F.ws + WS_DNPRE); const float* ba = (const float*)(F.ws + WS_BA); const float* cw = FIN(I_AB_CONVW) + (size_t)e * 4 * 3072;
    const unsigned fr = lane & 15, g = lane >> 4, q4 = fr >> 2, p = lane & 3;
    for (int ci = F.bx; ci < BATCH * NH_AB * (SEQ / 64); ci += F.G) {
        const int n = ci & 63, bh = ci >> 6, h = bh & 7, b = bh >> 3; const size_t rbase = (size_t)b * SEQ + n * 64;
        float* uT = (float*)(F.ws + WS_UT) + (size_t)ci * 8192; bf16* wT = (bf16*)(F.ws + WS_WT) + (size_t)ci * 8192; bf16* qdT = (bf16*)(F.ws + WS_QDT) + (size_t)ci * 8192;
        bf16* kd = (bf16*)(F.ws + WS_KD) + (size_t)ci * 8192; bf16* aqk = (bf16*)(F.ws + WS_AQK) + (size_t)ci * 4096;
        __syncthreads();
        float val[6][8];
        v4u wpre[6][4];
#pragma unroll
        for (int it = 0; it < 6; ++it) {
            const int sec = it >> 1, c = (tid >> 4) + 32 * (it & 1), gq = tid & 15, ch = sec * 1024 + h * HD + 8 * gq, t = n * 64 + c;
#pragma unroll
            for (int i = 0; i < 4; ++i) { const bool okt = t - 3 + i >= 0; wpre[it][i] = *(const GAS v4u*)(pre + (rbase + (okt ? c - 3 + i : c)) * 3072 + ch); }
        }
#pragma unroll
        for (int it = 0; it < 6; ++it) {
            const int sec = it >> 1, c = (tid >> 4) + 32 * (it & 1), gq = tid & 15, ch = sec * 1024 + h * HD + 8 * gq, t = n * 64 + c;
#pragma unroll
            for (int j = 0; j < 8; ++j) val[it][j] = 0.f;
#pragma unroll
            for (int i = 0; i < 4; ++i) {
                const f32x4 c0 = *(const GAS f32x4*)(cw + i * 3072 + ch), c1 = *(const GAS f32x4*)(cw + i * 3072 + ch + 4);
                if (t - 3 + i >= 0) {
                    const v4u w = wpre[it][i];
                    val[it][0] += c0[0] * bflo(w.x); val[it][1] += c0[1] * bfhi(w.x); val[it][2] += c0[2] * bflo(w.y); val[it][3] += c0[3] * bfhi(w.y);
                    val[it][4] += c1[0] * bflo(w.z); val[it][5] += c1[1] * bfhi(w.z); val[it][6] += c1[2] * bflo(w.w); val[it][7] += c1[3] * bfhi(w.w);
                }
            }
            float ss = 0.f;
#pragma unroll
            for (int j = 0; j < 8; ++j) { val[it][j] = silu_acc(val[it][j]); ss += val[it][j] * val[it][j]; }
            if (sec < 2) SSQ[(c * 2 + sec) * 16 + gq] = ss;
        }
        if (tid < 64) {
            const float braw = ba[(rbase + tid) * 16 + h], araw = ba[(rbase + tid) * 16 + 8 + h] + FIN(I_AB_DTB)[e * 8 + h];
            const float ea = __expf(araw); const float sp = araw > 20.f ? araw : (ea < 1e-3f ? ea * (1.0f - 0.5f * ea) : __logf(1.0f + ea));
            float gg = -__expf(FIN(I_AB_ALOG)[e * 8 + h]) * sp;
#pragma unroll
            for (int o = 1; o < 64; o <<= 1) { const float t2 = __shfl_up(gg, o); if (lane >= o) gg += t2; }
            TG[tid] = gg; TB[tid] = sigmoid_f(braw);
        }
        LDS_WAIT(); __syncthreads();
#pragma unroll
        for (int it = 0; it < 6; ++it) {
            const int sec = it >> 1, c = (tid >> 4) + 32 * (it & 1), gq = tid & 15; float sc = 1.0f;
            if (sec < 2) { float s = 0.f;
#pragma unroll
                for (int j = 0; j < 4; ++j) { const f32x4 q = *(const LAS f32x4*)(SSQ + (c * 2 + sec) * 16 + 4 * j); s += (q[0] + q[1]) + (q[2] + q[3]); }
                sc = (1.0f / sqrtf(s + EPS)) * (sec == 0 ? 0.08838834764831845f : 1.0f); }
            LAS char* img = sec == 0 ? QI : (sec == 1 ? KI : VI);
            v4u w; w.x = pg8::cvt_pk_bf16(val[it][0] * sc, val[it][1] * sc); w.y = pg8::cvt_pk_bf16(val[it][2] * sc, val[it][3] * sc); w.z = pg8::cvt_pk_bf16(val[it][4] * sc, val[it][5] * sc); w.w = pg8::cvt_pk_bf16(val[it][6] * sc, val[it][7] * sc);
            *(LAS v4u*)(img + 256 * c + 16 * ((unsigned)gq ^ att::swz((unsigned)c))) = w;
        }
        if (tid < 384) { const int pr = tid >> 6, ctz = pr < 3 ? 0 : (pr < 5 ? 1 : 2), stz = pr < 3 ? pr + 1 : (pr < 5 ? pr - 1 : 3), cz = 16 * ctz + ((tid & 63) >> 2), gz = tid & 3;
            *(GAS pg8::u32x2*)(aqk + cz * 64 + 32 * (stz >> 1) + 8 * gz + 4 * (stz & 1)) = (pg8::u32x2){0u, 0u}; }
        LDS_WAIT(); __syncthreads();
        for (int jb = wave; jb < 20; jb += NWAVES) {
            const int ty = jb >= 10 ? 1 : 0, ti = jb - 10 * ty; int ct = 0, st = ti;
            if (ti >= 6) { ct = 3; st = ti - 6; } else if (ti >= 3) { ct = 2; st = ti - 3; } else if (ti >= 1) { ct = 1; st = ti - 1; }
            f32x4 acc = {0.f, 0.f, 0.f, 0.f};
            if (ty == 0) {
#pragma unroll
                for (int ks = 0; ks < 4; ++ks) { const bf16x8 a = *(const LAS bf16x8*)(KI + 256u * (16u * ct + fr) + 16u * ((4u * ks + g) ^ att::swz(fr))), bb = *(const LAS bf16x8*)(KI + 256u * (16u * st + fr) + 16u * ((4u * ks + g) ^ att::swz(fr)));
                    acc = __builtin_amdgcn_mfma_f32_16x16x32_bf16(a, bb, acc, 0, 0, 0); }
                const int s = 16 * st + (int)fr; const float gs = TG[s];
#pragma unroll
                for (int r = 0; r < 4; ++r) { const int c = 16 * ct + 4 * (int)g + r; MI[c * dn::MPITCH + s] = s < c ? acc[r] * TB[c] * __expf(TG[c] - gs) : 0.f; }
            } else {
#pragma unroll
                for (int ks = 0; ks < 4; ++ks) { const bf16x8 a = *(const LAS bf16x8*)(KI + 256u * (16u * st + fr) + 16u * ((4u * ks + g) ^ att::swz(fr))), bb = *(const LAS bf16x8*)(QI + 256u * (16u * ct + fr) + 16u * ((4u * ks + g) ^ att::swz(fr)));
                    acc = __builtin_amdgcn_mfma_f32_16x16x32_bf16(a, bb, acc, 0, 0, 0); }
                const int c = 16 * ct + (int)fr; const float gc = TG[c]; f32x4 o;
#pragma unroll
                for (int r = 0; r < 4; ++r) { const int s = 16 * st + 4 * (int)g + r; o[r] = s <= c ? acc[r] * __expf(gc - TG[s]) : 0.f; }
                *(GAS dn::s16x4*)(aqk + c * 64 + 32 * (st >> 1) + 8 * g + 4 * (st & 1)) = dn::pack4(o);
            }
        }
        LDS_WAIT(); __syncthreads();
        if (wave == 0) {
            const int i = g, j = fr; float dc[16]; f32x4 mr[16][4];
#pragma unroll
            for (int r = 1; r < 16; ++r)
#pragma unroll
                for (int q = 0; q < 4; ++q) if (4 * q < r) mr[r][q] = *(const LAS f32x4*)(MI + (16 * i + r) * dn::MPITCH + 16 * i + 4 * q);
#pragma unroll
            for (int r = 0; r < 16; ++r) { float a = (r == j) ? 1.f : 0.f;
#pragma unroll
                for (int s = 0; s < r; ++s) a -= mr[r][s >> 2][s & 3] * dc[s];
                dc[r] = a; }
#pragma unroll
            for (int r = 0; r < 16; ++r) DI[(i * 16 + r) * dn::DPITCH + j] = dc[r];
        }
        LDS_WAIT(); __syncthreads();
#pragma unroll
        for (int job = 0; job < 2; ++job) {
            const LAS char* img = job ? KI : VI; dn::s16x4 xb[4];
#pragma unroll
            for (int i = 0; i < 4; ++i) {
                const unsigned row = 16u * i + 4u * g + q4;
                const dn::s16x4 raw = att::vtr(img + 256u * row + 16u * ((2u * wave + (p >> 1)) ^ att::swz(row)) + 8u * (p & 1u));
                f32x4 acc = dn::unpack4(raw);
#pragma unroll
                for (int r = 0; r < 4; ++r) { const int c = 16 * i + 4 * (int)g + r; acc[r] *= job ? TB[c] * __expf(TG[c]) : TB[c]; }
#pragma unroll
                for (int j = 0; j < 4; ++j) { if (j < i) { const f32x4 mm = *(const LAS f32x4*)(MI + (16 * i + (int)fr) * dn::MPITCH + 16 * j + 4 * (int)g);
                    acc = __builtin_amdgcn_mfma_f32_16x16x16bf16_1k(dn::pack4(-mm), xb[j], acc, 0, 0, 0); } }
                const f32x4 dd = *(const LAS f32x4*)(DI + (16 * i + (int)fr) * dn::DPITCH + 4 * (int)g);
                const f32x4 x = __builtin_amdgcn_mfma_f32_16x16x16bf16_1k(dn::pack4(dd), dn::pack4(acc), (f32x4){0.f, 0.f, 0.f, 0.f}, 0, 0, 0);
                xb[i] = dn::pack4(x);
                if (job == 0) *(GAS f32x4*)(uT + (16 * wave + (int)fr) * 64 + 16 * i + 4 * (int)g) = x;
                else *(GAS dn::s16x4*)(wT + (16 * wave + (int)fr) * 64 + 16 * i + 4 * (int)g) = dn::pack4(-x);
            }
        }
#pragma unroll
        for (int i = 0; i < 4; ++i) {
            const unsigned row = 16u * i + 4u * g + q4;
            f32x4 qv = dn::unpack4(att::vtr(QI + 256u * row + 16u * ((2u * wave + (p >> 1)) ^ att::swz(row)) + 8u * (p & 1u)));
#pragma unroll
            for (int r = 0; r < 4; ++r) qv[r] *= __expf(TG[16 * i + 4 * (int)g + r]);
            *(GAS dn::s16x4*)(qdT + (16 * wave + (int)fr) * 64 + 16 * i + 4 * (int)g) = dn::pack4(qv);
        }
        {
            const float glast = TG[63];
#pragma unroll
            for (int it = 0; it < 2; ++it) { const int item = tid + 512 * it, s = item >> 4, ch = item & 15; const float sc = __expf(glast - TG[s]);
                const v4u w = *(const LAS v4u*)(KI + 256 * s + 16 * ((unsigned)ch ^ att::swz((unsigned)s)));
                v4u o; o.x = pg8::cvt_pk_bf16(bflo(w.x) * sc, bfhi(w.x) * sc); o.y = pg8::cvt_pk_bf16(bflo(w.y) * sc, bfhi(w.y) * sc); o.z = pg8::cvt_pk_bf16(bflo(w.z) * sc, bfhi(w.z) * sc); o.w = pg8::cvt_pk_bf16(bflo(w.w) * sc, bfhi(w.w) * sc);
                *(GAS v4u*)(kd + s * 128 + 8 * ch) = o; }
            if (tid == 0) ((float*)(F.ws + WS_GL))[ci] = __expf(glast);
        }
    }
    __syncthreads();
}

#ifndef DN_TAIL_NORMGATE
#define DN_TAIL_NORMGATE 1
#endif
constexpr int CW_CHAIN = 8192;
__device__ __forceinline__ void chain_sync(Frame& F, gu32* word, unsigned want) {
    asm volatile("s_waitcnt vmcnt(0)" ::: "memory");
    __syncthreads();
    if (threadIdx.x == 0) {
        __builtin_amdgcn_fence(__ATOMIC_RELEASE, "agent"); asm volatile("s_waitcnt vmcnt(0)" ::: "memory");
        __hip_atomic_fetch_add(word, 1u, RLX_AGENT);
        unsigned sp = 0u;
        while (__hip_atomic_load(word, RLX_AGENT) < want) { __builtin_amdgcn_s_sleep(1); if (++sp > (1u << 22)) break; }
        __builtin_amdgcn_fence(__ATOMIC_ACQUIRE, "agent"); asm volatile("s_waitcnt vmcnt(0)" ::: "memory");
    }
    __syncthreads();
}
constexpr int NG_ = 8;
__device__ __forceinline__ void normgate_rows(Frame& F, const float* o, const bf16* gate, int nheads, const float* gw_, int ycol, int r0, int nr, int h) {
    PHASE_IDS();
    bf16* Y = (bf16*)(F.ws + WS_Y);
    const int hw = lane >> 5, l32 = lane & 31, ld = nheads * HD, hid = wave * 2 + hw;
    const f32x4 g4 = *(const GAS f32x4*)(gw_ + 4 * l32);
    for (int u0 = hid; u0 < nr; u0 += NG_ * 2 * NWAVES) {
        f32x4 v[NG_]; pg8::u32x2 gt[NG_];
#pragma unroll
        for (int j = 0; j < NG_; ++j) { const int un = u0 + j * 2 * NWAVES; if (un < nr) { const size_t row = (size_t)(r0 + un);
            v[j] = *(const GAS f32x4*)(o + row * ld + h * HD + 4 * l32); gt[j] = *(const GAS pg8::u32x2*)(gate + row * ld + h * HD + 4 * l32); } else { v[j] = (f32x4){0.f, 0.f, 0.f, 0.f}; gt[j] = (pg8::u32x2){0u, 0u}; } }
#pragma unroll
        for (int j = 0; j < NG_; ++j) { const int un = u0 + j * 2 * NWAVES;
            float ss = (v[j][0] * v[j][0] + v[j][1] * v[j][1]) + (v[j][2] * v[j][2] + v[j][3] * v[j][3]);
#pragma unroll
            for (int of = 1; of < 32; of <<= 1) ss += __shfl_xor(ss, of);
            const float rs = 1.0f / sqrtf(ss * (1.0f / HD) + EPS);
            if (un < nr) { const size_t row = (size_t)(r0 + un); pg8::u32x2 w;
                w.x = pg8::cvt_pk_bf16(v[j][0] * rs * g4[0] * silu_acc(bflo(gt[j].x)), v[j][1] * rs * g4[1] * silu_acc(bfhi(gt[j].x))); w.y = pg8::cvt_pk_bf16(v[j][2] * rs * g4[2] * silu_acc(bflo(gt[j].y)), v[j][3] * rs * g4[3] * silu_acc(bfhi(gt[j].y)));
                *(GAS pg8::u32x2*)(Y + row * D + ycol + h * HD + 4 * l32) = w; }
        }
    }
}
constexpr int CW_NGQ = 8192 + 128 * 16;
__device__ __forceinline__ void ng_help(Frame& F, int e) {
    PHASE_IDS();
    constexpr int SPL = 4, NCH = BATCH * NH_AB, TPC = 16, ROWS = SEQ / TPC;
    gu32* q = F.ctl + CW_NGQ + e * 16;
    for (;;) {
        unsigned tk = 0u; if (tid == 0) tk = __hip_atomic_fetch_add(q, 1u, RLX_AGENT);
        const unsigned t = cq_bcast(F, tk, tid);
        if (t >= (unsigned)(NCH * TPC)) break;
        const int bh = (int)t / TPC, k = (int)t % TPC, h = bh & 7, b = bh >> 3;
        if (tid == 0) { gu32* w = F.ctl + CW_CHAIN + (e * NCH + bh) * 16; unsigned sp = 0u;
            while (__hip_atomic_load(w, RLX_AGENT) < (unsigned)SPL) { __builtin_amdgcn_s_sleep(1); if (++sp > (1u << 22)) break; }
            __builtin_amdgcn_fence(__ATOMIC_ACQUIRE, "agent"); asm volatile("s_waitcnt vmcnt(0)" ::: "memory"); }
        __syncthreads();
        normgate_rows(F, (const float*)(F.ws + WS_DNO), (const bf16*)(F.ws + WS_DNGATE), NH_AB, FIN(I_AB_ONG) + e * HD, 1024, b * SEQ + k * ROWS, ROWS, h);
    }
}
template <int PM>
__device__ __forceinline__ void dn_scan_phase(Frame& F, int e) {
    constexpr int SPL = 4, NCH = BATCH * NH_AB;
    if (F.bx >= SPL * NCH) return;
    PHASE_IDS();
    const int bh = F.bx % NCH, part = F.bx / NCH, h = bh & 7, b = bh >> 3;
    const int dvt = (8 / SPL) * part + (wave & (8 / SPL - 1)); const bool active = wave < 8 / SPL;
    const int rot = part * (56 / SPL);
    LAS char* ring = (LAS char*)(F.lds + RING_OFF);
    constexpr int STG = 57344;
    const char* gWT = (const char*)(F.ws + WS_WT) + (size_t)bh * 64 * 16384; const char* gQD = (const char*)(F.ws + WS_QDT) + (size_t)bh * 64 * 16384;
    const char* gKD = (const char*)(F.ws + WS_KD) + (size_t)bh * 64 * 16384; const char* gAQ = (const char*)(F.ws + WS_AQK) + (size_t)bh * 64 * 8192;
    const float* gUT = (const float*)(F.ws + WS_UT) + (size_t)bh * 64 * 8192; const float* gGL = (const float*)(F.ws + WS_GL) + bh * 64;
    float* dno = (float*)(F.ws + (PM == 0 ? WS_DNO : WS_ACT));
#define DN_STAGE(n_, stg_) do { _Pragma("unroll") for (int pi_ = 0; pi_ < 7; ++pi_) { int pc_ = 7 * wave + pi_ + rot; pc_ -= pc_ >= 56 ? 56 : 0; const char* src_; \
        if (pc_ < 32 || pc_ >= 48) { const int q_ = pc_ < 16 ? pc_ : (pc_ < 32 ? pc_ - 16 : pc_ - 48); const unsigned row_ = 8u * q_ + ((unsigned)ln >> 3), ch_ = ((unsigned)ln & 7u) ^ dn::swz8(row_); \
            src_ = (pc_ < 16 ? gWT + (size_t)(n_) * 16384 : (pc_ < 32 ? gQD + (size_t)(n_) * 16384 : gAQ + (size_t)(n_) * 8192)) + row_ * 128u + ch_ * 16u; } \
        else { const int q_ = pc_ - 32; const unsigned row_ = 4u * q_ + ((unsigned)ln >> 4), ch_ = ((unsigned)ln & 15u) ^ att::swz(row_); src_ = gKD + (size_t)(n_) * 16384 + row_ * 256u + ch_ * 16u; } \
        att::glds16(src_, (unsigned)__builtin_amdgcn_readfirstlane((unsigned)(size_t)((stg_) + pc_ * 1024))); } } while (0)
    f32x4 S[8]; bf16x8 Sb[4];
#pragma unroll
    for (int dt = 0; dt < 8; ++dt) S[dt] = (f32x4){0.f, 0.f, 0.f, 0.f};
#pragma unroll
    for (int ks = 0; ks < 4; ++ks) Sb[ks] = (bf16x8){0, 0, 0, 0, 0, 0, 0, 0};
    { const int ln = lane; DN_STAGE(0, ring); }
    f32x4 un[4]; const int glbits = __float_as_int(gGL[lane]);
#pragma unroll
    for (int mt = 0; mt < 4; ++mt) un[mt] = *(const GAS f32x4*)(gUT + (16 * dvt + (lane & 15)) * 64 + 16 * mt + 4 * (lane >> 4));
    VM_WAIT(); __syncthreads();
    for (int n = 0; n < SEQ / 64; ++n) {
        LAS char* cur = ring + (n & 1) * STG; LAS char* nxt = ring + ((n + 1) & 1) * STG;
        const int ln = opaque_i(lane);
        asm volatile("" : "+v"(un[0]), "+v"(un[1]), "+v"(un[2]), "+v"(un[3]));
        f32x4 vn[4];
#pragma unroll
        for (int mt = 0; mt < 4; ++mt) vn[mt] = un[mt];
        if (PM != 1 && n + 1 < SEQ / 64) DN_STAGE(n + 1, nxt);
        const unsigned fr = ln & 15, g = (unsigned)ln >> 4, q4 = fr >> 2, p = ln & 3;
        const LAS char* WI = cur; const LAS char* QDI = cur + 16384; const LAS char* KDI = cur + 32768; const LAS char* AQI = cur + 49152;
        if (active && PM != 2) {
        const float gl = __int_as_float(__builtin_amdgcn_readlane(glbits, n));
        f32x4 oo[4];
#pragma unroll
        for (int mt = 0; mt < 4; ++mt) oo[mt] = (f32x4){0.f, 0.f, 0.f, 0.f};
        if (n + 1 < SEQ / 64) {
#pragma unroll
            for (int mt = 0; mt < 4; ++mt) un[mt] = *(const GAS f32x4*)(gUT + (size_t)(n + 1) * 8192 + (16 * dvt + (int)fr) * 64 + 16 * mt + 4 * (int)g);
        }
#define SB() __builtin_amdgcn_sched_barrier(0)
        const unsigned sw8 = (2u * g + (q4 >> 1)) & 7u, fv = (q4 << 2) | g;
#define DN_LD_WQ(mt_, W_, Q_) do { _Pragma("unroll") for (int ks_ = 0; ks_ < 4; ++ks_) { const unsigned r0_ = 32u * ks_ + 4u * g + q4, cb_ = 16u * ((2u * (mt_) + (p >> 1)) ^ sw8) + 8u * (p & 1u); \
            W_[ks_] = dn::join8(att::vtr(WI + 128u * r0_ + cb_), att::vtr(WI + 128u * (r0_ + 16u) + cb_)); Q_[ks_] = dn::join8(att::vtr(QDI + 128u * r0_ + cb_), att::vtr(QDI + 128u * (r0_ + 16u) + cb_)); } } while (0)
#define DN_MM_WQ(mt_, W_, Q_) do { _Pragma("unroll") for (int ks_ = 0; ks_ < 4; ++ks_) { vn[mt_] = __builtin_amdgcn_mfma_f32_16x16x32_bf16(W_[ks_], Sb[ks_], vn[mt_], 0, 0, 0); oo[mt_] = __builtin_amdgcn_mfma_f32_16x16x32_bf16(Q_[ks_], Sb[ks_], oo[mt_], 0, 0, 0); } } while (0)
#define DN_LD_KD(d0_, K_) do { _Pragma("unroll") for (int dd_ = 0; dd_ < 4; ++dd_) _Pragma("unroll") for (int k2_ = 0; k2_ < 2; ++k2_) { const unsigned r0_ = 32u * k2_ + 4u * g + q4, cb_ = 16u * ((2u * ((d0_) + dd_) + (p >> 1)) ^ fv) + 8u * (p & 1u); \
            K_[dd_][k2_] = dn::join8(att::vtr(KDI + 256u * r0_ + cb_), att::vtr(KDI + 256u * (r0_ + 16u) + cb_)); } } while (0)
        bf16x8 wA[4], qA[4], wB[4], qB[4], af[4][2], kA[4][2], kB[4][2];
        DN_LD_WQ(0, wA, qA); SB();
        DN_LD_WQ(1, wB, qB); SB(); DN_MM_WQ(0, wA, qA); SB();
        DN_LD_WQ(2, wA, qA); SB(); DN_MM_WQ(1, wB, qB); SB();
        DN_LD_WQ(3, wB, qB); SB(); DN_MM_WQ(2, wA, qA); SB();
#pragma unroll
        for (int mt = 0; mt < 4; ++mt)
#pragma unroll
            for (int k2 = 0; k2 < 2; ++k2) { const unsigned row = 16u * mt + fr; af[mt][k2] = *(const LAS bf16x8*)(AQI + 128u * row + 16u * ((4u * k2 + g) ^ dn::swz8(row))); }
        SB(); DN_MM_WQ(3, wB, qB); SB();
        DN_LD_KD(0, kA); SB();
        bf16x8 vb[2];
#pragma unroll
        for (int k2 = 0; k2 < 2; ++k2) vb[k2] = dn::join8(dn::pack4(vn[2 * k2]), dn::pack4(vn[2 * k2 + 1]));
#pragma unroll
        for (int mt = 0; mt < 4; ++mt)
#pragma unroll
            for (int k2 = 0; k2 < 2; ++k2) oo[mt] = __builtin_amdgcn_mfma_f32_16x16x32_bf16(af[mt][k2], vb[k2], oo[mt], 0, 0, 0);
        SB(); DN_LD_KD(4, kB); SB();
#pragma unroll
        for (int dt = 0; dt < 4; ++dt) { S[dt] = S[dt] * gl;
#pragma unroll
            for (int k2 = 0; k2 < 2; ++k2) S[dt] = __builtin_amdgcn_mfma_f32_16x16x32_bf16(kA[dt][k2], vb[k2], S[dt], 0, 0, 0); }
        SB();
#pragma unroll
        for (int dt = 4; dt < 8; ++dt) { S[dt] = S[dt] * gl;
#pragma unroll
            for (int k2 = 0; k2 < 2; ++k2) S[dt] = __builtin_amdgcn_mfma_f32_16x16x32_bf16(kB[dt - 4][k2], vb[k2], S[dt], 0, 0, 0); }
#pragma unroll
        for (int ks = 0; ks < 4; ++ks) Sb[ks] = dn::join8(dn::pack4(S[2 * ks]), dn::pack4(S[2 * ks + 1]));
#undef DN_LD_WQ
#undef DN_MM_WQ
#undef DN_LD_KD
#undef SB
        const size_t rbase = (size_t)b * SEQ + n * 64;
#pragma unroll
        for (int mt = 0; mt < 4; ++mt)
#pragma unroll
            for (int r = 0; r < 4; ++r) dno[(rbase + 16 * mt + 4 * g + r) * 1024 + h * HD + 16 * dvt + fr] = oo[mt][r];
        }
        VM_WAIT();
        __syncthreads();
    }
#undef DN_STAGE
    if constexpr (PM == 0 && DN_TAIL_NORMGATE == 2) {
        asm volatile("s_waitcnt vmcnt(0)" ::: "memory");
        __syncthreads();
        if (threadIdx.x == 0) { __builtin_amdgcn_fence(__ATOMIC_RELEASE, "agent"); asm volatile("s_waitcnt vmcnt(0)" ::: "memory"); __hip_atomic_fetch_add(F.ctl + CW_CHAIN + (e * NCH + bh) * 16, 1u, RLX_AGENT); }
    }
    if constexpr (PM == 0 && DN_TAIL_NORMGATE == 1) {
        chain_sync(F, F.ctl + CW_CHAIN + (e * NCH + bh) * 16, SPL);
        normgate_rows(F, (const float*)(F.ws + WS_DNO), (const bf16*)(F.ws + WS_DNGATE), NH_AB, FIN(I_AB_ONG) + e * HD, 1024, b * SEQ + part * (SEQ / SPL), SEQ / SPL, h);
    }
}

constexpr size_t WS_QEP = WS_END, WS_KE = WS_END + 32 * MiB, WS_AINT = WS_END + 64 * MiB, WS_GD = WS_END + 80 * MiB, WS_END2 = WS_END + 82 * MiB;
namespace gla { constexpr int BP = 132; }

__device__ __forceinline__ void gla_chunk_phase(Frame& F) {
    PHASE_IDS();
    LAS char* ring = (LAS char*)(F.lds + RING_OFF);
    LAS float* BI = (LAS float*)ring;
    LAS char* QS = ring + 34816;
    LAS char* KS = ring + 34816 + 16384;
    LAS float* PART = (LAS float*)(ring + 34816 + 16384 + 40960);
    const bf16* Cq = (const bf16*)(F.ws + WS_CQ); const bf16* Ck = (const bf16*)(F.ws + WS_CK); const float* Clf = (const float*)(F.ws + WS_CLF);
    const unsigned fr = lane & 15, g = lane >> 4;
    for (int ci = F.bx; ci < BATCH * NH_C * (SEQ / 64); ci += F.G) {
        const int n = ci & 63, bh = ci >> 6, h = bh & 15, b = bh >> 4; const size_t rbase = (size_t)b * SEQ + n * 64;
        bf16* qep = (bf16*)(F.ws + WS_QEP) + (size_t)ci * 8192; bf16* ke = (bf16*)(F.ws + WS_KE) + (size_t)ci * 8192; bf16* aint = (bf16*)(F.ws + WS_AINT) + (size_t)ci * 4096; float* gd = (float*)(F.ws + WS_GD) + (size_t)ci * 256;
        __syncthreads();
        float lfv[16];
        { const int d = tid & 127, qr = tid >> 7;
#pragma unroll
          for (int r = 0; r < 16; ++r) lfv[r] = Clf[(rbase + 16 * qr + r) * D + h * HD + d]; }
        v4u qwA[2], kwA[2], kwB[5]; pg8::u32x2 q0C[2], q1C[2];
#pragma unroll
        for (int it = 0; it < 2; ++it) { const int item = tid + 512 * it, c = item >> 4, gq = item & 15;
            qwA[it] = *(const GAS v4u*)(Cq + (rbase + c) * D + h * HD + 8 * gq); kwA[it] = *(const GAS v4u*)(Ck + (rbase + c) * D + h * HD + 8 * gq); }
#pragma unroll
        for (int it = 0; it < 5; ++it) { const int item = tid + 512 * it, ri = item >> 4, gq = item & 15; const int s = ri < 16 ? ri : (ri < 48 ? ri - 16 : (ri < 96 ? ri - 48 : ri - 96));
            kwB[it] = *(const GAS v4u*)(Ck + (rbase + s) * D + h * HD + 8 * gq); }
#pragma unroll
        for (int it = 0; it < 2; ++it) { const int item = tid + 512 * it, c = item >> 4, pc = item & 15, dk0 = 32 * (pc >> 2) + 4 * (pc & 3);
            q0C[it] = *(const GAS pg8::u32x2*)(Cq + (rbase + c) * D + h * HD + dk0); q1C[it] = *(const GAS pg8::u32x2*)(Cq + (rbase + c) * D + h * HD + dk0 + 16); }
        if (tid < 192) { const int pr = tid >> 5, ctz = pr < 3 ? 0 : (pr < 5 ? 1 : 2), stz = pr < 3 ? pr + 1 : (pr < 5 ? pr - 1 : 3), cz = 16 * ctz + ((tid & 31) >> 1);
            *(GAS v4u*)(aint + cz * 64 + 16 * stz + 8 * (tid & 1)) = (v4u){0u, 0u, 0u, 0u}; }
        {
            const int d = tid & 127, qr = tid >> 7; float loc[16]; float run = 0.f;
#pragma unroll
            for (int r = 0; r < 16; ++r) { run += lfv[r]; loc[r] = run; }
            PART[qr * 128 + d] = run;
            LDS_WAIT(); __syncthreads();
            float off = 0.f;
#pragma unroll
            for (int q2 = 0; q2 < 3; ++q2) if (q2 < qr) off += PART[q2 * 128 + d];
#pragma unroll
            for (int r = 0; r < 16; ++r) BI[(16 * qr + r) * gla::BP + d] = off + loc[r];
        }
        LDS_WAIT(); __syncthreads();
#pragma unroll
        for (int it = 0; it < 2; ++it) {
            const int item = tid + 512 * it, c = item >> 4, gq = item & 15;
            const v4u qw = qwA[it], kw = kwA[it];
            const LAS float* bc = BI + c * gla::BP + 8 * gq; const LAS float* br = BI + (c & ~15) * gla::BP + 8 * gq; const LAS float* bl = BI + 63 * gla::BP + 8 * gq;
            const f32x4 b0 = *(const LAS f32x4*)bc, b1 = *(const LAS f32x4*)(bc + 4), r0 = *(const LAS f32x4*)br, r1 = *(const LAS f32x4*)(br + 4), l0 = *(const LAS f32x4*)bl, l1 = *(const LAS f32x4*)(bl + 4);
            v4u o;
            o.x = pg8::cvt_pk_bf16(bflo(qw.x) * __expf(b0[0] - r0[0]), bfhi(qw.x) * __expf(b0[1] - r0[1])); o.y = pg8::cvt_pk_bf16(bflo(qw.y) * __expf(b0[2] - r0[2]), bfhi(qw.y) * __expf(b0[3] - r0[3]));
            o.z = pg8::cvt_pk_bf16(bflo(qw.z) * __expf(b1[0] - r1[0]), bfhi(qw.z) * __expf(b1[1] - r1[1])); o.w = pg8::cvt_pk_bf16(bflo(qw.w) * __expf(b1[2] - r1[2]), bfhi(qw.w) * __expf(b1[3] - r1[3]));
            *(LAS v4u*)(QS + 256 * c + 16 * ((unsigned)gq ^ att::swz((unsigned)c))) = o;
            o.x = pg8::cvt_pk_bf16(bflo(kw.x) * __expf(l0[0] - b0[0]), bfhi(kw.x) * __expf(l0[1] - b0[1])); o.y = pg8::cvt_pk_bf16(bflo(kw.y) * __expf(l0[2] - b0[2]), bfhi(kw.y) * __expf(l0[3] - b0[3]));
            o.z = pg8::cvt_pk_bf16(bflo(kw.z) * __expf(l1[0] - b1[0]), bfhi(kw.z) * __expf(l1[1] - b1[1])); o.w = pg8::cvt_pk_bf16(bflo(kw.w) * __expf(l1[2] - b1[2]), bfhi(kw.w) * __expf(l1[3] - b1[3]));
            *(GAS v4u*)(ke + c * 128 + 8 * gq) = o;
        }
#pragma unroll
        for (int it = 0; it < 5; ++it) {
            const int item = tid + 512 * it, ri = item >> 4, gq = item & 15;
            int i, s, base; if (ri < 16) { i = 0; s = ri; base = 0; } else if (ri < 48) { i = 1; s = ri - 16; base = 4096; } else if (ri < 96) { i = 2; s = ri - 48; base = 12288; } else { i = 3; s = ri - 96; base = 24576; }
            const v4u kw = kwB[it];
            const LAS float* bs = BI + s * gla::BP + 8 * gq; const LAS float* br = BI + 16 * i * gla::BP + 8 * gq;
            const f32x4 b0 = *(const LAS f32x4*)bs, b1 = *(const LAS f32x4*)(bs + 4), r0 = *(const LAS f32x4*)br, r1 = *(const LAS f32x4*)(br + 4);
            v4u o;
            o.x = pg8::cvt_pk_bf16(bflo(kw.x) * __expf(r0[0] - b0[0]), bfhi(kw.x) * __expf(r0[1] - b0[1])); o.y = pg8::cvt_pk_bf16(bflo(kw.y) * __expf(r0[2] - b0[2]), bfhi(kw.y) * __expf(r0[3] - b0[3]));
            o.z = pg8::cvt_pk_bf16(bflo(kw.z) * __expf(r1[0] - b1[0]), bfhi(kw.z) * __expf(r1[1] - b1[1])); o.w = pg8::cvt_pk_bf16(bflo(kw.w) * __expf(r1[2] - b1[2]), bfhi(kw.w) * __expf(r1[3] - b1[3]));
            *(LAS v4u*)(KS + base + 256 * s + 16 * ((unsigned)gq ^ att::swz((unsigned)s))) = o;
        }
#pragma unroll
        for (int it = 0; it < 2; ++it) {
            const int item = tid + 512 * it, c = item >> 4, pc = item & 15, ks = pc >> 2, gp = pc & 3, dk0 = 32 * ks + 4 * gp;
            const pg8::u32x2 q0 = q0C[it], q1 = q1C[it];
            const f32x4 b0 = *(const LAS f32x4*)(BI + c * gla::BP + dk0), b1 = *(const LAS f32x4*)(BI + c * gla::BP + dk0 + 16);
            v4u o;
            o.x = pg8::cvt_pk_bf16(bflo(q0.x) * __expf(b0[0]), bfhi(q0.x) * __expf(b0[1])); o.y = pg8::cvt_pk_bf16(bflo(q0.y) * __expf(b0[2]), bfhi(q0.y) * __expf(b0[3]));
            o.z = pg8::cvt_pk_bf16(bflo(q1.x) * __expf(b1[0]), bfhi(q1.x) * __expf(b1[1])); o.w = pg8::cvt_pk_bf16(bflo(q1.y) * __expf(b1[2]), bfhi(q1.y) * __expf(b1[3]));
            *(GAS v4u*)(qep + c * 128 + 8 * pc) = o;
        }
        if (tid < 256) gd[tid] = tid < 128 ? __expf(BI[63 * gla::BP + tid]) : 0.f;
        LDS_WAIT(); __syncthreads();
        for (int jb = wave; jb < 10; jb += NWAVES) {
            int ct = 0, st = jb; if (jb >= 6) { ct = 3; st = jb - 6; } else if (jb >= 3) { ct = 2; st = jb - 3; } else if (jb >= 1) { ct = 1; st = jb - 1; }
            const int base = ct == 0 ? 0 : (ct == 1 ? 4096 : (ct == 2 ? 12288 : 24576));
            f32x4 acc = {0.f, 0.f, 0.f, 0.f};
#pragma unroll
            for (int ks = 0; ks < 4; ++ks) { const bf16x8 a = *(const LAS bf16x8*)(KS + base + 256u * (16u * st + fr) + 16u * ((4u * ks + g) ^ att::swz(fr))), bb = *(const LAS bf16x8*)(QS + 256u * (16u * ct + fr) + 16u * ((4u * ks + g) ^ att::swz(fr)));
                acc = __builtin_amdgcn_mfma_f32_16x16x32_bf16(a, bb, acc, 0, 0, 0); }
            const int c = 16 * ct + (int)fr; f32x4 o;
#pragma unroll
            for (int r = 0; r < 4; ++r) { const int s = 16 * st + 4 * (int)g + r; o[r] = s <= c ? acc[r] : 0.f; }
            *(GAS dn::s16x4*)(aint + c * 64 + 16 * st + 4 * g) = dn::pack4(o);
        }
    }
    __syncthreads();
}

template <int PM>
__device__ __forceinline__ void gla_scan_phase(Frame& F) {
    constexpr int SPL = 4, NCH = BATCH * NH_C;
    if (F.bx >= SPL * NCH) return;
    PHASE_IDS();
    const int bh = F.bx % NCH, part = F.bx / NCH, h = bh & 15, b = bh >> 4;
    const int dvt = (8 / SPL) * part + (wave & (8 / SPL - 1)); const bool active = wave < 8 / SPL;
    const int rot = part * (56 / SPL);
    LAS char* ring = (LAS char*)(F.lds + RING_OFF);
    constexpr int STG = 58368;
    const char* gQE = (const char*)(F.ws + WS_QEP) + (size_t)bh * 64 * 16384; const char* gKE = (const char*)(F.ws + WS_KE) + (size_t)bh * 64 * 16384;
    const char* gA = (const char*)(F.ws + WS_AINT) + (size_t)bh * 64 * 8192; const char* gD = (const char*)(F.ws + WS_GD) + (size_t)bh * 64 * 1024;
    const char* gV = (const char*)((const bf16*)(F.ws + WS_CV) + (size_t)b * SEQ * D + h * HD);
    float* co = (float*)(F.ws + (PM == 0 ? WS_CO : WS_ACT));
#define GLA_PIECE(n_, stg_, pc_) do { const char* src_; \
        if ((pc_) < 48) { const int q_ = (pc_) & 15; const unsigned row_ = 4u * q_ + ((unsigned)ln >> 4), ch_ = ((unsigned)ln & 15u) ^ att::swz(row_); \
            src_ = (pc_) < 16 ? gQE + (size_t)(n_) * 16384 + row_ * 256u + ch_ * 16u : ((pc_) < 32 ? gKE + (size_t)(n_) * 16384 + row_ * 256u + ch_ * 16u : gV + ((size_t)(n_) * 64 + row_) * 4096 + ch_ * 16u); } \
        else if ((pc_) < 56) { const int q_ = (pc_) - 48; const unsigned row_ = 8u * q_ + ((unsigned)ln >> 3), ch_ = ((unsigned)ln & 7u) ^ dn::swz8(row_); src_ = gA + (size_t)(n_) * 8192 + row_ * 128u + ch_ * 16u; } \
        else src_ = gD + (size_t)(n_) * 1024 + (unsigned)ln * 16u; \
        att::glds16(src_, (unsigned)__builtin_amdgcn_readfirstlane((unsigned)(size_t)((stg_) + (pc_) * 1024))); } while (0)
#define GLA_STAGE(n_, stg_) do { _Pragma("unroll") for (int pi_ = 0; pi_ < 7; ++pi_) { int pcc_ = 7 * wave + pi_ + rot; pcc_ -= pcc_ >= 56 ? 56 : 0; GLA_PIECE(n_, stg_, pcc_); } if (wave == 0) { GLA_PIECE(n_, stg_, 56); } } while (0)
    f32x4 S[8]; bf16x8 Sb[4];
#pragma unroll
    for (int dt = 0; dt < 8; ++dt) S[dt] = (f32x4){0.f, 0.f, 0.f, 0.f};
#pragma unroll
    for (int ks = 0; ks < 4; ++ks) Sb[ks] = (bf16x8){0, 0, 0, 0, 0, 0, 0, 0};
    { const int ln = lane; GLA_STAGE(0, ring); }
    VM_WAIT(); __syncthreads();
    for (int n = 0; n < SEQ / 64; ++n) {
        LAS char* cur = ring + (n & 1) * STG; LAS char* nxt = ring + ((n + 1) & 1) * STG;
        const int ln = opaque_i(lane);
        if (PM != 1 && n + 1 < SEQ / 64) GLA_STAGE(n + 1, nxt);
        const unsigned fr = ln & 15, g = (unsigned)ln >> 4, q4 = fr >> 2, p = ln & 3;
        const LAS char* QEI = cur; const LAS char* KEI = cur + 16384; const LAS char* VI = cur + 32768; const LAS char* AI = cur + 49152; const LAS float* DV = (const LAS float*)(cur + 57344);
        if (active && PM != 2) {
        f32x4 oo[4];
#pragma unroll
        for (int mt = 0; mt < 4; ++mt) oo[mt] = (f32x4){0.f, 0.f, 0.f, 0.f};
#define SB() __builtin_amdgcn_sched_barrier(0)
#define GLA_LD_Q(mt_, Q_) do { _Pragma("unroll") for (int ks_ = 0; ks_ < 4; ++ks_) Q_[ks_] = *(const LAS bf16x8*)(QEI + 256u * (16u * (mt_) + fr) + 16u * ((4u * ks_ + g) ^ att::swz(fr))); } while (0)
#define GLA_MM_Q(mt_, Q_) do { _Pragma("unroll") for (int ks_ = 0; ks_ < 4; ++ks_) oo[mt_] = __builtin_amdgcn_mfma_f32_16x16x32_bf16(Q_[ks_], Sb[ks_], oo[mt_], 0, 0, 0); } while (0)
#define GLA_LD_KE(d0_, K_) do { _Pragma("unroll") for (int dd_ = 0; dd_ < 4; ++dd_) _Pragma("unroll") for (int k2_ = 0; k2_ < 2; ++k2_) { const unsigned r0_ = 32u * k2_ + 8u * g + q4, r1_ = r0_ + 4u; \
            K_[dd_][k2_] = dn::join8(att::vtr(KEI + 256u * r0_ + 16u * ((2u * ((d0_) + dd_) + (p >> 1)) ^ att::swz(r0_)) + 8u * (p & 1u)), att::vtr(KEI + 256u * r1_ + 16u * ((2u * ((d0_) + dd_) + (p >> 1)) ^ att::swz(r1_)) + 8u * (p & 1u))); } } while (0)
        bf16x8 qA[4], qB[4], af[4][2], kA[4][2], kB[4][2], vb[2];
        GLA_LD_Q(0, qA);
#pragma unroll
        for (int k2 = 0; k2 < 2; ++k2) {
            const unsigned r0 = 32u * k2 + 8u * g + q4, r1 = r0 + 4u;
            vb[k2] = dn::join8(att::vtr(VI + 256u * r0 + 16u * ((2u * dvt + (p >> 1)) ^ att::swz(r0)) + 8u * (p & 1u)), att::vtr(VI + 256u * r1 + 16u * ((2u * dvt + (p >> 1)) ^ att::swz(r1)) + 8u * (p & 1u)));
        }
        GLA_LD_Q(1, qB); SB(); GLA_MM_Q(0, qA); SB();
        GLA_LD_Q(2, qA);
#pragma unroll
        for (int mt = 0; mt < 4; ++mt)
#pragma unroll
            for (int k2 = 0; k2 < 2; ++k2) { const unsigned row = 16u * mt + fr; af[mt][k2] = *(const LAS bf16x8*)(AI + 128u * row + 16u * ((4u * k2 + g) ^ dn::swz8(row))); }
        SB(); GLA_MM_Q(1, qB); SB();
        GLA_LD_Q(3, qB); SB(); GLA_MM_Q(2, qA); SB();
        GLA_LD_KE(0, kA); SB(); GLA_MM_Q(3, qB);
#pragma unroll
        for (int mt = 0; mt < 4; ++mt)
#pragma unroll
            for (int k2 = 0; k2 < 2; ++k2) oo[mt] = __builtin_amdgcn_mfma_f32_16x16x32_bf16(af[mt][k2], vb[k2], oo[mt], 0, 0, 0);
        SB(); GLA_LD_KE(4, kB); SB();
#pragma unroll
        for (int dt = 0; dt < 4; ++dt) { const f32x4 dd = *(const LAS f32x4*)(DV + 16 * dt + 4 * g); S[dt] = S[dt] * dd;
#pragma unroll
            for (int k2 = 0; k2 < 2; ++k2) S[dt] = __builtin_amdgcn_mfma_f32_16x16x32_bf16(kA[dt][k2], vb[k2], S[dt], 0, 0, 0); }
        SB();
#pragma unroll
        for (int dt = 4; dt < 8; ++dt) { const f32x4 dd = *(const LAS f32x4*)(DV + 16 * dt + 4 * g); S[dt] = S[dt] * dd;
#pragma unroll
            for (int k2 = 0; k2 < 2; ++k2) S[dt] = __builtin_amdgcn_mfma_f32_16x16x32_bf16(kB[dt - 4][k2], vb[k2], S[dt], 0, 0, 0); }
#pragma unroll
        for (int ks = 0; ks < 4; ++ks) Sb[ks] = dn::join8(dn::pack4(S[2 * ks]), dn::pack4(S[2 * ks + 1]));
#undef GLA_LD_Q
#undef GLA_MM_Q
#undef GLA_LD_KE
#undef SB
        const size_t rbase = (size_t)b * SEQ + n * 64;
#pragma unroll
        for (int mt = 0; mt < 4; ++mt)
#pragma unroll
            for (int r = 0; r < 4; ++r) co[(rbase + 16 * mt + 4 * g + r) * D + h * HD + 16 * dvt + fr] = oo[mt][r];
        }
        VM_WAIT();
        __syncthreads();
    }
#undef GLA_STAGE
#undef GLA_PIECE
}

struct Args { const float* in[20]; float* out; unsigned char* ws; };
__global__ void __launch_bounds__(NWAVES * 64, 2) fwd(Args args) {
    extern __shared__ __attribute__((aligned(16))) unsigned char lds[];
    Frame F;
    F.lds = (LAS unsigned char*)lds;
    F.MISC = (volatile LAS unsigned*)(F.lds + MISC_OFF);
    F.tid = threadIdx.x; F.lane = F.tid & 63; F.wave = __builtin_amdgcn_readfirstlane(F.tid >> 6);
    F.G = gridDim.x; F.bx = (int)blockIdx.x;
    GAS unsigned char* ws = (GAS unsigned char*)args.ws; F.ws = ws; F.out = args.out;
    F.ctl = (gu32*)(ws + WS_CTL);
    F.ka = (const __attribute__((address_space(4))) unsigned long long*)__builtin_amdgcn_kernarg_segment_ptr();
    for (int u = F.tid; u < (LDS_BYTES - LDSCTL_OFF) / 4; u += NWAVES * 64) ((LAS unsigned*)(F.lds + LDSCTL_OFF))[u] = 0u;
    __syncthreads();
    XcdBarrier bar = xcd_barrier_post((unsigned*)(F.ctl + CW_BAR), F.MISC + 8);
#define GRID_BAR() xcd_barrier(bar)
    const LAS float* rtab = (const LAS float*)(F.lds + RTAB_OFF);
    bf16* XB; void* XLO; float* ROWSS; bf16* ACT; bf16* Y;
    constexpr bool XF = X_F16 == 1;

    p0_prologue(F);
    GRID_BAR();

    for (int s = 0; s < 2 * DEPTH; ++s) {
        { GAS unsigned char* w_ = F.ws; asm volatile("" : "+s"(w_)); F.ws = w_; ws = w_; auto k_ = F.ka; asm volatile("" : "+s"(k_)); F.ka = k_; int b_ = (int)blockIdx.x; asm volatile("" : "+s"(b_)); F.bx = b_; }
        XB = (bf16*)(ws + WS_XB); XLO = (void*)(ws + WS_X); ROWSS = (float*)(ws + WS_ROWSS); ACT = (bf16*)(ws + WS_ACT); Y = (bf16*)(ws + WS_Y);
        { pg8::EpiSwiGLU E{ACT, DFF, rtab, 0}; run_gemm<pg8::EpiSwiGLU, 0, XF, AIMG_XB != 0>(F, XB, (const bf16*)(ws + WS_W1T) + (size_t)s * NFF * D, M, F.G == 256 ? 40 * 256 : NFF, D, E, true, 0, 0, 1, F.G == 256 ? 5 : -1, 40, 3); }
        if (F.G == 256) { pg8::EpiSwiGLU E{ACT, DFF, rtab + 5 * 256, 1}; run_gemm_half<pg8::EpiSwiGLU, XF, AIMG_XB != 0>(F, XB, (const bf16*)(ws + WS_W1T) + (size_t)s * NFF * D, M, NFF, D, 40, 3, E, false); }
        conv_slot(F, F.G == 256 ? 192 : 0, 3);
        GRID_BAR();
        { pg8::EpiResidual E{s == 0 ? FIN(I_X) : (const float*)nullptr, XB, XLO, ROWSS, 0.5f, D, M}; run_gemm<pg8::EpiResidual, 0, false, AIMG_ACT != 0>(F, ACT, (const bf16*)(ws + WS_W2T) + (size_t)s * D * DFF, M, D, DFF, E, false); }
        if (!(s & 1)) conv_deadline(F, cq_n_mix(s >> 1)); else if (s + 1 < 2 * DEPTH) conv_deadline(F, cq_n_ffn(s + 1));
        GRID_BAR();
        if (!(s & 1)) {
            const int l = s >> 1;
            if (!(l & 1)) {
                const int e = l >> 1;
                { pg8::EpiABin E{(bf16*)(ws + WS_QM), (bf16*)(ws + WS_KM), (bf16*)(ws + WS_VM), (bf16*)(ws + WS_DNPRE), (bf16*)(ws + WS_DNGATE), (float*)(ws + WS_BA), (float*)(ws + WS_KMS), rtab, QK_SCALE_LOG2E};
                  run_gemm<pg8::EpiABin, 0, XF, AIMG_XB != 0>(F, XB, (const bf16*)(ws + WS_WABT) + (size_t)e * AB_PAD * D, M, AB_PAD, D, E, true); }
                conv_slot(F, F.G == 256 ? 160 : F.G, 6);
                GRID_BAR();
                dn_chunk_phase(F, e);
                GRID_BAR();
                dn_scan_phase<0>(F, e);
                moba_phase(F, 4 * BATCH * NH_AB);
                conv_slot(F, 4 * BATCH * NH_AB + BATCH * NH_AB * 8, 18);
                if (DN_TAIL_NORMGATE == 2) ng_help(F, e);
                GRID_BAR();
                if (DN_TAIL_NORMGATE == 0) { normgate(F, (const float*)(ws + WS_DNO), (const bf16*)(ws + WS_DNGATE), NH_AB, FIN(I_AB_ONG) + e * HD, 1024); GRID_BAR(); }
                { pg8::EpiResidual E{nullptr, XB, XLO, ROWSS, 1.0f, D, M}; run_gemm(F, Y, (const bf16*)(ws + WS_WABOT) + (size_t)e * D * D, M, D, D, E, false); }
                conv_deadline(F, cq_n_x(l));
                GRID_BAR();
            } else {
                const int o = l >> 1;
                { pg8::EpiCin E{(bf16*)(ws + WS_CQ), (bf16*)(ws + WS_CK), (bf16*)(ws + WS_CV), (bf16*)(ws + WS_CG), (float*)(ws + WS_CLF), (const float*)(ws + WS_LB) + (size_t)l * D, rtab};
                  run_gemm<pg8::EpiCin, 0, XF, AIMG_XB != 0>(F, XB, (const bf16*)(ws + WS_WCT) + (size_t)o * 4 * D * D, M, 4 * D, D, E, true); }
                GRID_BAR();
                gla_chunk_phase(F);
                GRID_BAR();
                gla_scan_phase<0>(F);
                conv_slot(F, 4 * BATCH * NH_C, 14);
                GRID_BAR();
                normgate(F, (const float*)(ws + WS_CO), (const bf16*)(ws + WS_CG), NH_C, FIN(I_C_ONG) + o * HD, 0);
                GRID_BAR();
                { pg8::EpiResidual E{nullptr, XB, XLO, ROWSS, 1.0f, D, M}; run_gemm(F, Y, (const bf16*)(ws + WS_WCOT) + (size_t)o * D * D, M, D, D, E, false); }
                conv_deadline(F, cq_n_x(l));
                GRID_BAR();
            }
            { pg8::EpiBf16Route E{(bf16*)(ws + WS_XQ), XW, rtab, QK_SCALE_LOG2E, 1}; run_gemm_half<pg8::EpiBf16Route, XF, AIMG_XB != 0>(F, XB, (const bf16*)(ws + WS_WXQT) + (size_t)l * XW * D, M, XW, D, 0, XW / 256, E, true, 0); }
            if (l == 0) { pg8::EpiBf16Route E{(bf16*)(ws + WS_KV), 4096, nullptr, 1.0f, 1}; run_gemm_half(F, (const bf16*)(ws + WS_MEMN), (const bf16*)(ws + WS_WXKVT), BATCH * MEMT, 4096, D, 0, 16, E, false, F.G - 128); }
            conv_slot(F, l == 0 ? 192 : 128, 3);
            GRID_BAR();
            xattn_phase(F, l);
            conv_slot(F, 128, 2);
            GRID_BAR();
            { pg8::EpiResidual E{nullptr, XB, XLO, ROWSS, 1.0f, D, M}; run_gemm(F, (const bf16*)(ws + WS_XO), (const bf16*)(ws + WS_WXOT) + (size_t)l * D * XW, M, D, XW, E, false); }
            conv_deadline(F, cq_n_ffn(s + 1));
            GRID_BAR();
        }
    }
    final_norm(F);
#undef GRID_BAR
}

extern "C" void kernel_launch(void* const* d_in, const int* in_sizes, int n_in, void* d_out, int out_size, void* d_ws, size_t ws_size, hipStream_t stream) {
    static int grid = 0;
    if (grid == 0) {
        if (n_in != 20 || in_sizes[0] != M * D || out_size != M * D || ws_size < WS_END2) { fprintf(stderr, "kernel_launch: unexpected shapes: n_in %d in0 %d out %d ws %zu (need %zu); nothing launched\n", n_in, n_in > 0 ? in_sizes[0] : -1, out_size, ws_size, (size_t)WS_END2); grid = -1; return; }
        int dev = 0, cus = 0, per_cu = 0;
        if (hipGetDevice(&dev) != hipSuccess || hipDeviceGetAttribute(&cus, hipDeviceAttributeMultiprocessorCount, dev) != hipSuccess) { fprintf(stderr, "kernel_launch: device query failed\n"); grid = -1; return; }
        if (hipFuncSetAttribute((const void*)fwd, hipFuncAttributeMaxDynamicSharedMemorySize, LDS_BYTES) != hipSuccess) { fprintf(stderr, "kernel_launch: hipFuncSetAttribute failed\n"); grid = -1; return; }
        if (hipOccupancyMaxActiveBlocksPerMultiprocessor(&per_cu, (const void*)fwd, NWAVES * 64, LDS_BYTES) != hipSuccess || per_cu < 1) fprintf(stderr, "kernel_launch: note: occupancy query reports %d workgroups per CU\n", per_cu);
        (void)hipGetLastError();
        grid = cus;
    }
    if (grid < 0) return;
    if (hipMemsetAsync((char*)d_ws + WS_CTL, 0, CTL_ZERO_BYTES, stream) != hipSuccess) { fprintf(stderr, "kernel_launch: memset failed\n"); return; }
    Args a{};
    for (int i = 0; i < 20; ++i) a.in[i] = (const float*)d_in[i];
    a.out = (float*)d_out; a.ws = (unsigned char*)d_ws;
    hipLaunchKernelGGL(fwd, dim3(grid), dim3(NWAVES * 64), LDS_BYTES, stream, a);
    const hipError_t le = hipPeekAtLastError();
    if (le != hipSuccess) fprintf(stderr, "kernel_launch: launch failed: %s\n", hipGetErrorName(le));
}
```

```cpp
#include <hip/hip_runtime.h>
#include <cstdio>
#include <cstdint>
namespace pg8 {
#define PG8_LAS __attribute__((address_space(3)))
typedef unsigned short bf16_t;
typedef short bf16x8 __attribute__((ext_vector_type(8)));
typedef float f32x4 __attribute__((ext_vector_type(4)));
typedef unsigned u32x4 __attribute__((ext_vector_type(4)));
constexpr int BM = 256, BK = 64, HALF = 128, HTB = HALF * BK * 2  , STAGE_BYTES = 8 * HTB, NXCD = 8, WGM = 4;

__host__ __device__ __forceinline__ int lds_byte(int r, int c) { const int st = (r >> 4) * 2 + (c >> 5), rr = r & 15, cc = c & 31, ob = rr * 64 + cc * 2; return st * 1024 + (ob ^ (((ob >> 9) & 1) << 5)); }
__host__ __device__ __forceinline__ void stage_rc(int b, int& R, int& C) { const int st = b / 1024, sb = b % 1024, swz = sb ^ (((sb >> 9) & 1) << 5); R = (st >> 1) * 16 + swz / 64; C = (st & 1) * 32 + (swz % 64) / 2; }
__host__ __device__ __forceinline__ int perm32(int rho) { const int n = rho >> 4, i = rho & 15; return 8 * (i >> 2) + 4 * n + (i & 3); }

#ifndef BIMG
#define BIMG 1
#endif
__host__ __device__ __forceinline__ int slot32(int c) { const int q = c & 31; return (c & ~31) + 16 * ((q >> 2) & 1) + 4 * (q >> 3) + (q & 3); }
__host__ __device__ __forceinline__ size_t img_off(int r, int k, int K) { return ((size_t)(r >> 4) * (K >> 5) + (k >> 5)) * 1024 + lds_byte(r & 15, k & 31); }
struct Unit { int pm, pn, half; };
struct Gemm { const bf16_t* A; const bf16_t* Bt; int M, N, K, ld, ks; };

struct StaticOrder {
    int nM, nN, nwg, G, c;
    __host__ __device__ void init(int M, int N, int G_, int c_) { nM = M / BM; nN = N / BM; nwg = nM * nN; G = G_; c = c_; }
    __host__ __device__ bool next(int i, Unit& u) const {
        const long L = (long)i * G + c; if (L >= nwg) return false;
        int wgid = (int)L; { const int q = nwg / NXCD, r = nwg % NXCD, xcd = wgid % NXCD, off = wgid / NXCD; wgid = (xcd < r ? xcd * (q + 1) : r * (q + 1) + (xcd - r) * q) + off; }
        const int nig = WGM * nN, gid = wgid / nig, fm = gid * WGM, gsz = (nM - fm) < WGM ? (nM - fm) : WGM;
        u.pm = fm + ((wgid % nig) % gsz); u.pn = (wgid % nig) / gsz; u.half = 0; return true;
    }
    __device__ __forceinline__ void a_ready(const Unit&) const {}
    __device__ __forceinline__ void done(const Unit&) const {}
};

struct HalfOrder {
    int nM, pn0, nhalf, G, c;
    __host__ __device__ void init(int M, int pn0_, int ntile, int G_, int c_) { nM = M / BM; pn0 = pn0_; nhalf = 2 * nM * ntile; G = G_; c = c_; }
    __host__ __device__ bool next(int i, Unit& u) const { const int L = i * G + c; if (L >= nhalf) return false; const int T = L >> 1; u.pm = T % nM; u.pn = pn0 + T / nM; u.half = L & 1; return true; }
    __device__ __forceinline__ void a_ready(const Unit&) const {}
    __device__ __forceinline__ void done(const Unit&) const {}
};

typedef float f32x2_cv __attribute__((ext_vector_type(2))); typedef __bf16 bf16x2_cv __attribute__((ext_vector_type(2)));
__device__ __forceinline__ unsigned cvt_pk_bf16(float lo, float hi) { const f32x2_cv v = {lo, hi}; const bf16x2_cv b = __builtin_convertvector(v, bf16x2_cv); return __builtin_bit_cast(unsigned, b); }
#ifndef X_F16
#define X_F16 2
#endif
typedef _Float16 f16x2_cv __attribute__((ext_vector_type(2))); typedef _Float16 f16x8 __attribute__((ext_vector_type(8)));
__device__ __forceinline__ unsigned cvt_pk_f16(float lo, float hi) { const f32x2_cv v = {lo, hi}; const f16x2_cv b = __builtin_convertvector(v, f16x2_cv); return __builtin_bit_cast(unsigned, b); }
__device__ __forceinline__ float f16_lo(unsigned w) { return (float)__builtin_bit_cast(f16x2_cv, w)[0]; }
__device__ __forceinline__ float f16_hi(unsigned w) { return (float)__builtin_bit_cast(f16x2_cv, w)[1]; }
__device__ __forceinline__ unsigned cvt_pk_x(float lo, float hi) { return X_F16 == 1 ? cvt_pk_f16(lo, hi) : cvt_pk_bf16(lo, hi); }
typedef float f32x2 __attribute__((ext_vector_type(2)));
typedef unsigned u32x2 __attribute__((ext_vector_type(2)));
__device__ __forceinline__ float fast_exp2(float x) { return __builtin_amdgcn_exp2f(x); }
__device__ __forceinline__ float fast_rcp(float x) { return __builtin_amdgcn_rcpf(x); }
__device__ __forceinline__ float silu_f(float a) { return a * fast_rcp(1.0f + fast_exp2(a * -1.44269504089f)); }
__device__ __forceinline__ u32x4 pack8(const f32x4& v0, const f32x4& v1) { u32x4 w; w.x = cvt_pk_bf16(v0[0], v0[1]); w.y = cvt_pk_bf16(v0[2], v0[3]); w.z = cvt_pk_bf16(v1[0], v1[1]); w.w = cvt_pk_bf16(v1[2], v1[3]); return w; }


#ifndef AIMG_ACT
#define AIMG_ACT 1
#endif
#ifndef AIMG_XB
#define AIMG_XB 1
#endif
struct EpiSwiGLU {
    static constexpr bool PERM = true, AFTER_DRAIN = false;
    bf16_t* O; int ldc; const PG8_LAS float* rtab; int hm;
    __device__ __forceinline__ void init(f32x4 (&acc)[2][2][4][2], const Unit&, int, int, int, int) const {
#pragma unroll
        for (int a = 0; a < 2; ++a)
#pragma unroll
            for (int b = 0; b < 2; ++b)
#pragma unroll
                for (int m = 0; m < 4; ++m)
#pragma unroll
                    for (int n = 0; n < 2; ++n) acc[a][b][m][n] = (f32x4){0.f, 0.f, 0.f, 0.f};
    }
    __device__ __forceinline__ void operator()(const f32x4 (&acc)[2][2][4][2], const Unit& u, int ui, int wr, int wc, int fr, int fq) const {
        const PG8_LAS float* rt = rtab + ui * 256;
#pragma unroll
        for (int ai = 0; ai < 2; ++ai)
#pragma unroll
            for (int m = 0; m < 4; ++m) {
                if (hm && ai == 1) continue;
                const int rl = (hm ? u.half : ai) * HALF + wr * 64 + m * 16 + fr; const float rs = rt[rl];
                bf16_t* rowp = AIMG_ACT ? (bf16_t*)((char*)O + img_off(u.pm * BM + rl, u.pn * HALF + wc * 32 + 8 * fq, ldc)) : O + (size_t)(u.pm * BM + rl) * ldc + u.pn * HALF + wc * 32 + 8 * fq;
                f32x4 h[2];
#pragma unroll
                for (int n = 0; n < 2; ++n)
#pragma unroll
                    for (int e = 0; e < 4; ++e) { const float a = acc[ai][0][m][n][e] * rs, b = acc[ai][1][m][n][e] * rs; h[n][e] = silu_f(a) * b; }
                *(u32x4*)rowp = pack8(h[0], h[1]);
            }
    }
};

#ifndef RES_LO
#define RES_LO 1
#endif
constexpr float LO_SCALE = 2048.0f;
__device__ __forceinline__ float bf_lo(unsigned w) { return __builtin_bit_cast(float, w << 16); }
__device__ __forceinline__ float bf_hi(unsigned w) { return __builtin_bit_cast(float, w & 0xffff0000u); }
__device__ __forceinline__ float lo_clamp(float v) { return __builtin_amdgcn_fmed3f(v * LO_SCALE, -448.0f, 448.0f); }
__device__ __forceinline__ unsigned lo_pack4(float a, float b, float c, float d) { int w = __builtin_amdgcn_cvt_pk_fp8_f32(lo_clamp(a), lo_clamp(b), 0, false); return (unsigned)__builtin_amdgcn_cvt_pk_fp8_f32(lo_clamp(c), lo_clamp(d), w, true); }
__device__ __forceinline__ f32x4 hilo4(unsigned h0, unsigned h1, unsigned l) {
    const auto a = __builtin_amdgcn_cvt_pk_f32_fp8((int)l, false), b = __builtin_amdgcn_cvt_pk_f32_fp8((int)l, true); constexpr float r = 1.0f / LO_SCALE;
    return (f32x4){__builtin_fmaf(a[0], r, bf_lo(h0)), __builtin_fmaf(a[1], r, bf_hi(h0)), __builtin_fmaf(b[0], r, bf_lo(h1)), __builtin_fmaf(b[1], r, bf_hi(h1))};
}
__device__ __forceinline__ size_t res_chunk(const Unit& u, int ldx, int wr, int wc, int ai, int m, int bj, int fr, int fq) {
    return (((((size_t)(u.pm * (ldx / BM) + u.pn) * 8 + (wr * 4 + wc)) * 8 + (ai * 4 + m)) * 2 + bj) * 64) + (fq * 16 + fr);
}
struct EpiResidual {
    static constexpr bool PERM = true, AFTER_DRAIN = false;
    const float* xf32; bf16_t* xhi; void* xlo; float* rowss; float scale; int ldx, rsld;
    __device__ __forceinline__ void init(f32x4 (&acc)[2][2][4][2], const Unit& u, int wr, int wc, int fr, int fq) const {
        const float inv = 1.0f / scale;
#pragma unroll
        for (int ai = 0; ai < 2; ++ai)
#pragma unroll
            for (int m = 0; m < 4; ++m) {
                const int row = u.pm * BM + ai * HALF + wr * 64 + m * 16 + fr;
#pragma unroll
                for (int bj = 0; bj < 2; ++bj) { const size_t off = (size_t)row * ldx + u.pn * BM + bj * HALF + wc * 32 + 8 * fq;
                    if (xf32) { acc[ai][bj][m][0] = *(const f32x4*)(xf32 + off) * inv; acc[ai][bj][m][1] = *(const f32x4*)(xf32 + off + 4) * inv; }
                    else { const u32x4 h = X_F16 == 2 ? ((const u32x4*)xlo)[res_chunk(u, ldx, wr, wc, ai, m, bj, fr, fq)] : *(const u32x4*)(xhi + off);
#if X_F16
                        acc[ai][bj][m][0] = (f32x4){f16_lo(h.x), f16_hi(h.x), f16_lo(h.y), f16_hi(h.y)} * inv; acc[ai][bj][m][1] = (f32x4){f16_lo(h.z), f16_hi(h.z), f16_lo(h.w), f16_hi(h.w)} * inv;
#elif RES_LO == 2
                        const u32x2 l = *(const u32x2*)((const unsigned char*)xlo + off);
                        acc[ai][bj][m][0] = hilo4(h.x, h.y, l.x) * inv; acc[ai][bj][m][1] = hilo4(h.z, h.w, l.y) * inv;
#elif RES_LO == 1
                        const u32x4 l = *(const u32x4*)((const bf16_t*)xlo + off);
                        acc[ai][bj][m][0] = (f32x4){bf_lo(h.x) + bf_lo(l.x), bf_hi(h.x) + bf_hi(l.x), bf_lo(h.y) + bf_lo(l.y), bf_hi(h.y) + bf_hi(l.y)} * inv;
                        acc[ai][bj][m][1] = (f32x4){bf_lo(h.z) + bf_lo(l.z), bf_hi(h.z) + bf_hi(l.z), bf_lo(h.w) + bf_lo(l.w), bf_hi(h.w) + bf_hi(l.w)} * inv;
#else
                        acc[ai][bj][m][0] = (f32x4){bf_lo(h.x), bf_hi(h.x), bf_lo(h.y), bf_hi(h.y)} * inv; acc[ai][bj][m][1] = (f32x4){bf_lo(h.z), bf_hi(h.z), bf_lo(h.w), bf_hi(h.w)} * inv;
#endif
                    }
                }
            }
    }
    __device__ __forceinline__ void operator()(const f32x4 (&acc)[2][2][4][2], const Unit& u, int ui, int wr, int wc, int fr, int fq) const {
#pragma unroll
        for (int ai = 0; ai < 2; ++ai)
#pragma unroll
            for (int m = 0; m < 4; ++m) {
                const int row = u.pm * BM + ai * HALF + wr * 64 + m * 16 + fr; float ss = 0.f;
#pragma unroll
                for (int bj = 0; bj < 2; ++bj) {
                    const size_t off = (size_t)row * ldx + u.pn * BM + bj * HALF + wc * 32 + 8 * fq;
                    const f32x4 o0 = acc[ai][bj][m][0] * scale, o1 = acc[ai][bj][m][1] * scale;
#if X_F16
                    *(X_F16 == 2 ? (u32x4*)xlo + res_chunk(u, ldx, wr, wc, ai, m, bj, fr, fq) : (u32x4*)(xhi + off)) = (u32x4){cvt_pk_f16(o0[0], o0[1]), cvt_pk_f16(o0[2], o0[3]), cvt_pk_f16(o1[0], o1[1]), cvt_pk_f16(o1[2], o1[3])};
                    if constexpr (X_F16 == 2) *(u32x4*)(AIMG_XB ? (bf16_t*)((char*)xhi + img_off(row, u.pn * BM + bj * HALF + wc * 32 + 8 * fq, ldx)) : xhi + off) = pack8(o0, o1);
#else
                    const u32x4 h = pack8(o0, o1);
                    *(u32x4*)(xhi + off) = h;
#endif
#if RES_LO && !X_F16
                    const f32x4 r0 = o0 - (f32x4){bf_lo(h.x), bf_hi(h.x), bf_lo(h.y), bf_hi(h.y)}, r1 = o1 - (f32x4){bf_lo(h.z), bf_hi(h.z), bf_lo(h.w), bf_hi(h.w)};
#if RES_LO == 2
                    *(u32x2*)((unsigned char*)xlo + off) = (u32x2){lo_pack4(r0[0], r0[1], r0[2], r0[3]), lo_pack4(r1[0], r1[1], r1[2], r1[3])};
#else
                    *(u32x4*)((bf16_t*)xlo + off) = pack8(r0, r1);
#endif
#endif
                    ss += (o0[0] * o0[0] + o0[1] * o0[1]) + (o0[2] * o0[2] + o0[3] * o0[3]) + (o1[0] * o1[0] + o1[1] * o1[1]) + (o1[2] * o1[2] + o1[3] * o1[3]);
                }
                ss += __shfl_xor(ss, 16); ss += __shfl_xor(ss, 32);
                if (fq == 0) rowss[(size_t)(u.pn * 4 + wc) * rsld + row] = ss;
            }
    }
};

struct EpiBf16Route {
    static constexpr bool PERM = true, AFTER_DRAIN = false;
    bf16_t* O; int ldc; const PG8_LAS float* rtab; float scale; int hm;
    __device__ __forceinline__ void init(f32x4 (&acc)[2][2][4][2], const Unit&, int, int, int, int) const {
#pragma unroll
        for (int a = 0; a < 2; ++a)
#pragma unroll
            for (int b = 0; b < 2; ++b)
#pragma unroll
                for (int m = 0; m < 4; ++m)
#pragma unroll
                    for (int n = 0; n < 2; ++n) acc[a][b][m][n] = (f32x4){0.f, 0.f, 0.f, 0.f};
    }
    __device__ __forceinline__ void operator()(const f32x4 (&acc)[2][2][4][2], const Unit& u, int ui, int wr, int wc, int fr, int fq) const {
#pragma unroll
        for (int ai = 0; ai < 2; ++ai)
#pragma unroll
            for (int m = 0; m < 4; ++m) {
                if (hm && ai == 1) continue;
                const int rl = (hm ? u.half : ai) * HALF + wr * 64 + m * 16 + fr; const float rs = (rtab ? rtab[ui * 256 + rl] : 1.0f) * scale;
                bf16_t* rowp = O + (size_t)(u.pm * BM + rl) * ldc + u.pn * BM + wc * 32 + 8 * fq;
#pragma unroll
                for (int bj = 0; bj < 2; ++bj) *(u32x4*)(rowp + bj * HALF) = pack8(acc[ai][bj][m][0] * rs, acc[ai][bj][m][1] * rs);
            }
    }
};

struct EpiF32Part {
    static constexpr bool PERM = true, AFTER_DRAIN = false;
    float* P; int ldc; int ks; size_t part_stride;
    __device__ __forceinline__ void init(f32x4 (&acc)[2][2][4][2], const Unit&, int, int, int, int) const {
#pragma unroll
        for (int a = 0; a < 2; ++a)
#pragma unroll
            for (int b = 0; b < 2; ++b)
#pragma unroll
                for (int m = 0; m < 4; ++m)
#pragma unroll
                    for (int n = 0; n < 2; ++n) acc[a][b][m][n] = (f32x4){0.f, 0.f, 0.f, 0.f};
    }
    __device__ __forceinline__ void operator()(const f32x4 (&acc)[2][2][4][2], const Unit& u, int ui, int wr, int wc, int fr, int fq) const {
        float* base = P + (size_t)(u.pn % ks) * part_stride + (size_t)(u.pn / ks) * BM + wc * 32 + 8 * fq;
#pragma unroll
        for (int ai = 0; ai < 2; ++ai)
#pragma unroll
            for (int m = 0; m < 4; ++m) {
                float* rowp = base + (size_t)(u.pm * BM + ai * HALF + wr * 64 + m * 16 + fr) * ldc;
#pragma unroll
                for (int bj = 0; bj < 2; ++bj) { *(f32x4*)(rowp + bj * HALF) = acc[ai][bj][m][0]; *(f32x4*)(rowp + bj * HALF + 4) = acc[ai][bj][m][1]; }
            }
    }
};

struct EpiABin {
    static constexpr bool PERM = true, AFTER_DRAIN = false;
    bf16_t *Qm, *Km, *Vm, *DNpre, *DNgate; float* ba; float* kms; const PG8_LAS float* rtab; float qscale;
    __device__ __forceinline__ void init(f32x4 (&acc)[2][2][4][2], const Unit&, int, int, int, int) const {
#pragma unroll
        for (int a = 0; a < 2; ++a)
#pragma unroll
            for (int b = 0; b < 2; ++b)
#pragma unroll
                for (int m = 0; m < 4; ++m)
#pragma unroll
                    for (int n = 0; n < 2; ++n) acc[a][b][m][n] = (f32x4){0.f, 0.f, 0.f, 0.f};
    }
    __device__ __forceinline__ void operator()(const f32x4 (&acc)[2][2][4][2], const Unit& u, int ui, int wr, int wc, int fr, int fq) const {
        const int pn = u.pn; const PG8_LAS float* rt = rtab + ui * 256;
        if (pn < 28) {
            bf16_t* base; int ld = 1024, ct; float sc = 1.0f;
            if (pn < 4) { base = Qm; ct = pn; sc = qscale; } else if (pn < 8) { base = Km; ct = pn - 4; } else if (pn < 12) { base = Vm; ct = pn - 8; }
            else if (pn < 24) { base = DNpre; ld = 3072; ct = pn - 12; } else { base = DNgate; ct = pn - 24; }
            f32x4 cs[2][2];
#pragma unroll
            for (int bj = 0; bj < 2; ++bj)
#pragma unroll
                for (int n = 0; n < 2; ++n) cs[bj][n] = (f32x4){0.f, 0.f, 0.f, 0.f};
#pragma unroll
            for (int ai = 0; ai < 2; ++ai)
#pragma unroll
                for (int m = 0; m < 4; ++m) {
                    const int rl = ai * HALF + wr * 64 + m * 16 + fr; const float rs = rt[rl] * sc;
                    bf16_t* rowp = base + (size_t)(u.pm * BM + rl) * ld + ct * BM + wc * 32 + 8 * fq;
#pragma unroll
                    for (int bj = 0; bj < 2; ++bj) { const f32x4 v0 = acc[ai][bj][m][0] * rs, v1 = acc[ai][bj][m][1] * rs; *(u32x4*)(rowp + bj * HALF) = pack8(v0, v1); cs[bj][0] += v0; cs[bj][1] += v1; }
                }
            if (pn >= 4 && pn < 8) {
#pragma unroll
                for (int bj = 0; bj < 2; ++bj)
#pragma unroll
                    for (int n = 0; n < 2; ++n) {
                        f32x4 s = cs[bj][n];
#pragma unroll
                        for (int o = 1; o < 16; o <<= 1) { s[0] += __shfl_xor(s[0], o); s[1] += __shfl_xor(s[1], o); s[2] += __shfl_xor(s[2], o); s[3] += __shfl_xor(s[3], o); }
                        if (fr == 0) *(f32x4*)(kms + (size_t)(u.pm * 2 + wr) * 1024 + (pn - 4) * BM + bj * HALF + wc * 32 + 8 * fq + 4 * n) = s;
                    }
            }
        } else {
            if (wc == 0 && fq < 2) {
#pragma unroll
                for (int ai = 0; ai < 2; ++ai)
#pragma unroll
                    for (int m = 0; m < 4; ++m) {
                        const int rl = ai * HALF + wr * 64 + m * 16 + fr; const float rs = rt[rl];
                        float* p = ba + (size_t)(u.pm * BM + rl) * 16 + 8 * fq;
                        *(f32x4*)p = acc[ai][0][m][0] * rs; *(f32x4*)(p + 4) = acc[ai][0][m][1] * rs;
                    }
            }
        }
    }
};

struct EpiCin {
    static constexpr bool PERM = true, AFTER_DRAIN = false;
    bf16_t *Cq, *Ck, *Cv, *Cg; float* Clf; const float* lb; const PG8_LAS float* rtab;
    __device__ __forceinline__ void init(f32x4 (&acc)[2][2][4][2], const Unit&, int, int, int, int) const {
#pragma unroll
        for (int a = 0; a < 2; ++a)
#pragma unroll
            for (int b = 0; b < 2; ++b)
#pragma unroll
                for (int m = 0; m < 4; ++m)
#pragma unroll
                    for (int n = 0; n < 2; ++n) acc[a][b][m][n] = (f32x4){0.f, 0.f, 0.f, 0.f};
    }
    __device__ __forceinline__ void operator()(const f32x4 (&acc)[2][2][4][2], const Unit& u, int ui, int wr, int wc, int fr, int fq) const {
        const int pn = u.pn, sec = pn >> 3, ct = pn & 7; const PG8_LAS float* rt = rtab + ui * 256;
        bf16_t* base = sec == 0 ? Cq : (sec == 1 ? Ck : (sec == 2 ? Cv : Cg));
        const int cl = ct * BM + wc * 32 + 8 * fq;
        f32x4 lbv[2][2];
        if (sec == 1) {
#pragma unroll
            for (int bj = 0; bj < 2; ++bj) { lbv[bj][0] = *(const f32x4*)(lb + cl + bj * HALF); lbv[bj][1] = *(const f32x4*)(lb + cl + bj * HALF + 4); }
        }
#pragma unroll
        for (int ai = 0; ai < 2; ++ai)
#pragma unroll
            for (int m = 0; m < 4; ++m) {
                const int rl = ai * HALF + wr * 64 + m * 16 + fr; const float rs = rt[rl];
                const size_t off = (size_t)(u.pm * BM + rl) * 2048 + cl;
#pragma unroll
                for (int bj = 0; bj < 2; ++bj) {
                    f32x4 v[2] = {acc[ai][bj][m][0] * rs, acc[ai][bj][m][1] * rs};
                    if (sec == 0) {
#pragma unroll
                        for (int n = 0; n < 2; ++n)
#pragma unroll
                            for (int e = 0; e < 4; ++e) v[n][e] = silu_f(v[n][e]) * 0.08838834764831845f;
                    } else if (sec == 1) {
                        f32x4 lf[2];
#pragma unroll
                        for (int n = 0; n < 2; ++n)
#pragma unroll
                            for (int e = 0; e < 4; ++e) {
                                const float ex = fast_exp2(v[n][e] * -1.44269504089f), r = fast_rcp(1.0f + ex), l = lbv[bj][n][e];
                                lf[n][e] = __logf(l + (1.0f - l) * r); v[n][e] = (1.0f - l) * ex * r;
                            }
                        *(f32x4*)(Clf + off + bj * HALF) = lf[0]; *(f32x4*)(Clf + off + bj * HALF + 4) = lf[1];
                    }
                    *(u32x4*)(base + off + bj * HALF) = pack8(v[0], v[1]);
                }
            }
    }
};
#ifndef PG8_KROT
#define PG8_KROT 0
#endif
template <class Epi, class Sched, bool ALIGN_EPI = false, bool SP2 = false, int PM = 0, bool HM = false, bool F16 = false, bool AIMG = false>
__device__ __forceinline__ void gemm_phase(PG8_LAS unsigned char* lds, const Gemm g, const Sched& S, const Epi& E) {
    int tid_ = threadIdx.x; asm volatile("" : "+v"(tid_));
    const int tid = tid_, wid = __builtin_amdgcn_readfirstlane(tid >> 6), lane = tid & 63, wr = wid >> 2, wc = wid & 3, fr = lane & 15, fq = lane >> 4;
    const int K = g.K, nt = K / BK, ld = g.ld, ks = g.ks;
    unsigned voffA[2], voffB[2];
#pragma unroll
    for (int i = 0; i < 2; ++i) { int R, C; stage_rc(tid * 16 + i * 8192, R, C); const int Rb = Epi::PERM ? ((R & ~31) + perm32(R & 31)) : R;
        voffA[i] = AIMG ? (unsigned)(((R >> 4) * (ld >> 5) + (C >> 5)) * 1024 + (lds_byte(R, C) & 1023)) : (unsigned)(R * ld + C) * 2u; voffB[i] = BIMG ? (unsigned)(((R >> 4) * (ld >> 5) + (C >> 5)) * 1024 + (lds_byte(R, C) & 1023)) : (unsigned)(Rb * ld + C) * 2u; }
    const size_t kstep = AIMG ? (size_t)2048 : (size_t)(BK * 2), kstepB = BIMG ? (size_t)2048 : (size_t)(BK * 2);
    const size_t hstep = (size_t)HALF * ld * 2;
    const size_t tstep = 2 * hstep;
    const unsigned ldsw = (unsigned)wid * 1024u;
    const int aoff = lds_byte(wr * 64 + fr, fq * 8), boff = lds_byte(wc * 32 + fr, fq * 8);
#define PG8_SA(b, h) (((b) * 2 + (h)) * HTB)
#define PG8_SB(b, h) ((4 + (b) * 2 + (h)) * HTB)
#define PG8_STAGE(bufoff, gbase, voff) do { _Pragma("unroll") for (int _i = 0; _i < 2; ++_i) \
        __builtin_amdgcn_global_load_lds((const unsigned*)((const char*)(gbase) + (voff)[_i]), (PG8_LAS unsigned*)(lds + (bufoff) + ldsw + _i * 8192), 16, 0, 0); } while (0)
#define PG8_LDA(dst, b, h) do { _Pragma("unroll") for (int m = 0; m < 4; ++m) _Pragma("unroll") for (int k = 0; k < 2; ++k) dst[m][k] = *(const PG8_LAS bf16x8*)(lds + PG8_SA(b, h) + aoff + m * 2048 + k * 1024); } while (0)
#define PG8_LDB(dst, b, h) do { _Pragma("unroll") for (int n = 0; n < 2; ++n) _Pragma("unroll") for (int k = 0; k < 2; ++k) dst[n][k] = *(const PG8_LAS bf16x8*)(lds + PG8_SB(b, h) + boff + n * 2048 + k * 1024); } while (0)
#define PG8_MMA(ai, bj, At, Bt) do { __builtin_amdgcn_s_setprio(1); _Pragma("unroll") for (int m = 0; m < 4; ++m) _Pragma("unroll") for (int n = 0; n < 2; ++n) _Pragma("unroll") for (int k = 0; k < 2; ++k) \
        { if constexpr (F16) acc[ai][bj][m][n] = __builtin_amdgcn_mfma_f32_16x16x32_f16(__builtin_bit_cast(f16x8, Bt[n][k]), __builtin_bit_cast(f16x8, At[m][k]), acc[ai][bj][m][n], 0, 0, 0); \
          else acc[ai][bj][m][n] = __builtin_amdgcn_mfma_f32_16x16x32_bf16(Bt[n][k], At[m][k], acc[ai][bj][m][n], 0, 0, 0); } __builtin_amdgcn_s_setprio(0); } while (0)
#define PG8_STAGE_L(bufoff, gbase, voff) do { if constexpr (PM != 1) PG8_STAGE(bufoff, gbase, voff); } while (0)
#define PG8_MMA_L(ai, bj, At, Bt) do { if constexpr (PM != 2) PG8_MMA(ai, bj, At, Bt); } while (0)
#define PG8_WAIT_V(n) asm volatile("s_waitcnt vmcnt(" #n ")" ::: "memory")
#define PG8_WAIT_L(n) asm volatile("s_waitcnt lgkmcnt(" #n ")" ::: "memory")
#define PG8_BAR __builtin_amdgcn_s_barrier()
#define PG8_SCHED __builtin_amdgcn_sched_barrier(0)
    Unit cur, nxt; int ui = 0;
    if (!S.next(0, cur)) return;
    f32x4 acc[2][2][4][2];
    E.init(acc, cur, wr, wc, fr, fq);
    bf16x8 At[4][2], B0[2][2], B1[2][2];
    const char* cA = (const char*)g.A + (size_t)cur.pm * tstep + (size_t)(cur.pn % ks) * K * 2 + (HM ? (size_t)cur.half * hstep : 0); const char* cB = (const char*)g.Bt + (size_t)(cur.pn / ks) * tstep + (size_t)(cur.pn % ks) * K * 2;
    int koff = PG8_KROT ? (PG8_KROT * (cur.pm + cur.pn)) % nt : 0;
    S.a_ready(cur);
    const char* cA0 = cA + (size_t)koff * kstep; const char* cB0 = cB + (size_t)koff * kstepB; const long k1d = (koff + 1 >= nt) ? -(long)koff * (long)kstep : (long)kstep, k1dB = (koff + 1 >= nt) ? -(long)koff * (long)kstepB : (long)kstepB;
    if constexpr (SP2) {
        static_assert(!HM || SP2, "HM needs the SP2 loop");
        PG8_STAGE(PG8_SB(0, 0), cB0, voffB); PG8_STAGE(PG8_SB(0, 1), cB0 + hstep, voffB); PG8_STAGE(PG8_SA(0, 0), cA0, voffA); if constexpr (!HM) PG8_STAGE(PG8_SA(0, 1), cA0 + hstep, voffA);
        if (wr == 1) PG8_BAR;
        if constexpr (HM) PG8_WAIT_V(0); else PG8_WAIT_V(2);
        PG8_BAR;
        PG8_STAGE(PG8_SB(1, 0), cB0 + k1dB, voffB); PG8_STAGE(PG8_SA(1, 0), cA0 + k1d, voffA); PG8_STAGE(PG8_SB(1, 1), cB0 + hstep + k1dB, voffB);
        PG8_WAIT_V(6); PG8_BAR;
    } else {
        PG8_STAGE(PG8_SB(0, 0), cB0, voffB); PG8_STAGE(PG8_SA(0, 0), cA0, voffA); PG8_STAGE(PG8_SB(0, 1), cB0 + hstep, voffB); PG8_STAGE(PG8_SA(0, 1), cA0 + hstep, voffA);
        if (wr == 1) PG8_BAR;
        PG8_WAIT_V(4); PG8_BAR;
        PG8_STAGE(PG8_SB(1, 0), cB0 + k1dB, voffB); PG8_STAGE(PG8_SA(1, 0), cA0 + k1d, voffA); PG8_STAGE(PG8_SB(1, 1), cB0 + hstep + k1dB, voffB);
        PG8_WAIT_V(6); PG8_BAR;
    }
    for (;;) {
        const bool has_next = S.next(ui + 1, nxt);
        const char* nA = has_next ? (const char*)g.A + (size_t)nxt.pm * tstep + (size_t)(nxt.pn % ks) * K * 2 + (HM ? (size_t)nxt.half * hstep : 0) : cA; const char* nB = has_next ? (const char*)g.Bt + (size_t)(nxt.pn / ks) * tstep + (size_t)(nxt.pn % ks) * K * 2 : cB;
        const int koffN = (PG8_KROT && has_next) ? (PG8_KROT * (nxt.pm + nxt.pn)) % nt : koff;
        int e0 = koff;
        for (int t = 0; t < nt; t += 2) {
            const bool last = (t == nt - 2);
            const int e1 = (e0 + 1 >= nt) ? e0 + 1 - nt : e0 + 1, e2 = (e0 + 2 >= nt) ? e0 + 2 - nt : e0 + 2, e3 = (e2 + 1 >= nt) ? 0 : e2 + 1, n1 = (koffN + 1 >= nt) ? 0 : koffN + 1;
            const char* a1 = cA + (size_t)e1 * kstep;
            const char* a2 = last ? nA + (size_t)koffN * kstep : cA + (size_t)e2 * kstep; const char* b2 = last ? nB + (size_t)koffN * kstepB : cB + (size_t)e2 * kstepB;
            const char* a3 = last ? nA + (size_t)n1 * kstep : cA + (size_t)e3 * kstep; const char* b3 = last ? nB + (size_t)n1 * kstepB : cB + (size_t)e3 * kstepB;
            e0 = e2;
            if (last && has_next) S.a_ready(nxt);
            if constexpr (SP2) {
#define PG8_WAIT_VL() do { if constexpr (HM) PG8_WAIT_V(6); else PG8_WAIT_V(8); } while (0)
            PG8_LDB(B0, 0, 0); PG8_LDB(B1, 0, 1); PG8_SCHED; PG8_LDA(At, 0, 0); if constexpr (!HM) PG8_STAGE_L(PG8_SA(1, 1), a1 + hstep, voffA);
            PG8_WAIT_VL(); PG8_WAIT_L(0); PG8_BAR; PG8_MMA_L(0, 0, At, B0); PG8_MMA_L(0, 1, At, B1); PG8_BAR; PG8_SCHED;
            if constexpr (!HM) PG8_LDA(At, 0, 1); PG8_STAGE_L(PG8_SB(0, 0), b2, voffB); PG8_STAGE_L(PG8_SB(0, 1), b2 + hstep, voffB); PG8_STAGE_L(PG8_SA(0, 0), a2, voffA);
            PG8_WAIT_VL(); PG8_WAIT_L(0); PG8_BAR; if constexpr (!HM) { PG8_MMA_L(1, 0, At, B0); PG8_MMA_L(1, 1, At, B1); } PG8_BAR; PG8_SCHED;
            PG8_LDB(B0, 1, 0); PG8_LDB(B1, 1, 1); PG8_SCHED; PG8_LDA(At, 1, 0); if constexpr (!HM) PG8_STAGE_L(PG8_SA(0, 1), a2 + hstep, voffA);
            PG8_WAIT_VL(); PG8_WAIT_L(0); PG8_BAR; PG8_MMA_L(0, 0, At, B0); PG8_MMA_L(0, 1, At, B1); PG8_BAR; PG8_SCHED;
            if constexpr (!HM) PG8_LDA(At, 1, 1); PG8_STAGE_L(PG8_SB(1, 0), b3, voffB); PG8_STAGE_L(PG8_SB(1, 1), b3 + hstep, voffB); PG8_STAGE_L(PG8_SA(1, 0), a3, voffA);
            PG8_WAIT_VL(); PG8_WAIT_L(0); PG8_BAR; if constexpr (!HM) { PG8_MMA_L(1, 0, At, B0); PG8_MMA_L(1, 1, At, B1); } PG8_BAR; PG8_SCHED;
#undef PG8_WAIT_VL
            } else {
            PG8_LDB(B0, 0, 0); PG8_SCHED; PG8_LDA(At, 0, 0); PG8_STAGE_L(PG8_SA(1, 1), a1 + hstep, voffA);
            PG8_WAIT_L(8); PG8_BAR; PG8_WAIT_L(0); PG8_MMA_L(0, 0, At, B0); PG8_BAR; PG8_SCHED;
            PG8_LDB(B1, 0, 1); PG8_STAGE_L(PG8_SB(0, 0), b2, voffB);
            PG8_BAR; PG8_WAIT_L(0); PG8_MMA_L(0, 1, At, B1); PG8_BAR;
            PG8_LDA(At, 0, 1); PG8_STAGE_L(PG8_SA(0, 0), a2, voffA);
            PG8_BAR; PG8_WAIT_L(0); PG8_MMA_L(1, 0, At, B0); PG8_BAR; PG8_SCHED;
            PG8_STAGE_L(PG8_SB(0, 1), b2 + hstep, voffB);
            PG8_WAIT_V(6); PG8_BAR; PG8_MMA_L(1, 1, At, B1); PG8_BAR;
            PG8_LDB(B0, 1, 0); PG8_SCHED; PG8_LDA(At, 1, 0); PG8_STAGE_L(PG8_SA(0, 1), a2 + hstep, voffA);
            PG8_WAIT_L(8); PG8_BAR; PG8_WAIT_L(0); PG8_MMA_L(0, 0, At, B0); PG8_BAR; PG8_SCHED;
            PG8_LDB(B1, 1, 1); PG8_STAGE_L(PG8_SB(1, 0), b3, voffB);
            PG8_BAR; PG8_WAIT_L(0); PG8_MMA_L(0, 1, At, B1); PG8_BAR;
            PG8_LDA(At, 1, 1); PG8_STAGE_L(PG8_SA(1, 0), a3, voffA);
            PG8_BAR; PG8_WAIT_L(0); PG8_MMA_L(1, 0, At, B0); PG8_BAR; PG8_SCHED;
            PG8_STAGE_L(PG8_SB(1, 1), b3 + hstep, voffB);
            PG8_WAIT_V(6); PG8_BAR; PG8_MMA_L(1, 1, At, B1); PG8_BAR;
            }
        }
        if constexpr (ALIGN_EPI) { if (wr == 0) PG8_BAR; }
        if constexpr (!Epi::AFTER_DRAIN) { E(acc, cur, ui, wr, wc, fr, fq); S.done(cur); }
        if (!has_next) break;
        cur = nxt; cA = nA; cB = nB; koff = koffN; ++ui;
        E.init(acc, cur, wr, wc, fr, fq);
        if constexpr (ALIGN_EPI) { if (wr == 1) PG8_BAR; }
    }
    PG8_WAIT_V(0);
    if constexpr (!ALIGN_EPI) { if (wr == 0) PG8_BAR; }
    PG8_BAR;
    if constexpr (Epi::AFTER_DRAIN) { E.fused(acc, cur, wr, wc, fr, fq, lds, wid, lane); S.done(cur); }
#undef PG8_SA
#undef PG8_SB
#undef PG8_STAGE
#undef PG8_STAGE_L
#undef PG8_MMA_L
#undef PG8_LDA
#undef PG8_LDB
#undef PG8_MMA
#undef PG8_WAIT_V
#undef PG8_WAIT_L
#undef PG8_BAR
#undef PG8_SCHED
}
}

constexpr int BATCH = 2, SEQ = 4096, D = 2048, DEPTH = 4, M = BATCH * SEQ;
constexpr int DFF = 5504, NFF = 2 * DFF;
constexpr int AB_IN = 7184, AB_PAD = 7424;
constexpr int HD = 128, NH_AB = 8, NH_C = 16, MEMT = 256, XW = 512, NBLK = SEQ / 256;
constexpr float EPS = 1e-6f;
constexpr float QK_SCALE_LOG2E = 0.08838834764831845f * 1.4426950408889634f;
constexpr int NWAVES = 8;

constexpr size_t MiB = 1u << 20;
constexpr size_t WS_CTL = 0, CTL_ZERO_BYTES = 1 * MiB;
constexpr size_t WS_X = 1 * MiB, WS_XB = 65 * MiB, WS_ROWSS = 97 * MiB, WS_ACT = 98 * MiB;
constexpr size_t WS_W1T = 184 * MiB, WS_W2T = 528 * MiB, WS_WABT = 700 * MiB, WS_WABOT = 758 * MiB, WS_WCT = 774 * MiB, WS_WCOT = 838 * MiB, WS_WXQT = 854 * MiB, WS_WXKVT = 862 * MiB, WS_WXOT = 878 * MiB;
constexpr size_t WS_MIX = 886 * MiB;
constexpr size_t WS_QM = WS_MIX, WS_KM = WS_MIX + 16 * MiB, WS_VM = WS_MIX + 32 * MiB, WS_DNPRE = WS_MIX + 48 * MiB, WS_DNGATE = WS_MIX + 96 * MiB, WS_BA = WS_MIX + 112 * MiB, WS_KMS = WS_MIX + 113 * MiB,
                 WS_DQ = WS_MIX + 114 * MiB, WS_DK = WS_MIX + 146 * MiB, WS_DV = WS_MIX + 178 * MiB, WS_BG = WS_MIX + 210 * MiB, WS_DNO = WS_MIX + 211 * MiB;
constexpr size_t WS_CQ = WS_MIX, WS_CK = WS_MIX + 32 * MiB, WS_CV = WS_MIX + 64 * MiB, WS_CG = WS_MIX + 96 * MiB, WS_CLF = WS_MIX + 128 * MiB, WS_CO = WS_MIX + 192 * MiB;
constexpr size_t WS_Y = WS_MIX + 256 * MiB, WS_XQ = WS_Y + 32 * MiB, WS_XO = WS_XQ + 8 * MiB, WS_MEMN = WS_XO + 8 * MiB, WS_KV = WS_MEMN + 2 * MiB, WS_LB = WS_KV + 4 * MiB, WS_END = WS_LB + 1 * MiB;
static_assert(WS_W1T + (size_t)8 * NFF * D * 2 <= WS_W2T && WS_W2T + (size_t)8 * D * DFF * 2 <= WS_WABT && WS_WABT + (size_t)2 * AB_PAD * D * 2 <= WS_WABOT && WS_ACT + (size_t)M * DFF * 2 <= WS_W1T, "ws map");
constexpr int CW_TMO = 0, CW_CODE = 1, CW_BAR = 4096;

constexpr int RING_OFF = 0, RING_BYTES = 131072;
constexpr int RTAB_OFF = RING_BYTES, RTAB_BYTES = 8 * 1024;
constexpr int LDSCTL_OFF = RTAB_OFF + RTAB_BYTES, MISC_OFF = LDSCTL_OFF + 320;
constexpr int LDS_BYTES = 147456;
static_assert(MISC_OFF + 128 <= LDS_BYTES, "LDS map");
#define GAS __attribute__((address_space(1)))
#define LAS __attribute__((address_space(3)))
typedef unsigned short bf16;
typedef unsigned v4u __attribute__((ext_vector_type(4)));
typedef float f32x4 __attribute__((ext_vector_type(4)));
typedef short bf16x8 __attribute__((ext_vector_type(8)));
typedef GAS unsigned gu32;
typedef GAS unsigned long long gu64;
#define RLX_AGENT __ATOMIC_RELAXED, __HIP_MEMORY_SCOPE_AGENT
#define LDS_WAIT() asm volatile("s_waitcnt lgkmcnt(0)" ::: "memory")
#define VM_WAIT() asm volatile("s_waitcnt vmcnt(0)" ::: "memory")
__device__ __forceinline__ unsigned long long rt() { return __builtin_amdgcn_s_memrealtime(); }
__device__ __forceinline__ unsigned f2bf(float f) { unsigned u = __builtin_bit_cast(unsigned, f); return (u + 0x7fffu + ((u >> 16) & 1u)) >> 16; }
__device__ __forceinline__ unsigned pk2(float lo, float hi) { return f2bf(lo) | (f2bf(hi) << 16); }
#define XB_TMO      128
#define XB_XCNT(j)  (256  + 64 * (j))
#define XB_XSUB(j)  (1280 + 64 * (j))
#define XB_XGEN(j)  (2304 + 64 * (j))
#define XB_TOP      3328
#define XB_TOPGEN   3392
#define XCD_BAR_WORDS 3456
#define XB_SPIN_CAP (1u << 18)

__device__ __forceinline__ unsigned xb_ld(unsigned* p)              { return __hip_atomic_load(p, __ATOMIC_RELAXED, __HIP_MEMORY_SCOPE_AGENT); }
__device__ __forceinline__ unsigned xb_add(unsigned* p, unsigned v) { return __hip_atomic_fetch_add(p, v, __ATOMIC_RELAXED, __HIP_MEMORY_SCOPE_AGENT); }
__device__ __forceinline__ unsigned xb_xcc_id() { return (unsigned)__builtin_amdgcn_s_getreg((3 << 11) | 20) & 0xFu; }
#define XB_SPIN(cond, bar) do { unsigned _sp = 0; while (cond) { __builtin_amdgcn_s_sleep(1); \
    if ((++_sp & 255u) == 0u) { if (xb_ld(&(bar)[XB_TMO])) break; if (_sp > XB_SPIN_CAP) { atomicAdd(&(bar)[XB_TMO], 1u); break; } } } } while (0)

struct XcdBarrier {
    unsigned* bar; unsigned x;
    volatile LAS unsigned* st;
};

__device__ __forceinline__ XcdBarrier xcd_barrier_post(unsigned* bar, volatile LAS unsigned* st) {
    XcdBarrier b; b.bar = bar; b.x = xb_xcc_id(); b.st = st;
    if (threadIdx.x == 0) (void)xb_add(&bar[XB_XCNT(b.x)], 1u);
    return b;
}
__device__ __forceinline__ void xcd_barrier_complete(unsigned* bar, unsigned x, unsigned& nloc, unsigned& nx) {
    const unsigned G = gridDim.x * gridDim.y * gridDim.z;
    unsigned sum, cnt, mine, sp = 0u;
    for (;;) {
        sum = 0u; cnt = 0u; mine = 0u;
#pragma unroll
        for (unsigned j = 0; j < 16; ++j) { const unsigned c = xb_ld(&bar[XB_XCNT(j)]); sum += c; cnt += (c > 0u) ? 1u : 0u; mine = (j == x) ? c : mine; }
        if (sum == G) break;
        __builtin_amdgcn_s_sleep(1);
        if ((++sp & 255u) == 0u) { if (xb_ld(&bar[XB_TMO])) break; if (sp > XB_SPIN_CAP) { atomicAdd(&bar[XB_TMO], 1u); break; } }
    }
    nloc = mine > 0u ? mine : 1u; nx = cnt > 0u ? cnt : 1u;
}

__device__ __forceinline__ void xcd_barrier(const XcdBarrier& b) {
    asm volatile("s_waitcnt vmcnt(0)" ::: "memory");
    __syncthreads();
    if (threadIdx.x == 0) {
        GAS unsigned* bar_g = (GAS unsigned*)b.bar; asm volatile("" : "+s"(bar_g)); unsigned* bar = (unsigned*)bar_g;
        __builtin_amdgcn_s_waitcnt(0);
        unsigned nloc = b.st[0], nx = b.st[1];
        if (nloc == 0u) { xcd_barrier_complete(bar, b.x, nloc, nx); b.st[0] = nloc; b.st[1] = nx; }
        const unsigned old = xb_add(&bar[XB_XSUB(b.x)], 1u);
        const unsigned gen = old / nloc;
        if (old + 1u == (gen + 1u) * nloc) {
            __builtin_amdgcn_fence(__ATOMIC_RELEASE, "agent");
            asm volatile("s_waitcnt vmcnt(0)" ::: "memory");
            const unsigned og = xb_add(&bar[XB_TOP], 1u);
            const unsigned tg = og / nx;
            if (og + 1u == (tg + 1u) * nx) xb_add(&bar[XB_TOPGEN], 1u);
            else XB_SPIN(xb_ld(&bar[XB_TOPGEN]) == tg, bar);
            __builtin_amdgcn_fence(__ATOMIC_ACQUIRE, "agent");
            xb_add(&bar[XB_XGEN(b.x)], 1u);
            asm volatile("s_waitcnt vmcnt(0)" ::: "memory");
        } else {
            XB_SPIN(xb_ld(&bar[XB_XGEN(b.x)]) == gen, bar);
            __builtin_amdgcn_fence(__ATOMIC_ACQUIRE, "agent");
            asm volatile("s_waitcnt vmcnt(0)" ::: "memory");
        }
    }
    __syncthreads();
}

struct Frame {
    LAS unsigned char* lds;
    volatile LAS unsigned* MISC;
    gu32* ctl;
    int tid, lane, wave, G, bx;
    const __attribute__((address_space(4))) unsigned long long* ka;
    float* out; GAS unsigned char* ws;
};
#define FIN(i) ((const float*)(const GAS float*)F.ka[i])
enum { I_X = 0, I_MEM, I_NORMG, I_MEMG, I_FINALG, I_FFN_WIN, I_FFN_WOUT, I_AB_WIN, I_AB_CONVW, I_AB_ALOG, I_AB_DTB, I_AB_ONG, I_AB_WOUT, I_C_WIN, I_C_LBL, I_C_ONG, I_C_WOUT, I_X_WQ, I_X_WKV, I_X_WO };

__device__ __forceinline__ int opaque_i(int v) { asm volatile("" : "+v"(v)); return v; }
#define PHASE_IDS() const int tid = opaque_i(F.tid), lane = tid & 63, wave = __builtin_amdgcn_readfirstlane(tid >> 6); (void)lane; (void)wave
__device__ __forceinline__ float wave_sum(float v) {
#pragma unroll
    for (int o = 1; o < 64; o <<= 1) v += __shfl_xor(v, o);
    return v;
}
__device__ __forceinline__ float wave_max(float v) {
#pragma unroll
    for (int o = 1; o < 64; o <<= 1) v = fmaxf(v, __shfl_xor(v, o));
    return v;
}
__device__ __forceinline__ float bflo(unsigned w) { return __uint_as_float(w << 16); }
__device__ __forceinline__ float bfhi(unsigned w) { return __uint_as_float(w & 0xffff0000u); }
__device__ __forceinline__ float sigmoid_f(float a) { return 1.0f / (1.0f + __expf(-a)); }
__device__ __forceinline__ float silu_acc(float a) { return a / (1.0f + __expf(-a)); }

__device__ __forceinline__ void conv_tile(const float* src, bf16* dst, int K, int N, int mode, const float* gain, int kb, int nb, int wave, int lane) {
    const int k0 = kb * 128 + wave * 16, n = nb * 256 + lane * 4;
    if (n >= N) return;
    const bool xw = X_F16 == 1 && gain != nullptr;
    f32x4 v[16];
#pragma unroll
    for (int r = 0; r < 16; ++r) v[r] = *(const GAS f32x4*)(src + (size_t)(k0 + r) * N + n);
    if (gain) {
#pragma unroll
        for (int r = 0; r < 16; ++r) v[r] = v[r] * gain[k0 + r];
    }
#pragma unroll
    for (int e = 0; e < 4; ++e) {
        const int col = n + e; int drow = col;
        if (mode == 1) { const int half = col >= DFF ? 1 : 0, j = col - half * DFF; drow = (j >> 7) * 256 + half * 128 + (j & 127); }
        v4u w0, w1;
#define CV2(a_, b_) (xw ? pg8::cvt_pk_f16(a_, b_) : pg8::cvt_pk_bf16(a_, b_))
        w0.x = CV2(v[0][e], v[1][e]); w0.y = CV2(v[2][e], v[3][e]); w0.z = CV2(v[4][e], v[5][e]); w0.w = CV2(v[6][e], v[7][e]);
        w1.x = CV2(v[8][e], v[9][e]); w1.y = CV2(v[10][e], v[11][e]); w1.z = CV2(v[12][e], v[13][e]); w1.w = CV2(v[14][e], v[15][e]);
#undef CV2
        GAS v4u* o = BIMG ? (GAS v4u*)((GAS char*)dst + pg8::img_off(pg8::slot32(drow), k0, K)) : (GAS v4u*)(dst + (size_t)drow * K + k0);
        o[0] = w0; o[1] = w1;
    }
}
constexpr int IT_W1M = 16 * 43, IT_W2M = 43 * 8;
__device__ __forceinline__ int conv_family_tiles(int fam) { return fam == 0 ? IT_W1M + IT_W2M : (fam == 1 ? 16 * 29 + 16 * 8 : (fam == 2 ? 16 * 32 + 16 * 8 : (fam == 3 ? 64 : 256))); }
__device__ __forceinline__ void conv_family_item(Frame& F, int fam, int m, int r, int wave, int lane) {
    const float* normg = FIN(I_NORMG); const float* src; bf16* dst; const float* gain = nullptr; int K = D, N = D, mode = 0, kb, nb;
    if (fam == 0) {
        if (r < IT_W1M) { kb = r / 43; nb = r - kb * 43; src = FIN(I_FFN_WIN) + (size_t)m * D * NFF; dst = (bf16*)(F.ws + WS_W1T) + (size_t)m * NFF * D; N = NFF; mode = 1; gain = normg + (size_t)((m >> 1) * 4 + ((m & 1) ? 3 : 0)) * D; }
        else { r -= IT_W1M; kb = r >> 3; nb = r & 7; src = FIN(I_FFN_WOUT) + (size_t)m * DFF * D; dst = (bf16*)(F.ws + WS_W2T) + (size_t)m * D * DFF; K = DFF; }
    } else if (fam == 1) {
        if (r < 16 * 29) { kb = r / 29; nb = r - kb * 29; src = FIN(I_AB_WIN) + (size_t)m * D * AB_IN; dst = (bf16*)(F.ws + WS_WABT) + (size_t)m * AB_PAD * D; N = AB_IN; gain = normg + (size_t)((2 * m) * 4 + 1) * D; }
        else { r -= 16 * 29; kb = r >> 3; nb = r & 7; src = FIN(I_AB_WOUT) + (size_t)m * D * D; dst = (bf16*)(F.ws + WS_WABOT) + (size_t)m * D * D; }
    } else if (fam == 2) {
        if (r < 16 * 32) { kb = r >> 5; nb = r & 31; src = FIN(I_C_WIN) + (size_t)m * D * 4 * D; dst = (bf16*)(F.ws + WS_WCT) + (size_t)m * 4 * D * D; N = 4 * D; gain = normg + (size_t)((2 * m + 1) * 4 + 1) * D; }
        else { r -= 16 * 32; kb = r >> 3; nb = r & 7; src = FIN(I_C_WOUT) + (size_t)m * D * D; dst = (bf16*)(F.ws + WS_WCOT) + (size_t)m * D * D; }
    } else if (fam == 3) {
        if (r < 32) { kb = r >> 1; nb = r & 1; src = FIN(I_X_WQ) + (size_t)m * D * XW; dst = (bf16*)(F.ws + WS_WXQT) + (size_t)m * XW * D; N = XW; gain = normg + (size_t)(m * 4 + 2) * D; }
        else { r -= 32; kb = r >> 3; nb = r & 7; src = FIN(I_X_WO) + (size_t)m * XW * D; dst = (bf16*)(F.ws + WS_WXOT) + (size_t)m * D * XW; K = XW; }
    } else { const int mat = r >> 6, q = r & 63; kb = q >> 2; nb = q & 3; src = FIN(I_X_WKV) + (size_t)mat * D * 2 * XW; dst = (bf16*)(F.ws + WS_WXKVT) + (size_t)mat * 2 * XW * D; N = 2 * XW; }
    conv_tile(src, dst, K, N, mode, gain, kb, nb, wave, lane);
}
__device__ __forceinline__ void conv_family(Frame& F, int fam, int m, int first, int skip_lo = 0, int skip_hi = 0, int part = 0) {
    if (F.bx < first || (F.bx >= skip_lo && F.bx < skip_hi)) return;
    PHASE_IDS();
    const int nall = conv_family_tiles(fam), r0 = part == 2 ? nall / 2 : 0, nt = part == 1 ? nall / 2 : nall, vb = F.bx - first - (F.bx >= skip_hi ? skip_hi - skip_lo : 0), nb = F.G - first - (skip_hi - skip_lo);
    for (int r = r0 + vb; r < nt; r += nb) conv_family_item(F, fam, m, r, wave, lane);
    if (part == 2) return;
    if (fam == 1) {
        constexpr int PADV = (AB_PAD - AB_IN) * (D / 16);
        for (int i = vb * 512 + tid; i < PADV; i += nb * 512) { const int c = AB_IN + i / (D / 16), k0 = (i % (D / 16)) * 16;
            GAS v4u* o = BIMG ? (GAS v4u*)(F.ws + WS_WABT + (size_t)m * AB_PAD * D * 2 + pg8::img_off(pg8::slot32(c), k0, D)) : (GAS v4u*)(F.ws + WS_WABT + ((size_t)m * AB_PAD + c) * D * 2 + k0 * 2); o[0] = (v4u){0u, 0u, 0u, 0u}; o[1] = (v4u){0u, 0u, 0u, 0u}; }
    }
}

constexpr int CQ_NSEG = 17;
__device__ __forceinline__ void conv_queue_tile(Frame& F, int t, int wave, int lane, int tid) {
    int fam = 0, m = 0, base = 0;
#define CQ_SEG(f_, m_, n_) if (t >= base + (n_)) base += (n_); else { fam = (f_); m = (m_); goto found; }
    CQ_SEG(0, 0, 1032) CQ_SEG(1, 0, 592) CQ_SEG(4, 0, 256) CQ_SEG(3, 0, 64) CQ_SEG(0, 1, 1032) CQ_SEG(0, 2, 1032) CQ_SEG(2, 0, 640) CQ_SEG(3, 1, 64) CQ_SEG(0, 3, 1032)
    CQ_SEG(0, 4, 1032) CQ_SEG(1, 1, 592) CQ_SEG(3, 2, 64) CQ_SEG(0, 5, 1032) CQ_SEG(0, 6, 1032) CQ_SEG(2, 1, 640) CQ_SEG(3, 3, 64) CQ_SEG(0, 7, 1032)
    return;
#undef CQ_SEG
found:
    const int r = t - base;
    conv_family_item(F, fam, m, r, wave, lane);
    if (fam == 1 && r == 0) {
        constexpr int PADV = (AB_PAD - AB_IN) * (D / 16);
        for (int i2 = tid; i2 < PADV; i2 += NWAVES * 64) { const int c = AB_IN + i2 / (D / 16), k0 = (i2 % (D / 16)) * 16;
            GAS v4u* o = BIMG ? (GAS v4u*)(F.ws + WS_WABT + (size_t)m * AB_PAD * D * 2 + pg8::img_off(pg8::slot32(c), k0, D)) : (GAS v4u*)(F.ws + WS_WABT + ((size_t)m * AB_PAD + c) * D * 2 + k0 * 2); o[0] = (v4u){0u, 0u, 0u, 0u}; o[1] = (v4u){0u, 0u, 0u, 0u}; }
    }
}
constexpr int CQ_TOTAL = 11232, CW_CONVQ = 2048;
__device__ __forceinline__ int cq_n_ffn(int s) { return s == 0 ? 1032 : s == 1 ? 2976 : s == 2 ? 4008 : s == 3 ? 5744 : s == 4 ? 6776 : s == 5 ? 8464 : s == 6 ? 9496 : 11232; }
__device__ __forceinline__ int cq_n_mix(int l) { return l == 0 ? 1624 : l == 1 ? 4648 : l == 2 ? 7368 : 10136; }
__device__ __forceinline__ int cq_n_x(int l) { return l == 0 ? 1944 : l == 1 ? 4712 : l == 2 ? 7432 : 10200; }
__device__ __forceinline__ unsigned cq_bcast(Frame& F, unsigned v, int tid) { __syncthreads(); if (tid == 0) F.MISC[20] = v; __syncthreads(); return F.MISC[20]; }
__device__ __forceinline__ void conv_slot(Frame& F, int first, int quota, int skip_lo = 0, int skip_hi = 0) {
    if (F.bx < first || (F.bx >= skip_lo && F.bx < skip_hi)) return;
    PHASE_IDS();
    gu32* q = F.ctl + CW_CONVQ;
    unsigned tk = 0u; if (tid == 0) tk = __hip_atomic_fetch_add(q, 1u, RLX_AGENT);
    for (int i = 0; i < quota; ++i) {
        const unsigned t = cq_bcast(F, tk, tid);
        if (t >= (unsigned)CQ_TOTAL) break;
        if (tid == 0 && i + 1 < quota) tk = __hip_atomic_fetch_add(q, 1u, RLX_AGENT);
        conv_queue_tile(F, (int)t, wave, lane, tid);
    }
}
__device__ __forceinline__ void conv_deadline(Frame& F, int need) {
    PHASE_IDS();
    gu32* q = F.ctl + CW_CONVQ;
    for (;;) {
        unsigned cur = 0u; if (tid == 0) cur = __hip_atomic_load(q, RLX_AGENT);
        if (cq_bcast(F, cur, tid) >= (unsigned)need) break;
        unsigned tk = 0u; if (tid == 0) tk = __hip_atomic_fetch_add(q, 1u, RLX_AGENT);
        const unsigned t = cq_bcast(F, tk, tid);
        if (t < (unsigned)CQ_TOTAL) conv_queue_tile(F, (int)t, wave, lane, tid);
    }
}

__device__ __forceinline__ void p0_prologue(Frame& F) {
    PHASE_IDS();
    conv_deadline(F, cq_n_ffn(0));
    const int gw = F.bx * NWAVES + wave, NGW = F.G * NWAVES;
    {
        const float* x = FIN(I_X); bf16* xb = (bf16*)(F.ws + WS_XB); float* rowss = (float*)(F.ws + WS_ROWSS);
        for (int m = gw; m < M; m += NGW) {
            const GAS f32x4* xr = (const GAS f32x4*)(x + (size_t)m * D) + lane; f32x4 v[8]; float ss = 0.f;
#pragma unroll
            for (int j = 0; j < 8; ++j) { v[j] = xr[64 * j]; ss += (v[j][0] * v[j][0] + v[j][1] * v[j][1]) + (v[j][2] * v[j][2] + v[j][3] * v[j][3]); }
            ss = wave_sum(ss);
            GAS pg8::u32x2* o = (GAS pg8::u32x2*)(xb + (size_t)m * D) + lane;
#pragma unroll
            for (int j = 0; j < 8; ++j) { pg8::u32x2 w; w.x = pg8::cvt_pk_x(v[j][0], v[j][1]); w.y = pg8::cvt_pk_x(v[j][2], v[j][3]);
                if (AIMG_XB) *(GAS pg8::u32x2*)((GAS char*)xb + pg8::img_off(m, 4 * lane + 256 * j, D)) = w; else o[64 * j] = w; }
            if (lane < 32) rowss[(size_t)lane * M + m] = lane == 0 ? ss : 0.f;
        }
    }
    {
        const float* mem = FIN(I_MEM); const float* mg = FIN(I_MEMG); bf16* mn = (bf16*)(F.ws + WS_MEMN);
        for (int m = gw; m < BATCH * MEMT; m += NGW) {
            const GAS f32x4* xr = (const GAS f32x4*)(mem + (size_t)m * D) + lane; f32x4 v[8]; float ss = 0.f;
#pragma unroll
            for (int j = 0; j < 8; ++j) { v[j] = xr[64 * j]; ss += (v[j][0] * v[j][0] + v[j][1] * v[j][1]) + (v[j][2] * v[j][2] + v[j][3] * v[j][3]); }
            const float rs = 1.0f / sqrtf(wave_sum(ss) * (1.0f / D) + EPS);
            GAS pg8::u32x2* o = (GAS pg8::u32x2*)(mn + (size_t)m * D) + lane;
#pragma unroll
            for (int j = 0; j < 8; ++j) { const f32x4 g = ((const GAS f32x4*)mg)[lane + 64 * j]; pg8::u32x2 w; w.x = pg8::cvt_pk_bf16(v[j][0] * rs * g[0], v[j][1] * rs * g[1]); w.y = pg8::cvt_pk_bf16(v[j][2] * rs * g[2], v[j][3] * rs * g[3]); o[64 * j] = w; }
        }
    }
    {
        const float* lg = FIN(I_C_LBL); float* lb = (float*)(F.ws + WS_LB);
        for (int c = F.bx * 512 + tid; c < D; c += F.G * 512) {
            const float a0 = lg[c], a1 = lg[D + c], a2 = lg[2 * D + c], a3 = lg[3 * D + c];
            const float mx = fmaxf(fmaxf(a0, a1), fmaxf(a2, a3));
            const float e0 = expf(a0 - mx), e1 = expf(a1 - mx), e2 = expf(a2 - mx), e3 = expf(a3 - mx), inv = 1.0f / (e0 + e1 + e2 + e3);
            const float p1 = e1 * inv, p2 = e2 * inv, p3 = e3 * inv;
            lb[c] = 0.f; lb[D + c] = p1; lb[2 * D + c] = p1 + p2; lb[3 * D + c] = p1 + p2 + p3;
        }
    }
}

template <class Sched> __device__ __forceinline__ void build_rtab(Frame& F, const Sched& S, int xi = -1, int xpn0 = 0, int xnt = 0) {
    PHASE_IDS();
    const float* rowss = (const float*)(F.ws + WS_ROWSS); LAS float* rt = (LAS float*)(F.lds + RTAB_OFF);
    int xpm = -1; if (xi >= 0) { pg8::HalfOrder H; H.init(M, xpn0, xnt, F.G, F.bx); pg8::Unit hu; if (H.next(0, hu)) xpm = hu.pm; xpm = __builtin_amdgcn_readfirstlane(xpm); }
    float v[4][32]; bool ok[4];
#pragma unroll
    for (int it = 0; it < 4; ++it) {
        const int idx = tid + it * NWAVES * 64, i = idx >> 8, r = idx & 255; pg8::Unit u; ok[it] = S.next(i, u);
        if (!ok[it] && i == xi && xpm >= 0) { ok[it] = true; u.pm = xpm; }
        const GAS float* p = (const GAS float*)rowss + (size_t)((ok[it] ? u.pm : 0) * 256 + r);
        if (ok[it]) {
#pragma unroll
            for (int j = 0; j < 32; ++j) v[it][j] = p[(size_t)j * M];
        } else {
#pragma unroll
            for (int j = 0; j < 32; ++j) v[it][j] = 0.f;
        }
    }
#pragma unroll
    for (int it = 0; it < 4; ++it) {
        float s = 0.f;
#pragma unroll
        for (int j = 0; j < 8; ++j) s += (v[it][4 * j] + v[it][4 * j + 1]) + (v[it][4 * j + 2] + v[it][4 * j + 3]);
        if (ok[it]) rt[tid + it * NWAVES * 64] = 1.0f / sqrtf(s * (1.0f / D) + EPS);
    }
    LDS_WAIT(); __syncthreads();
}
template <class Epi, int PM = 0, bool F16 = false, bool AIMG = false> __device__ __forceinline__ void run_gemm(Frame& F, const bf16* A, const bf16* Bt, int Mrows, int N, int K, const Epi& E, bool need_rtab, int rot = 0, int ld = 0, int ks = 1, int xi = -1, int xpn0 = 0, int xnt = 0) {
    pg8::Gemm g{A, Bt, Mrows, N, K, ld ? ld : K, ks}; pg8::StaticOrder S; S.init(Mrows, N, F.G, (int)(((unsigned)F.bx + (unsigned)rot) % (unsigned)F.G));
    if (need_rtab) build_rtab(F, S, xi, xpn0, xnt);
    pg8::gemm_phase<Epi, pg8::StaticOrder, true, true, PM, false, F16, AIMG>(F.lds + RING_OFF, g, S, E);
}

template <class Epi, bool F16 = false, bool AIMG = false> __device__ __forceinline__ void run_gemm_half(Frame& F, const bf16* A, const bf16* Bt, int Mrows, int N, int K, int pn0, int ntile, const Epi& E, bool need_rtab = true, int rot = 0) {
    pg8::Gemm g{A, Bt, Mrows, N, K, K, 1}; pg8::HalfOrder S; S.init(Mrows, pn0, ntile, F.G, (int)(((unsigned)F.bx + (unsigned)rot) % (unsigned)F.G));
    if (need_rtab) build_rtab(F, S);
    pg8::gemm_phase<Epi, pg8::HalfOrder, true, true, 0, true, F16, AIMG>(F.lds + RING_OFF, g, S, E);
}
__device__ __forceinline__ void normgate(Frame& F, const float* o, const bf16* gate, int nheads, const float* gw_, int ycol) {
    PHASE_IDS();
    bf16* Y = (bf16*)(F.ws + WS_Y);
    const int hw = lane >> 5, l32 = lane & 31, ld = nheads * HD, total = M * nheads;
    const int gw = (F.bx * NWAVES + wave) * 2 + hw, NGW = F.G * NWAVES * 2;
    const f32x4 g4 = *(const GAS f32x4*)(gw_ + 4 * l32);
    for (int u0 = gw; u0 < total; u0 += 4 * NGW) {
        f32x4 v[4]; pg8::u32x2 gt[4];
#pragma unroll
        for (int j = 0; j < 4; ++j) { const int un = u0 + j * NGW; if (un < total) { const int row = un / nheads, h = un - row * nheads;
            v[j] = *(const GAS f32x4*)(o + (size_t)row * ld + h * HD + 4 * l32); gt[j] = *(const GAS pg8::u32x2*)(gate + (size_t)row * ld + h * HD + 4 * l32); } else { v[j] = (f32x4){0.f, 0.f, 0.f, 0.f}; gt[j] = (pg8::u32x2){0u, 0u}; } }
#pragma unroll
        for (int j = 0; j < 4; ++j) { const int un = u0 + j * NGW;
            float ss = (v[j][0] * v[j][0] + v[j][1] * v[j][1]) + (v[j][2] * v[j][2] + v[j][3] * v[j][3]);
#pragma unroll
            for (int of = 1; of < 32; of <<= 1) ss += __shfl_xor(ss, of);
            const float rs = 1.0f / sqrtf(ss * (1.0f / HD) + EPS);
            if (un < total) { const int row = un / nheads, h = un - row * nheads; pg8::u32x2 w;
                w.x = pg8::cvt_pk_bf16(v[j][0] * rs * g4[0] * silu_acc(bflo(gt[j].x)), v[j][1] * rs * g4[1] * silu_acc(bfhi(gt[j].x))); w.y = pg8::cvt_pk_bf16(v[j][2] * rs * g4[2] * silu_acc(bflo(gt[j].y)), v[j][3] * rs * g4[3] * silu_acc(bfhi(gt[j].y)));
                *(GAS pg8::u32x2*)(Y + (size_t)row * D + ycol + h * HD + 4 * l32) = w; }
        }
    }
}
__device__ __forceinline__ void final_norm(Frame& F) {
    PHASE_IDS();
    static_assert(X_F16 == 2, "final_norm reads the fragment-ordered f16 residual plane");
    const GAS pg8::u32x4* xn = (const GAS pg8::u32x4*)(F.ws + WS_X); const GAS float* rowss = (const GAS float*)(F.ws + WS_ROWSS); const float* fg = FIN(I_FINALG);
    const int gw = F.bx * NWAVES + wave, NGW = F.G * NWAVES, fr = lane & 15, fq = lane >> 4;
    constexpr int NT = (M / 256) * (D / 256) * 64;
    for (int t0 = gw; t0 < NT; t0 += 2 * NGW) {
        pg8::u32x4 c0[2], c1[2]; float s[2]; int row[2], tt[2];
#pragma unroll
        for (int u = 0; u < 2; ++u) { const int t = t0 + u * NGW < NT ? t0 + u * NGW : t0; tt[u] = t;
            const int am = t & 7, wid = (t >> 3) & 7, U = t >> 6, pm = U / (D / 256), wr = wid >> 2;
            row[u] = pm * 256 + (am >> 2) * 128 + wr * 64 + (am & 3) * 16 + fr;
            c0[u] = xn[((size_t)t * 2 + 0) * 64 + lane]; c1[u] = xn[((size_t)t * 2 + 1) * 64 + lane];
            float a = 0.f;
#pragma unroll
            for (int k = 0; k < 8; ++k) a += rowss[(size_t)(fq * 8 + k) * M + row[u]];
            s[u] = a; }
#pragma unroll
        for (int u = 0; u < 2; ++u) { if (u == 1 && t0 + NGW >= NT) break;
            const int t = tt[u], wid = (t >> 3) & 7, U = t >> 6, pn = U % (D / 256), wc = wid & 3;
            float a = s[u]; a += __shfl_xor(a, 16); a += __shfl_xor(a, 32);
            const float rs = 1.0f / sqrtf(a * (1.0f / D) + EPS);
#pragma unroll
            for (int bj = 0; bj < 2; ++bj) { const pg8::u32x4 c = bj ? c1[u] : c0[u]; const int col = pn * 256 + bj * 128 + wc * 32 + 8 * fq;
                const f32x4 g0 = *(const GAS f32x4*)(fg + col), g1 = *(const GAS f32x4*)(fg + col + 4);
                const f32x4 x0 = {pg8::f16_lo(c.x), pg8::f16_hi(c.x), pg8::f16_lo(c.y), pg8::f16_hi(c.y)}, x1 = {pg8::f16_lo(c.z), pg8::f16_hi(c.z), pg8::f16_lo(c.w), pg8::f16_hi(c.w)};
                GAS f32x4* o = (GAS f32x4*)(F.out + (size_t)row[u] * D + col); o[0] = x0 * rs * g0; o[1] = x1 * rs * g1; }
        }
    }
}

namespace att {
typedef short s16x4 __attribute__((ext_vector_type(4)));
typedef short v4i16_t __attribute__((ext_vector_type(4)));
__device__ __forceinline__ unsigned swz(unsigned row) { return ((row & 3u) << 2) | ((row >> 2) & 3u); }
__device__ __forceinline__ void glds16(const void* gsrc, unsigned lds_dst) { unsigned keep;
    asm volatile("s_mov_b32 %0, m0\n\ts_mov_b32 m0, %2\n\ts_nop 0\n\tglobal_load_lds_dwordx4 %1, off\n\ts_mov_b32 m0, %0" : "=&s"(keep) : "v"(gsrc), "s"(lds_dst) : "memory"); }
__device__ __forceinline__ s16x4 vtr(const LAS char* p) { return __builtin_bit_cast(s16x4, __builtin_amdgcn_ds_read_tr16_b64_v4i16((LAS v4i16_t*)p)); }
__device__ __forceinline__ void stage_half(const char* g, size_t pitch, LAS char* img, int wave, int lane) {
#pragma unroll
    for (int p = 0; p < 4; ++p) {
        const int piece = 4 * wave + p; const unsigned row = 4u * piece + ((unsigned)lane >> 4), ch = ((unsigned)lane & 15u) ^ swz(row);
        glds16(g + (size_t)row * pitch + ch * 16u, (unsigned)__builtin_amdgcn_readfirstlane((unsigned)(size_t)(img + piece * 1024)));
    }
}
struct State { f32x4 o[2][8]; float m[2], l[2]; };
__device__ __forceinline__ void half_step(State& st, const bf16x8 (&qf)[2][4], const LAS char* Kimg, const LAS char* Vimg, int lane, int maskmode, int kbase, const int (&qidx)[2], const bool (&valid)[2]) {
    const unsigned fr = lane & 15, g = lane >> 4, q4 = fr >> 2, p = lane & 3;
    const unsigned fk = swz(fr);
    f32x4 s[2][8];
#pragma unroll
    for (int qt = 0; qt < 2; ++qt)
#pragma unroll
        for (int kt = 0; kt < 8; ++kt) s[qt][kt] = (f32x4){0.f, 0.f, 0.f, 0.f};
#define SB() __builtin_amdgcn_sched_barrier(0)
#define ATT_LDK(kt_, K_) do { _Pragma("unroll") for (int ks_ = 0; ks_ < 4; ++ks_) K_[ks_] = *(const LAS bf16x8*)(Kimg + 256u * (16u * (kt_) + fr) + 16u * ((4u * ks_ + g) ^ fk)); } while (0)
#define ATT_MMK(kt_, K_) do { _Pragma("unroll") for (int ks_ = 0; ks_ < 4; ++ks_) { s[0][kt_] = __builtin_amdgcn_mfma_f32_16x16x32_bf16(K_[ks_], qf[0][ks_], s[0][kt_], 0, 0, 0); s[1][kt_] = __builtin_amdgcn_mfma_f32_16x16x32_bf16(K_[ks_], qf[1][ks_], s[1][kt_], 0, 0, 0); } } while (0)
    {
        bf16x8 kA[4], kB[4];
        ATT_LDK(0, kA); SB();
        ATT_LDK(1, kB); SB(); ATT_MMK(0, kA); SB();
        ATT_LDK(2, kA); SB(); ATT_MMK(1, kB); SB();
        ATT_LDK(3, kB); SB(); ATT_MMK(2, kA); SB();
        ATT_LDK(4, kA); SB(); ATT_MMK(3, kB); SB();
        ATT_LDK(5, kB); SB(); ATT_MMK(4, kA); SB();
        ATT_LDK(6, kA); SB(); ATT_MMK(5, kB); SB();
        ATT_LDK(7, kB); SB(); ATT_MMK(6, kA); SB();
        ATT_MMK(7, kB); SB();
    }
#undef ATT_LDK
#undef ATT_MMK
    bf16x8 pf[2][4];
    if (maskmode == 1) {
#pragma unroll
        for (int qt = 0; qt < 2; ++qt)
#pragma unroll
            for (int kt = 0; kt < 8; ++kt)
#pragma unroll
                for (int r = 0; r < 4; ++r) if (kbase + 16 * kt + 4 * (int)g + r > qidx[qt]) s[qt][kt][r] = -INFINITY;
    }
#pragma unroll
    for (int qt = 0; qt < 2; ++qt) {
        float mx = -INFINITY;
#pragma unroll
        for (int kt = 0; kt < 8; ++kt)
#pragma unroll
            for (int r = 0; r < 4; ++r) mx = fmaxf(mx, s[qt][kt][r]);
        mx = fmaxf(mx, __shfl_xor(mx, 16)); mx = fmaxf(mx, __shfl_xor(mx, 32));
        if (!valid[qt]) mx = -INFINITY;
        const float mn = fmaxf(st.m[qt], mx);
        const float alpha = (st.m[qt] == -INFINITY) ? 0.f : __builtin_amdgcn_exp2f(st.m[qt] - mn);
        const float msub = (!valid[qt] || mn == -INFINITY) ? INFINITY : mn;
        st.m[qt] = mn;
        float sum = 0.f;
#pragma unroll
        for (int kt = 0; kt < 8; ++kt)
#pragma unroll
            for (int r = 0; r < 4; ++r) { const float pv = __builtin_amdgcn_exp2f(s[qt][kt][r] - msub); s[qt][kt][r] = pv; sum += pv; }
        st.l[qt] = st.l[qt] * alpha + sum;
        if (__any(alpha != 1.0f)) {
#pragma unroll
            for (int dt = 0; dt < 8; ++dt) st.o[qt][dt] = st.o[qt][dt] * alpha;
        }
#pragma unroll
        for (int ks = 0; ks < 4; ++ks) {
            pg8::u32x4 w; w.x = pg8::cvt_pk_bf16(s[qt][2 * ks][0], s[qt][2 * ks][1]); w.y = pg8::cvt_pk_bf16(s[qt][2 * ks][2], s[qt][2 * ks][3]);
            w.z = pg8::cvt_pk_bf16(s[qt][2 * ks + 1][0], s[qt][2 * ks + 1][1]); w.w = pg8::cvt_pk_bf16(s[qt][2 * ks + 1][2], s[qt][2 * ks + 1][3]);
            pf[qt][ks] = __builtin_bit_cast(bf16x8, w);
        }
    }
    const unsigned fv = (q4 << 2) | g;
#define ATT_LDV(dt_, V_) do { const unsigned vb_ = 256u * (4u * g + q4) + 16u * ((2u * (dt_) + (p >> 1)) ^ fv) + 8u * (p & 1u); _Pragma("unroll") for (int ks_ = 0; ks_ < 4; ++ks_) { \
        const s16x4 v0_ = vtr(Vimg + vb_ + 256u * (32u * ks_)), v1_ = vtr(Vimg + vb_ + 256u * (32u * ks_ + 16u)); bf16x8 t_; t_[0] = v0_[0]; t_[1] = v0_[1]; t_[2] = v0_[2]; t_[3] = v0_[3]; t_[4] = v1_[0]; t_[5] = v1_[1]; t_[6] = v1_[2]; t_[7] = v1_[3]; V_[ks_] = t_; } } while (0)
#define ATT_MMV(dt_, V_) do { _Pragma("unroll") for (int ks_ = 0; ks_ < 4; ++ks_) { st.o[0][dt_] = __builtin_amdgcn_mfma_f32_16x16x32_bf16(V_[ks_], pf[0][ks_], st.o[0][dt_], 0, 0, 0); st.o[1][dt_] = __builtin_amdgcn_mfma_f32_16x16x32_bf16(V_[ks_], pf[1][ks_], st.o[1][dt_], 0, 0, 0); } } while (0)
    {
        bf16x8 vA[4], vB[4];
        ATT_LDV(0, vA); SB();
        ATT_LDV(1, vB); SB(); ATT_MMV(0, vA); SB();
        ATT_LDV(2, vA); SB(); ATT_MMV(1, vB); SB();
        ATT_LDV(3, vB); SB(); ATT_MMV(2, vA); SB();
        ATT_LDV(4, vA); SB(); ATT_MMV(3, vB); SB();
        ATT_LDV(5, vB); SB(); ATT_MMV(4, vA); SB();
        ATT_LDV(6, vA); SB(); ATT_MMV(5, vB); SB();
        ATT_LDV(7, vB); SB(); ATT_MMV(6, vA); SB();
        ATT_MMV(7, vB); SB();
    }
#undef ATT_LDV
#undef ATT_MMV
#undef SB
}
}

template <int MODE>
__device__ __forceinline__ void attn_unit(Frame& F, int tid_in, int wave, int b, int h, int qblk, int l) {
    const int tid = opaque_i(tid_in), lane = tid & 63;
    LAS char* ring = (LAS char*)(F.lds + RING_OFF);
    LAS unsigned* sel = (LAS unsigned*)(F.lds + RTAB_OFF);
    const bf16* Qp; int ldq; bf16* Op; int ldo;
    if (MODE == 0) { Qp = (const bf16*)(F.ws + WS_XQ); ldq = XW; Op = (bf16*)(F.ws + WS_XO); ldo = XW; }
    else { Qp = (const bf16*)(F.ws + WS_QM); ldq = 1024; Op = (bf16*)(F.ws + WS_Y); ldo = D; }
    const int row0 = b * SEQ + qblk * 256;
    const unsigned fr = lane & 15, g = lane >> 4;
    int nsteps = 2;
    if (MODE == 1) {
        const float* kms = (const float*)(F.ws + WS_KMS);
        LAS float* km = (LAS float*)ring; LAS float* gl = (LAS float*)(ring + 8192);
        __syncthreads();
        for (int i = tid; i < qblk * 128; i += NWAVES * 64) { const int j = i >> 7, d = i & 127; const float* p0 = kms + (size_t)((b * NBLK + j) * 2) * 1024 + h * HD + d; km[i] = p0[0] + p0[1024]; }
        LDS_WAIT(); __syncthreads();
        {
            const int q = tid >> 1, par = tid & 1; float ga[8];
#pragma unroll
            for (int jj = 0; jj < 8; ++jj) ga[jj] = 0.f;
            const GAS v4u* qr = (const GAS v4u*)(Qp + (size_t)(row0 + q) * ldq + h * HD);
            for (int c = 0; c < 16; ++c) {
                const v4u w = qr[c]; const float q0 = bflo(w.x), q1 = bfhi(w.x), q2 = bflo(w.y), q3 = bfhi(w.y), q4 = bflo(w.z), q5 = bfhi(w.z), q6 = bflo(w.w), q7 = bfhi(w.w);
#pragma unroll
                for (int jj = 0; jj < 8; ++jj) { const int j = 2 * jj + par; if (j < qblk) { const f32x4 k0 = *(const LAS f32x4*)(km + j * 128 + 8 * c), k1 = *(const LAS f32x4*)(km + j * 128 + 8 * c + 4);
                    ga[jj] += (q0 * k0[0] + q1 * k0[1]) + (q2 * k0[2] + q3 * k0[3]) + (q4 * k1[0] + q5 * k1[1]) + (q6 * k1[2] + q7 * k1[3]); } }
            }
#pragma unroll
            for (int jj = 0; jj < 8; ++jj) gl[q * 16 + 2 * jj + par] = ga[jj];
        }
        LDS_WAIT(); __syncthreads();
        if (tid < 256) {
            float v1 = -INFINITY, v2 = -INFINITY, v3 = -INFINITY; int i1 = -1, i2 = -1, i3 = -1;
            for (int j = 0; j < qblk; ++j) { const float gj = gl[tid * 16 + j];
                if (gj > v1) { v3 = v2; i3 = i2; v2 = v1; i2 = i1; v1 = gj; i1 = j; } else if (gj > v2) { v3 = v2; i3 = i2; v2 = gj; i2 = j; } else if (gj > v3) { v3 = gj; i3 = j; } }
            unsigned mbits = 1u << qblk; if (i1 >= 0) mbits |= 1u << i1; if (i2 >= 0) mbits |= 1u << i2; if (i3 >= 0) mbits |= 1u << i3;
            sel[tid] = mbits;
        }
        LDS_WAIT(); __syncthreads();
        nsteps = 2 * (qblk + 1);
    } else { __syncthreads(); }
    bf16x8 qf[2][4]; int qidx[2]; unsigned selq[2];
#pragma unroll
    for (int qt = 0; qt < 2; ++qt) {
        qidx[qt] = 32 * wave + 16 * qt + (int)fr; selq[qt] = MODE == 1 ? sel[qidx[qt]] : 0u;
        const bf16* qrow = Qp + (size_t)(row0 + qidx[qt]) * ldq + h * HD;
#pragma unroll
        for (int ks = 0; ks < 4; ++ks) qf[qt][ks] = *(const GAS bf16x8*)(qrow + 32 * ks + 8 * g);
    }
    att::State st;
#pragma unroll
    for (int qt = 0; qt < 2; ++qt) { st.m[qt] = -INFINITY; st.l[qt] = 0.f;
#pragma unroll
        for (int dt = 0; dt < 8; ++dt) st.o[qt][dt] = (f32x4){0.f, 0.f, 0.f, 0.f}; }
    const size_t pitch = MODE == 0 ? (size_t)4096 * 2 : (size_t)1024 * 2;
#define KBASE_OF(i) (MODE == 0 ? (const char*)((const bf16*)(F.ws + WS_KV) + (size_t)(b * MEMT + (i) * 128) * 4096 + l * 1024 + h * HD) \
                               : (const char*)((const bf16*)(F.ws + WS_KM) + (size_t)(b * SEQ + ((i) < 2 ? qblk : (((i) - 2) >> 1)) * 256 + ((i) & 1) * 128) * 1024 + h * HD))
#define VBASE_OF(i) (MODE == 0 ? (const char*)((const bf16*)(F.ws + WS_KV) + (size_t)(b * MEMT + (i) * 128) * 4096 + l * 1024 + 512 + h * HD) \
                               : (const char*)((const bf16*)(F.ws + WS_VM) + (size_t)(b * SEQ + ((i) < 2 ? qblk : (((i) - 2) >> 1)) * 256 + ((i) & 1) * 128) * 1024 + h * HD))
    att::stage_half(KBASE_OF(0), pitch, ring, wave, lane); att::stage_half(VBASE_OF(0), pitch, ring + 32768, wave, lane);
    VM_WAIT(); __syncthreads();
    for (int i = 0; i < nsteps; ++i) {
        LAS char* cur = ring + (i & 1) * 65536; LAS char* nxt = ring + ((i + 1) & 1) * 65536;
        const int ln = opaque_i(lane);
        if (i + 1 < nsteps) { att::stage_half(KBASE_OF(i + 1), pitch, nxt, wave, ln); att::stage_half(VBASE_OF(i + 1), pitch, nxt + 32768, wave, ln); }
        bool valid[2] = {true, true}; int maskmode = 0; bool run = true;
        if (MODE == 1) {
            if (i < 2) { maskmode = 1; if (i == 1 && wave < 4) run = false; }
            else { const int blk = (i - 2) >> 1; valid[0] = (selq[0] >> blk) & 1u; valid[1] = (selq[1] >> blk) & 1u; run = __any((int)(valid[0] || valid[1])) != 0; }
        }
        if (run) att::half_step(st, qf, cur, cur + 32768, opaque_i(ln), maskmode, (i & 1) * 128, qidx, valid);
        VM_WAIT(); __syncthreads();
    }
#pragma unroll
    for (int qt = 0; qt < 2; ++qt) {
        float lt = st.l[qt]; lt += __shfl_xor(lt, 16); lt += __shfl_xor(lt, 32);
        const float inv = 1.0f / lt;
        bf16* orow = Op + (size_t)(row0 + qidx[qt]) * ldo + h * HD + 4 * g;
#pragma unroll
        for (int dt = 0; dt < 8; ++dt) { pg8::u32x2 w; w.x = pg8::cvt_pk_bf16(st.o[qt][dt][0] * inv, st.o[qt][dt][1] * inv); w.y = pg8::cvt_pk_bf16(st.o[qt][dt][2] * inv, st.o[qt][dt][3] * inv); *(GAS pg8::u32x2*)(orow + 16 * dt) = w; }
    }
}
#undef KBASE_OF
#undef VBASE_OF
__device__ __forceinline__ void moba_phase(Frame& F, int blk0) {
    if (F.bx < blk0) return;
    PHASE_IDS();
    const int nb = F.G - blk0;
    for (int pr = F.bx - blk0; pr < BATCH * NH_AB * 8; pr += nb) {
        const int bh = pr >> 3, k = pr & 7, b = bh >> 3, h = bh & 7;
        for (int rep = 0; rep < 2; ++rep) attn_unit<1>(F, tid, wave, b, h, rep ? k : 15 - k, 0);
    }
}
__device__ __forceinline__ void xattn_phase(Frame& F, int l) {
    PHASE_IDS();
    for (int un = F.bx; un < BATCH * 4 * (SEQ / 256); un += F.G) {
        const int qblk = un & 15, bh = un >> 4, b = bh >> 2, h = bh & 3;
        attn_unit<0>(F, tid, wave, b, h, qblk, l);
    }
}

constexpr size_t WS_UT = WS_MIX + 114 * MiB, WS_WT = WS_MIX + 146 * MiB, WS_QDT = WS_MIX + 162 * MiB, WS_KD = WS_MIX + 178 * MiB, WS_AQK = WS_MIX + 194 * MiB, WS_GL = WS_MIX + 202 * MiB;
namespace dn {
typedef short s16x4 __attribute__((ext_vector_type(4)));
__device__ __forceinline__ unsigned swz8(unsigned row) { return (row >> 1) & 7u; }
__device__ __forceinline__ s16x4 pack4(const f32x4& v) { pg8::u32x2 w; w.x = pg8::cvt_pk_bf16(v[0], v[1]); w.y = pg8::cvt_pk_bf16(v[2], v[3]); return __builtin_bit_cast(s16x4, w); }
__device__ __forceinline__ f32x4 unpack4(const s16x4& v) { const pg8::u32x2 w = __builtin_bit_cast(pg8::u32x2, v); return (f32x4){bflo(w.x), bfhi(w.x), bflo(w.y), bfhi(w.y)}; }
__device__ __forceinline__ bf16x8 join8(const s16x4& a, const s16x4& b) { bf16x8 r; r[0] = a[0]; r[1] = a[1]; r[2] = a[2]; r[3] = a[3]; r[4] = b[0]; r[5] = b[1]; r[6] = b[2]; r[7] = b[3]; return r; }
constexpr int MPITCH = 68, DPITCH = 20;
}

__device__ __forceinline__ void dn_chunk_phase(Frame& F, int e) {
    PHASE_IDS();
    LAS char* ring = (LAS char*)(F.lds + RING_OFF);
    LAS char* QI = ring; LAS char* KI = ring + 16384; LAS char* VI = ring + 32768;
    LAS float* MI = (LAS float*)(ring + 49152);
    LAS float* DI = (LAS float*)(ring + 49152 + 64 * dn::MPITCH * 4);
    LAS float* TG = DI + 4 * 16 * dn::DPITCH; LAS float* TB = TG + 64; LAS float* SSQ = (LAS float*)(F.lds + RTAB_OFF);
    LAS char* SLAB = ring + 78848;
#define DN_SLAB(ci_) do { const int n_ = (ci_) & 63, bh_ = (ci_) >> 6, h_ = bh_ & 7, b_ = bh_ >> 3; const long rb_ = (long)b_ * SEQ + n_ * 64; const int ln_ = opaque_i(lane);        \
        _Pragma("unroll") for (int k_ = 0; k_ < 7; ++k_) { const int q_ = wave + 8 * k_; if (q_ < 51) { const int P_ = q_ * 64 + ln_; int rp_ = P_ >> 4; rp_ = rp_ > 200 ? 200 : rp_; const int tok_ = rp_ / 3, sec_ = rp_ - 3 * tok_; \
            const long row_ = (n_ == 0 && tok_ < 3) ? rb_ : rb_ + tok_ - 3; \
            att::glds16(pre + (size_t)row_ * 3072 + sec_ * 1024 + h_ * HD + 8 * (P_ & 15), (unsigned)__builtin_amdgcn_readfirstlane((unsigned)(size_t)(SLAB + q_ * 1024))); } } } while (0)
    const bf16* pre = (const bf16*)(F.ws + WS_DNPRE); const float* ba = (const float*)(F.ws + WS_BA); const float* cw = FIN(I_AB_CONVW) + (size_t)e * 4 * 3072;
    const unsigned fr = lane & 15, g = lane >> 4, q4 = fr >> 2, p = lane & 3;
    if (F.bx < BATCH * NH_AB * (SEQ / 64)) DN_SLAB(F.bx);
    for (int ci = F.bx; ci < BATCH * NH_AB * (SEQ / 64); ci += F.G) {
        const int n = ci & 63, bh = ci >> 6, h = bh & 7, b = bh >> 3; const size_t rbase = (size_t)b * SEQ + n * 64;
        float* uT = (float*)(F.ws + WS_UT) + (size_t)ci * 8192; bf16* wT = (bf16*)(F.ws + WS_WT) + (size_t)ci * 8192; bf16* qdT = (bf16*)(F.ws + WS_QDT) + (size_t)ci * 8192;
        bf16* kd = (bf16*)(F.ws + WS_KD) + (size_t)ci * 8192; bf16* aqk = (bf16*)(F.ws + WS_AQK) + (size_t)ci * 4096;
        VM_WAIT(); __syncthreads();
        float braw_ = 0.f, araw_ = 0.f, alog_ = 0.f;
        if (tid < 64) { braw_ = ba[(rbase + tid) * 16 + h]; araw_ = ba[(rbase + tid) * 16 + 8 + h] + FIN(I_AB_DTB)[e * 8 + h]; alog_ = FIN(I_AB_ALOG)[e * 8 + h]; }
        float val[6][8];
        v4u wpre[6][4];
#pragma unroll
        for (int it = 0; it < 6; ++it) {
            const int sec = it >> 1, c = (tid >> 4) + 32 * (it & 1), gq = tid & 15, ch = sec * 1024 + h * HD + 8 * gq, t = n * 64 + c;
#pragma unroll
            for (int i = 0; i < 4; ++i) wpre[it][i] = *(const LAS v4u*)(SLAB + (((c + i) * 3 + sec) * 16 + gq) * 16);
        }
#pragma unroll
        for (int it = 0; it < 6; ++it) {
            const int sec = it >> 1, c = (tid >> 4) + 32 * (it & 1), gq = tid & 15, ch = sec * 1024 + h * HD + 8 * gq, t = n * 64 + c;
#pragma unroll
            for (int j = 0; j < 8; ++j) val[it][j] = 0.f;
#pragma unroll
            for (int i = 0; i < 4; ++i) {
                const f32x4 c0 = *(const GAS f32x4*)(cw + i * 3072 + ch), c1 = *(const GAS f32x4*)(cw + i * 3072 + ch + 4);
                if (t - 3 + i >= 0) {
                    const v4u w = wpre[it][i];
                    val[it][0] += c0[0] * bflo(w.x); val[it][1] += c0[1] * bfhi(w.x); val[it][2] += c0[2] * bflo(w.y); val[it][3] += c0[3] * bfhi(w.y);
                    val[it][4] += c1[0] * bflo(w.z); val[it][5] += c1[1] * bfhi(w.z); val[it][6] += c1[2] * bflo(w.w); val[it][7] += c1[3] * bfhi(w.w);
                }
            }
            float ss = 0.f;
#pragma unroll
            for (int j = 0; j < 8; ++j) { val[it][j] = pg8::silu_f(val[it][j]); ss += val[it][j] * val[it][j]; }
            if (sec < 2) SSQ[(c * 2 + sec) * 16 + gq] = ss;
        }
        if (tid < 64) {
            const float braw = braw_, araw = araw_;
            const float ea = __expf(araw); const float sp = araw > 20.f ? araw : (ea < 1e-3f ? ea * (1.0f - 0.5f * ea) : __logf(1.0f + ea));
            float gg = -__expf(alog_) * sp;
#pragma unroll
            for (int o = 1; o < 64; o <<= 1) { const float t2 = __shfl_up(gg, o); if (lane >= o) gg += t2; }
            TG[tid] = gg; TB[tid] = sigmoid_f(braw);
        }
        LDS_WAIT(); __syncthreads();
        if (ci + F.G < BATCH * NH_AB * (SEQ / 64)) DN_SLAB(ci + F.G);
#pragma unroll
        for (int it = 0; it < 6; ++it) {
            const int sec = it >> 1, c = (tid >> 4) + 32 * (it & 1), gq = tid & 15; float sc = 1.0f;
            if (sec < 2) { float s = 0.f;
#pragma unroll
                for (int j = 0; j < 4; ++j) { const f32x4 q = *(const LAS f32x4*)(SSQ + (c * 2 + sec) * 16 + 4 * j); s += (q[0] + q[1]) + (q[2] + q[3]); }
                sc = (1.0f / sqrtf(s + EPS)) * (sec == 0 ? 0.08838834764831845f : 1.0f); }
            LAS char* img = sec == 0 ? QI : (sec == 1 ? KI : VI);
            v4u w; w.x = pg8::cvt_pk_bf16(val[it][0] * sc, val[it][1] * sc); w.y = pg8::cvt_pk_bf16(val[it][2] * sc, val[it][3] * sc); w.z = pg8::cvt_pk_bf16(val[it][4] * sc, val[it][5] * sc); w.w = pg8::cvt_pk_bf16(val[it][6] * sc, val[it][7] * sc);
            *(LAS v4u*)(img + 256 * c + 16 * ((unsigned)gq ^ att::swz((unsigned)c))) = w;
        }
        if (tid < 384) { const int pr = tid >> 6, ctz = pr < 3 ? 0 : (pr < 5 ? 1 : 2), stz = pr < 3 ? pr + 1 : (pr < 5 ? pr - 1 : 3), cz = 16 * ctz + ((tid & 63) >> 2), gz = tid & 3;
            *(GAS pg8::u32x2*)(aqk + cz * 64 + 32 * (stz >> 1) + 8 * gz + 4 * (stz & 1)) = (pg8::u32x2){0u, 0u}; }
        LDS_WAIT(); __syncthreads();
        for (int jb = wave; jb < 20; jb += NWAVES) {
            const int ty = jb >= 10 ? 1 : 0, ti = jb - 10 * ty; int ct = 0, st = ti;
            if (ti >= 6) { ct = 3; st = ti - 6; } else if (ti >= 3) { ct = 2; st = ti - 3; } else if (ti >= 1) { ct = 1; st = ti - 1; }
            f32x4 acc = {0.f, 0.f, 0.f, 0.f};
            if (ty == 0) {
#pragma unroll
                for (int ks = 0; ks < 4; ++ks) { const bf16x8 a = *(const LAS bf16x8*)(KI + 256u * (16u * ct + fr) + 16u * ((4u * ks + g) ^ att::swz(fr))), bb = *(const LAS bf16x8*)(KI + 256u * (16u * st + fr) + 16u * ((4u * ks + g) ^ att::swz(fr)));
                    acc = __builtin_amdgcn_mfma_f32_16x16x32_bf16(a, bb, acc, 0, 0, 0); }
                const int s = 16 * st + (int)fr; const float gs = TG[s];
#pragma unroll
                for (int r = 0; r < 4; ++r) { const int c = 16 * ct + 4 * (int)g + r; MI[c * dn::MPITCH + s] = s < c ? acc[r] * TB[c] * __expf(TG[c] - gs) : 0.f; }
            } else {
#pragma unroll
                for (int ks = 0; ks < 4; ++ks) { const bf16x8 a = *(const LAS bf16x8*)(KI + 256u * (16u * st + fr) + 16u * ((4u * ks + g) ^ att::swz(fr))), bb = *(const LAS bf16x8*)(QI + 256u * (16u * ct + fr) + 16u * ((4u * ks + g) ^ att::swz(fr)));
                    acc = __builtin_amdgcn_mfma_f32_16x16x32_bf16(a, bb, acc, 0, 0, 0); }
                const int c = 16 * ct + (int)fr; const float gc = TG[c]; f32x4 o;
#pragma unroll
                for (int r = 0; r < 4; ++r) { const int s = 16 * st + 4 * (int)g + r; o[r] = s <= c ? acc[r] * __expf(gc - TG[s]) : 0.f; }
                *(GAS dn::s16x4*)(aqk + c * 64 + 32 * (st >> 1) + 8 * g + 4 * (st & 1)) = dn::pack4(o);
            }
        }
        LDS_WAIT(); __syncthreads();
        if (wave == 0) {
            const int i = g, j = fr; float dc[16]; f32x4 mr[16][4];
#pragma unroll
            for (int r = 1; r < 16; ++r)
#pragma unroll
                for (int q = 0; q < 4; ++q) if (4 * q < r) mr[r][q] = *(const LAS f32x4*)(MI + (16 * i + r) * dn::MPITCH + 16 * i + 4 * q);
#pragma unroll
            for (int r = 0; r < 16; ++r) { float a = (r == j) ? 1.f : 0.f;
#pragma unroll
                for (int s = 0; s < r; ++s) a -= mr[r][s >> 2][s & 3] * dc[s];
                dc[r] = a; }
#pragma unroll
            for (int r = 0; r < 16; ++r) DI[(i * 16 + r) * dn::DPITCH + j] = dc[r];
        }
        LDS_WAIT(); __syncthreads();
#pragma unroll
        for (int job = 0; job < 2; ++job) {
            const LAS char* img = job ? KI : VI; dn::s16x4 xb[4];
#pragma unroll
            for (int i = 0; i < 4; ++i) {
                const unsigned row = 16u * i + 4u * g + q4;
                const dn::s16x4 raw = att::vtr(img + 256u * row + 16u * ((2u * wave + (p >> 1)) ^ att::swz(row)) + 8u * (p & 1u));
                f32x4 acc = dn::unpack4(raw);
#pragma unroll
                for (int r = 0; r < 4; ++r) { const int c = 16 * i + 4 * (int)g + r; acc[r] *= job ? TB[c] * __expf(TG[c]) : TB[c]; }
#pragma unroll
                for (int j = 0; j < 4; ++j) { if (j < i) { const f32x4 mm = *(const LAS f32x4*)(MI + (16 * i + (int)fr) * dn::MPITCH + 16 * j + 4 * (int)g);
                    acc = __builtin_amdgcn_mfma_f32_16x16x16bf16_1k(dn::pack4(-mm), xb[j], acc, 0, 0, 0); } }
                const f32x4 dd = *(const LAS f32x4*)(DI + (16 * i + (int)fr) * dn::DPITCH + 4 * (int)g);
                const f32x4 x = __builtin_amdgcn_mfma_f32_16x16x16bf16_1k(dn::pack4(dd), dn::pack4(acc), (f32x4){0.f, 0.f, 0.f, 0.f}, 0, 0, 0);
                xb[i] = dn::pack4(x);
                if (job == 0) *(GAS f32x4*)(uT + (16 * wave + (int)fr) * 64 + 16 * i + 4 * (int)g) = x;
                else *(GAS dn::s16x4*)(wT + (16 * wave + (int)fr) * 64 + 16 * i + 4 * (int)g) = dn::pack4(-x);
            }
        }
#pragma unroll
        for (int i = 0; i < 4; ++i) {
            const unsigned row = 16u * i + 4u * g + q4;
            f32x4 qv = dn::unpack4(att::vtr(QI + 256u * row + 16u * ((2u * wave + (p >> 1)) ^ att::swz(row)) + 8u * (p & 1u)));
#pragma unroll
            for (int r = 0; r < 4; ++r) qv[r] *= __expf(TG[16 * i + 4 * (int)g + r]);
            *(GAS dn::s16x4*)(qdT + (16 * wave + (int)fr) * 64 + 16 * i + 4 * (int)g) = dn::pack4(qv);
        }
        {
            const float glast = TG[63];
#pragma unroll
            for (int it = 0; it < 2; ++it) { const int item = tid + 512 * it, s = item >> 4, ch = item & 15; const float sc = __expf(glast - TG[s]);
                const v4u w = *(const LAS v4u*)(KI + 256 * s + 16 * ((unsigned)ch ^ att::swz((unsigned)s)));
                v4u o; o.x = pg8::cvt_pk_bf16(bflo(w.x) * sc, bfhi(w.x) * sc); o.y = pg8::cvt_pk_bf16(bflo(w.y) * sc, bfhi(w.y) * sc); o.z = pg8::cvt_pk_bf16(bflo(w.z) * sc, bfhi(w.z) * sc); o.w = pg8::cvt_pk_bf16(bflo(w.w) * sc, bfhi(w.w) * sc);
                *(GAS v4u*)(kd + s * 128 + 8 * ch) = o; }
            if (tid == 0) ((float*)(F.ws + WS_GL))[ci] = __expf(glast);
        }
    }
#undef DN_SLAB
    __syncthreads();
}

#ifndef DN_TAIL_NORMGATE
#define DN_TAIL_NORMGATE 1
#endif
constexpr int CW_CHAIN = 8192;
__device__ __forceinline__ void chain_sync(Frame& F, gu32* word, unsigned want) {
    asm volatile("s_waitcnt vmcnt(0)" ::: "memory");
    __syncthreads();
    if (threadIdx.x == 0) {
        __builtin_amdgcn_fence(__ATOMIC_RELEASE, "agent"); asm volatile("s_waitcnt vmcnt(0)" ::: "memory");
        __hip_atomic_fetch_add(word, 1u, RLX_AGENT);
        unsigned sp = 0u;
        while (__hip_atomic_load(word, RLX_AGENT) < want) { __builtin_amdgcn_s_sleep(1); if (++sp > (1u << 22)) break; }
        __builtin_amdgcn_fence(__ATOMIC_ACQUIRE, "agent"); asm volatile("s_waitcnt vmcnt(0)" ::: "memory");
    }
    __syncthreads();
}
constexpr int NG_ = 8;
__device__ __forceinline__ void normgate_rows(Frame& F, const float* o, const bf16* gate, int nheads, const float* gw_, int ycol, int r0, int nr, int h) {
    PHASE_IDS();
    bf16* Y = (bf16*)(F.ws + WS_Y);
    const int hw = lane >> 5, l32 = lane & 31, ld = nheads * HD, hid = wave * 2 + hw;
    const f32x4 g4 = *(const GAS f32x4*)(gw_ + 4 * l32);
    for (int u0 = hid; u0 < nr; u0 += NG_ * 2 * NWAVES) {
        f32x4 v[NG_]; pg8::u32x2 gt[NG_];
#pragma unroll
        for (int j = 0; j < NG_; ++j) { const int un = u0 + j * 2 * NWAVES; if (un < nr) { const size_t row = (size_t)(r0 + un);
            v[j] = *(const GAS f32x4*)(o + row * ld + h * HD + 4 * l32); gt[j] = *(const GAS pg8::u32x2*)(gate + row * ld + h * HD + 4 * l32); } else { v[j] = (f32x4){0.f, 0.f, 0.f, 0.f}; gt[j] = (pg8::u32x2){0u, 0u}; } }
#pragma unroll
        for (int j = 0; j < NG_; ++j) { const int un = u0 + j * 2 * NWAVES;
            float ss = (v[j][0] * v[j][0] + v[j][1] * v[j][1]) + (v[j][2] * v[j][2] + v[j][3] * v[j][3]);
#pragma unroll
            for (int of = 1; of < 32; of <<= 1) ss += __shfl_xor(ss, of);
            const float rs = 1.0f / sqrtf(ss * (1.0f / HD) + EPS);
            if (un < nr) { const size_t row = (size_t)(r0 + un); pg8::u32x2 w;
                w.x = pg8::cvt_pk_bf16(v[j][0] * rs * g4[0] * silu_acc(bflo(gt[j].x)), v[j][1] * rs * g4[1] * silu_acc(bfhi(gt[j].x))); w.y = pg8::cvt_pk_bf16(v[j][2] * rs * g4[2] * silu_acc(bflo(gt[j].y)), v[j][3] * rs * g4[3] * silu_acc(bfhi(gt[j].y)));
                *(GAS pg8::u32x2*)(Y + row * D + ycol + h * HD + 4 * l32) = w; }
        }
    }
}
constexpr int CW_NGQ = 8192 + 128 * 16;
__device__ __forceinline__ void ng_help(Frame& F, int e) {
    PHASE_IDS();
    constexpr int SPL = 4, NCH = BATCH * NH_AB, TPC = 16, ROWS = SEQ / TPC;
    gu32* q = F.ctl + CW_NGQ + e * 16;
    for (;;) {
        unsigned tk = 0u; if (tid == 0) tk = __hip_atomic_fetch_add(q, 1u, RLX_AGENT);
        const unsigned t = cq_bcast(F, tk, tid);
        if (t >= (unsigned)(NCH * TPC)) break;
        const int bh = (int)t / TPC, k = (int)t % TPC, h = bh & 7, b = bh >> 3;
        if (tid == 0) { gu32* w = F.ctl + CW_CHAIN + (e * NCH + bh) * 16; unsigned sp = 0u;
            while (__hip_atomic_load(w, RLX_AGENT) < (unsigned)SPL) { __builtin_amdgcn_s_sleep(1); if (++sp > (1u << 22)) break; }
            __builtin_amdgcn_fence(__ATOMIC_ACQUIRE, "agent"); asm volatile("s_waitcnt vmcnt(0)" ::: "memory"); }
        __syncthreads();
        normgate_rows(F, (const float*)(F.ws + WS_DNO), (const bf16*)(F.ws + WS_DNGATE), NH_AB, FIN(I_AB_ONG) + e * HD, 1024, b * SEQ + k * ROWS, ROWS, h);
    }
}
template <int PM>
__device__ __forceinline__ void dn_scan_phase(Frame& F, int e) {
    constexpr int SPL = 4, NCH = BATCH * NH_AB;
    if (F.bx >= SPL * NCH) return;
    PHASE_IDS();
    const int bh = F.bx % NCH, part = F.bx / NCH, h = bh & 7, b = bh >> 3;
    const int dvt = (8 / SPL) * part + (wave & (8 / SPL - 1)); const bool active = wave < 8 / SPL;
    const int rot = part * (56 / SPL);
    LAS char* ring = (LAS char*)(F.lds + RING_OFF);
    constexpr int STG = 57344;
    const char* gWT = (const char*)(F.ws + WS_WT) + (size_t)bh * 64 * 16384; const char* gQD = (const char*)(F.ws + WS_QDT) + (size_t)bh * 64 * 16384;
    const char* gKD = (const char*)(F.ws + WS_KD) + (size_t)bh * 64 * 16384; const char* gAQ = (const char*)(F.ws + WS_AQK) + (size_t)bh * 64 * 8192;
    const float* gUT = (const float*)(F.ws + WS_UT) + (size_t)bh * 64 * 8192; const float* gGL = (const float*)(F.ws + WS_GL) + bh * 64;
    float* dno = (float*)(F.ws + (PM == 0 ? WS_DNO : WS_ACT));
#define DN_STAGE(n_, stg_) do { _Pragma("unroll") for (int pi_ = 0; pi_ < 7; ++pi_) { int pc_ = 7 * wave + pi_ + rot; pc_ -= pc_ >= 56 ? 56 : 0; const char* src_; \
        if (pc_ < 32 || pc_ >= 48) { const int q_ = pc_ < 16 ? pc_ : (pc_ < 32 ? pc_ - 16 : pc_ - 48); const unsigned row_ = 8u * q_ + ((unsigned)ln >> 3), ch_ = ((unsigned)ln & 7u) ^ dn::swz8(row_); \
            src_ = (pc_ < 16 ? gWT + (size_t)(n_) * 16384 : (pc_ < 32 ? gQD + (size_t)(n_) * 16384 : gAQ + (size_t)(n_) * 8192)) + row_ * 128u + ch_ * 16u; } \
        else { const int q_ = pc_ - 32; const unsigned row_ = 4u * q_ + ((unsigned)ln >> 4), ch_ = ((unsigned)ln & 15u) ^ att::swz(row_); src_ = gKD + (size_t)(n_) * 16384 + row_ * 256u + ch_ * 16u; } \
        att::glds16(src_, (unsigned)__builtin_amdgcn_readfirstlane((unsigned)(size_t)((stg_) + pc_ * 1024))); } } while (0)
    f32x4 S[8]; bf16x8 Sb[4];
#pragma unroll
    for (int dt = 0; dt < 8; ++dt) S[dt] = (f32x4){0.f, 0.f, 0.f, 0.f};
#pragma unroll
    for (int ks = 0; ks < 4; ++ks) Sb[ks] = (bf16x8){0, 0, 0, 0, 0, 0, 0, 0};
    { const int ln = lane; DN_STAGE(0, ring); }
    f32x4 un[4]; const int glbits = __float_as_int(gGL[lane]);
#pragma unroll
    for (int mt = 0; mt < 4; ++mt) un[mt] = *(const GAS f32x4*)(gUT + (16 * dvt + (lane & 15)) * 64 + 16 * mt + 4 * (lane >> 4));
    VM_WAIT(); __syncthreads();
    for (int n = 0; n < SEQ / 64; ++n) {
        LAS char* cur = ring + (n & 1) * STG; LAS char* nxt = ring + ((n + 1) & 1) * STG;
        const int ln = opaque_i(lane);
        asm volatile("" : "+v"(un[0]), "+v"(un[1]), "+v"(un[2]), "+v"(un[3]));
        f32x4 vn[4];
#pragma unroll
        for (int mt = 0; mt < 4; ++mt) vn[mt] = un[mt];
        if (PM != 1 && n + 1 < SEQ / 64) DN_STAGE(n + 1, nxt);
        const unsigned fr = ln & 15, g = (unsigned)ln >> 4, q4 = fr >> 2, p = ln & 3;
        const LAS char* WI = cur; const LAS char* QDI = cur + 16384; const LAS char* KDI = cur + 32768; const LAS char* AQI = cur + 49152;
        if (active && PM != 2) {
        const float gl = __int_as_float(__builtin_amdgcn_readlane(glbits, n));
        f32x4 oo[4];
#pragma unroll
        for (int mt = 0; mt < 4; ++mt) oo[mt] = (f32x4){0.f, 0.f, 0.f, 0.f};
        if (n + 1 < SEQ / 64) {
#pragma unroll
            for (int mt = 0; mt < 4; ++mt) un[mt] = *(const GAS f32x4*)(gUT + (size_t)(n + 1) * 8192 + (16 * dvt + (int)fr) * 64 + 16 * mt + 4 * (int)g);
        }
#define SB() __builtin_amdgcn_sched_barrier(0)
        const unsigned sw8 = (2u * g + (q4 >> 1)) & 7u, fv = (q4 << 2) | g;
#define DN_LD_WQ(mt_, W_, Q_) do { _Pragma("unroll") for (int ks_ = 0; ks_ < 4; ++ks_) { const unsigned r0_ = 32u * ks_ + 4u * g + q4, cb_ = 16u * ((2u * (mt_) + (p >> 1)) ^ sw8) + 8u * (p & 1u); \
            W_[ks_] = dn::join8(att::vtr(WI + 128u * r0_ + cb_), att::vtr(WI + 128u * (r0_ + 16u) + cb_)); Q_[ks_] = dn::join8(att::vtr(QDI + 128u * r0_ + cb_), att::vtr(QDI + 128u * (r0_ + 16u) + cb_)); } } while (0)
#define DN_MM_WQ(mt_, W_, Q_) do { _Pragma("unroll") for (int ks_ = 0; ks_ < 4; ++ks_) { vn[mt_] = __builtin_amdgcn_mfma_f32_16x16x32_bf16(W_[ks_], Sb[ks_], vn[mt_], 0, 0, 0); oo[mt_] = __builtin_amdgcn_mfma_f32_16x16x32_bf16(Q_[ks_], Sb[ks_], oo[mt_], 0, 0, 0); } } while (0)
#define DN_LD_KD(d0_, K_) do { _Pragma("unroll") for (int dd_ = 0; dd_ < 4; ++dd_) _Pragma("unroll") for (int k2_ = 0; k2_ < 2; ++k2_) { const unsigned r0_ = 32u * k2_ + 4u * g + q4, cb_ = 16u * ((2u * ((d0_) + dd_) + (p >> 1)) ^ fv) + 8u * (p & 1u); \
            K_[dd_][k2_] = dn::join8(att::vtr(KDI + 256u * r0_ + cb_), att::vtr(KDI + 256u * (r0_ + 16u) + cb_)); } } while (0)
        bf16x8 wA[4], qA[4], wB[4], qB[4], af[4][2], kA[4][2], kB[4][2];
        DN_LD_WQ(0, wA, qA); SB();
        DN_LD_WQ(1, wB, qB); SB(); DN_MM_WQ(0, wA, qA); SB();
        DN_LD_WQ(2, wA, qA); SB(); DN_MM_WQ(1, wB, qB); SB();
        DN_LD_WQ(3, wB, qB); SB(); DN_MM_WQ(2, wA, qA); SB();
#pragma unroll
        for (int mt = 0; mt < 4; ++mt)
#pragma unroll
            for (int k2 = 0; k2 < 2; ++k2) { const unsigned row = 16u * mt + fr; af[mt][k2] = *(const LAS bf16x8*)(AQI + 128u * row + 16u * ((4u * k2 + g) ^ dn::swz8(row))); }
        SB(); DN_MM_WQ(3, wB, qB); SB();
        DN_LD_KD(0, kA); SB();
        bf16x8 vb[2];
#pragma unroll
        for (int k2 = 0; k2 < 2; ++k2) vb[k2] = dn::join8(dn::pack4(vn[2 * k2]), dn::pack4(vn[2 * k2 + 1]));
#pragma unroll
        for (int mt = 0; mt < 4; ++mt)
#pragma unroll
            for (int k2 = 0; k2 < 2; ++k2) oo[mt] = __builtin_amdgcn_mfma_f32_16x16x32_bf16(af[mt][k2], vb[k2], oo[mt], 0, 0, 0);
        SB(); DN_LD_KD(4, kB); SB();
#pragma unroll
        for (int dt = 0; dt < 4; ++dt) { S[dt] = S[dt] * gl;
#pragma unroll
            for (int k2 = 0; k2 < 2; ++k2) S[dt] = __builtin_amdgcn_mfma_f32_16x16x32_bf16(kA[dt][k2], vb[k2], S[dt], 0, 0, 0); }
        SB();
#pragma unroll
        for (int dt = 4; dt < 8; ++dt) { S[dt] = S[dt] * gl;
#pragma unroll
            for (int k2 = 0; k2 < 2; ++k2) S[dt] = __builtin_amdgcn_mfma_f32_16x16x32_bf16(kB[dt - 4][k2], vb[k2], S[dt], 0, 0, 0); }
#pragma unroll
        for (int ks = 0; ks < 4; ++ks) Sb[ks] = dn::join8(dn::pack4(S[2 * ks]), dn::pack4(S[2 * ks + 1]));
#undef DN_LD_WQ
#undef DN_MM_WQ
#undef DN_LD_KD
#undef SB
        const size_t rbase = (size_t)b * SEQ + n * 64;
#pragma unroll
        for (int mt = 0; mt < 4; ++mt)
#pragma unroll
            for (int r = 0; r < 4; ++r) dno[(rbase + 16 * mt + 4 * g + r) * 1024 + h * HD + 16 * dvt + fr] = oo[mt][r];
        }
        VM_WAIT();
        __syncthreads();
    }
#undef DN_STAGE
    if constexpr (PM == 0 && DN_TAIL_NORMGATE == 2) {
        asm volatile("s_waitcnt vmcnt(0)" ::: "memory");
        __syncthreads();
        if (threadIdx.x == 0) { __builtin_amdgcn_fence(__ATOMIC_RELEASE, "agent"); asm volatile("s_waitcnt vmcnt(0)" ::: "memory"); __hip_atomic_fetch_add(F.ctl + CW_CHAIN + (e * NCH + bh) * 16, 1u, RLX_AGENT); }
    }
    if constexpr (PM == 0 && DN_TAIL_NORMGATE == 1) {
        chain_sync(F, F.ctl + CW_CHAIN + (e * NCH + bh) * 16, SPL);
        normgate_rows(F, (const float*)(F.ws + WS_DNO), (const bf16*)(F.ws + WS_DNGATE), NH_AB, FIN(I_AB_ONG) + e * HD, 1024, b * SEQ + part * (SEQ / SPL), SEQ / SPL, h);
    }
}

constexpr size_t WS_QEP = WS_END, WS_KE = WS_END + 32 * MiB, WS_AINT = WS_END + 64 * MiB, WS_GD = WS_END + 80 * MiB, WS_END2 = WS_END + 82 * MiB;
namespace gla { constexpr int BP = 132; }

__device__ __forceinline__ void gla_chunk_phase(Frame& F) {
    PHASE_IDS();
    LAS char* ring = (LAS char*)(F.lds + RING_OFF);
    LAS float* BI = (LAS float*)ring;
    LAS char* QS = ring + 34816;
    LAS char* KS = ring + 34816 + 16384;
    LAS float* PART = (LAS float*)(ring + 34816 + 16384 + 40960);
    const bf16* Cq = (const bf16*)(F.ws + WS_CQ); const bf16* Ck = (const bf16*)(F.ws + WS_CK); const float* Clf = (const float*)(F.ws + WS_CLF);
    const unsigned fr = lane & 15, g = lane >> 4;
    for (int ci = F.bx; ci < BATCH * NH_C * (SEQ / 64); ci += F.G) {
        const int n = ci & 63, bh = ci >> 6, h = bh & 15, b = bh >> 4; const size_t rbase = (size_t)b * SEQ + n * 64;
        bf16* qep = (bf16*)(F.ws + WS_QEP) + (size_t)ci * 8192; bf16* ke = (bf16*)(F.ws + WS_KE) + (size_t)ci * 8192; bf16* aint = (bf16*)(F.ws + WS_AINT) + (size_t)ci * 4096; float* gd = (float*)(F.ws + WS_GD) + (size_t)ci * 256;
        __syncthreads();
        float lfv[16];
        { const int d = tid & 127, qr = tid >> 7;
#pragma unroll
          for (int r = 0; r < 16; ++r) lfv[r] = Clf[(rbase + 16 * qr + r) * D + h * HD + d]; }
        v4u qwA[2], kwA[2], kwB[5]; pg8::u32x2 q0C[2], q1C[2];
#pragma unroll
        for (int it = 0; it < 2; ++it) { const int item = tid + 512 * it, c = item >> 4, gq = item & 15;
            qwA[it] = *(const GAS v4u*)(Cq + (rbase + c) * D + h * HD + 8 * gq); kwA[it] = *(const GAS v4u*)(Ck + (rbase + c) * D + h * HD + 8 * gq); }
#pragma unroll
        for (int it = 0; it < 5; ++it) { const int item = tid + 512 * it, ri = item >> 4, gq = item & 15; const int s = ri < 16 ? ri : (ri < 48 ? ri - 16 : (ri < 96 ? ri - 48 : ri - 96));
            kwB[it] = *(const GAS v4u*)(Ck + (rbase + s) * D + h * HD + 8 * gq); }
#pragma unroll
        for (int it = 0; it < 2; ++it) { const int item = tid + 512 * it, c = item >> 4, pc = item & 15, dk0 = 32 * (pc >> 2) + 4 * (pc & 3);
            q0C[it] = *(const GAS pg8::u32x2*)(Cq + (rbase + c) * D + h * HD + dk0); q1C[it] = *(const GAS pg8::u32x2*)(Cq + (rbase + c) * D + h * HD + dk0 + 16); }
        if (tid < 192) { const int pr = tid >> 5, ctz = pr < 3 ? 0 : (pr < 5 ? 1 : 2), stz = pr < 3 ? pr + 1 : (pr < 5 ? pr - 1 : 3), cz = 16 * ctz + ((tid & 31) >> 1);
            *(GAS v4u*)(aint + cz * 64 + 16 * stz + 8 * (tid & 1)) = (v4u){0u, 0u, 0u, 0u}; }
        {
            const int d = tid & 127, qr = tid >> 7; float loc[16]; float run = 0.f;
#pragma unroll
            for (int r = 0; r < 16; ++r) { run += lfv[r]; loc[r] = run; }
            PART[qr * 128 + d] = run;
            LDS_WAIT(); __syncthreads();
            float off = 0.f;
#pragma unroll
            for (int q2 = 0; q2 < 3; ++q2) if (q2 < qr) off += PART[q2 * 128 + d];
#pragma unroll
            for (int r = 0; r < 16; ++r) BI[(16 * qr + r) * gla::BP + d] = off + loc[r];
        }
        LDS_WAIT(); __syncthreads();
#pragma unroll
        for (int it = 0; it < 2; ++it) {
            const int item = tid + 512 * it, c = item >> 4, gq = item & 15;
            const v4u qw = qwA[it], kw = kwA[it];
            const LAS float* bc = BI + c * gla::BP + 8 * gq; const LAS float* br = BI + (c & ~15) * gla::BP + 8 * gq; const LAS float* bl = BI + 63 * gla::BP + 8 * gq;
            const f32x4 b0 = *(const LAS f32x4*)bc, b1 = *(const LAS f32x4*)(bc + 4), r0 = *(const LAS f32x4*)br, r1 = *(const LAS f32x4*)(br + 4), l0 = *(const LAS f32x4*)bl, l1 = *(const LAS f32x4*)(bl + 4);
            v4u o;
            o.x = pg8::cvt_pk_bf16(bflo(qw.x) * __expf(b0[0] - r0[0]), bfhi(qw.x) * __expf(b0[1] - r0[1])); o.y = pg8::cvt_pk_bf16(bflo(qw.y) * __expf(b0[2] - r0[2]), bfhi(qw.y) * __expf(b0[3] - r0[3]));
            o.z = pg8::cvt_pk_bf16(bflo(qw.z) * __expf(b1[0] - r1[0]), bfhi(qw.z) * __expf(b1[1] - r1[1])); o.w = pg8::cvt_pk_bf16(bflo(qw.w) * __expf(b1[2] - r1[2]), bfhi(qw.w) * __expf(b1[3] - r1[3]));
            *(LAS v4u*)(QS + 256 * c + 16 * ((unsigned)gq ^ att::swz((unsigned)c))) = o;
            o.x = pg8::cvt_pk_bf16(bflo(kw.x) * __expf(l0[0] - b0[0]), bfhi(kw.x) * __expf(l0[1] - b0[1])); o.y = pg8::cvt_pk_bf16(bflo(kw.y) * __expf(l0[2] - b0[2]), bfhi(kw.y) * __expf(l0[3] - b0[3]));
            o.z = pg8::cvt_pk_bf16(bflo(kw.z) * __expf(l1[0] - b1[0]), bfhi(kw.z) * __expf(l1[1] - b1[1])); o.w = pg8::cvt_pk_bf16(bflo(kw.w) * __expf(l1[2] - b1[2]), bfhi(kw.w) * __expf(l1[3] - b1[3]));
            *(GAS v4u*)(ke + c * 128 + 8 * gq) = o;
        }
#pragma unroll
        for (int it = 0; it < 5; ++it) {
            const int item = tid + 512 * it, ri = item >> 4, gq = item & 15;
            int i, s, base; if (ri < 16) { i = 0; s = ri; base = 0; } else if (ri < 48) { i = 1; s = ri - 16; base = 4096; } else if (ri < 96) { i = 2; s = ri - 48; base = 12288; } else { i = 3; s = ri - 96; base = 24576; }
            const v4u kw = kwB[it];
            const LAS float* bs = BI + s * gla::BP + 8 * gq; const LAS float* br = BI + 16 * i * gla::BP + 8 * gq;
            const f32x4 b0 = *(const LAS f32x4*)bs, b1 = *(const LAS f32x4*)(bs + 4), r0 = *(const LAS f32x4*)br, r1 = *(const LAS f32x4*)(br + 4);
            v4u o;
            o.x = pg8::cvt_pk_bf16(bflo(kw.x) * __expf(r0[0] - b0[0]), bfhi(kw.x) * __expf(r0[1] - b0[1])); o.y = pg8::cvt_pk_bf16(bflo(kw.y) * __expf(r0[2] - b0[2]), bfhi(kw.y) * __expf(r0[3] - b0[3]));
            o.z = pg8::cvt_pk_bf16(bflo(kw.z) * __expf(r1[0] - b1[0]), bfhi(kw.z) * __expf(r1[1] - b1[1])); o.w = pg8::cvt_pk_bf16(bflo(kw.w) * __expf(r1[2] - b1[2]), bfhi(kw.w) * __expf(r1[3] - b1[3]));
            *(LAS v4u*)(KS + base + 256 * s + 16 * ((unsigned)gq ^ att::swz((unsigned)s))) = o;
        }
#pragma unroll
        for (int it = 0; it < 2; ++it) {
            const int item = tid + 512 * it, c = item >> 4, pc = item & 15, ks = pc >> 2, gp = pc & 3, dk0 = 32 * ks + 4 * gp;
            const pg8::u32x2 q0 = q0C[it], q1 = q1C[it];
            const f32x4 b0 = *(const LAS f32x4*)(BI + c * gla::BP + dk0), b1 = *(const LAS f32x4*)(BI + c * gla::BP + dk0 + 16);
            v4u o;
            o.x = pg8::cvt_pk_bf16(bflo(q0.x) * __expf(b0[0]), bfhi(q0.x) * __expf(b0[1])); o.y = pg8::cvt_pk_bf16(bflo(q0.y) * __expf(b0[2]), bfhi(q0.y) * __expf(b0[3]));
            o.z = pg8::cvt_pk_bf16(bflo(q1.x) * __expf(b1[0]), bfhi(q1.x) * __expf(b1[1])); o.w = pg8::cvt_pk_bf16(bflo(q1.y) * __expf(b1[2]), bfhi(q1.y) * __expf(b1[3]));
            *(GAS v4u*)(qep + c * 128 + 8 * pc) = o;
        }
        if (tid < 256) gd[tid] = tid < 128 ? __expf(BI[63 * gla::BP + tid]) : 0.f;
        LDS_WAIT(); __syncthreads();
        for (int jb = wave; jb < 10; jb += NWAVES) {
            int ct = 0, st = jb; if (jb >= 6) { ct = 3; st = jb - 6; } else if (jb >= 3) { ct = 2; st = jb - 3; } else if (jb >= 1) { ct = 1; st = jb - 1; }
            const int base = ct == 0 ? 0 : (ct == 1 ? 4096 : (ct == 2 ? 12288 : 24576));
            f32x4 acc = {0.f, 0.f, 0.f, 0.f};
#pragma unroll
            for (int ks = 0; ks < 4; ++ks) { const bf16x8 a = *(const LAS bf16x8*)(KS + base + 256u * (16u * st + fr) + 16u * ((4u * ks + g) ^ att::swz(fr))), bb = *(const LAS bf16x8*)(QS + 256u * (16u * ct + fr) + 16u * ((4u * ks + g) ^ att::swz(fr)));
                acc = __builtin_amdgcn_mfma_f32_16x16x32_bf16(a, bb, acc, 0, 0, 0); }
            const int c = 16 * ct + (int)fr; f32x4 o;
#pragma unroll
            for (int r = 0; r < 4; ++r) { const int s = 16 * st + 4 * (int)g + r; o[r] = s <= c ? acc[r] : 0.f; }
            *(GAS dn::s16x4*)(aint + c * 64 + 16 * st + 4 * g) = dn::pack4(o);
        }
    }
    __syncthreads();
}

template <int PM>
__device__ __forceinline__ void gla_scan_phase(Frame& F) {
    constexpr int SPL = 4, NCH = BATCH * NH_C;
    if (F.bx >= SPL * NCH) return;
    PHASE_IDS();
    const int bh = F.bx % NCH, part = F.bx / NCH, h = bh & 15, b = bh >> 4;
    const int dvt = (8 / SPL) * part + (wave & (8 / SPL - 1)); const bool active = wave < 8 / SPL;
    const int rot = part * (56 / SPL);
    LAS char* ring = (LAS char*)(F.lds + RING_OFF);
    constexpr int STG = 58368;
    const char* gQE = (const char*)(F.ws + WS_QEP) + (size_t)bh * 64 * 16384; const char* gKE = (const char*)(F.ws + WS_KE) + (size_t)bh * 64 * 16384;
    const char* gA = (const char*)(F.ws + WS_AINT) + (size_t)bh * 64 * 8192; const char* gD = (const char*)(F.ws + WS_GD) + (size_t)bh * 64 * 1024;
    const char* gV = (const char*)((const bf16*)(F.ws + WS_CV) + (size_t)b * SEQ * D + h * HD);
    float* co = (float*)(F.ws + (PM == 0 ? WS_CO : WS_ACT));
#define GLA_PIECE(n_, stg_, pc_) do { const char* src_; \
        if ((pc_) < 48) { const int q_ = (pc_) & 15; const unsigned row_ = 4u * q_ + ((unsigned)ln >> 4), ch_ = ((unsigned)ln & 15u) ^ att::swz(row_); \
            src_ = (pc_) < 16 ? gQE + (size_t)(n_) * 16384 + row_ * 256u + ch_ * 16u : ((pc_) < 32 ? gKE + (size_t)(n_) * 16384 + row_ * 256u + ch_ * 16u : gV + ((size_t)(n_) * 64 + row_) * 4096 + ch_ * 16u); } \
        else if ((pc_) < 56) { const int q_ = (pc_) - 48; const unsigned row_ = 8u * q_ + ((unsigned)ln >> 3), ch_ = ((unsigned)ln & 7u) ^ dn::swz8(row_); src_ = gA + (size_t)(n_) * 8192 + row_ * 128u + ch_ * 16u; } \
        else src_ = gD + (size_t)(n_) * 1024 + (unsigned)ln * 16u; \
        att::glds16(src_, (unsigned)__builtin_amdgcn_readfirstlane((unsigned)(size_t)((stg_) + (pc_) * 1024))); } while (0)
#define GLA_STAGE(n_, stg_) do { _Pragma("unroll") for (int pi_ = 0; pi_ < 7; ++pi_) { int pcc_ = 7 * wave + pi_ + rot; pcc_ -= pcc_ >= 56 ? 56 : 0; GLA_PIECE(n_, stg_, pcc_); } if (wave == 0) { GLA_PIECE(n_, stg_, 56); } } while (0)
    f32x4 S[8]; bf16x8 Sb[4];
#pragma unroll
    for (int dt = 0; dt < 8; ++dt) S[dt] = (f32x4){0.f, 0.f, 0.f, 0.f};
#pragma unroll
    for (int ks = 0; ks < 4; ++ks) Sb[ks] = (bf16x8){0, 0, 0, 0, 0, 0, 0, 0};
    { const int ln = lane; GLA_STAGE(0, ring); }
    VM_WAIT(); __syncthreads();
    for (int n = 0; n < SEQ / 64; ++n) {
        LAS char* cur = ring + (n & 1) * STG; LAS char* nxt = ring + ((n + 1) & 1) * STG;
        const int ln = opaque_i(lane);
        if (PM != 1 && n + 1 < SEQ / 64) GLA_STAGE(n + 1, nxt);
        const unsigned fr = ln & 15, g = (unsigned)ln >> 4, q4 = fr >> 2, p = ln & 3;
        const LAS char* QEI = cur; const LAS char* KEI = cur + 16384; const LAS char* VI = cur + 32768; const LAS char* AI = cur + 49152; const LAS float* DV = (const LAS float*)(cur + 57344);
        if (active && PM != 2) {
        f32x4 oo[4];
#pragma unroll
        for (int mt = 0; mt < 4; ++mt) oo[mt] = (f32x4){0.f, 0.f, 0.f, 0.f};
#define SB() __builtin_amdgcn_sched_barrier(0)
#define GLA_LD_Q(mt_, Q_) do { _Pragma("unroll") for (int ks_ = 0; ks_ < 4; ++ks_) Q_[ks_] = *(const LAS bf16x8*)(QEI + 256u * (16u * (mt_) + fr) + 16u * ((4u * ks_ + g) ^ att::swz(fr))); } while (0)
#define GLA_MM_Q(mt_, Q_) do { _Pragma("unroll") for (int ks_ = 0; ks_ < 4; ++ks_) oo[mt_] = __builtin_amdgcn_mfma_f32_16x16x32_bf16(Q_[ks_], Sb[ks_], oo[mt_], 0, 0, 0); } while (0)
#define GLA_LD_KE(d0_, K_) do { _Pragma("unroll") for (int dd_ = 0; dd_ < 4; ++dd_) _Pragma("unroll") for (int k2_ = 0; k2_ < 2; ++k2_) { const unsigned r0_ = 32u * k2_ + 8u * g + q4, r1_ = r0_ + 4u; \
            K_[dd_][k2_] = dn::join8(att::vtr(KEI + 256u * r0_ + 16u * ((2u * ((d0_) + dd_) + (p >> 1)) ^ att::swz(r0_)) + 8u * (p & 1u)), att::vtr(KEI + 256u * r1_ + 16u * ((2u * ((d0_) + dd_) + (p >> 1)) ^ att::swz(r1_)) + 8u * (p & 1u))); } } while (0)
        bf16x8 qA[4], qB[4], af[4][2], kA[4][2], kB[4][2], vb[2];
        GLA_LD_Q(0, qA);
#pragma unroll
        for (int k2 = 0; k2 < 2; ++k2) {
            const unsigned r0 = 32u * k2 + 8u * g + q4, r1 = r0 + 4u;
            vb[k2] = dn::join8(att::vtr(VI + 256u * r0 + 16u * ((2u * dvt + (p >> 1)) ^ att::swz(r0)) + 8u * (p & 1u)), att::vtr(VI + 256u * r1 + 16u * ((2u * dvt + (p >> 1)) ^ att::swz(r1)) + 8u * (p & 1u)));
        }
        GLA_LD_Q(1, qB); SB(); GLA_MM_Q(0, qA); SB();
        GLA_LD_Q(2, qA);
#pragma unroll
        for (int mt = 0; mt < 4; ++mt)
#pragma unroll
            for (int k2 = 0; k2 < 2; ++k2) { const unsigned row = 16u * mt + fr; af[mt][k2] = *(const LAS bf16x8*)(AI + 128u * row + 16u * ((4u * k2 + g) ^ dn::swz8(row))); }
        SB(); GLA_MM_Q(1, qB); SB();
        GLA_LD_Q(3, qB); SB(); GLA_MM_Q(2, qA); SB();
        GLA_LD_KE(0, kA); SB(); GLA_MM_Q(3, qB);
#pragma unroll
        for (int mt = 0; mt < 4; ++mt)
#pragma unroll
            for (int k2 = 0; k2 < 2; ++k2) oo[mt] = __builtin_amdgcn_mfma_f32_16x16x32_bf16(af[mt][k2], vb[k2], oo[mt], 0, 0, 0);
        SB(); GLA_LD_KE(4, kB); SB();
#pragma unroll
        for (int dt = 0; dt < 4; ++dt) { const f32x4 dd = *(const LAS f32x4*)(DV + 16 * dt + 4 * g); S[dt] = S[dt] * dd;
#pragma unroll
            for (int k2 = 0; k2 < 2; ++k2) S[dt] = __builtin_amdgcn_mfma_f32_16x16x32_bf16(kA[dt][k2], vb[k2], S[dt], 0, 0, 0); }
        SB();
#pragma unroll
        for (int dt = 4; dt < 8; ++dt) { const f32x4 dd = *(const LAS f32x4*)(DV + 16 * dt + 4 * g); S[dt] = S[dt] * dd;
#pragma unroll
            for (int k2 = 0; k2 < 2; ++k2) S[dt] = __builtin_amdgcn_mfma_f32_16x16x32_bf16(kB[dt - 4][k2], vb[k2], S[dt], 0, 0, 0); }
#pragma unroll
        for (int ks = 0; ks < 4; ++ks) Sb[ks] = dn::join8(dn::pack4(S[2 * ks]), dn::pack4(S[2 * ks + 1]));
#undef GLA_LD_Q
#undef GLA_MM_Q
#undef GLA_LD_KE
#undef SB
        const size_t rbase = (size_t)b * SEQ + n * 64;
#pragma unroll
        for (int mt = 0; mt < 4; ++mt)
#pragma unroll
            for (int r = 0; r < 4; ++r) co[(rbase + 16 * mt + 4 * g + r) * D + h * HD + 16 * dvt + fr] = oo[mt][r];
        }
        VM_WAIT();
        __syncthreads();
    }
#undef GLA_STAGE
#undef GLA_PIECE
}

struct Args { const float* in[20]; float* out; unsigned char* ws; };
__global__ void __launch_bounds__(NWAVES * 64, 2) fwd(Args args) {
    extern __shared__ __attribute__((aligned(16))) unsigned char lds[];
    Frame F;
    F.lds = (LAS unsigned char*)lds;
    F.MISC = (volatile LAS unsigned*)(F.lds + MISC_OFF);
    F.tid = threadIdx.x; F.lane = F.tid & 63; F.wave = __builtin_amdgcn_readfirstlane(F.tid >> 6);
    F.G = gridDim.x; F.bx = (int)blockIdx.x;
    GAS unsigned char* ws = (GAS unsigned char*)args.ws; F.ws = ws; F.out = args.out;
    F.ctl = (gu32*)(ws + WS_CTL);
    F.ka = (const __attribute__((address_space(4))) unsigned long long*)__builtin_amdgcn_kernarg_segment_ptr();
    for (int u = F.tid; u < (LDS_BYTES - LDSCTL_OFF) / 4; u += NWAVES * 64) ((LAS unsigned*)(F.lds + LDSCTL_OFF))[u] = 0u;
    __syncthreads();
    XcdBarrier bar = xcd_barrier_post((unsigned*)(F.ctl + CW_BAR), F.MISC + 8);
#define GRID_BAR() xcd_barrier(bar)
    const LAS float* rtab = (const LAS float*)(F.lds + RTAB_OFF);
    bf16* XB; void* XLO; float* ROWSS; bf16* ACT; bf16* Y;
    constexpr bool XF = X_F16 == 1;

    p0_prologue(F);
    GRID_BAR();

    for (int s = 0; s < 2 * DEPTH; ++s) {
        { GAS unsigned char* w_ = F.ws; asm volatile("" : "+s"(w_)); F.ws = w_; ws = w_; auto k_ = F.ka; asm volatile("" : "+s"(k_)); F.ka = k_; int b_ = (int)blockIdx.x; asm volatile("" : "+s"(b_)); F.bx = b_; }
        XB = (bf16*)(ws + WS_XB); XLO = (void*)(ws + WS_X); ROWSS = (float*)(ws + WS_ROWSS); ACT = (bf16*)(ws + WS_ACT); Y = (bf16*)(ws + WS_Y);
        { pg8::EpiSwiGLU E{ACT, DFF, rtab, 0}; run_gemm<pg8::EpiSwiGLU, 0, XF, AIMG_XB != 0>(F, XB, (const bf16*)(ws + WS_W1T) + (size_t)s * NFF * D, M, F.G == 256 ? 40 * 256 : NFF, D, E, true, 0, 0, 1, F.G == 256 ? 5 : -1, 40, 3); }
        if (F.G == 256) { pg8::EpiSwiGLU E{ACT, DFF, rtab + 5 * 256, 1}; run_gemm_half<pg8::EpiSwiGLU, XF, AIMG_XB != 0>(F, XB, (const bf16*)(ws + WS_W1T) + (size_t)s * NFF * D, M, NFF, D, 40, 3, E, false); }
        conv_slot(F, F.G == 256 ? 192 : 0, 3);
        GRID_BAR();
        { pg8::EpiResidual E{s == 0 ? FIN(I_X) : (const float*)nullptr, XB, XLO, ROWSS, 0.5f, D, M}; run_gemm<pg8::EpiResidual, 0, false, AIMG_ACT != 0>(F, ACT, (const bf16*)(ws + WS_W2T) + (size_t)s * D * DFF, M, D, DFF, E, false); }
        if (!(s & 1)) conv_deadline(F, cq_n_mix(s >> 1)); else if (s + 1 < 2 * DEPTH) conv_deadline(F, cq_n_ffn(s + 1));
        GRID_BAR();
        if (!(s & 1)) {
            const int l = s >> 1;
            if (!(l & 1)) {
                const int e = l >> 1;
                { pg8::EpiABin E{(bf16*)(ws + WS_QM), (bf16*)(ws + WS_KM), (bf16*)(ws + WS_VM), (bf16*)(ws + WS_DNPRE), (bf16*)(ws + WS_DNGATE), (float*)(ws + WS_BA), (float*)(ws + WS_KMS), rtab, QK_SCALE_LOG2E};
                  run_gemm<pg8::EpiABin, 0, XF, AIMG_XB != 0>(F, XB, (const bf16*)(ws + WS_WABT) + (size_t)e * AB_PAD * D, M, AB_PAD, D, E, true); }
                conv_slot(F, F.G == 256 ? 160 : F.G, 6);
                GRID_BAR();
                dn_chunk_phase(F, e);
                GRID_BAR();
                dn_scan_phase<0>(F, e);
                moba_phase(F, 4 * BATCH * NH_AB);
                conv_slot(F, 4 * BATCH * NH_AB + BATCH * NH_AB * 8, 18);
                if (DN_TAIL_NORMGATE == 2) ng_help(F, e);
                GRID_BAR();
                if (DN_TAIL_NORMGATE == 0) { normgate(F, (const float*)(ws + WS_DNO), (const bf16*)(ws + WS_DNGATE), NH_AB, FIN(I_AB_ONG) + e * HD, 1024); GRID_BAR(); }
                { pg8::EpiResidual E{nullptr, XB, XLO, ROWSS, 1.0f, D, M}; run_gemm(F, Y, (const bf16*)(ws + WS_WABOT) + (size_t)e * D * D, M, D, D, E, false); }
                conv_deadline(F, cq_n_x(l));
                GRID_BAR();
            } else {
                const int o = l >> 1;
                { pg8::EpiCin E{(bf16*)(ws + WS_CQ), (bf16*)(ws + WS_CK), (bf16*)(ws + WS_CV), (bf16*)(ws + WS_CG), (float*)(ws + WS_CLF), (const float*)(ws + WS_LB) + (size_t)l * D, rtab};
                  run_gemm<pg8::EpiCin, 0, XF, AIMG_XB != 0>(F, XB, (const bf16*)(ws + WS_WCT) + (size_t)o * 4 * D * D, M, 4 * D, D, E, true); }
                GRID_BAR();
                gla_chunk_phase(F);
                GRID_BAR();
                gla_scan_phase<0>(F);
                conv_slot(F, 4 * BATCH * NH_C, 14);
                GRID_BAR();
                normgate(F, (const float*)(ws + WS_CO), (const bf16*)(ws + WS_CG), NH_C, FIN(I_C_ONG) + o * HD, 0);
                GRID_BAR();
                { pg8::EpiResidual E{nullptr, XB, XLO, ROWSS, 1.0f, D, M}; run_gemm(F, Y, (const bf16*)(ws + WS_WCOT) + (size_t)o * D * D, M, D, D, E, false); }
                conv_deadline(F, cq_n_x(l));
                GRID_BAR();
            }
            { pg8::EpiBf16Route E{(bf16*)(ws + WS_XQ), XW, rtab, QK_SCALE_LOG2E, 1}; run_gemm_half<pg8::EpiBf16Route, XF, AIMG_XB != 0>(F, XB, (const bf16*)(ws + WS_WXQT) + (size_t)l * XW * D, M, XW, D, 0, XW / 256, E, true, 0); }
            if (l == 0) { pg8::EpiBf16Route E{(bf16*)(ws + WS_KV), 4096, nullptr, 1.0f, 1}; run_gemm_half(F, (const bf16*)(ws + WS_MEMN), (const bf16*)(ws + WS_WXKVT), BATCH * MEMT, 4096, D, 0, 16, E, false, F.G - 128); }
            conv_slot(F, l == 0 ? 192 : 128, 3);
            GRID_BAR();
            xattn_phase(F, l);
            conv_slot(F, 128, 2);
            GRID_BAR();
            { pg8::EpiResidual E{nullptr, XB, XLO, ROWSS, 1.0f, D, M}; run_gemm(F, (const bf16*)(ws + WS_XO), (const bf16*)(ws + WS_WXOT) + (size_t)l * D * XW, M, D, XW, E, false); }
            conv_deadline(F, cq_n_ffn(s + 1));
            GRID_BAR();
        }
    }
    final_norm(F);
#undef GRID_BAR
}

extern "C" void kernel_launch(void* const* d_in, const int* in_sizes, int n_in, void* d_out, int out_size, void* d_ws, size_t ws_size, hipStream_t stream) {
    static int grid = 0;
    if (grid == 0) {
        if (n_in != 20 || in_sizes[0] != M * D || out_size != M * D || ws_size < WS_END2) { fprintf(stderr, "kernel_launch: unexpected shapes: n_in %d in0 %d out %d ws %zu (need %zu); nothing launched\n", n_in, n_in > 0 ? in_sizes[0] : -1, out_size, ws_size, (size_t)WS_END2); grid = -1; return; }
        int dev = 0, cus = 0, per_cu = 0;
        if (hipGetDevice(&dev) != hipSuccess || hipDeviceGetAttribute(&cus, hipDeviceAttributeMultiprocessorCount, dev) != hipSuccess) { fprintf(stderr, "kernel_launch: device query failed\n"); grid = -1; return; }
        if (hipFuncSetAttribute((const void*)fwd, hipFuncAttributeMaxDynamicSharedMemorySize, LDS_BYTES) != hipSuccess) { fprintf(stderr, "kernel_launch: hipFuncSetAttribute failed\n"); grid = -1; return; }
        if (hipOccupancyMaxActiveBlocksPerMultiprocessor(&per_cu, (const void*)fwd, NWAVES * 64, LDS_BYTES) != hipSuccess || per_cu < 1) fprintf(stderr, "kernel_launch: note: occupancy query reports %d workgroups per CU\n", per_cu);
        (void)hipGetLastError();
        grid = cus;
    }
    if (grid < 0) return;
    if (hipMemsetAsync((char*)d_ws + WS_CTL, 0, CTL_ZERO_BYTES, stream) != hipSuccess) { fprintf(stderr, "kernel_launch: memset failed\n"); return; }
    Args a{};
    for (int i = 0; i < 20; ++i) a.in[i] = (const float*)d_in[i];
    a.out = (float*)d_out; a.ws = (unsigned char*)d_ws;
    hipLaunchKernelGGL(fwd, dim3(grid), dim3(NWAVES * 64), LDS_BYTES, stream, a);
    const hipError_t le = hipPeekAtLastError();
    if (le != hipSuccess) fprintf(stderr, "kernel_launch: launch failed: %s\n", hipGetErrorName(le));
}
```

```cpp
#include <hip/hip_runtime.h>
#include <cstdio>
#include <cstdint>
namespace pg8 {
#define PG8_LAS __attribute__((address_space(3)))
typedef unsigned short bf16_t;
typedef short bf16x8 __attribute__((ext_vector_type(8)));
typedef float f32x4 __attribute__((ext_vector_type(4)));
typedef unsigned u32x4 __attribute__((ext_vector_type(4)));
constexpr int BM = 256, BK = 64, HALF = 128, HTB = HALF * BK * 2  , STAGE_BYTES = 8 * HTB, NXCD = 8, WGM = 4;

__host__ __device__ __forceinline__ int lds_byte(int r, int c) { const int st = (r >> 4) * 2 + (c >> 5), rr = r & 15, cc = c & 31, ob = rr * 64 + cc * 2; return st * 1024 + (ob ^ (((ob >> 9) & 1) << 5)); }
__host__ __device__ __forceinline__ void stage_rc(int b, int& R, int& C) { const int st = b / 1024, sb = b % 1024, swz = sb ^ (((sb >> 9) & 1) << 5); R = (st >> 1) * 16 + swz / 64; C = (st & 1) * 32 + (swz % 64) / 2; }
__host__ __device__ __forceinline__ int perm32(int rho) { const int n = rho >> 4, i = rho & 15; return 8 * (i >> 2) + 4 * n + (i & 3); }

#ifndef BIMG
#define BIMG 1
#endif
__host__ __device__ __forceinline__ int slot32(int c) { const int q = c & 31; return (c & ~31) + 16 * ((q >> 2) & 1) + 4 * (q >> 3) + (q & 3); }
__host__ __device__ __forceinline__ size_t img_off(int r, int k, int K) { return ((size_t)(r >> 4) * (K >> 5) + (k >> 5)) * 1024 + lds_byte(r & 15, k & 31); }
struct Unit { int pm, pn, half; };
struct Gemm { const bf16_t* A; const bf16_t* Bt; int M, N, K, ld, ks; };

struct StaticOrder {
    int nM, nN, nwg, G, c;
    __host__ __device__ void init(int M, int N, int G_, int c_) { nM = M / BM; nN = N / BM; nwg = nM * nN; G = G_; c = c_; }
    __host__ __device__ bool next(int i, Unit& u) const {
        const long L = (long)i * G + c; if (L >= nwg) return false;
        int wgid = (int)L; { const int q = nwg / NXCD, r = nwg % NXCD, xcd = wgid % NXCD, off = wgid / NXCD; wgid = (xcd < r ? xcd * (q + 1) : r * (q + 1) + (xcd - r) * q) + off; }
        const int nig = WGM * nN, gid = wgid / nig, fm = gid * WGM, gsz = (nM - fm) < WGM ? (nM - fm) : WGM;
        u.pm = fm + ((wgid % nig) % gsz); u.pn = (wgid % nig) / gsz; u.half = 0; return true;
    }
    __device__ __forceinline__ void a_ready(const Unit&) const {}
    __device__ __forceinline__ void done(const Unit&) const {}
};

struct HalfOrder {
    int nM, pn0, nhalf, G, c;
    __host__ __device__ void init(int M, int pn0_, int ntile, int G_, int c_) { nM = M / BM; pn0 = pn0_; nhalf = 2 * nM * ntile; G = G_; c = c_; }
    __host__ __device__ bool next(int i, Unit& u) const { const int L = i * G + c; if (L >= nhalf) return false; const int T = L >> 1; u.pm = T % nM; u.pn = pn0 + T / nM; u.half = L & 1; return true; }
    __device__ __forceinline__ void a_ready(const Unit&) const {}
    __device__ __forceinline__ void done(const Unit&) const {}
};

typedef float f32x2_cv __attribute__((ext_vector_type(2))); typedef __bf16 bf16x2_cv __attribute__((ext_vector_type(2)));
__device__ __forceinline__ unsigned cvt_pk_bf16(float lo, float hi) { const f32x2_cv v = {lo, hi}; const bf16x2_cv b = __builtin_convertvector(v, bf16x2_cv); return __builtin_bit_cast(unsigned, b); }
#ifndef X_F16
#define X_F16 2
#endif
typedef _Float16 f16x2_cv __attribute__((ext_vector_type(2))); typedef _Float16 f16x8 __attribute__((ext_vector_type(8)));
__device__ __forceinline__ unsigned cvt_pk_f16(float lo, float hi) { const f32x2_cv v = {lo, hi}; const f16x2_cv b = __builtin_convertvector(v, f16x2_cv); return __builtin_bit_cast(unsigned, b); }
__device__ __forceinline__ float f16_lo(unsigned w) { return (float)__builtin_bit_cast(f16x2_cv, w)[0]; }
__device__ __forceinline__ float f16_hi(unsigned w) { return (float)__builtin_bit_cast(f16x2_cv, w)[1]; }
__device__ __forceinline__ unsigned cvt_pk_x(float lo, float hi) { return X_F16 == 1 ? cvt_pk_f16(lo, hi) : cvt_pk_bf16(lo, hi); }
typedef float f32x2 __attribute__((ext_vector_type(2)));
typedef unsigned u32x2 __attribute__((ext_vector_type(2)));
__device__ __forceinline__ float fast_exp2(float x) { return __builtin_amdgcn_exp2f(x); }
__device__ __forceinline__ float fast_rcp(float x) { return __builtin_amdgcn_rcpf(x); }
__device__ __forceinline__ float silu_f(float a) { return a * fast_rcp(1.0f + fast_exp2(a * -1.44269504089f)); }
__device__ __forceinline__ u32x4 pack8(const f32x4& v0, const f32x4& v1) { u32x4 w; w.x = cvt_pk_bf16(v0[0], v0[1]); w.y = cvt_pk_bf16(v0[2], v0[3]); w.z = cvt_pk_bf16(v1[0], v1[1]); w.w = cvt_pk_bf16(v1[2], v1[3]); return w; }


#ifndef AIMG_ACT
#define AIMG_ACT 1
#endif
#ifndef AIMG_XB
#define AIMG_XB 1
#endif
struct EpiSwiGLU {
    static constexpr bool PERM = true, AFTER_DRAIN = false;
    bf16_t* O; int ldc; const PG8_LAS float* rtab; int hm;
    __device__ __forceinline__ void init(f32x4 (&acc)[2][2][4][2], const Unit&, int, int, int, int) const {
#pragma unroll
        for (int a = 0; a < 2; ++a)
#pragma unroll
            for (int b = 0; b < 2; ++b)
#pragma unroll
                for (int m = 0; m < 4; ++m)
#pragma unroll
                    for (int n = 0; n < 2; ++n) acc[a][b][m][n] = (f32x4){0.f, 0.f, 0.f, 0.f};
    }
    __device__ __forceinline__ void operator()(const f32x4 (&acc)[2][2][4][2], const Unit& u, int ui, int wr, int wc, int fr, int fq) const {
        const PG8_LAS float* rt = rtab + ui * 256;
#pragma unroll
        for (int ai = 0; ai < 2; ++ai)
#pragma unroll
            for (int m = 0; m < 4; ++m) {
                if (hm && ai == 1) continue;
                const int rl = (hm ? u.half : ai) * HALF + wr * 64 + m * 16 + fr; const float rs = rt[rl];
                bf16_t* rowp = AIMG_ACT ? (bf16_t*)((char*)O + img_off(u.pm * BM + rl, u.pn * HALF + wc * 32 + 8 * fq, ldc)) : O + (size_t)(u.pm * BM + rl) * ldc + u.pn * HALF + wc * 32 + 8 * fq;
                f32x4 h[2];
#pragma unroll
                for (int n = 0; n < 2; ++n)
#pragma unroll
                    for (int e = 0; e < 4; ++e) { const float a = acc[ai][0][m][n][e] * rs, b = acc[ai][1][m][n][e] * rs; h[n][e] = silu_f(a) * b; }
                *(u32x4*)rowp = pack8(h[0], h[1]);
            }
    }
};

#ifndef RES_LO
#define RES_LO 1
#endif
constexpr float LO_SCALE = 2048.0f;
__device__ __forceinline__ float bf_lo(unsigned w) { return __builtin_bit_cast(float, w << 16); }
__device__ __forceinline__ float bf_hi(unsigned w) { return __builtin_bit_cast(float, w & 0xffff0000u); }
__device__ __forceinline__ float lo_clamp(float v) { return __builtin_amdgcn_fmed3f(v * LO_SCALE, -448.0f, 448.0f); }
__device__ __forceinline__ unsigned lo_pack4(float a, float b, float c, float d) { int w = __builtin_amdgcn_cvt_pk_fp8_f32(lo_clamp(a), lo_clamp(b), 0, false); return (unsigned)__builtin_amdgcn_cvt_pk_fp8_f32(lo_clamp(c), lo_clamp(d), w, true); }
__device__ __forceinline__ f32x4 hilo4(unsigned h0, unsigned h1, unsigned l) {
    const auto a = __builtin_amdgcn_cvt_pk_f32_fp8((int)l, false), b = __builtin_amdgcn_cvt_pk_f32_fp8((int)l, true); constexpr float r = 1.0f / LO_SCALE;
    return (f32x4){__builtin_fmaf(a[0], r, bf_lo(h0)), __builtin_fmaf(a[1], r, bf_hi(h0)), __builtin_fmaf(b[0], r, bf_lo(h1)), __builtin_fmaf(b[1], r, bf_hi(h1))};
}
__device__ __forceinline__ size_t res_chunk(const Unit& u, int ldx, int wr, int wc, int ai, int m, int bj, int fr, int fq) {
    return (((((size_t)(u.pm * (ldx / BM) + u.pn) * 8 + (wr * 4 + wc)) * 8 + (ai * 4 + m)) * 2 + bj) * 64) + (fq * 16 + fr);
}
struct EpiResidual {
    static constexpr bool PERM = true, AFTER_DRAIN = false;
    const float* xf32; bf16_t* xhi; void* xlo; float* rowss; float scale; int ldx, rsld;
    __device__ __forceinline__ void init(f32x4 (&acc)[2][2][4][2], const Unit& u, int wr, int wc, int fr, int fq) const {
        const float inv = 1.0f / scale;
#pragma unroll
        for (int ai = 0; ai < 2; ++ai)
#pragma unroll
            for (int m = 0; m < 4; ++m) {
                const int row = u.pm * BM + ai * HALF + wr * 64 + m * 16 + fr;
#pragma unroll
                for (int bj = 0; bj < 2; ++bj) { const size_t off = (size_t)row * ldx + u.pn * BM + bj * HALF + wc * 32 + 8 * fq;
                    if (xf32) { acc[ai][bj][m][0] = *(const f32x4*)(xf32 + off) * inv; acc[ai][bj][m][1] = *(const f32x4*)(xf32 + off + 4) * inv; }
                    else { const u32x4 h = X_F16 == 2 ? ((const u32x4*)xlo)[res_chunk(u, ldx, wr, wc, ai, m, bj, fr, fq)] : *(const u32x4*)(xhi + off);
#if X_F16
                        acc[ai][bj][m][0] = (f32x4){f16_lo(h.x), f16_hi(h.x), f16_lo(h.y), f16_hi(h.y)} * inv; acc[ai][bj][m][1] = (f32x4){f16_lo(h.z), f16_hi(h.z), f16_lo(h.w), f16_hi(h.w)} * inv;
#elif RES_LO == 2
                        const u32x2 l = *(const u32x2*)((const unsigned char*)xlo + off);
                        acc[ai][bj][m][0] = hilo4(h.x, h.y, l.x) * inv; acc[ai][bj][m][1] = hilo4(h.z, h.w, l.y) * inv;
#elif RES_LO == 1
                        const u32x4 l = *(const u32x4*)((const bf16_t*)xlo + off);
                        acc[ai][bj][m][0] = (f32x4){bf_lo(h.x) + bf_lo(l.x), bf_hi(h.x) + bf_hi(l.x), bf_lo(h.y) + bf_lo(l.y), bf_hi(h.y) + bf_hi(l.y)} * inv;
                        acc[ai][bj][m][1] = (f32x4){bf_lo(h.z) + bf_lo(l.z), bf_hi(h.z) + bf_hi(l.z), bf_lo(h.w) + bf_lo(l.w), bf_hi(h.w) + bf_hi(l.w)} * inv;
#else
                        acc[ai][bj][m][0] = (f32x4){bf_lo(h.x), bf_hi(h.x), bf_lo(h.y), bf_hi(h.y)} * inv; acc[ai][bj][m][1] = (f32x4){bf_lo(h.z), bf_hi(h.z), bf_lo(h.w), bf_hi(h.w)} * inv;
#endif
                    }
                }
            }
    }
    __device__ __forceinline__ void operator()(const f32x4 (&acc)[2][2][4][2], const Unit& u, int ui, int wr, int wc, int fr, int fq) const {
#pragma unroll
        for (int ai = 0; ai < 2; ++ai)
#pragma unroll
            for (int m = 0; m < 4; ++m) {
                const int row = u.pm * BM + ai * HALF + wr * 64 + m * 16 + fr; float ss = 0.f;
#pragma unroll
                for (int bj = 0; bj < 2; ++bj) {
                    const size_t off = (size_t)row * ldx + u.pn * BM + bj * HALF + wc * 32 + 8 * fq;
                    const f32x4 o0 = acc[ai][bj][m][0] * scale, o1 = acc[ai][bj][m][1] * scale;
#if X_F16
                    *(X_F16 == 2 ? (u32x4*)xlo + res_chunk(u, ldx, wr, wc, ai, m, bj, fr, fq) : (u32x4*)(xhi + off)) = (u32x4){cvt_pk_f16(o0[0], o0[1]), cvt_pk_f16(o0[2], o0[3]), cvt_pk_f16(o1[0], o1[1]), cvt_pk_f16(o1[2], o1[3])};
                    if constexpr (X_F16 == 2) *(u32x4*)(AIMG_XB ? (bf16_t*)((char*)xhi + img_off(row, u.pn * BM + bj * HALF + wc * 32 + 8 * fq, ldx)) : xhi + off) = pack8(o0, o1);
#else
                    const u32x4 h = pack8(o0, o1);
                    *(u32x4*)(xhi + off) = h;
#endif
#if RES_LO && !X_F16
                    const f32x4 r0 = o0 - (f32x4){bf_lo(h.x), bf_hi(h.x), bf_lo(h.y), bf_hi(h.y)}, r1 = o1 - (f32x4){bf_lo(h.z), bf_hi(h.z), bf_lo(h.w), bf_hi(h.w)};
#if RES_LO == 2
                    *(u32x2*)((unsigned char*)xlo + off) = (u32x2){lo_pack4(r0[0], r0[1], r0[2], r0[3]), lo_pack4(r1[0], r1[1], r1[2], r1[3])};
#else
                    *(u32x4*)((bf16_t*)xlo + off) = pack8(r0, r1);
#endif
#endif
                    ss += (o0[0] * o0[0] + o0[1] * o0[1]) + (o0[2] * o0[2] + o0[3] * o0[3]) + (o1[0] * o1[0] + o1[1] * o1[1]) + (o1[2] * o1[2] + o1[3] * o1[3]);
                }
                ss += __shfl_xor(ss, 16); ss += __shfl_xor(ss, 32);
                if (fq == 0) rowss[(size_t)(u.pn * 4 + wc) * rsld + row] = ss;
            }
    }
};

struct EpiBf16Route {
    static constexpr bool PERM = true, AFTER_DRAIN = false;
    bf16_t* O; int ldc; const PG8_LAS float* rtab; float scale; int hm;
    __device__ __forceinline__ void init(f32x4 (&acc)[2][2][4][2], const Unit&, int, int, int, int) const {
#pragma unroll
        for (int a = 0; a < 2; ++a)
#pragma unroll
            for (int b = 0; b < 2; ++b)
#pragma unroll
                for (int m = 0; m < 4; ++m)
#pragma unroll
                    for (int n = 0; n < 2; ++n) acc[a][b][m][n] = (f32x4){0.f, 0.f, 0.f, 0.f};
    }
    __device__ __forceinline__ void operator()(const f32x4 (&acc)[2][2][4][2], const Unit& u, int ui, int wr, int wc, int fr, int fq) const {
#pragma unroll
        for (int ai = 0; ai < 2; ++ai)
#pragma unroll
            for (int m = 0; m < 4; ++m) {
                if (hm && ai == 1) continue;
                const int rl = (hm ? u.half : ai) * HALF + wr * 64 + m * 16 + fr; const float rs = (rtab ? rtab[ui * 256 + rl] : 1.0f) * scale;
                bf16_t* rowp = O + (size_t)(u.pm * BM + rl) * ldc + u.pn * BM + wc * 32 + 8 * fq;
#pragma unroll
                for (int bj = 0; bj < 2; ++bj) *(u32x4*)(rowp + bj * HALF) = pack8(acc[ai][bj][m][0] * rs, acc[ai][bj][m][1] * rs);
            }
    }
};

struct EpiF32Part {
    static constexpr bool PERM = true, AFTER_DRAIN = false;
    float* P; int ldc; int ks; size_t part_stride;
    __device__ __forceinline__ void init(f32x4 (&acc)[2][2][4][2], const Unit&, int, int, int, int) const {
#pragma unroll
        for (int a = 0; a < 2; ++a)
#pragma unroll
            for (int b = 0; b < 2; ++b)
#pragma unroll
                for (int m = 0; m < 4; ++m)
#pragma unroll
                    for (int n = 0; n < 2; ++n) acc[a][b][m][n] = (f32x4){0.f, 0.f, 0.f, 0.f};
    }
    __device__ __forceinline__ void operator()(const f32x4 (&acc)[2][2][4][2], const Unit& u, int ui, int wr, int wc, int fr, int fq) const {
        float* base = P + (size_t)(u.pn % ks) * part_stride + (size_t)(u.pn / ks) * BM + wc * 32 + 8 * fq;
#pragma unroll
        for (int ai = 0; ai < 2; ++ai)
#pragma unroll
            for (int m = 0; m < 4; ++m) {
                float* rowp = base + (size_t)(u.pm * BM + ai * HALF + wr * 64 + m * 16 + fr) * ldc;
#pragma unroll
                for (int bj = 0; bj < 2; ++bj) { *(f32x4*)(rowp + bj * HALF) = acc[ai][bj][m][0]; *(f32x4*)(rowp + bj * HALF + 4) = acc[ai][bj][m][1]; }
            }
    }
};

struct EpiABin {
    static constexpr bool PERM = true, AFTER_DRAIN = false;
    bf16_t *Qm, *Km, *Vm, *DNpre, *DNgate; float* ba; float* kms; const PG8_LAS float* rtab; float qscale;
    __device__ __forceinline__ void init(f32x4 (&acc)[2][2][4][2], const Unit&, int, int, int, int) const {
#pragma unroll
        for (int a = 0; a < 2; ++a)
#pragma unroll
            for (int b = 0; b < 2; ++b)
#pragma unroll
                for (int m = 0; m < 4; ++m)
#pragma unroll
                    for (int n = 0; n < 2; ++n) acc[a][b][m][n] = (f32x4){0.f, 0.f, 0.f, 0.f};
    }
    __device__ __forceinline__ void operator()(const f32x4 (&acc)[2][2][4][2], const Unit& u, int ui, int wr, int wc, int fr, int fq) const {
        const int pn = u.pn; const PG8_LAS float* rt = rtab + ui * 256;
        if (pn < 28) {
            bf16_t* base; int ld = 1024, ct; float sc = 1.0f;
            if (pn < 4) { base = Qm; ct = pn; sc = qscale; } else if (pn < 8) { base = Km; ct = pn - 4; } else if (pn < 12) { base = Vm; ct = pn - 8; }
            else if (pn < 24) { base = DNpre; ld = 3072; ct = pn - 12; } else { base = DNgate; ct = pn - 24; }
            f32x4 cs[2][2];
#pragma unroll
            for (int bj = 0; bj < 2; ++bj)
#pragma unroll
                for (int n = 0; n < 2; ++n) cs[bj][n] = (f32x4){0.f, 0.f, 0.f, 0.f};
#pragma unroll
            for (int ai = 0; ai < 2; ++ai)
#pragma unroll
                for (int m = 0; m < 4; ++m) {
                    const int rl = ai * HALF + wr * 64 + m * 16 + fr; const float rs = rt[rl] * sc;
                    bf16_t* rowp = base + (size_t)(u.pm * BM + rl) * ld + ct * BM + wc * 32 + 8 * fq;
#pragma unroll
                    for (int bj = 0; bj < 2; ++bj) { const f32x4 v0 = acc[ai][bj][m][0] * rs, v1 = acc[ai][bj][m][1] * rs; *(u32x4*)(rowp + bj * HALF) = pack8(v0, v1); cs[bj][0] += v0; cs[bj][1] += v1; }
                }
            if (pn >= 4 && pn < 8) {
#pragma unroll
                for (int bj = 0; bj < 2; ++bj)
#pragma unroll
                    for (int n = 0; n < 2; ++n) {
                        f32x4 s = cs[bj][n];
#pragma unroll
                        for (int o = 1; o < 16; o <<= 1) { s[0] += __shfl_xor(s[0], o); s[1] += __shfl_xor(s[1], o); s[2] += __shfl_xor(s[2], o); s[3] += __shfl_xor(s[3], o); }
                        if (fr == 0) *(f32x4*)(kms + (size_t)(u.pm * 2 + wr) * 1024 + (pn - 4) * BM + bj * HALF + wc * 32 + 8 * fq + 4 * n) = s;
                    }
            }
        } else {
            if (wc == 0 && fq < 2) {
#pragma unroll
                for (int ai = 0; ai < 2; ++ai)
#pragma unroll
                    for (int m = 0; m < 4; ++m) {
                        const int rl = ai * HALF + wr * 64 + m * 16 + fr; const float rs = rt[rl];
                        float* p = ba + (size_t)(u.pm * BM + rl) * 16 + 8 * fq;
                        *(f32x4*)p = acc[ai][0][m][0] * rs; *(f32x4*)(p + 4) = acc[ai][0][m][1] * rs;
                    }
            }
        }
    }
};

struct EpiCin {
    static constexpr bool PERM = true, AFTER_DRAIN = false;
    bf16_t *Cq, *Ck, *Cv, *Cg; float* Clf; const float* lb; const PG8_LAS float* rtab;
    __device__ __forceinline__ void init(f32x4 (&acc)[2][2][4][2], const Unit&, int, int, int, int) const {
#pragma unroll
        for (int a = 0; a < 2; ++a)
#pragma unroll
            for (int b = 0; b < 2; ++b)
#pragma unroll
                for (int m = 0; m < 4; ++m)
#pragma unroll
                    for (int n = 0; n < 2; ++n) acc[a][b][m][n] = (f32x4){0.f, 0.f, 0.f, 0.f};
    }
    __device__ __forceinline__ void operator()(const f32x4 (&acc)[2][2][4][2], const Unit& u, int ui, int wr, int wc, int fr, int fq) const {
        const int pn = u.pn, sec = pn >> 3, ct = pn & 7; const PG8_LAS float* rt = rtab + ui * 256;
        bf16_t* base = sec == 0 ? Cq : (sec == 1 ? Ck : (sec == 2 ? Cv : Cg));
        const int cl = ct * BM + wc * 32 + 8 * fq;
        f32x4 lbv[2][2];
        if (sec == 1) {
#pragma unroll
            for (int bj = 0; bj < 2; ++bj) { lbv[bj][0] = *(const f32x4*)(lb + cl + bj * HALF); lbv[bj][1] = *(const f32x4*)(lb + cl + bj * HALF + 4); }
        }
#pragma unroll
        for (int ai = 0; ai < 2; ++ai)
#pragma unroll
            for (int m = 0; m < 4; ++m) {
                const int rl = ai * HALF + wr * 64 + m * 16 + fr; const float rs = rt[rl];
                const size_t off = (size_t)(u.pm * BM + rl) * 2048 + cl;
#pragma unroll
                for (int bj = 0; bj < 2; ++bj) {
                    f32x4 v[2] = {acc[ai][bj][m][0] * rs, acc[ai][bj][m][1] * rs};
                    if (sec == 0) {
#pragma unroll
                        for (int n = 0; n < 2; ++n)
#pragma unroll
                            for (int e = 0; e < 4; ++e) v[n][e] = silu_f(v[n][e]) * 0.08838834764831845f;
                    } else if (sec == 1) {
                        f32x4 lf[2];
#pragma unroll
                        for (int n = 0; n < 2; ++n)
#pragma unroll
                            for (int e = 0; e < 4; ++e) {
                                const float ex = fast_exp2(v[n][e] * -1.44269504089f), r = fast_rcp(1.0f + ex), l = lbv[bj][n][e];
                                lf[n][e] = __logf(l + (1.0f - l) * r); v[n][e] = (1.0f - l) * ex * r;
                            }
                        *(f32x4*)(Clf + off + bj * HALF) = lf[0]; *(f32x4*)(Clf + off + bj * HALF + 4) = lf[1];
                    }
                    *(u32x4*)(base + off + bj * HALF) = pack8(v[0], v[1]);
                }
            }
    }
};
#ifndef PG8_KROT
#define PG8_KROT 0
#endif
template <class Epi, class Sched, bool ALIGN_EPI = false, bool SP2 = false, int PM = 0, bool HM = false, bool F16 = false, bool AIMG = false>
__device__ __forceinline__ void gemm_phase(PG8_LAS unsigned char* lds, const Gemm g, const Sched& S, const Epi& E) {
    int tid_ = threadIdx.x; asm volatile("" : "+v"(tid_));
    const int tid = tid_, wid = __builtin_amdgcn_readfirstlane(tid >> 6), lane = tid & 63, wr = wid >> 2, wc = wid & 3, fr = lane & 15, fq = lane >> 4;
    const int K = g.K, nt = K / BK, ld = g.ld, ks = g.ks;
    unsigned voffA[2], voffB[2];
#pragma unroll
    for (int i = 0; i < 2; ++i) { int R, C; stage_rc(tid * 16 + i * 8192, R, C); const int Rb = Epi::PERM ? ((R & ~31) + perm32(R & 31)) : R;
        voffA[i] = AIMG ? (unsigned)(((R >> 4) * (ld >> 5) + (C >> 5)) * 1024 + (lds_byte(R, C) & 1023)) : (unsigned)(R * ld + C) * 2u; voffB[i] = BIMG ? (unsigned)(((R >> 4) * (ld >> 5) + (C >> 5)) * 1024 + (lds_byte(R, C) & 1023)) : (unsigned)(Rb * ld + C) * 2u; }
    const size_t kstep = AIMG ? (size_t)2048 : (size_t)(BK * 2), kstepB = BIMG ? (size_t)2048 : (size_t)(BK * 2);
    const size_t hstep = (size_t)HALF * ld * 2;
    const size_t tstep = 2 * hstep;
    const unsigned ldsw = (unsigned)wid * 1024u;
    const int aoff = lds_byte(wr * 64 + fr, fq * 8), boff = lds_byte(wc * 32 + fr, fq * 8);
#define PG8_SA(b, h) (((b) * 2 + (h)) * HTB)
#define PG8_SB(b, h) ((4 + (b) * 2 + (h)) * HTB)
#define PG8_STAGE(bufoff, gbase, voff) do { _Pragma("unroll") for (int _i = 0; _i < 2; ++_i) \
        __builtin_amdgcn_global_load_lds((const unsigned*)((const char*)(gbase) + (voff)[_i]), (PG8_LAS unsigned*)(lds + (bufoff) + ldsw + _i * 8192), 16, 0, 0); } while (0)
#define PG8_LDA(dst, b, h) do { _Pragma("unroll") for (int m = 0; m < 4; ++m) _Pragma("unroll") for (int k = 0; k < 2; ++k) dst[m][k] = *(const PG8_LAS bf16x8*)(lds + PG8_SA(b, h) + aoff + m * 2048 + k * 1024); } while (0)
#define PG8_LDB(dst, b, h) do { _Pragma("unroll") for (int n = 0; n < 2; ++n) _Pragma("unroll") for (int k = 0; k < 2; ++k) dst[n][k] = *(const PG8_LAS bf16x8*)(lds + PG8_SB(b, h) + boff + n * 2048 + k * 1024); } while (0)
#define PG8_MMA(ai, bj, At, Bt) do { __builtin_amdgcn_s_setprio(1); _Pragma("unroll") for (int m = 0; m < 4; ++m) _Pragma("unroll") for (int n = 0; n < 2; ++n) _Pragma("unroll") for (int k = 0; k < 2; ++k) \
        { if constexpr (F16) acc[ai][bj][m][n] = __builtin_amdgcn_mfma_f32_16x16x32_f16(__builtin_bit_cast(f16x8, Bt[n][k]), __builtin_bit_cast(f16x8, At[m][k]), acc[ai][bj][m][n], 0, 0, 0); \
          else acc[ai][bj][m][n] = __builtin_amdgcn_mfma_f32_16x16x32_bf16(Bt[n][k], At[m][k], acc[ai][bj][m][n], 0, 0, 0); } __builtin_amdgcn_s_setprio(0); } while (0)
#define PG8_STAGE_L(bufoff, gbase, voff) do { if constexpr (PM != 1) PG8_STAGE(bufoff, gbase, voff); } while (0)
#define PG8_MMA_L(ai, bj, At, Bt) do { if constexpr (PM != 2) PG8_MMA(ai, bj, At, Bt); } while (0)
#define PG8_WAIT_V(n) asm volatile("s_waitcnt vmcnt(" #n ")" ::: "memory")
#define PG8_WAIT_L(n) asm volatile("s_waitcnt lgkmcnt(" #n ")" ::: "memory")
#define PG8_BAR __builtin_amdgcn_s_barrier()
#define PG8_SCHED __builtin_amdgcn_sched_barrier(0)
    Unit cur, nxt; int ui = 0;
    if (!S.next(0, cur)) return;
    f32x4 acc[2][2][4][2];
    E.init(acc, cur, wr, wc, fr, fq);
    bf16x8 At[4][2], B0[2][2], B1[2][2];
    const char* cA = (const char*)g.A + (size_t)cur.pm * tstep + (size_t)(cur.pn % ks) * K * 2 + (HM ? (size_t)cur.half * hstep : 0); const char* cB = (const char*)g.Bt + (size_t)(cur.pn / ks) * tstep + (size_t)(cur.pn % ks) * K * 2;
    int koff = PG8_KROT ? (PG8_KROT * (cur.pm + cur.pn)) % nt : 0;
    S.a_ready(cur);
    const char* cA0 = cA + (size_t)koff * kstep; const char* cB0 = cB + (size_t)koff * kstepB; const long k1d = (koff + 1 >= nt) ? -(long)koff * (long)kstep : (long)kstep, k1dB = (koff + 1 >= nt) ? -(long)koff * (long)kstepB : (long)kstepB;
    if constexpr (SP2) {
        static_assert(!HM || SP2, "HM needs the SP2 loop");
        PG8_STAGE(PG8_SB(0, 0), cB0, voffB); PG8_STAGE(PG8_SB(0, 1), cB0 + hstep, voffB); PG8_STAGE(PG8_SA(0, 0), cA0, voffA); if constexpr (!HM) PG8_STAGE(PG8_SA(0, 1), cA0 + hstep, voffA);
        if (wr == 1) PG8_BAR;
        if constexpr (HM) PG8_WAIT_V(0); else PG8_WAIT_V(2);
        PG8_BAR;
        PG8_STAGE(PG8_SB(1, 0), cB0 + k1dB, voffB); PG8_STAGE(PG8_SA(1, 0), cA0 + k1d, voffA); PG8_STAGE(PG8_SB(1, 1), cB0 + hstep + k1dB, voffB);
        PG8_WAIT_V(6); PG8_BAR;
    } else {
        PG8_STAGE(PG8_SB(0, 0), cB0, voffB); PG8_STAGE(PG8_SA(0, 0), cA0, voffA); PG8_STAGE(PG8_SB(0, 1), cB0 + hstep, voffB); PG8_STAGE(PG8_SA(0, 1), cA0 + hstep, voffA);
        if (wr == 1) PG8_BAR;
        PG8_WAIT_V(4); PG8_BAR;
        PG8_STAGE(PG8_SB(1, 0), cB0 + k1dB, voffB); PG8_STAGE(PG8_SA(1, 0), cA0 + k1d, voffA); PG8_STAGE(PG8_SB(1, 1), cB0 + hstep + k1dB, voffB);
        PG8_WAIT_V(6); PG8_BAR;
    }
    for (;;) {
        const bool has_next = S.next(ui + 1, nxt);
        const char* nA = has_next ? (const char*)g.A + (size_t)nxt.pm * tstep + (size_t)(nxt.pn % ks) * K * 2 + (HM ? (size_t)nxt.half * hstep : 0) : cA; const char* nB = has_next ? (const char*)g.Bt + (size_t)(nxt.pn / ks) * tstep + (size_t)(nxt.pn % ks) * K * 2 : cB;
        const int koffN = (PG8_KROT && has_next) ? (PG8_KROT * (nxt.pm + nxt.pn)) % nt : koff;
        int e0 = koff;
        for (int t = 0; t < nt; t += 2) {
            const bool last = (t == nt - 2);
            const int e1 = (e0 + 1 >= nt) ? e0 + 1 - nt : e0 + 1, e2 = (e0 + 2 >= nt) ? e0 + 2 - nt : e0 + 2, e3 = (e2 + 1 >= nt) ? 0 : e2 + 1, n1 = (koffN + 1 >= nt) ? 0 : koffN + 1;
            const char* a1 = cA + (size_t)e1 * kstep;
            const char* a2 = last ? nA + (size_t)koffN * kstep : cA + (size_t)e2 * kstep; const char* b2 = last ? nB + (size_t)koffN * kstepB : cB + (size_t)e2 * kstepB;
            const char* a3 = last ? nA + (size_t)n1 * kstep : cA + (size_t)e3 * kstep; const char* b3 = last ? nB + (size_t)n1 * kstepB : cB + (size_t)e3 * kstepB;
            e0 = e2;
            if (last && has_next) S.a_ready(nxt);
            if constexpr (SP2) {
#define PG8_WAIT_VL() do { if constexpr (HM) PG8_WAIT_V(6); else PG8_WAIT_V(8); } while (0)
            PG8_LDB(B0, 0, 0); PG8_LDB(B1, 0, 1); PG8_SCHED; PG8_LDA(At, 0, 0); if constexpr (!HM) PG8_STAGE_L(PG8_SA(1, 1), a1 + hstep, voffA);
            PG8_WAIT_VL(); PG8_WAIT_L(0); PG8_BAR; PG8_MMA_L(0, 0, At, B0); PG8_MMA_L(0, 1, At, B1); PG8_BAR; PG8_SCHED;
            if constexpr (!HM) PG8_LDA(At, 0, 1); PG8_STAGE_L(PG8_SB(0, 0), b2, voffB); PG8_STAGE_L(PG8_SB(0, 1), b2 + hstep, voffB); PG8_STAGE_L(PG8_SA(0, 0), a2, voffA);
            PG8_WAIT_VL(); PG8_WAIT_L(0); PG8_BAR; if constexpr (!HM) { PG8_MMA_L(1, 0, At, B0); PG8_MMA_L(1, 1, At, B1); } PG8_BAR; PG8_SCHED;
            PG8_LDB(B0, 1, 0); PG8_LDB(B1, 1, 1); PG8_SCHED; PG8_LDA(At, 1, 0); if constexpr (!HM) PG8_STAGE_L(PG8_SA(0, 1), a2 + hstep, voffA);
            PG8_WAIT_VL(); PG8_WAIT_L(0); PG8_BAR; PG8_MMA_L(0, 0, At, B0); PG8_MMA_L(0, 1, At, B1); PG8_BAR; PG8_SCHED;
            if constexpr (!HM) PG8_LDA(At, 1, 1); PG8_STAGE_L(PG8_SB(1, 0), b3, voffB); PG8_STAGE_L(PG8_SB(1, 1), b3 + hstep, voffB); PG8_STAGE_L(PG8_SA(1, 0), a3, voffA);
            PG8_WAIT_VL(); PG8_WAIT_L(0); PG8_BAR; if constexpr (!HM) { PG8_MMA_L(1, 0, At, B0); PG8_MMA_L(1, 1, At, B1); } PG8_BAR; PG8_SCHED;
#undef PG8_WAIT_VL
            } else {
            PG8_LDB(B0, 0, 0); PG8_SCHED; PG8_LDA(At, 0, 0); PG8_STAGE_L(PG8_SA(1, 1), a1 + hstep, voffA);
            PG8_WAIT_L(8); PG8_BAR; PG8_WAIT_L(0); PG8_MMA_L(0, 0, At, B0); PG8_BAR; PG8_SCHED;
            PG8_LDB(B1, 0, 1); PG8_STAGE_L(PG8_SB(0, 0), b2, voffB);
            PG8_BAR; PG8_WAIT_L(0); PG8_MMA_L(0, 1, At, B1); PG8_BAR;
            PG8_LDA(At, 0, 1); PG8_STAGE_L(PG8_SA(0, 0), a2, voffA);
            PG8_BAR; PG8_WAIT_L(0); PG8_MMA_L(1, 0, At, B0); PG8_BAR; PG8_SCHED;
            PG8_STAGE_L(PG8_SB(0, 1), b2 + hstep, voffB);
            PG8_WAIT_V(6); PG8_BAR; PG8_MMA_L(1, 1, At, B1); PG8_BAR;
            PG8_LDB(B0, 1, 0); PG8_SCHED; PG8_LDA(At, 1, 0); PG8_STAGE_L(PG8_SA(0, 1), a2 + hstep, voffA);
            PG8_WAIT_L(8); PG8_BAR; PG8_WAIT_L(0); PG8_MMA_L(0, 0, At, B0); PG8_BAR; PG8_SCHED;
            PG8_LDB(B1, 1, 1); PG8_STAGE_L(PG8_SB(1, 0), b3, voffB);
            PG8_BAR; PG8_WAIT_L(0); PG8_MMA_L(0, 1, At, B1); PG8_BAR;
            PG8_LDA(At, 1, 1); PG8_STAGE_L(PG8_SA(1, 0), a3, voffA);
            PG8_BAR; PG8_WAIT_L(0); PG8_MMA_L(1, 0, At, B0); PG8_BAR; PG8_SCHED;
            PG8_STAGE_L(PG8_SB(1, 1), b3 + hstep, voffB);
            PG8_WAIT_V(6); PG8_BAR; PG8_MMA_L(1, 1, At, B1); PG8_BAR;
            }
        }
        if constexpr (ALIGN_EPI) { if (wr == 0) PG8_BAR; }
        if constexpr (!Epi::AFTER_DRAIN) { E(acc, cur, ui, wr, wc, fr, fq); S.done(cur); }
        if (!has_next) break;
        cur = nxt; cA = nA; cB = nB; koff = koffN; ++ui;
        E.init(acc, cur, wr, wc, fr, fq);
        if constexpr (ALIGN_EPI) { if (wr == 1) PG8_BAR; }
    }
    PG8_WAIT_V(0);
    if constexpr (!ALIGN_EPI) { if (wr == 0) PG8_BAR; }
    PG8_BAR;
    if constexpr (Epi::AFTER_DRAIN) { E.fused(acc, cur, wr, wc, fr, fq, lds, wid, lane); S.done(cur); }
#undef PG8_SA
#undef PG8_SB
#undef PG8_STAGE
#undef PG8_STAGE_L
#undef PG8_MMA_L
#undef PG8_LDA
#undef PG8_LDB
#undef PG8_MMA
#undef PG8_WAIT_V
#undef PG8_WAIT_L
#undef PG8_BAR
#undef PG8_SCHED
}
}

constexpr int BATCH = 2, SEQ = 4096, D = 2048, DEPTH = 4, M = BATCH * SEQ;
constexpr int DFF = 5504, NFF = 2 * DFF;
constexpr int AB_IN = 7184, AB_PAD = 7424;
constexpr int HD = 128, NH_AB = 8, NH_C = 16, MEMT = 256, XW = 512, NBLK = SEQ / 256;
constexpr float EPS = 1e-6f;
constexpr float QK_SCALE_LOG2E = 0.08838834764831845f * 1.4426950408889634f;
constexpr int NWAVES = 8;

constexpr size_t MiB = 1u << 20;
constexpr size_t WS_CTL = 0, CTL_ZERO_BYTES = 1 * MiB;
constexpr size_t WS_X = 1 * MiB, WS_XB = 65 * MiB, WS_ROWSS = 97 * MiB, WS_ACT = 98 * MiB;
constexpr size_t WS_W1T = 184 * MiB, WS_W2T = 528 * MiB, WS_WABT = 700 * MiB, WS_WABOT = 758 * MiB, WS_WCT = 774 * MiB, WS_WCOT = 838 * MiB, WS_WXQT = 854 * MiB, WS_WXKVT = 862 * MiB, WS_WXOT = 878 * MiB;
constexpr size_t WS_MIX = 886 * MiB;
constexpr size_t WS_QM = WS_MIX, WS_KM = WS_MIX + 16 * MiB, WS_VM = WS_MIX + 32 * MiB, WS_DNPRE = WS_MIX + 48 * MiB, WS_DNGATE = WS_MIX + 96 * MiB, WS_BA = WS_MIX + 112 * MiB, WS_KMS = WS_MIX + 113 * MiB,
                 WS_DQ = WS_MIX + 114 * MiB, WS_DK = WS_MIX + 146 * MiB, WS_DV = WS_MIX + 178 * MiB, WS_BG = WS_MIX + 210 * MiB, WS_DNO = WS_MIX + 211 * MiB;
constexpr size_t WS_CQ = WS_MIX, WS_CK = WS_MIX + 32 * MiB, WS_CV = WS_MIX + 64 * MiB, WS_CG = WS_MIX + 96 * MiB, WS_CLF = WS_MIX + 128 * MiB, WS_CO = WS_MIX + 192 * MiB;
constexpr size_t WS_Y = WS_MIX + 256 * MiB, WS_XQ = WS_Y + 32 * MiB, WS_XO = WS_XQ + 8 * MiB, WS_MEMN = WS_XO + 8 * MiB, WS_KV = WS_MEMN + 2 * MiB, WS_LB = WS_KV + 4 * MiB, WS_END = WS_LB + 1 * MiB;
static_assert(WS_W1T + (size_t)8 * NFF * D * 2 <= WS_W2T && WS_W2T + (size_t)8 * D * DFF * 2 <= WS_WABT && WS_WABT + (size_t)2 * AB_PAD * D * 2 <= WS_WABOT && WS_ACT + (size_t)M * DFF * 2 <= WS_W1T, "ws map");
constexpr int CW_TMO = 0, CW_CODE = 1, CW_BAR = 4096;

constexpr int RING_OFF = 0, RING_BYTES = 131072;
constexpr int RTAB_OFF = RING_BYTES, RTAB_BYTES = 8 * 1024;
constexpr int LDSCTL_OFF = RTAB_OFF + RTAB_BYTES, MISC_OFF = LDSCTL_OFF + 320;
constexpr int LDS_BYTES = 147456;
static_assert(MISC_OFF + 128 <= LDS_BYTES, "LDS map");
#define GAS __attribute__((address_space(1)))
#define LAS __attribute__((address_space(3)))
typedef unsigned short bf16;
typedef unsigned v4u __attribute__((ext_vector_type(4)));
typedef float f32x4 __attribute__((ext_vector_type(4)));
typedef short bf16x8 __attribute__((ext_vector_type(8)));
typedef GAS unsigned gu32;
typedef GAS unsigned long long gu64;
#define RLX_AGENT __ATOMIC_RELAXED, __HIP_MEMORY_SCOPE_AGENT
#define LDS_WAIT() asm volatile("s_waitcnt lgkmcnt(0)" ::: "memory")
#define VM_WAIT() asm volatile("s_waitcnt vmcnt(0)" ::: "memory")
__device__ __forceinline__ unsigned long long rt() { return __builtin_amdgcn_s_memrealtime(); }
__device__ __forceinline__ unsigned f2bf(float f) { unsigned u = __builtin_bit_cast(unsigned, f); return (u + 0x7fffu + ((u >> 16) & 1u)) >> 16; }
__device__ __forceinline__ unsigned pk2(float lo, float hi) { return f2bf(lo) | (f2bf(hi) << 16); }
#define XB_TMO      128
#define XB_XCNT(j)  (256  + 64 * (j))
#define XB_XSUB(j)  (1280 + 64 * (j))
#define XB_XGEN(j)  (2304 + 64 * (j))
#define XB_TOP      3328
#define XB_TOPGEN   3392
#define XCD_BAR_WORDS 3456
#define XB_SPIN_CAP (1u << 18)

__device__ __forceinline__ unsigned xb_ld(unsigned* p)              { return __hip_atomic_load(p, __ATOMIC_RELAXED, __HIP_MEMORY_SCOPE_AGENT); }
__device__ __forceinline__ unsigned xb_add(unsigned* p, unsigned v) { return __hip_atomic_fetch_add(p, v, __ATOMIC_RELAXED, __HIP_MEMORY_SCOPE_AGENT); }
__device__ __forceinline__ unsigned xb_xcc_id() { return (unsigned)__builtin_amdgcn_s_getreg((3 << 11) | 20) & 0xFu; }
#define XB_SPIN(cond, bar) do { unsigned _sp = 0; while (cond) { __builtin_amdgcn_s_sleep(1); \
    if ((++_sp & 255u) == 0u) { if (xb_ld(&(bar)[XB_TMO])) break; if (_sp > XB_SPIN_CAP) { atomicAdd(&(bar)[XB_TMO], 1u); break; } } } } while (0)

struct XcdBarrier {
    unsigned* bar; unsigned x;
    volatile LAS unsigned* st;
};

__device__ __forceinline__ XcdBarrier xcd_barrier_post(unsigned* bar, volatile LAS unsigned* st) {
    XcdBarrier b; b.bar = bar; b.x = xb_xcc_id(); b.st = st;
    if (threadIdx.x == 0) (void)xb_add(&bar[XB_XCNT(b.x)], 1u);
    return b;
}
__device__ __forceinline__ void xcd_barrier_complete(unsigned* bar, unsigned x, unsigned& nloc, unsigned& nx) {
    const unsigned G = gridDim.x * gridDim.y * gridDim.z;
    unsigned sum, cnt, mine, sp = 0u;
    for (;;) {
        sum = 0u; cnt = 0u; mine = 0u;
#pragma unroll
        for (unsigned j = 0; j < 16; ++j) { const unsigned c = xb_ld(&bar[XB_XCNT(j)]); sum += c; cnt += (c > 0u) ? 1u : 0u; mine = (j == x) ? c : mine; }
        if (sum == G) break;
        __builtin_amdgcn_s_sleep(1);
        if ((++sp & 255u) == 0u) { if (xb_ld(&bar[XB_TMO])) break; if (sp > XB_SPIN_CAP) { atomicAdd(&bar[XB_TMO], 1u); break; } }
    }
    nloc = mine > 0u ? mine : 1u; nx = cnt > 0u ? cnt : 1u;
}

__device__ __forceinline__ void xcd_barrier(const XcdBarrier& b) {
    asm volatile("s_waitcnt vmcnt(0)" ::: "memory");
    __syncthreads();
    if (threadIdx.x == 0) {
        GAS unsigned* bar_g = (GAS unsigned*)b.bar; asm volatile("" : "+s"(bar_g)); unsigned* bar = (unsigned*)bar_g;
        __builtin_amdgcn_s_waitcnt(0);
        unsigned nloc = b.st[0], nx = b.st[1];
        if (nloc == 0u) { xcd_barrier_complete(bar, b.x, nloc, nx); b.st[0] = nloc; b.st[1] = nx; }
        const unsigned old = xb_add(&bar[XB_XSUB(b.x)], 1u);
        const unsigned gen = old / nloc;
        if (old + 1u == (gen + 1u) * nloc) {
            __builtin_amdgcn_fence(__ATOMIC_RELEASE, "agent");
            asm volatile("s_waitcnt vmcnt(0)" ::: "memory");
            const unsigned og = xb_add(&bar[XB_TOP], 1u);
            const unsigned tg = og / nx;
            if (og + 1u == (tg + 1u) * nx) xb_add(&bar[XB_TOPGEN], 1u);
            else XB_SPIN(xb_ld(&bar[XB_TOPGEN]) == tg, bar);
            __builtin_amdgcn_fence(__ATOMIC_ACQUIRE, "agent");
            xb_add(&bar[XB_XGEN(b.x)], 1u);
            asm volatile("s_waitcnt vmcnt(0)" ::: "memory");
        } else {
            XB_SPIN(xb_ld(&bar[XB_XGEN(b.x)]) == gen, bar);
            __builtin_amdgcn_fence(__ATOMIC_ACQUIRE, "agent");
            asm volatile("s_waitcnt vmcnt(0)" ::: "memory");
        }
    }
    __syncthreads();
}

struct Frame {
    LAS unsigned char* lds;
    volatile LAS unsigned* MISC;
    gu32* ctl;
    int tid, lane, wave, G, bx;
    const __attribute__((address_space(4))) unsigned long long* ka;
    float* out; GAS unsigned char* ws;
};
#define FIN(i) ((const float*)(const GAS float*)F.ka[i])
enum { I_X = 0, I_MEM, I_NORMG, I_MEMG, I_FINALG, I_FFN_WIN, I_FFN_WOUT, I_AB_WIN, I_AB_CONVW, I_AB_ALOG, I_AB_DTB, I_AB_ONG, I_AB_WOUT, I_C_WIN, I_C_LBL, I_C_ONG, I_C_WOUT, I_X_WQ, I_X_WKV, I_X_WO };

__device__ __forceinline__ int opaque_i(int v) { asm volatile("" : "+v"(v)); return v; }
#define PHASE_IDS() const int tid = opaque_i(F.tid), lane = tid & 63, wave = __builtin_amdgcn_readfirstlane(tid >> 6); (void)lane; (void)wave
__device__ __forceinline__ float wave_sum(float v) {
#pragma unroll
    for (int o = 1; o < 64; o <<= 1) v += __shfl_xor(v, o);
    return v;
}
__device__ __forceinline__ float wave_max(float v) {
#pragma unroll
    for (int o = 1; o < 64; o <<= 1) v = fmaxf(v, __shfl_xor(v, o));
    return v;
}
__device__ __forceinline__ float bflo(unsigned w) { return __uint_as_float(w << 16); }
__device__ __forceinline__ float bfhi(unsigned w) { return __uint_as_float(w & 0xffff0000u); }
__device__ __forceinline__ float sigmoid_f(float a) { return 1.0f / (1.0f + __expf(-a)); }
__device__ __forceinline__ float silu_acc(float a) { return a / (1.0f + __expf(-a)); }

__device__ __forceinline__ void conv_tile(const float* src, bf16* dst, int K, int N, int mode, const float* gain, int kb, int nb, int wave, int lane) {
    const int k0 = kb * 128 + wave * 16, n = nb * 256 + lane * 4;
    if (n >= N) return;
    const bool xw = X_F16 == 1 && gain != nullptr;
    f32x4 v[16];
#pragma unroll
    for (int r = 0; r < 16; ++r) v[r] = *(const GAS f32x4*)(src + (size_t)(k0 + r) * N + n);
    if (gain) {
#pragma unroll
        for (int r = 0; r < 16; ++r) v[r] = v[r] * gain[k0 + r];
    }
#pragma unroll
    for (int e = 0; e < 4; ++e) {
        const int col = n + e; int drow = col;
        if (mode == 1) { const int half = col >= DFF ? 1 : 0, j = col - half * DFF; drow = (j >> 7) * 256 + half * 128 + (j & 127); }
        v4u w0, w1;
#define CV2(a_, b_) (xw ? pg8::cvt_pk_f16(a_, b_) : pg8::cvt_pk_bf16(a_, b_))
        w0.x = CV2(v[0][e], v[1][e]); w0.y = CV2(v[2][e], v[3][e]); w0.z = CV2(v[4][e], v[5][e]); w0.w = CV2(v[6][e], v[7][e]);
        w1.x = CV2(v[8][e], v[9][e]); w1.y = CV2(v[10][e], v[11][e]); w1.z = CV2(v[12][e], v[13][e]); w1.w = CV2(v[14][e], v[15][e]);
#undef CV2
        GAS v4u* o = BIMG ? (GAS v4u*)((GAS char*)dst + pg8::img_off(pg8::slot32(drow), k0, K)) : (GAS v4u*)(dst + (size_t)drow * K + k0);
        o[0] = w0; o[1] = w1;
    }
}
constexpr int IT_W1M = 16 * 43, IT_W2M = 43 * 8;
__device__ __forceinline__ int conv_family_tiles(int fam) { return fam == 0 ? IT_W1M + IT_W2M : (fam == 1 ? 16 * 29 + 16 * 8 : (fam == 2 ? 16 * 32 + 16 * 8 : (fam == 3 ? 64 : 256))); }
__device__ __forceinline__ void conv_family_item(Frame& F, int fam, int m, int r, int wave, int lane) {
    const float* normg = FIN(I_NORMG); const float* src; bf16* dst; const float* gain = nullptr; int K = D, N = D, mode = 0, kb, nb;
    if (fam == 0) {
        if (r < IT_W1M) { kb = r / 43; nb = r - kb * 43; src = FIN(I_FFN_WIN) + (size_t)m * D * NFF; dst = (bf16*)(F.ws + WS_W1T) + (size_t)m * NFF * D; N = NFF; mode = 1; gain = normg + (size_t)((m >> 1) * 4 + ((m & 1) ? 3 : 0)) * D; }
        else { r -= IT_W1M; kb = r >> 3; nb = r & 7; src = FIN(I_FFN_WOUT) + (size_t)m * DFF * D; dst = (bf16*)(F.ws + WS_W2T) + (size_t)m * D * DFF; K = DFF; }
    } else if (fam == 1) {
        if (r < 16 * 29) { kb = r / 29; nb = r - kb * 29; src = FIN(I_AB_WIN) + (size_t)m * D * AB_IN; dst = (bf16*)(F.ws + WS_WABT) + (size_t)m * AB_PAD * D; N = AB_IN; gain = normg + (size_t)((2 * m) * 4 + 1) * D; }
        else { r -= 16 * 29; kb = r >> 3; nb = r & 7; src = FIN(I_AB_WOUT) + (size_t)m * D * D; dst = (bf16*)(F.ws + WS_WABOT) + (size_t)m * D * D; }
    } else if (fam == 2) {
        if (r < 16 * 32) { kb = r >> 5; nb = r & 31; src = FIN(I_C_WIN) + (size_t)m * D * 4 * D; dst = (bf16*)(F.ws + WS_WCT) + (size_t)m * 4 * D * D; N = 4 * D; gain = normg + (size_t)((2 * m + 1) * 4 + 1) * D; }
        else { r -= 16 * 32; kb = r >> 3; nb = r & 7; src = FIN(I_C_WOUT) + (size_t)m * D * D; dst = (bf16*)(F.ws + WS_WCOT) + (size_t)m * D * D; }
    } else if (fam == 3) {
        if (r < 32) { kb = r >> 1; nb = r & 1; src = FIN(I_X_WQ) + (size_t)m * D * XW; dst = (bf16*)(F.ws + WS_WXQT) + (size_t)m * XW * D; N = XW; gain = normg + (size_t)(m * 4 + 2) * D; }
        else { r -= 32; kb = r >> 3; nb = r & 7; src = FIN(I_X_WO) + (size_t)m * XW * D; dst = (bf16*)(F.ws + WS_WXOT) + (size_t)m * D * XW; K = XW; }
    } else { const int mat = r >> 6, q = r & 63; kb = q >> 2; nb = q & 3; src = FIN(I_X_WKV) + (size_t)mat * D * 2 * XW; dst = (bf16*)(F.ws + WS_WXKVT) + (size_t)mat * 2 * XW * D; N = 2 * XW; }
    conv_tile(src, dst, K, N, mode, gain, kb, nb, wave, lane);
}
__device__ __forceinline__ void conv_family(Frame& F, int fam, int m, int first, int skip_lo = 0, int skip_hi = 0, int part = 0) {
    if (F.bx < first || (F.bx >= skip_lo && F.bx < skip_hi)) return;
    PHASE_IDS();
    const int nall = conv_family_tiles(fam), r0 = part == 2 ? nall / 2 : 0, nt = part == 1 ? nall / 2 : nall, vb = F.bx - first - (F.bx >= skip_hi ? skip_hi - skip_lo : 0), nb = F.G - first - (skip_hi - skip_lo);
    for (int r = r0 + vb; r < nt; r += nb) conv_family_item(F, fam, m, r, wave, lane);
    if (part == 2) return;
    if (fam == 1) {
        constexpr int PADV = (AB_PAD - AB_IN) * (D / 16);
        for (int i = vb * 512 + tid; i < PADV; i += nb * 512) { const int c = AB_IN + i / (D / 16), k0 = (i % (D / 16)) * 16;
            GAS v4u* o = BIMG ? (GAS v4u*)(F.ws + WS_WABT + (size_t)m * AB_PAD * D * 2 + pg8::img_off(pg8::slot32(c), k0, D)) : (GAS v4u*)(F.ws + WS_WABT + ((size_t)m * AB_PAD + c) * D * 2 + k0 * 2); o[0] = (v4u){0u, 0u, 0u, 0u}; o[1] = (v4u){0u, 0u, 0u, 0u}; }
    }
}

constexpr int CQ_NSEG = 17;
__device__ __forceinline__ void conv_queue_tile(Frame& F, int t, int wave, int lane, int tid) {
    int fam = 0, m = 0, base = 0;
#define CQ_SEG(f_, m_, n_) if (t >= base + (n_)) base += (n_); else { fam = (f_); m = (m_); goto found; }
    CQ_SEG(0, 0, 1032) CQ_SEG(1, 0, 592) CQ_SEG(4, 0, 256) CQ_SEG(3, 0, 64) CQ_SEG(0, 1, 1032) CQ_SEG(0, 2, 1032) CQ_SEG(2, 0, 640) CQ_SEG(3, 1, 64) CQ_SEG(0, 3, 1032)
    CQ_SEG(0, 4, 1032) CQ_SEG(1, 1, 592) CQ_SEG(3, 2, 64) CQ_SEG(0, 5, 1032) CQ_SEG(0, 6, 1032) CQ_SEG(2, 1, 640) CQ_SEG(3, 3, 64) CQ_SEG(0, 7, 1032)
    return;
#undef CQ_SEG
found:
    const int r = t - base;
    conv_family_item(F, fam, m, r, wave, lane);
    if (fam == 1 && r == 0) {
        constexpr int PADV = (AB_PAD - AB_IN) * (D / 16);
        for (int i2 = tid; i2 < PADV; i2 += NWAVES * 64) { const int c = AB_IN + i2 / (D / 16), k0 = (i2 % (D / 16)) * 16;
            GAS v4u* o = BIMG ? (GAS v4u*)(F.ws + WS_WABT + (size_t)m * AB_PAD * D * 2 + pg8::img_off(pg8::slot32(c), k0, D)) : (GAS v4u*)(F.ws + WS_WABT + ((size_t)m * AB_PAD + c) * D * 2 + k0 * 2); o[0] = (v4u){0u, 0u, 0u, 0u}; o[1] = (v4u){0u, 0u, 0u, 0u}; }
    }
}
constexpr int CQ_TOTAL = 11232, CW_CONVQ = 2048;
__device__ __forceinline__ int cq_n_ffn(int s) { return s == 0 ? 1032 : s == 1 ? 2976 : s == 2 ? 4008 : s == 3 ? 5744 : s == 4 ? 6776 : s == 5 ? 8464 : s == 6 ? 9496 : 11232; }
__device__ __forceinline__ int cq_n_mix(int l) { return l == 0 ? 1624 : l == 1 ? 4648 : l == 2 ? 7368 : 10136; }
__device__ __forceinline__ int cq_n_x(int l) { return l == 0 ? 1944 : l == 1 ? 4712 : l == 2 ? 7432 : 10200; }
__device__ __forceinline__ unsigned cq_bcast(Frame& F, unsigned v, int tid) { __syncthreads(); if (tid == 0) F.MISC[20] = v; __syncthreads(); return F.MISC[20]; }
__device__ __forceinline__ void conv_slot(Frame& F, int first, int quota, int skip_lo = 0, int skip_hi = 0) {
    if (F.bx < first || (F.bx >= skip_lo && F.bx < skip_hi)) return;
    PHASE_IDS();
    gu32* q = F.ctl + CW_CONVQ;
    unsigned tk = 0u; if (tid == 0) tk = __hip_atomic_fetch_add(q, 1u, RLX_AGENT);
    for (int i = 0; i < quota; ++i) {
        const unsigned t = cq_bcast(F, tk, tid);
        if (t >= (unsigned)CQ_TOTAL) break;
        if (tid == 0 && i + 1 < quota) tk = __hip_atomic_fetch_add(q, 1u, RLX_AGENT);
        conv_queue_tile(F, (int)t, wave, lane, tid);
    }
}
__device__ __forceinline__ void conv_deadline(Frame& F, int need) {
    PHASE_IDS();
    gu32* q = F.ctl + CW_CONVQ;
    for (;;) {
        unsigned cur = 0u; if (tid == 0) cur = __hip_atomic_load(q, RLX_AGENT);
        if (cq_bcast(F, cur, tid) >= (unsigned)need) break;
        unsigned tk = 0u; if (tid == 0) tk = __hip_atomic_fetch_add(q, 1u, RLX_AGENT);
        const unsigned t = cq_bcast(F, tk, tid);
        if (t < (unsigned)CQ_TOTAL) conv_queue_tile(F, (int)t, wave, lane, tid);
    }
}

__device__ __forceinline__ void p0_prologue(Frame& F) {
    PHASE_IDS();
    conv_deadline(F, cq_n_ffn(0));
    const int gw = F.bx * NWAVES + wave, NGW = F.G * NWAVES;
    {
        const float* x = FIN(I_X); bf16* xb = (bf16*)(F.ws + WS_XB); float* rowss = (float*)(F.ws + WS_ROWSS);
        for (int m = gw; m < M; m += NGW) {
            const GAS f32x4* xr = (const GAS f32x4*)(x + (size_t)m * D) + lane; f32x4 v[8]; float ss = 0.f;
#pragma unroll
            for (int j = 0; j < 8; ++j) { v[j] = xr[64 * j]; ss += (v[j][0] * v[j][0] + v[j][1] * v[j][1]) + (v[j][2] * v[j][2] + v[j][3] * v[j][3]); }
            ss = wave_sum(ss);
            GAS pg8::u32x2* o = (GAS pg8::u32x2*)(xb + (size_t)m * D) + lane;
#pragma unroll
            for (int j = 0; j < 8; ++j) { pg8::u32x2 w; w.x = pg8::cvt_pk_x(v[j][0], v[j][1]); w.y = pg8::cvt_pk_x(v[j][2], v[j][3]);
                if (AIMG_XB) *(GAS pg8::u32x2*)((GAS char*)xb + pg8::img_off(m, 4 * lane + 256 * j, D)) = w; else o[64 * j] = w; }
            if (lane < 32) rowss[(size_t)lane * M + m] = lane == 0 ? ss : 0.f;
        }
    }
    {
        const float* mem = FIN(I_MEM); const float* mg = FIN(I_MEMG); bf16* mn = (bf16*)(F.ws + WS_MEMN);
        for (int m = gw; m < BATCH * MEMT; m += NGW) {
            const GAS f32x4* xr = (const GAS f32x4*)(mem + (size_t)m * D) + lane; f32x4 v[8]; float ss = 0.f;
#pragma unroll
            for (int j = 0; j < 8; ++j) { v[j] = xr[64 * j]; ss += (v[j][0] * v[j][0] + v[j][1] * v[j][1]) + (v[j][2] * v[j][2] + v[j][3] * v[j][3]); }
            const float rs = 1.0f / sqrtf(wave_sum(ss) * (1.0f / D) + EPS);
            GAS pg8::u32x2* o = (GAS pg8::u32x2*)(mn + (size_t)m * D) + lane;
#pragma unroll
            for (int j = 0; j < 8; ++j) { const f32x4 g = ((const GAS f32x4*)mg)[lane + 64 * j]; pg8::u32x2 w; w.x = pg8::cvt_pk_bf16(v[j][0] * rs * g[0], v[j][1] * rs * g[1]); w.y = pg8::cvt_pk_bf16(v[j][2] * rs * g[2], v[j][3] * rs * g[3]); o[64 * j] = w; }
        }
    }
    {
        const float* lg = FIN(I_C_LBL); float* lb = (float*)(F.ws + WS_LB);
        for (int c = F.bx * 512 + tid; c < D; c += F.G * 512) {
            const float a0 = lg[c], a1 = lg[D + c], a2 = lg[2 * D + c], a3 = lg[3 * D + c];
            const float mx = fmaxf(fmaxf(a0, a1), fmaxf(a2, a3));
            const float e0 = expf(a0 - mx), e1 = expf(a1 - mx), e2 = expf(a2 - mx), e3 = expf(a3 - mx), inv = 1.0f / (e0 + e1 + e2 + e3);
            const float p1 = e1 * inv, p2 = e2 * inv, p3 = e3 * inv;
            lb[c] = 0.f; lb[D + c] = p1; lb[2 * D + c] = p1 + p2; lb[3 * D + c] = p1 + p2 + p3;
        }
    }
}

template <class Sched> __device__ __forceinline__ void build_rtab(Frame& F, const Sched& S, int xi = -1, int xpn0 = 0, int xnt = 0) {
    PHASE_IDS();
    const float* rowss = (const float*)(F.ws + WS_ROWSS); LAS float* rt = (LAS float*)(F.lds + RTAB_OFF);
    int xpm = -1; if (xi >= 0) { pg8::HalfOrder H; H.init(M, xpn0, xnt, F.G, F.bx); pg8::Unit hu; if (H.next(0, hu)) xpm = hu.pm; xpm = __builtin_amdgcn_readfirstlane(xpm); }
    float v[4][32]; bool ok[4];
#pragma unroll
    for (int it = 0; it < 4; ++it) {
        const int idx = tid + it * NWAVES * 64, i = idx >> 8, r = idx & 255; pg8::Unit u; ok[it] = S.next(i, u);
        if (!ok[it] && i == xi && xpm >= 0) { ok[it] = true; u.pm = xpm; }
        const GAS float* p = (const GAS float*)rowss + (size_t)((ok[it] ? u.pm : 0) * 256 + r);
        if (ok[it]) {
#pragma unroll
            for (int j = 0; j < 32; ++j) v[it][j] = p[(size_t)j * M];
        } else {
#pragma unroll
            for (int j = 0; j < 32; ++j) v[it][j] = 0.f;
        }
    }
#pragma unroll
    for (int it = 0; it < 4; ++it) {
        float s = 0.f;
#pragma unroll
        for (int j = 0; j < 8; ++j) s += (v[it][4 * j] + v[it][4 * j + 1]) + (v[it][4 * j + 2] + v[it][4 * j + 3]);
        if (ok[it]) rt[tid + it * NWAVES * 64] = 1.0f / sqrtf(s * (1.0f / D) + EPS);
    }
    LDS_WAIT(); __syncthreads();
}
template <class Epi, int PM = 0, bool F16 = false, bool AIMG = false> __device__ __forceinline__ void run_gemm(Frame& F, const bf16* A, const bf16* Bt, int Mrows, int N, int K, const Epi& E, bool need_rtab, int rot = 0, int ld = 0, int ks = 1, int xi = -1, int xpn0 = 0, int xnt = 0) {
    pg8::Gemm g{A, Bt, Mrows, N, K, ld ? ld : K, ks}; pg8::StaticOrder S; S.init(Mrows, N, F.G, (int)(((unsigned)F.bx + (unsigned)rot) % (unsigned)F.G));
    if (need_rtab) build_rtab(F, S, xi, xpn0, xnt);
    pg8::gemm_phase<Epi, pg8::StaticOrder, true, true, PM, false, F16, AIMG>(F.lds + RING_OFF, g, S, E);
}

template <class Epi, bool F16 = false, bool AIMG = false> __device__ __forceinline__ void run_gemm_half(Frame& F, const bf16* A, const bf16* Bt, int Mrows, int N, int K, int pn0, int ntile, const Epi& E, bool need_rtab = true, int rot = 0) {
    pg8::Gemm g{A, Bt, Mrows, N, K, K, 1}; pg8::HalfOrder S; S.init(Mrows, pn0, ntile, F.G, (int)(((unsigned)F.bx + (unsigned)rot) % (unsigned)F.G));
    if (need_rtab) build_rtab(F, S);
    pg8::gemm_phase<Epi, pg8::HalfOrder, true, true, 0, true, F16, AIMG>(F.lds + RING_OFF, g, S, E);
}
__device__ __forceinline__ void normgate(Frame& F, const float* o, const bf16* gate, int nheads, const float* gw_, int ycol) {
    PHASE_IDS();
    bf16* Y = (bf16*)(F.ws + WS_Y);
    const int hw = lane >> 5, l32 = lane & 31, ld = nheads * HD, total = M * nheads;
    const int gw = (F.bx * NWAVES + wave) * 2 + hw, NGW = F.G * NWAVES * 2;
    const f32x4 g4 = *(const GAS f32x4*)(gw_ + 4 * l32);
    for (int u0 = gw; u0 < total; u0 += 4 * NGW) {
        f32x4 v[4]; pg8::u32x2 gt[4];
#pragma unroll
        for (int j = 0; j < 4; ++j) { const int un = u0 + j * NGW; if (un < total) { const int row = un / nheads, h = un - row * nheads;
            v[j] = *(const GAS f32x4*)(o + (size_t)row * ld + h * HD + 4 * l32); gt[j] = *(const GAS pg8::u32x2*)(gate + (size_t)row * ld + h * HD + 4 * l32); } else { v[j] = (f32x4){0.f, 0.f, 0.f, 0.f}; gt[j] = (pg8::u32x2){0u, 0u}; } }
#pragma unroll
        for (int j = 0; j < 4; ++j) { const int un = u0 + j * NGW;
            float ss = (v[j][0] * v[j][0] + v[j][1] * v[j][1]) + (v[j][2] * v[j][2] + v[j][3] * v[j][3]);
#pragma unroll
            for (int of = 1; of < 32; of <<= 1) ss += __shfl_xor(ss, of);
            const float rs = 1.0f / sqrtf(ss * (1.0f / HD) + EPS);
            if (un < total) { const int row = un / nheads, h = un - row * nheads; pg8::u32x2 w;
                w.x = pg8::cvt_pk_bf16(v[j][0] * rs * g4[0] * silu_acc(bflo(gt[j].x)), v[j][1] * rs * g4[1] * silu_acc(bfhi(gt[j].x))); w.y = pg8::cvt_pk_bf16(v[j][2] * rs * g4[2] * silu_acc(bflo(gt[j].y)), v[j][3] * rs * g4[3] * silu_acc(bfhi(gt[j].y)));
                *(GAS pg8::u32x2*)(Y + (size_t)row * D + ycol + h * HD + 4 * l32) = w; }
        }
    }
}
__device__ __forceinline__ void final_norm(Frame& F) {
    PHASE_IDS();
    static_assert(X_F16 == 2, "final_norm reads the fragment-ordered f16 residual plane");
    const GAS pg8::u32x4* xn = (const GAS pg8::u32x4*)(F.ws + WS_X); const GAS float* rowss = (const GAS float*)(F.ws + WS_ROWSS); const float* fg = FIN(I_FINALG);
    const int gw = F.bx * NWAVES + wave, NGW = F.G * NWAVES, fr = lane & 15, fq = lane >> 4;
    constexpr int NT = (M / 256) * (D / 256) * 64;
    for (int t0 = gw; t0 < NT; t0 += 2 * NGW) {
        pg8::u32x4 c0[2], c1[2]; float s[2]; int row[2], tt[2];
#pragma unroll
        for (int u = 0; u < 2; ++u) { const int t = t0 + u * NGW < NT ? t0 + u * NGW : t0; tt[u] = t;
            const int am = t & 7, wid = (t >> 3) & 7, U = t >> 6, pm = U / (D / 256), wr = wid >> 2;
            row[u] = pm * 256 + (am >> 2) * 128 + wr * 64 + (am & 3) * 16 + fr;
            c0[u] = xn[((size_t)t * 2 + 0) * 64 + lane]; c1[u] = xn[((size_t)t * 2 + 1) * 64 + lane];
            float a = 0.f;
#pragma unroll
            for (int k = 0; k < 8; ++k) a += rowss[(size_t)(fq * 8 + k) * M + row[u]];
            s[u] = a; }
#pragma unroll
        for (int u = 0; u < 2; ++u) { if (u == 1 && t0 + NGW >= NT) break;
            const int t = tt[u], wid = (t >> 3) & 7, U = t >> 6, pn = U % (D / 256), wc = wid & 3;
            float a = s[u]; a += __shfl_xor(a, 16); a += __shfl_xor(a, 32);
            const float rs = 1.0f / sqrtf(a * (1.0f / D) + EPS);
#pragma unroll
            for (int bj = 0; bj < 2; ++bj) { const pg8::u32x4 c = bj ? c1[u] : c0[u]; const int col = pn * 256 + bj * 128 + wc * 32 + 8 * fq;
                const f32x4 g0 = *(const GAS f32x4*)(fg + col), g1 = *(const GAS f32x4*)(fg + col + 4);
                const f32x4 x0 = {pg8::f16_lo(c.x), pg8::f16_hi(c.x), pg8::f16_lo(c.y), pg8::f16_hi(c.y)}, x1 = {pg8::f16_lo(c.z), pg8::f16_hi(c.z), pg8::f16_lo(c.w), pg8::f16_hi(c.w)};
                GAS f32x4* o = (GAS f32x4*)(F.out + (size_t)row[u] * D + col); o[0] = x0 * rs * g0; o[1] = x1 * rs * g1; }
        }
    }
}

namespace att {
typedef short s16x4 __attribute__((ext_vector_type(4)));
typedef short v4i16_t __attribute__((ext_vector_type(4)));
__device__ __forceinline__ unsigned swz(unsigned row) { return ((row & 3u) << 2) | ((row >> 2) & 3u); }
__device__ __forceinline__ void glds16(const void* gsrc, unsigned lds_dst) { unsigned keep;
    asm volatile("s_mov_b32 %0, m0\n\ts_mov_b32 m0, %2\n\ts_nop 0\n\tglobal_load_lds_dwordx4 %1, off\n\ts_mov_b32 m0, %0" : "=&s"(keep) : "v"(gsrc), "s"(lds_dst) : "memory"); }
__device__ __forceinline__ s16x4 vtr(const LAS char* p) { return __builtin_bit_cast(s16x4, __builtin_amdgcn_ds_read_tr16_b64_v4i16((LAS v4i16_t*)p)); }
__device__ __forceinline__ void stage_half(const char* g, size_t pitch, LAS char* img, int wave, int lane) {
#pragma unroll
    for (int p = 0; p < 4; ++p) {
        const int piece = 4 * wave + p; const unsigned row = 4u * piece + ((unsigned)lane >> 4), ch = ((unsigned)lane & 15u) ^ swz(row);
        glds16(g + (size_t)row * pitch + ch * 16u, (unsigned)__builtin_amdgcn_readfirstlane((unsigned)(size_t)(img + piece * 1024)));
    }
}
struct State { f32x4 o[2][8]; float m[2], l[2]; };
__device__ __forceinline__ void half_step(State& st, const bf16x8 (&qf)[2][4], const LAS char* Kimg, const LAS char* Vimg, int lane, int maskmode, int kbase, const int (&qidx)[2], const bool (&valid)[2]) {
    const unsigned fr = lane & 15, g = lane >> 4, q4 = fr >> 2, p = lane & 3;
    const unsigned fk = swz(fr);
    f32x4 s[2][8];
#pragma unroll
    for (int qt = 0; qt < 2; ++qt)
#pragma unroll
        for (int kt = 0; kt < 8; ++kt) s[qt][kt] = (f32x4){0.f, 0.f, 0.f, 0.f};
#define SB() __builtin_amdgcn_sched_barrier(0)
#define ATT_LDK(kt_, K_) do { _Pragma("unroll") for (int ks_ = 0; ks_ < 4; ++ks_) K_[ks_] = *(const LAS bf16x8*)(Kimg + 256u * (16u * (kt_) + fr) + 16u * ((4u * ks_ + g) ^ fk)); } while (0)
#define ATT_MMK(kt_, K_) do { _Pragma("unroll") for (int ks_ = 0; ks_ < 4; ++ks_) { s[0][kt_] = __builtin_amdgcn_mfma_f32_16x16x32_bf16(K_[ks_], qf[0][ks_], s[0][kt_], 0, 0, 0); s[1][kt_] = __builtin_amdgcn_mfma_f32_16x16x32_bf16(K_[ks_], qf[1][ks_], s[1][kt_], 0, 0, 0); } } while (0)
    {
        bf16x8 kA[4], kB[4];
        ATT_LDK(0, kA); SB();
        ATT_LDK(1, kB); SB(); ATT_MMK(0, kA); SB();
        ATT_LDK(2, kA); SB(); ATT_MMK(1, kB); SB();
        ATT_LDK(3, kB); SB(); ATT_MMK(2, kA); SB();
        ATT_LDK(4, kA); SB(); ATT_MMK(3, kB); SB();
        ATT_LDK(5, kB); SB(); ATT_MMK(4, kA); SB();
        ATT_LDK(6, kA); SB(); ATT_MMK(5, kB); SB();
        ATT_LDK(7, kB); SB(); ATT_MMK(6, kA); SB();
        ATT_MMK(7, kB); SB();
    }
#undef ATT_LDK
#undef ATT_MMK
    bf16x8 pf[2][4];
    if (maskmode == 1) {
#pragma unroll
        for (int qt = 0; qt < 2; ++qt)
#pragma unroll
            for (int kt = 0; kt < 8; ++kt)
#pragma unroll
                for (int r = 0; r < 4; ++r) if (kbase + 16 * kt + 4 * (int)g + r > qidx[qt]) s[qt][kt][r] = -INFINITY;
    }
#pragma unroll
    for (int qt = 0; qt < 2; ++qt) {
        float mx = -INFINITY;
#pragma unroll
        for (int kt = 0; kt < 8; ++kt)
#pragma unroll
            for (int r = 0; r < 4; ++r) mx = fmaxf(mx, s[qt][kt][r]);
        mx = fmaxf(mx, __shfl_xor(mx, 16)); mx = fmaxf(mx, __shfl_xor(mx, 32));
        if (!valid[qt]) mx = -INFINITY;
        const float mn = fmaxf(st.m[qt], mx);
        const float alpha = (st.m[qt] == -INFINITY) ? 0.f : __builtin_amdgcn_exp2f(st.m[qt] - mn);
        const float msub = (!valid[qt] || mn == -INFINITY) ? INFINITY : mn;
        st.m[qt] = mn;
        float sum = 0.f;
#pragma unroll
        for (int kt = 0; kt < 8; ++kt)
#pragma unroll
            for (int r = 0; r < 4; ++r) { const float pv = __builtin_amdgcn_exp2f(s[qt][kt][r] - msub); s[qt][kt][r] = pv; sum += pv; }
        st.l[qt] = st.l[qt] * alpha + sum;
        if (__any(alpha != 1.0f)) {
#pragma unroll
            for (int dt = 0; dt < 8; ++dt) st.o[qt][dt] = st.o[qt][dt] * alpha;
        }
#pragma unroll
        for (int ks = 0; ks < 4; ++ks) {
            pg8::u32x4 w; w.x = pg8::cvt_pk_bf16(s[qt][2 * ks][0], s[qt][2 * ks][1]); w.y = pg8::cvt_pk_bf16(s[qt][2 * ks][2], s[qt][2 * ks][3]);
            w.z = pg8::cvt_pk_bf16(s[qt][2 * ks + 1][0], s[qt][2 * ks + 1][1]); w.w = pg8::cvt_pk_bf16(s[qt][2 * ks + 1][2], s[qt][2 * ks + 1][3]);
            pf[qt][ks] = __builtin_bit_cast(bf16x8, w);
        }
    }
    const unsigned fv = (q4 << 2) | g;
#define ATT_LDV(dt_, V_) do { const unsigned vb_ = 256u * (4u * g + q4) + 16u * ((2u * (dt_) + (p >> 1)) ^ fv) + 8u * (p & 1u); _Pragma("unroll") for (int ks_ = 0; ks_ < 4; ++ks_) { \
        const s16x4 v0_ = vtr(Vimg + vb_ + 256u * (32u * ks_)), v1_ = vtr(Vimg + vb_ + 256u * (32u * ks_ + 16u)); bf16x8 t_; t_[0] = v0_[0]; t_[1] = v0_[1]; t_[2] = v0_[2]; t_[3] = v0_[3]; t_[4] = v1_[0]; t_[5] = v1_[1]; t_[6] = v1_[2]; t_[7] = v1_[3]; V_[ks_] = t_; } } while (0)
#define ATT_MMV(dt_, V_) do { _Pragma("unroll") for (int ks_ = 0; ks_ < 4; ++ks_) { st.o[0][dt_] = __builtin_amdgcn_mfma_f32_16x16x32_bf16(V_[ks_], pf[0][ks_], st.o[0][dt_], 0, 0, 0); st.o[1][dt_] = __builtin_amdgcn_mfma_f32_16x16x32_bf16(V_[ks_], pf[1][ks_], st.o[1][dt_], 0, 0, 0); } } while (0)
    {
        bf16x8 vA[4], vB[4];
        ATT_LDV(0, vA); SB();
        ATT_LDV(1, vB); SB(); ATT_MMV(0, vA); SB();
        ATT_LDV(2, vA); SB(); ATT_MMV(1, vB); SB();
        ATT_LDV(3, vB); SB(); ATT_MMV(2, vA); SB();
        ATT_LDV(4, vA); SB(); ATT_MMV(3, vB); SB();
        ATT_LDV(5, vB); SB(); ATT_MMV(4, vA); SB();
        ATT_LDV(6, vA); SB(); ATT_MMV(5, vB); SB();
        ATT_LDV(7, vB); SB(); ATT_MMV(6, vA); SB();
        ATT_MMV(7, vB); SB();
    }
#undef ATT_LDV
#undef ATT_MMV
#undef SB
}
}

template <int MODE>
__device__ __forceinline__ void attn_unit(Frame& F, int tid_in, int wave, int b, int h, int qblk, int l) {
    const int tid = opaque_i(tid_in), lane = tid & 63;
    LAS char* ring = (LAS char*)(F.lds + RING_OFF);
    LAS unsigned* sel = (LAS unsigned*)(F.lds + RTAB_OFF);
    const bf16* Qp; int ldq; bf16* Op; int ldo;
    if (MODE == 0) { Qp = (const bf16*)(F.ws + WS_XQ); ldq = XW; Op = (bf16*)(F.ws + WS_XO); ldo = XW; }
    else { Qp = (const bf16*)(F.ws + WS_QM); ldq = 1024; Op = (bf16*)(F.ws + WS_Y); ldo = D; }
    const int row0 = b * SEQ + qblk * 256;
    const unsigned fr = lane & 15, g = lane >> 4;
    int nsteps = 2;
    if (MODE == 1) {
        const float* kms = (const float*)(F.ws + WS_KMS);
        LAS float* km = (LAS float*)ring; LAS float* gl = (LAS float*)(ring + 8192);
        __syncthreads();
        for (int i = tid; i < qblk * 128; i += NWAVES * 64) { const int j = i >> 7, d = i & 127; const float* p0 = kms + (size_t)((b * NBLK + j) * 2) * 1024 + h * HD + d; km[i] = p0[0] + p0[1024]; }
        LDS_WAIT(); __syncthreads();
        {
            const int q = tid >> 1, par = tid & 1; float ga[8];
#pragma unroll
            for (int jj = 0; jj < 8; ++jj) ga[jj] = 0.f;
            const GAS v4u* qr = (const GAS v4u*)(Qp + (size_t)(row0 + q) * ldq + h * HD);
            for (int c = 0; c < 16; ++c) {
                const v4u w = qr[c]; const float q0 = bflo(w.x), q1 = bfhi(w.x), q2 = bflo(w.y), q3 = bfhi(w.y), q4 = bflo(w.z), q5 = bfhi(w.z), q6 = bflo(w.w), q7 = bfhi(w.w);
#pragma unroll
                for (int jj = 0; jj < 8; ++jj) { const int j = 2 * jj + par; if (j < qblk) { const f32x4 k0 = *(const LAS f32x4*)(km + j * 128 + 8 * c), k1 = *(const LAS f32x4*)(km + j * 128 + 8 * c + 4);
                    ga[jj] += (q0 * k0[0] + q1 * k0[1]) + (q2 * k0[2] + q3 * k0[3]) + (q4 * k1[0] + q5 * k1[1]) + (q6 * k1[2] + q7 * k1[3]); } }
            }
#pragma unroll
            for (int jj = 0; jj < 8; ++jj) gl[q * 16 + 2 * jj + par] = ga[jj];
        }
        LDS_WAIT(); __syncthreads();
        if (tid < 256) {
            float v1 = -INFINITY, v2 = -INFINITY, v3 = -INFINITY; int i1 = -1, i2 = -1, i3 = -1;
            for (int j = 0; j < qblk; ++j) { const float gj = gl[tid * 16 + j];
                if (gj > v1) { v3 = v2; i3 = i2; v2 = v1; i2 = i1; v1 = gj; i1 = j; } else if (gj > v2) { v3 = v2; i3 = i2; v2 = gj; i2 = j; } else if (gj > v3) { v3 = gj; i3 = j; } }
            unsigned mbits = 1u << qblk; if (i1 >= 0) mbits |= 1u << i1; if (i2 >= 0) mbits |= 1u << i2; if (i3 >= 0) mbits |= 1u << i3;
            sel[tid] = mbits;
        }
        LDS_WAIT(); __syncthreads();
        nsteps = 2 * (qblk + 1);
    } else { __syncthreads(); }
    bf16x8 qf[2][4]; int qidx[2]; unsigned selq[2];
#pragma unroll
    for (int qt = 0; qt < 2; ++qt) {
        qidx[qt] = 32 * wave + 16 * qt + (int)fr; selq[qt] = MODE == 1 ? sel[qidx[qt]] : 0u;
        const bf16* qrow = Qp + (size_t)(row0 + qidx[qt]) * ldq + h * HD;
#pragma unroll
        for (int ks = 0; ks < 4; ++ks) qf[qt][ks] = *(const GAS bf16x8*)(qrow + 32 * ks + 8 * g);
    }
    att::State st;
#pragma unroll
    for (int qt = 0; qt < 2; ++qt) { st.m[qt] = -INFINITY; st.l[qt] = 0.f;
#pragma unroll
        for (int dt = 0; dt < 8; ++dt) st.o[qt][dt] = (f32x4){0.f, 0.f, 0.f, 0.f}; }
    const size_t pitch = MODE == 0 ? (size_t)4096 * 2 : (size_t)1024 * 2;
#define KBASE_OF(i) (MODE == 0 ? (const char*)((const bf16*)(F.ws + WS_KV) + (size_t)(b * MEMT + (i) * 128) * 4096 + l * 1024 + h * HD) \
                               : (const char*)((const bf16*)(F.ws + WS_KM) + (size_t)(b * SEQ + ((i) < 2 ? qblk : (((i) - 2) >> 1)) * 256 + ((i) & 1) * 128) * 1024 + h * HD))
#define VBASE_OF(i) (MODE == 0 ? (const char*)((const bf16*)(F.ws + WS_KV) + (size_t)(b * MEMT + (i) * 128) * 4096 + l * 1024 + 512 + h * HD) \
                               : (const char*)((const bf16*)(F.ws + WS_VM) + (size_t)(b * SEQ + ((i) < 2 ? qblk : (((i) - 2) >> 1)) * 256 + ((i) & 1) * 128) * 1024 + h * HD))
    att::stage_half(KBASE_OF(0), pitch, ring, wave, lane); att::stage_half(VBASE_OF(0), pitch, ring + 32768, wave, lane);
    VM_WAIT(); __syncthreads();
    for (int i = 0; i < nsteps; ++i) {
        LAS char* cur = ring + (i & 1) * 65536; LAS char* nxt = ring + ((i + 1) & 1) * 65536;
        const int ln = opaque_i(lane);
        if (i + 1 < nsteps) { att::stage_half(KBASE_OF(i + 1), pitch, nxt, wave, ln); att::stage_half(VBASE_OF(i + 1), pitch, nxt + 32768, wave, ln); }
        bool valid[2] = {true, true}; int maskmode = 0; bool run = true;
        if (MODE == 1) {
            if (i < 2) { maskmode = 1; if (i == 1 && wave < 4) run = false; }
            else { const int blk = (i - 2) >> 1; valid[0] = (selq[0] >> blk) & 1u; valid[1] = (selq[1] >> blk) & 1u; run = __any((int)(valid[0] || valid[1])) != 0; }
        }
        if (run) att::half_step(st, qf, cur, cur + 32768, opaque_i(ln), maskmode, (i & 1) * 128, qidx, valid);
        VM_WAIT(); __syncthreads();
    }
#pragma unroll
    for (int qt = 0; qt < 2; ++qt) {
        float lt = st.l[qt]; lt += __shfl_xor(lt, 16); lt += __shfl_xor(lt, 32);
        const float inv = 1.0f / lt;
        bf16* orow = Op + (size_t)(row0 + qidx[qt]) * ldo + h * HD + 4 * g;
#pragma unroll
        for (int dt = 0; dt < 8; ++dt) { pg8::u32x2 w; w.x = pg8::cvt_pk_bf16(st.o[qt][dt][0] * inv, st.o[qt][dt][1] * inv); w.y = pg8::cvt_pk_bf16(st.o[qt][dt][2] * inv, st.o[qt][dt][3] * inv); *(GAS pg8::u32x2*)(orow + 16 * dt) = w; }
    }
}
#undef KBASE_OF
#undef VBASE_OF
__device__ __forceinline__ void moba_phase(Frame& F, int blk0) {
    if (F.bx < blk0) return;
    PHASE_IDS();
    const int nb = F.G - blk0;
    for (int pr = F.bx - blk0; pr < BATCH * NH_AB * 8; pr += nb) {
        const int bh = pr >> 3, k = pr & 7, b = bh >> 3, h = bh & 7;
        for (int rep = 0; rep < 2; ++rep) attn_unit<1>(F, tid, wave, b, h, rep ? k : 15 - k, 0);
    }
}
__device__ __forceinline__ void xattn_phase(Frame& F, int l) {
    PHASE_IDS();
    for (int un = F.bx; un < BATCH * 4 * (SEQ / 256); un += F.G) {
        const int qblk = un & 15, bh = un >> 4, b = bh >> 2, h = bh & 3;
        attn_unit<0>(F, tid, wave, b, h, qblk, l);
    }
}

constexpr size_t WS_UT = WS_MIX + 114 * MiB, WS_WT = WS_MIX + 146 * MiB, WS_QDT = WS_MIX + 162 * MiB, WS_KD = WS_MIX + 178 * MiB, WS_AQK = WS_MIX + 194 * MiB, WS_GL = WS_MIX + 202 * MiB;
namespace dn {
typedef short s16x4 __attribute__((ext_vector_type(4)));
__device__ __forceinline__ unsigned swz8(unsigned row) { return (row >> 1) & 7u; }
__device__ __forceinline__ s16x4 pack4(const f32x4& v) { pg8::u32x2 w; w.x = pg8::cvt_pk_bf16(v[0], v[1]); w.y = pg8::cvt_pk_bf16(v[2], v[3]); return __builtin_bit_cast(s16x4, w); }
__device__ __forceinline__ f32x4 unpack4(const s16x4& v) { const pg8::u32x2 w = __builtin_bit_cast(pg8::u32x2, v); return (f32x4){bflo(w.x), bfhi(w.x), bflo(w.y), bfhi(w.y)}; }
__device__ __forceinline__ bf16x8 join8(const s16x4& a, const s16x4& b) { bf16x8 r; r[0] = a[0]; r[1] = a[1]; r[2] = a[2]; r[3] = a[3]; r[4] = b[0]; r[5] = b[1]; r[6] = b[2]; r[7] = b[3]; return r; }
constexpr int MPITCH = 68, DPITCH = 20;
}

__device__ __forceinline__ void dn_chunk_phase(Frame& F, int e) {
    PHASE_IDS();
    LAS char* ring = (LAS char*)(F.lds + RING_OFF);
    LAS char* QI = ring; LAS char* KI = ring + 16384; LAS char* VI = ring + 32768;
    LAS float* MI = (LAS float*)(ring + 49152);
    LAS float* DI = (LAS float*)(ring + 49152 + 64 * dn::MPITCH * 4);
    LAS float* TG = DI + 4 * 16 * dn::DPITCH; LAS float* TB = TG + 64; LAS float* SSQ = (LAS float*)(F.lds + RTAB_OFF);
    LAS char* CWL = ring + 72192;
    LAS char* SLAB = ring + 78848;
#define DN_SLAB(ci_) do { const int n_ = (ci_) & 63, bh_ = (ci_) >> 6, h_ = bh_ & 7, b_ = bh_ >> 3; const long rb_ = (long)b_ * SEQ + n_ * 64; const int ln_ = opaque_i(lane);        \
        _Pragma("unroll") for (int k_ = 0; k_ < 7; ++k_) { const int q_ = wave + 8 * k_; if (q_ < 51) { const int P_ = q_ * 64 + ln_; int rp_ = P_ >> 4; rp_ = rp_ > 200 ? 200 : rp_; const int tok_ = rp_ / 3, sec_ = rp_ - 3 * tok_; \
            const long row_ = (n_ == 0 && tok_ < 3) ? rb_ : rb_ + tok_ - 3; \
            att::glds16(pre + (size_t)row_ * 3072 + sec_ * 1024 + h_ * HD + 8 * (P_ & 15), (unsigned)__builtin_amdgcn_readfirstlane((unsigned)(size_t)(SLAB + q_ * 1024))); } } \
        if (wave < 6) { const int P_ = wave * 64 + ln_, rp_ = P_ >> 5, i_ = rp_ / 3, sec_ = rp_ - 3 * i_;        \
            att::glds16(cw + i_ * 3072 + sec_ * 1024 + h_ * HD + 4 * (P_ & 31), (unsigned)__builtin_amdgcn_readfirstlane((unsigned)(size_t)(CWL + wave * 1024))); } } while (0)
    const bf16* pre = (const bf16*)(F.ws + WS_DNPRE); const float* ba = (const float*)(F.ws + WS_BA); const float* cw = FIN(I_AB_CONVW) + (size_t)e * 4 * 3072;
    const unsigned fr = lane & 15, g = lane >> 4, q4 = fr >> 2, p = lane & 3;
    if (F.bx < BATCH * NH_AB * (SEQ / 64)) DN_SLAB(F.bx);
    for (int ci = F.bx; ci < BATCH * NH_AB * (SEQ / 64); ci += F.G) {
        const int n = ci & 63, bh = ci >> 6, h = bh & 7, b = bh >> 3; const size_t rbase = (size_t)b * SEQ + n * 64;
        float* uT = (float*)(F.ws + WS_UT) + (size_t)ci * 8192; bf16* wT = (bf16*)(F.ws + WS_WT) + (size_t)ci * 8192; bf16* qdT = (bf16*)(F.ws + WS_QDT) + (size_t)ci * 8192;
        bf16* kd = (bf16*)(F.ws + WS_KD) + (size_t)ci * 8192; bf16* aqk = (bf16*)(F.ws + WS_AQK) + (size_t)ci * 4096;
        VM_WAIT(); __syncthreads();
        float braw_ = 0.f, araw_ = 0.f, alog_ = 0.f;
        if (tid < 64) { braw_ = ba[(rbase + tid) * 16 + h]; araw_ = ba[(rbase + tid) * 16 + 8 + h] + FIN(I_AB_DTB)[e * 8 + h]; alog_ = FIN(I_AB_ALOG)[e * 8 + h]; }
        float val[6][8];
        v4u wpre[6][4];
#pragma unroll
        for (int it = 0; it < 6; ++it) {
            const int sec = it >> 1, c = (tid >> 4) + 32 * (it & 1), gq = tid & 15, ch = sec * 1024 + h * HD + 8 * gq, t = n * 64 + c;
#pragma unroll
            for (int i = 0; i < 4; ++i) wpre[it][i] = *(const LAS v4u*)(SLAB + (((c + i) * 3 + sec) * 16 + gq) * 16);
        }
#pragma unroll
        for (int it = 0; it < 6; ++it) {
            const int sec = it >> 1, c = (tid >> 4) + 32 * (it & 1), gq = tid & 15, ch = sec * 1024 + h * HD + 8 * gq, t = n * 64 + c;
#pragma unroll
            for (int j = 0; j < 8; ++j) val[it][j] = 0.f;
#pragma unroll
            for (int i = 0; i < 4; ++i) {
                const f32x4 c0 = *(const LAS f32x4*)(CWL + (i * 3 + sec) * 512 + gq * 32), c1 = *(const LAS f32x4*)(CWL + (i * 3 + sec) * 512 + gq * 32 + 16);
                if (t - 3 + i >= 0) {
                    const v4u w = wpre[it][i];
                    val[it][0] += c0[0] * bflo(w.x); val[it][1] += c0[1] * bfhi(w.x); val[it][2] += c0[2] * bflo(w.y); val[it][3] += c0[3] * bfhi(w.y);
                    val[it][4] += c1[0] * bflo(w.z); val[it][5] += c1[1] * bfhi(w.z); val[it][6] += c1[2] * bflo(w.w); val[it][7] += c1[3] * bfhi(w.w);
                }
            }
            float ss = 0.f;
#pragma unroll
            for (int j = 0; j < 8; ++j) { val[it][j] = pg8::silu_f(val[it][j]); ss += val[it][j] * val[it][j]; }
            if (sec < 2) SSQ[(c * 2 + sec) * 16 + gq] = ss;
        }
        if (tid < 64) {
            const float braw = braw_, araw = araw_;
            const float ea = __expf(araw); const float sp = araw > 20.f ? araw : (ea < 1e-3f ? ea * (1.0f - 0.5f * ea) : __logf(1.0f + ea));
            float gg = -__expf(alog_) * sp;
#pragma unroll
            for (int o = 1; o < 64; o <<= 1) { const float t2 = __shfl_up(gg, o); if (lane >= o) gg += t2; }
            TG[tid] = gg; TB[tid] = sigmoid_f(braw);
        }
        LDS_WAIT(); __syncthreads();
        if (ci + F.G < BATCH * NH_AB * (SEQ / 64)) DN_SLAB(ci + F.G);
#pragma unroll
        for (int it = 0; it < 6; ++it) {
            const int sec = it >> 1, c = (tid >> 4) + 32 * (it & 1), gq = tid & 15; float sc = 1.0f;
            if (sec < 2) { float s = 0.f;
#pragma unroll
                for (int j = 0; j < 4; ++j) { const f32x4 q = *(const LAS f32x4*)(SSQ + (c * 2 + sec) * 16 + 4 * j); s += (q[0] + q[1]) + (q[2] + q[3]); }
                sc = (1.0f / sqrtf(s + EPS)) * (sec == 0 ? 0.08838834764831845f : 1.0f); }
            LAS char* img = sec == 0 ? QI : (sec == 1 ? KI : VI);
            v4u w; w.x = pg8::cvt_pk_bf16(val[it][0] * sc, val[it][1] * sc); w.y = pg8::cvt_pk_bf16(val[it][2] * sc, val[it][3] * sc); w.z = pg8::cvt_pk_bf16(val[it][4] * sc, val[it][5] * sc); w.w = pg8::cvt_pk_bf16(val[it][6] * sc, val[it][7] * sc);
            *(LAS v4u*)(img + 256 * c + 16 * ((unsigned)gq ^ att::swz((unsigned)c))) = w;
        }
        if (tid < 384) { const int pr = tid >> 6, ctz = pr < 3 ? 0 : (pr < 5 ? 1 : 2), stz = pr < 3 ? pr + 1 : (pr < 5 ? pr - 1 : 3), cz = 16 * ctz + ((tid & 63) >> 2), gz = tid & 3;
            *(GAS pg8::u32x2*)(aqk + cz * 64 + 32 * (stz >> 1) + 8 * gz + 4 * (stz & 1)) = (pg8::u32x2){0u, 0u}; }
        LDS_WAIT(); __syncthreads();
        for (int jb = wave; jb < 20; jb += NWAVES) {
            const int ty = jb >= 10 ? 1 : 0, ti = jb - 10 * ty; int ct = 0, st = ti;
            if (ti >= 6) { ct = 3; st = ti - 6; } else if (ti >= 3) { ct = 2; st = ti - 3; } else if (ti >= 1) { ct = 1; st = ti - 1; }
            f32x4 acc = {0.f, 0.f, 0.f, 0.f};
            if (ty == 0) {
#pragma unroll
                for (int ks = 0; ks < 4; ++ks) { const bf16x8 a = *(const LAS bf16x8*)(KI + 256u * (16u * ct + fr) + 16u * ((4u * ks + g) ^ att::swz(fr))), bb = *(const LAS bf16x8*)(KI + 256u * (16u * st + fr) + 16u * ((4u * ks + g) ^ att::swz(fr)));
                    acc = __builtin_amdgcn_mfma_f32_16x16x32_bf16(a, bb, acc, 0, 0, 0); }
                const int s = 16 * st + (int)fr; const float gs = TG[s];
#pragma unroll
                for (int r = 0; r < 4; ++r) { const int c = 16 * ct + 4 * (int)g + r; MI[c * dn::MPITCH + s] = s < c ? acc[r] * TB[c] * __expf(TG[c] - gs) : 0.f; }
            } else {
#pragma unroll
                for (int ks = 0; ks < 4; ++ks) { const bf16x8 a = *(const LAS bf16x8*)(KI + 256u * (16u * st + fr) + 16u * ((4u * ks + g) ^ att::swz(fr))), bb = *(const LAS bf16x8*)(QI + 256u * (16u * ct + fr) + 16u * ((4u * ks + g) ^ att::swz(fr)));
                    acc = __builtin_amdgcn_mfma_f32_16x16x32_bf16(a, bb, acc, 0, 0, 0); }
                const int c = 16 * ct + (int)fr; const float gc = TG[c]; f32x4 o;
#pragma unroll
                for (int r = 0; r < 4; ++r) { const int s = 16 * st + 4 * (int)g + r; o[r] = s <= c ? acc[r] * __expf(gc - TG[s]) : 0.f; }
                *(GAS dn::s16x4*)(aqk + c * 64 + 32 * (st >> 1) + 8 * g + 4 * (st & 1)) = dn::pack4(o);
            }
        }
        LDS_WAIT(); __syncthreads();
        if (wave == 0) {
            const int i = g, j = fr; float dc[16]; f32x4 mr[16][4];
            dc[0] = (j == 0) ? 1.f : 0.f;
#pragma unroll
            for (int r = 1; r < 9; ++r)
#pragma unroll
                for (int q = 0; q < 4; ++q) if (4 * q < r) mr[r][q] = *(const LAS f32x4*)(MI + (16 * i + r) * dn::MPITCH + 16 * i + 4 * q);
#pragma unroll
            for (int r = 1; r < 9; ++r)
#pragma unroll
                for (int q = 0; q < 4; ++q) if (4 * q < r) asm volatile("" : "+v"(mr[r][q]));
#pragma unroll
            for (int r = 1; r < 9; ++r) { float a = (r == j) ? 1.f : 0.f;
#pragma unroll
                for (int s = 0; s < r; ++s) a -= mr[r][s >> 2][s & 3] * dc[s];
                dc[r] = a; }
#pragma unroll
            for (int r = 9; r < 16; ++r)
#pragma unroll
                for (int q = 0; q < 4; ++q) if (4 * q < r) mr[r][q] = *(const LAS f32x4*)(MI + (16 * i + r) * dn::MPITCH + 16 * i + 4 * q);
#pragma unroll
            for (int r = 9; r < 16; ++r)
#pragma unroll
                for (int q = 0; q < 4; ++q) if (4 * q < r) asm volatile("" : "+v"(mr[r][q]));
#pragma unroll
            for (int r = 9; r < 16; ++r) { float a = (r == j) ? 1.f : 0.f;
#pragma unroll
                for (int s = 0; s < r; ++s) a -= mr[r][s >> 2][s & 3] * dc[s];
                dc[r] = a; }
#pragma unroll
            for (int r = 0; r < 16; ++r) DI[(i * 16 + r) * dn::DPITCH + j] = dc[r];
        }
        LDS_WAIT(); __syncthreads();
#pragma unroll
        for (int job = 0; job < 2; ++job) {
            const LAS char* img = job ? KI : VI; dn::s16x4 xb[4];
#pragma unroll
            for (int i = 0; i < 4; ++i) {
                const unsigned row = 16u * i + 4u * g + q4;
                const dn::s16x4 raw = att::vtr(img + 256u * row + 16u * ((2u * wave + (p >> 1)) ^ att::swz(row)) + 8u * (p & 1u));
                f32x4 acc = dn::unpack4(raw);
#pragma unroll
                for (int r = 0; r < 4; ++r) { const int c = 16 * i + 4 * (int)g + r; acc[r] *= job ? TB[c] * __expf(TG[c]) : TB[c]; }
#pragma unroll
                for (int j = 0; j < 4; ++j) { if (j < i) { const f32x4 mm = *(const LAS f32x4*)(MI + (16 * i + (int)fr) * dn::MPITCH + 16 * j + 4 * (int)g);
                    acc = __builtin_amdgcn_mfma_f32_16x16x16bf16_1k(dn::pack4(-mm), xb[j], acc, 0, 0, 0); } }
                const f32x4 dd = *(const LAS f32x4*)(DI + (16 * i + (int)fr) * dn::DPITCH + 4 * (int)g);
                const f32x4 x = __builtin_amdgcn_mfma_f32_16x16x16bf16_1k(dn::pack4(dd), dn::pack4(acc), (f32x4){0.f, 0.f, 0.f, 0.f}, 0, 0, 0);
                xb[i] = dn::pack4(x);
                if (job == 0) *(GAS f32x4*)(uT + (16 * wave + (int)fr) * 64 + 16 * i + 4 * (int)g) = x;
                else *(GAS dn::s16x4*)(wT + (16 * wave + (int)fr) * 64 + 16 * i + 4 * (int)g) = dn::pack4(-x);
            }
        }
#pragma unroll
        for (int i = 0; i < 4; ++i) {
            const unsigned row = 16u * i + 4u * g + q4;
            f32x4 qv = dn::unpack4(att::vtr(QI + 256u * row + 16u * ((2u * wave + (p >> 1)) ^ att::swz(row)) + 8u * (p & 1u)));
#pragma unroll
            for (int r = 0; r < 4; ++r) qv[r] *= __expf(TG[16 * i + 4 * (int)g + r]);
            *(GAS dn::s16x4*)(qdT + (16 * wave + (int)fr) * 64 + 16 * i + 4 * (int)g) = dn::pack4(qv);
        }
        {
            const float glast = TG[63];
#pragma unroll
            for (int it = 0; it < 2; ++it) { const int item = tid + 512 * it, s = item >> 4, ch = item & 15; const float sc = __expf(glast - TG[s]);
                const v4u w = *(const LAS v4u*)(KI + 256 * s + 16 * ((unsigned)ch ^ att::swz((unsigned)s)));
                v4u o; o.x = pg8::cvt_pk_bf16(bflo(w.x) * sc, bfhi(w.x) * sc); o.y = pg8::cvt_pk_bf16(bflo(w.y) * sc, bfhi(w.y) * sc); o.z = pg8::cvt_pk_bf16(bflo(w.z) * sc, bfhi(w.z) * sc); o.w = pg8::cvt_pk_bf16(bflo(w.w) * sc, bfhi(w.w) * sc);
                *(GAS v4u*)(kd + s * 128 + 8 * ch) = o; }
            if (tid == 0) ((float*)(F.ws + WS_GL))[ci] = __expf(glast);
        }
    }
#undef DN_SLAB
    __syncthreads();
}

#ifndef DN_TAIL_NORMGATE
#define DN_TAIL_NORMGATE 1
#endif
constexpr int CW_CHAIN = 8192;
__device__ __forceinline__ void chain_sync(Frame& F, gu32* word, unsigned want) {
    asm volatile("s_waitcnt vmcnt(0)" ::: "memory");
    __syncthreads();
    if (threadIdx.x == 0) {
        __builtin_amdgcn_fence(__ATOMIC_RELEASE, "agent"); asm volatile("s_waitcnt vmcnt(0)" ::: "memory");
        __hip_atomic_fetch_add(word, 1u, RLX_AGENT);
        unsigned sp = 0u;
        while (__hip_atomic_load(word, RLX_AGENT) < want) { __builtin_amdgcn_s_sleep(1); if (++sp > (1u << 22)) break; }
        __builtin_amdgcn_fence(__ATOMIC_ACQUIRE, "agent"); asm volatile("s_waitcnt vmcnt(0)" ::: "memory");
    }
    __syncthreads();
}
constexpr int NG_ = 8;
__device__ __forceinline__ void normgate_rows(Frame& F, const float* o, const bf16* gate, int nheads, const float* gw_, int ycol, int r0, int nr, int h) {
    PHASE_IDS();
    bf16* Y = (bf16*)(F.ws + WS_Y);
    const int hw = lane >> 5, l32 = lane & 31, ld = nheads * HD, hid = wave * 2 + hw;
    const f32x4 g4 = *(const GAS f32x4*)(gw_ + 4 * l32);
    for (int u0 = hid; u0 < nr; u0 += NG_ * 2 * NWAVES) {
        f32x4 v[NG_]; pg8::u32x2 gt[NG_];
#pragma unroll
        for (int j = 0; j < NG_; ++j) { const int un = u0 + j * 2 * NWAVES; if (un < nr) { const size_t row = (size_t)(r0 + un);
            v[j] = *(const GAS f32x4*)(o + row * ld + h * HD + 4 * l32); gt[j] = *(const GAS pg8::u32x2*)(gate + row * ld + h * HD + 4 * l32); } else { v[j] = (f32x4){0.f, 0.f, 0.f, 0.f}; gt[j] = (pg8::u32x2){0u, 0u}; } }
#pragma unroll
        for (int j = 0; j < NG_; ++j) { const int un = u0 + j * 2 * NWAVES;
            float ss = (v[j][0] * v[j][0] + v[j][1] * v[j][1]) + (v[j][2] * v[j][2] + v[j][3] * v[j][3]);
#pragma unroll
            for (int of = 1; of < 32; of <<= 1) ss += __shfl_xor(ss, of);
            const float rs = 1.0f / sqrtf(ss * (1.0f / HD) + EPS);
            if (un < nr) { const size_t row = (size_t)(r0 + un); pg8::u32x2 w;
                w.x = pg8::cvt_pk_bf16(v[j][0] * rs * g4[0] * silu_acc(bflo(gt[j].x)), v[j][1] * rs * g4[1] * silu_acc(bfhi(gt[j].x))); w.y = pg8::cvt_pk_bf16(v[j][2] * rs * g4[2] * silu_acc(bflo(gt[j].y)), v[j][3] * rs * g4[3] * silu_acc(bfhi(gt[j].y)));
                *(GAS pg8::u32x2*)(Y + row * D + ycol + h * HD + 4 * l32) = w; }
        }
    }
}
constexpr int CW_NGQ = 8192 + 128 * 16;
__device__ __forceinline__ void ng_help(Frame& F, int e) {
    PHASE_IDS();
    constexpr int SPL = 4, NCH = BATCH * NH_AB, TPC = 16, ROWS = SEQ / TPC;
    gu32* q = F.ctl + CW_NGQ + e * 16;
    for (;;) {
        unsigned tk = 0u; if (tid == 0) tk = __hip_atomic_fetch_add(q, 1u, RLX_AGENT);
        const unsigned t = cq_bcast(F, tk, tid);
        if (t >= (unsigned)(NCH * TPC)) break;
        const int bh = (int)t / TPC, k = (int)t % TPC, h = bh & 7, b = bh >> 3;
        if (tid == 0) { gu32* w = F.ctl + CW_CHAIN + (e * NCH + bh) * 16; unsigned sp = 0u;
            while (__hip_atomic_load(w, RLX_AGENT) < (unsigned)SPL) { __builtin_amdgcn_s_sleep(1); if (++sp > (1u << 22)) break; }
            __builtin_amdgcn_fence(__ATOMIC_ACQUIRE, "agent"); asm volatile("s_waitcnt vmcnt(0)" ::: "memory"); }
        __syncthreads();
        normgate_rows(F, (const float*)(F.ws + WS_DNO), (const bf16*)(F.ws + WS_DNGATE), NH_AB, FIN(I_AB_ONG) + e * HD, 1024, b * SEQ + k * ROWS, ROWS, h);
    }
}
template <int PM>
__device__ __forceinline__ void dn_scan_phase(Frame& F, int e) {
    constexpr int SPL = 4, NCH = BATCH * NH_AB;
    if (F.bx >= SPL * NCH) return;
    PHASE_IDS();
    const int bh = F.bx % NCH, part = F.bx / NCH, h = bh & 7, b = bh >> 3;
    const int dvt = (8 / SPL) * part + (wave & (8 / SPL - 1)); const bool active = wave < 8 / SPL;
    const int rot = part * (56 / SPL);
    LAS char* ring = (LAS char*)(F.lds + RING_OFF);
    constexpr int STG = 57344;
    const char* gWT = (const char*)(F.ws + WS_WT) + (size_t)bh * 64 * 16384; const char* gQD = (const char*)(F.ws + WS_QDT) + (size_t)bh * 64 * 16384;
    const char* gKD = (const char*)(F.ws + WS_KD) + (size_t)bh * 64 * 16384; const char* gAQ = (const char*)(F.ws + WS_AQK) + (size_t)bh * 64 * 8192;
    const float* gUT = (const float*)(F.ws + WS_UT) + (size_t)bh * 64 * 8192; const float* gGL = (const float*)(F.ws + WS_GL) + bh * 64;
    float* dno = (float*)(F.ws + (PM == 0 ? WS_DNO : WS_ACT));
#define DN_STAGE(n_, stg_) do { _Pragma("unroll") for (int pi_ = 0; pi_ < 7; ++pi_) { int pc_ = 7 * wave + pi_ + rot; pc_ -= pc_ >= 56 ? 56 : 0; const char* src_; \
        if (pc_ < 32 || pc_ >= 48) { const int q_ = pc_ < 16 ? pc_ : (pc_ < 32 ? pc_ - 16 : pc_ - 48); const unsigned row_ = 8u * q_ + ((unsigned)ln >> 3), ch_ = ((unsigned)ln & 7u) ^ dn::swz8(row_); \
            src_ = (pc_ < 16 ? gWT + (size_t)(n_) * 16384 : (pc_ < 32 ? gQD + (size_t)(n_) * 16384 : gAQ + (size_t)(n_) * 8192)) + row_ * 128u + ch_ * 16u; } \
        else { const int q_ = pc_ - 32; const unsigned row_ = 4u * q_ + ((unsigned)ln >> 4), ch_ = ((unsigned)ln & 15u) ^ att::swz(row_); src_ = gKD + (size_t)(n_) * 16384 + row_ * 256u + ch_ * 16u; } \
        att::glds16(src_, (unsigned)__builtin_amdgcn_readfirstlane((unsigned)(size_t)((stg_) + pc_ * 1024))); } } while (0)
    f32x4 S[8]; bf16x8 Sb[4];
#pragma unroll
    for (int dt = 0; dt < 8; ++dt) S[dt] = (f32x4){0.f, 0.f, 0.f, 0.f};
#pragma unroll
    for (int ks = 0; ks < 4; ++ks) Sb[ks] = (bf16x8){0, 0, 0, 0, 0, 0, 0, 0};
    { const int ln = lane; DN_STAGE(0, ring); }
    f32x4 un[4]; const int glbits = __float_as_int(gGL[lane]);
#pragma unroll
    for (int mt = 0; mt < 4; ++mt) un[mt] = *(const GAS f32x4*)(gUT + (16 * dvt + (lane & 15)) * 64 + 16 * mt + 4 * (lane >> 4));
    VM_WAIT(); __syncthreads();
    for (int n = 0; n < SEQ / 64; ++n) {
        LAS char* cur = ring + (n & 1) * STG; LAS char* nxt = ring + ((n + 1) & 1) * STG;
        const int ln = opaque_i(lane);
        asm volatile("" : "+v"(un[0]), "+v"(un[1]), "+v"(un[2]), "+v"(un[3]));
        f32x4 vn[4];
#pragma unroll
        for (int mt = 0; mt < 4; ++mt) vn[mt] = un[mt];
        if (PM != 1 && n + 1 < SEQ / 64) DN_STAGE(n + 1, nxt);
        const unsigned fr = ln & 15, g = (unsigned)ln >> 4, q4 = fr >> 2, p = ln & 3;
        const LAS char* WI = cur; const LAS char* QDI = cur + 16384; const LAS char* KDI = cur + 32768; const LAS char* AQI = cur + 49152;
        if (active && PM != 2) {
        const float gl = __int_as_float(__builtin_amdgcn_readlane(glbits, n));
        f32x4 oo[4];
#pragma unroll
        for (int mt = 0; mt < 4; ++mt) oo[mt] = (f32x4){0.f, 0.f, 0.f, 0.f};
        if (n + 1 < SEQ / 64) {
#pragma unroll
            for (int mt = 0; mt < 4; ++mt) un[mt] = *(const GAS f32x4*)(gUT + (size_t)(n + 1) * 8192 + (16 * dvt + (int)fr) * 64 + 16 * mt + 4 * (int)g);
        }
#define SB() __builtin_amdgcn_sched_barrier(0)
        const unsigned sw8 = (2u * g + (q4 >> 1)) & 7u, fv = (q4 << 2) | g;
#define DN_LD_WQ(mt_, W_, Q_) do { _Pragma("unroll") for (int ks_ = 0; ks_ < 4; ++ks_) { const unsigned r0_ = 32u * ks_ + 4u * g + q4, cb_ = 16u * ((2u * (mt_) + (p >> 1)) ^ sw8) + 8u * (p & 1u); \
            W_[ks_] = dn::join8(att::vtr(WI + 128u * r0_ + cb_), att::vtr(WI + 128u * (r0_ + 16u) + cb_)); Q_[ks_] = dn::join8(att::vtr(QDI + 128u * r0_ + cb_), att::vtr(QDI + 128u * (r0_ + 16u) + cb_)); } } while (0)
#define DN_MM_WQ(mt_, W_, Q_) do { _Pragma("unroll") for (int ks_ = 0; ks_ < 4; ++ks_) { vn[mt_] = __builtin_amdgcn_mfma_f32_16x16x32_bf16(W_[ks_], Sb[ks_], vn[mt_], 0, 0, 0); oo[mt_] = __builtin_amdgcn_mfma_f32_16x16x32_bf16(Q_[ks_], Sb[ks_], oo[mt_], 0, 0, 0); } } while (0)
#define DN_LD_KD(d0_, K_) do { _Pragma("unroll") for (int dd_ = 0; dd_ < 4; ++dd_) _Pragma("unroll") for (int k2_ = 0; k2_ < 2; ++k2_) { const unsigned r0_ = 32u * k2_ + 4u * g + q4, cb_ = 16u * ((2u * ((d0_) + dd_) + (p >> 1)) ^ fv) + 8u * (p & 1u); \
            K_[dd_][k2_] = dn::join8(att::vtr(KDI + 256u * r0_ + cb_), att::vtr(KDI + 256u * (r0_ + 16u) + cb_)); } } while (0)
        bf16x8 wA[4], qA[4], wB[4], qB[4], af[4][2], kA[4][2], kB[4][2];
        DN_LD_WQ(0, wA, qA); SB();
        DN_LD_WQ(1, wB, qB); SB(); DN_MM_WQ(0, wA, qA); SB();
        DN_LD_WQ(2, wA, qA); SB(); DN_MM_WQ(1, wB, qB); SB();
        DN_LD_WQ(3, wB, qB); SB(); DN_MM_WQ(2, wA, qA); SB();
#pragma unroll
        for (int mt = 0; mt < 4; ++mt)
#pragma unroll
            for (int k2 = 0; k2 < 2; ++k2) { const unsigned row = 16u * mt + fr; af[mt][k2] = *(const LAS bf16x8*)(AQI + 128u * row + 16u * ((4u * k2 + g) ^ dn::swz8(row))); }
        SB(); DN_MM_WQ(3, wB, qB); SB();
        DN_LD_KD(0, kA); SB();
        bf16x8 vb[2];
#pragma unroll
        for (int k2 = 0; k2 < 2; ++k2) vb[k2] = dn::join8(dn::pack4(vn[2 * k2]), dn::pack4(vn[2 * k2 + 1]));
#pragma unroll
        for (int mt = 0; mt < 4; ++mt)
#pragma unroll
            for (int k2 = 0; k2 < 2; ++k2) oo[mt] = __builtin_amdgcn_mfma_f32_16x16x32_bf16(af[mt][k2], vb[k2], oo[mt], 0, 0, 0);
        SB(); DN_LD_KD(4, kB); SB();
#pragma unroll
        for (int dt = 0; dt < 4; ++dt) { S[dt] = S[dt] * gl;
#pragma unroll
            for (int k2 = 0; k2 < 2; ++k2) S[dt] = __builtin_amdgcn_mfma_f32_16x16x32_bf16(kA[dt][k2], vb[k2], S[dt], 0, 0, 0); }
        SB();
#pragma unroll
        for (int dt = 4; dt < 8; ++dt) { S[dt] = S[dt] * gl;
#pragma unroll
            for (int k2 = 0; k2 < 2; ++k2) S[dt] = __builtin_amdgcn_mfma_f32_16x16x32_bf16(kB[dt - 4][k2], vb[k2], S[dt], 0, 0, 0); }
#pragma unroll
        for (int ks = 0; ks < 4; ++ks) Sb[ks] = dn::join8(dn::pack4(S[2 * ks]), dn::pack4(S[2 * ks + 1]));
#undef DN_LD_WQ
#undef DN_MM_WQ
#undef DN_LD_KD
#undef SB
        const size_t rbase = (size_t)b * SEQ + n * 64;
#pragma unroll
        for (int mt = 0; mt < 4; ++mt)
#pragma unroll
            for (int r = 0; r < 4; ++r) dno[(rbase + 16 * mt + 4 * g + r) * 1024 + h * HD + 16 * dvt + fr] = oo[mt][r];
        }
        VM_WAIT();
        __syncthreads();
    }
#undef DN_STAGE
    if constexpr (PM == 0 && DN_TAIL_NORMGATE == 2) {
        asm volatile("s_waitcnt vmcnt(0)" ::: "memory");
        __syncthreads();
        if (threadIdx.x == 0) { __builtin_amdgcn_fence(__ATOMIC_RELEASE, "agent"); asm volatile("s_waitcnt vmcnt(0)" ::: "memory"); __hip_atomic_fetch_add(F.ctl + CW_CHAIN + (e * NCH + bh) * 16, 1u, RLX_AGENT); }
    }
    if constexpr (PM == 0 && DN_TAIL_NORMGATE == 1) {
        chain_sync(F, F.ctl + CW_CHAIN + (e * NCH + bh) * 16, SPL);
        normgate_rows(F, (const float*)(F.ws + WS_DNO), (const bf16*)(F.ws + WS_DNGATE), NH_AB, FIN(I_AB_ONG) + e * HD, 1024, b * SEQ + part * (SEQ / SPL), SEQ / SPL, h);
    }
}

constexpr size_t WS_QEP = WS_END, WS_KE = WS_END + 32 * MiB, WS_AINT = WS_END + 64 * MiB, WS_GD = WS_END + 80 * MiB, WS_END2 = WS_END + 82 * MiB;
namespace gla { constexpr int BP = 132; }

__device__ __forceinline__ void gla_chunk_phase(Frame& F) {
    PHASE_IDS();
    LAS char* ring = (LAS char*)(F.lds + RING_OFF);
    LAS float* BI = (LAS float*)ring;
    LAS char* QS = ring + 34816;
    LAS char* KS = ring + 34816 + 16384;
    LAS float* PART = (LAS float*)(ring + 34816 + 16384 + 40960);
    const bf16* Cq = (const bf16*)(F.ws + WS_CQ); const bf16* Ck = (const bf16*)(F.ws + WS_CK); const float* Clf = (const float*)(F.ws + WS_CLF);
    const unsigned fr = lane & 15, g = lane >> 4;
    for (int ci = F.bx; ci < BATCH * NH_C * (SEQ / 64); ci += F.G) {
        const int n = ci & 63, bh = ci >> 6, h = bh & 15, b = bh >> 4; const size_t rbase = (size_t)b * SEQ + n * 64;
        bf16* qep = (bf16*)(F.ws + WS_QEP) + (size_t)ci * 8192; bf16* ke = (bf16*)(F.ws + WS_KE) + (size_t)ci * 8192; bf16* aint = (bf16*)(F.ws + WS_AINT) + (size_t)ci * 4096; float* gd = (float*)(F.ws + WS_GD) + (size_t)ci * 256;
        __syncthreads();
        float lfv[16];
        { const int d = tid & 127, qr = tid >> 7;
#pragma unroll
          for (int r = 0; r < 16; ++r) lfv[r] = Clf[(rbase + 16 * qr + r) * D + h * HD + d]; }
        v4u qwA[2], kwA[2], kwB[5]; pg8::u32x2 q0C[2], q1C[2];
#pragma unroll
        for (int it = 0; it < 2; ++it) { const int item = tid + 512 * it, c = item >> 4, gq = item & 15;
            qwA[it] = *(const GAS v4u*)(Cq + (rbase + c) * D + h * HD + 8 * gq); kwA[it] = *(const GAS v4u*)(Ck + (rbase + c) * D + h * HD + 8 * gq); }
#pragma unroll
        for (int it = 0; it < 5; ++it) { const int item = tid + 512 * it, ri = item >> 4, gq = item & 15; const int s = ri < 16 ? ri : (ri < 48 ? ri - 16 : (ri < 96 ? ri - 48 : ri - 96));
            kwB[it] = *(const GAS v4u*)(Ck + (rbase + s) * D + h * HD + 8 * gq); }
#pragma unroll
        for (int it = 0; it < 2; ++it) { const int item = tid + 512 * it, c = item >> 4, pc = item & 15, dk0 = 32 * (pc >> 2) + 4 * (pc & 3);
            q0C[it] = *(const GAS pg8::u32x2*)(Cq + (rbase + c) * D + h * HD + dk0); q1C[it] = *(const GAS pg8::u32x2*)(Cq + (rbase + c) * D + h * HD + dk0 + 16); }
        if (tid < 192) { const int pr = tid >> 5, ctz = pr < 3 ? 0 : (pr < 5 ? 1 : 2), stz = pr < 3 ? pr + 1 : (pr < 5 ? pr - 1 : 3), cz = 16 * ctz + ((tid & 31) >> 1);
            *(GAS v4u*)(aint + cz * 64 + 16 * stz + 8 * (tid & 1)) = (v4u){0u, 0u, 0u, 0u}; }
        {
            const int d = tid & 127, qr = tid >> 7; float loc[16]; float run = 0.f;
#pragma unroll
            for (int r = 0; r < 16; ++r) { run += lfv[r]; loc[r] = run; }
            PART[qr * 128 + d] = run;
            LDS_WAIT(); __syncthreads();
            float off = 0.f;
#pragma unroll
            for (int q2 = 0; q2 < 3; ++q2) if (q2 < qr) off += PART[q2 * 128 + d];
#pragma unroll
            for (int r = 0; r < 16; ++r) BI[(16 * qr + r) * gla::BP + d] = off + loc[r];
        }
        LDS_WAIT(); __syncthreads();
#pragma unroll
        for (int it = 0; it < 2; ++it) {
            const int item = tid + 512 * it, c = item >> 4, gq = item & 15;
            const v4u qw = qwA[it], kw = kwA[it];
            const LAS float* bc = BI + c * gla::BP + 8 * gq; const LAS float* br = BI + (c & ~15) * gla::BP + 8 * gq; const LAS float* bl = BI + 63 * gla::BP + 8 * gq;
            const f32x4 b0 = *(const LAS f32x4*)bc, b1 = *(const LAS f32x4*)(bc + 4), r0 = *(const LAS f32x4*)br, r1 = *(const LAS f32x4*)(br + 4), l0 = *(const LAS f32x4*)bl, l1 = *(const LAS f32x4*)(bl + 4);
            v4u o;
            o.x = pg8::cvt_pk_bf16(bflo(qw.x) * __expf(b0[0] - r0[0]), bfhi(qw.x) * __expf(b0[1] - r0[1])); o.y = pg8::cvt_pk_bf16(bflo(qw.y) * __expf(b0[2] - r0[2]), bfhi(qw.y) * __expf(b0[3] - r0[3]));
            o.z = pg8::cvt_pk_bf16(bflo(qw.z) * __expf(b1[0] - r1[0]), bfhi(qw.z) * __expf(b1[1] - r1[1])); o.w = pg8::cvt_pk_bf16(bflo(qw.w) * __expf(b1[2] - r1[2]), bfhi(qw.w) * __expf(b1[3] - r1[3]));
            *(LAS v4u*)(QS + 256 * c + 16 * ((unsigned)gq ^ att::swz((unsigned)c))) = o;
            o.x = pg8::cvt_pk_bf16(bflo(kw.x) * __expf(l0[0] - b0[0]), bfhi(kw.x) * __expf(l0[1] - b0[1])); o.y = pg8::cvt_pk_bf16(bflo(kw.y) * __expf(l0[2] - b0[2]), bfhi(kw.y) * __expf(l0[3] - b0[3]));
            o.z = pg8::cvt_pk_bf16(bflo(kw.z) * __expf(l1[0] - b1[0]), bfhi(kw.z) * __expf(l1[1] - b1[1])); o.w = pg8::cvt_pk_bf16(bflo(kw.w) * __expf(l1[2] - b1[2]), bfhi(kw.w) * __expf(l1[3] - b1[3]));
            *(GAS v4u*)(ke + c * 128 + 8 * gq) = o;
        }
#pragma unroll
        for (int it = 0; it < 5; ++it) {
            const int item = tid + 512 * it, ri = item >> 4, gq = item & 15;
            int i, s, base; if (ri < 16) { i = 0; s = ri; base = 0; } else if (ri < 48) { i = 1; s = ri - 16; base = 4096; } else if (ri < 96) { i = 2; s = ri - 48; base = 12288; } else { i = 3; s = ri - 96; base = 24576; }
            const v4u kw = kwB[it];
            const LAS float* bs = BI + s * gla::BP + 8 * gq; const LAS float* br = BI + 16 * i * gla::BP + 8 * gq;
            const f32x4 b0 = *(const LAS f32x4*)bs, b1 = *(const LAS f32x4*)(bs + 4), r0 = *(const LAS f32x4*)br, r1 = *(const LAS f32x4*)(br + 4);
            v4u o;
            o.x = pg8::cvt_pk_bf16(bflo(kw.x) * __expf(r0[0] - b0[0]), bfhi(kw.x) * __expf(r0[1] - b0[1])); o.y = pg8::cvt_pk_bf16(bflo(kw.y) * __expf(r0[2] - b0[2]), bfhi(kw.y) * __expf(r0[3] - b0[3]));
            o.z = pg8::cvt_pk_bf16(bflo(kw.z) * __expf(r1[0] - b1[0]), bfhi(kw.z) * __expf(r1[1] - b1[1])); o.w = pg8::cvt_pk_bf16(bflo(kw.w) * __expf(r1[2] - b1[2]), bfhi(kw.w) * __expf(r1[3] - b1[3]));
            *(LAS v4u*)(KS + base + 256 * s + 16 * ((unsigned)gq ^ att::swz((unsigned)s))) = o;
        }
#pragma unroll
        for (int it = 0; it < 2; ++it) {
            const int item = tid + 512 * it, c = item >> 4, pc = item & 15, ks = pc >> 2, gp = pc & 3, dk0 = 32 * ks + 4 * gp;
            const pg8::u32x2 q0 = q0C[it], q1 = q1C[it];
            const f32x4 b0 = *(const LAS f32x4*)(BI + c * gla::BP + dk0), b1 = *(const LAS f32x4*)(BI + c * gla::BP + dk0 + 16);
            v4u o;
            o.x = pg8::cvt_pk_bf16(bflo(q0.x) * __expf(b0[0]), bfhi(q0.x) * __expf(b0[1])); o.y = pg8::cvt_pk_bf16(bflo(q0.y) * __expf(b0[2]), bfhi(q0.y) * __expf(b0[3]));
            o.z = pg8::cvt_pk_bf16(bflo(q1.x) * __expf(b1[0]), bfhi(q1.x) * __expf(b1[1])); o.w = pg8::cvt_pk_bf16(bflo(q1.y) * __expf(b1[2]), bfhi(q1.y) * __expf(b1[3]));
            *(GAS v4u*)(qep + c * 128 + 8 * pc) = o;
        }
        if (tid < 256) gd[tid] = tid < 128 ? __expf(BI[63 * gla::BP + tid]) : 0.f;
        LDS_WAIT(); __syncthreads();
        for (int jb = wave; jb < 10; jb += NWAVES) {
            int ct = 0, st = jb; if (jb >= 6) { ct = 3; st = jb - 6; } else if (jb >= 3) { ct = 2; st = jb - 3; } else if (jb >= 1) { ct = 1; st = jb - 1; }
            const int base = ct == 0 ? 0 : (ct == 1 ? 4096 : (ct == 2 ? 12288 : 24576));
            f32x4 acc = {0.f, 0.f, 0.f, 0.f};
#pragma unroll
            for (int ks = 0; ks < 4; ++ks) { const bf16x8 a = *(const LAS bf16x8*)(KS + base + 256u * (16u * st + fr) + 16u * ((4u * ks + g) ^ att::swz(fr))), bb = *(const LAS bf16x8*)(QS + 256u * (16u * ct + fr) + 16u * ((4u * ks + g) ^ att::swz(fr)));
                acc = __builtin_amdgcn_mfma_f32_16x16x32_bf16(a, bb, acc, 0, 0, 0); }
            const int c = 16 * ct + (int)fr; f32x4 o;
#pragma unroll
            for (int r = 0; r < 4; ++r) { const int s = 16 * st + 4 * (int)g + r; o[r] = s <= c ? acc[r] : 0.f; }
            *(GAS dn::s16x4*)(aint + c * 64 + 16 * st + 4 * g) = dn::pack4(o);
        }
    }
    __syncthreads();
}

template <int PM>
__device__ __forceinline__ void gla_scan_phase(Frame& F) {
    constexpr int SPL = 4, NCH = BATCH * NH_C;
    if (F.bx >= SPL * NCH) return;
    PHASE_IDS();
    const int bh = F.bx % NCH, part = F.bx / NCH, h = bh & 15, b = bh >> 4;
    const int dvt = (8 / SPL) * part + (wave & (8 / SPL - 1)); const bool active = wave < 8 / SPL;
    const int rot = part * (56 / SPL);
    LAS char* ring = (LAS char*)(F.lds + RING_OFF);
    constexpr int STG = 58368;
    const char* gQE = (const char*)(F.ws + WS_QEP) + (size_t)bh * 64 * 16384; const char* gKE = (const char*)(F.ws + WS_KE) + (size_t)bh * 64 * 16384;
    const char* gA = (const char*)(F.ws + WS_AINT) + (size_t)bh * 64 * 8192; const char* gD = (const char*)(F.ws + WS_GD) + (size_t)bh * 64 * 1024;
    const char* gV = (const char*)((const bf16*)(F.ws + WS_CV) + (size_t)b * SEQ * D + h * HD);
    float* co = (float*)(F.ws + (PM == 0 ? WS_CO : WS_ACT));
#define GLA_PIECE(n_, stg_, pc_) do { const char* src_; \
        if ((pc_) < 48) { const int q_ = (pc_) & 15; const unsigned row_ = 4u * q_ + ((unsigned)ln >> 4), ch_ = ((unsigned)ln & 15u) ^ att::swz(row_); \
            src_ = (pc_) < 16 ? gQE + (size_t)(n_) * 16384 + row_ * 256u + ch_ * 16u : ((pc_) < 32 ? gKE + (size_t)(n_) * 16384 + row_ * 256u + ch_ * 16u : gV + ((size_t)(n_) * 64 + row_) * 4096 + ch_ * 16u); } \
        else if ((pc_) < 56) { const int q_ = (pc_) - 48; const unsigned row_ = 8u * q_ + ((unsigned)ln >> 3), ch_ = ((unsigned)ln & 7u) ^ dn::swz8(row_); src_ = gA + (size_t)(n_) * 8192 + row_ * 128u + ch_ * 16u; } \
        else src_ = gD + (size_t)(n_) * 1024 + (unsigned)ln * 16u; \
        att::glds16(src_, (unsigned)__builtin_amdgcn_readfirstlane((unsigned)(size_t)((stg_) + (pc_) * 1024))); } while (0)
#define GLA_STAGE(n_, stg_) do { _Pragma("unroll") for (int pi_ = 0; pi_ < 7; ++pi_) { int pcc_ = 7 * wave + pi_ + rot; pcc_ -= pcc_ >= 56 ? 56 : 0; GLA_PIECE(n_, stg_, pcc_); } if (wave == 0) { GLA_PIECE(n_, stg_, 56); } } while (0)
    f32x4 S[8]; bf16x8 Sb[4];
#pragma unroll
    for (int dt = 0; dt < 8; ++dt) S[dt] = (f32x4){0.f, 0.f, 0.f, 0.f};
#pragma unroll
    for (int ks = 0; ks < 4; ++ks) Sb[ks] = (bf16x8){0, 0, 0, 0, 0, 0, 0, 0};
    { const int ln = lane; GLA_STAGE(0, ring); }
    VM_WAIT(); __syncthreads();
    for (int n = 0; n < SEQ / 64; ++n) {
        LAS char* cur = ring + (n & 1) * STG; LAS char* nxt = ring + ((n + 1) & 1) * STG;
        const int ln = opaque_i(lane);
        if (PM != 1 && n + 1 < SEQ / 64) GLA_STAGE(n + 1, nxt);
        const unsigned fr = ln & 15, g = (unsigned)ln >> 4, q4 = fr >> 2, p = ln & 3;
        const LAS char* QEI = cur; const LAS char* KEI = cur + 16384; const LAS char* VI = cur + 32768; const LAS char* AI = cur + 49152; const LAS float* DV = (const LAS float*)(cur + 57344);
        if (active && PM != 2) {
        f32x4 oo[4];
#pragma unroll
        for (int mt = 0; mt < 4; ++mt) oo[mt] = (f32x4){0.f, 0.f, 0.f, 0.f};
#define SB() __builtin_amdgcn_sched_barrier(0)
#define GLA_LD_Q(mt_, Q_) do { _Pragma("unroll") for (int ks_ = 0; ks_ < 4; ++ks_) Q_[ks_] = *(const LAS bf16x8*)(QEI + 256u * (16u * (mt_) + fr) + 16u * ((4u * ks_ + g) ^ att::swz(fr))); } while (0)
#define GLA_MM_Q(mt_, Q_) do { _Pragma("unroll") for (int ks_ = 0; ks_ < 4; ++ks_) oo[mt_] = __builtin_amdgcn_mfma_f32_16x16x32_bf16(Q_[ks_], Sb[ks_], oo[mt_], 0, 0, 0); } while (0)
#define GLA_LD_KE(d0_, K_) do { _Pragma("unroll") for (int dd_ = 0; dd_ < 4; ++dd_) _Pragma("unroll") for (int k2_ = 0; k2_ < 2; ++k2_) { const unsigned r0_ = 32u * k2_ + 8u * g + q4, r1_ = r0_ + 4u; \
            K_[dd_][k2_] = dn::join8(att::vtr(KEI + 256u * r0_ + 16u * ((2u * ((d0_) + dd_) + (p >> 1)) ^ att::swz(r0_)) + 8u * (p & 1u)), att::vtr(KEI + 256u * r1_ + 16u * ((2u * ((d0_) + dd_) + (p >> 1)) ^ att::swz(r1_)) + 8u * (p & 1u))); } } while (0)
        bf16x8 qA[4], qB[4], af[4][2], kA[4][2], kB[4][2], vb[2];
        GLA_LD_Q(0, qA);
#pragma unroll
        for (int k2 = 0; k2 < 2; ++k2) {
            const unsigned r0 = 32u * k2 + 8u * g + q4, r1 = r0 + 4u;
            vb[k2] = dn::join8(att::vtr(VI + 256u * r0 + 16u * ((2u * dvt + (p >> 1)) ^ att::swz(r0)) + 8u * (p & 1u)), att::vtr(VI + 256u * r1 + 16u * ((2u * dvt + (p >> 1)) ^ att::swz(r1)) + 8u * (p & 1u)));
        }
        GLA_LD_Q(1, qB); SB(); GLA_MM_Q(0, qA); SB();
        GLA_LD_Q(2, qA);
#pragma unroll
        for (int mt = 0; mt < 4; ++mt)
#pragma unroll
            for (int k2 = 0; k2 < 2; ++k2) { const unsigned row = 16u * mt + fr; af[mt][k2] = *(const LAS bf16x8*)(AI + 128u * row + 16u * ((4u * k2 + g) ^ dn::swz8(row))); }
        SB(); GLA_MM_Q(1, qB); SB();
        GLA_LD_Q(3, qB); SB(); GLA_MM_Q(2, qA); SB();
        GLA_LD_KE(0, kA); SB(); GLA_MM_Q(3, qB);
#pragma unroll
        for (int mt = 0; mt < 4; ++mt)
#pragma unroll
            for (int k2 = 0; k2 < 2; ++k2) oo[mt] = __builtin_amdgcn_mfma_f32_16x16x32_bf16(af[mt][k2], vb[k2], oo[mt], 0, 0, 0);
        SB(); GLA_LD_KE(4, kB); SB();
#pragma unroll
        for (int dt = 0; dt < 4; ++dt) { const f32x4 dd = *(const LAS f32x4*)(DV + 16 * dt + 4 * g); S[dt] = S[dt] * dd;
#pragma unroll
            for (int k2 = 0; k2 < 2; ++k2) S[dt] = __builtin_amdgcn_mfma_f32_16x16x32_bf16(kA[dt][k2], vb[k2], S[dt], 0, 0, 0); }
        SB();
#pragma unroll
        for (int dt = 4; dt < 8; ++dt) { const f32x4 dd = *(const LAS f32x4*)(DV + 16 * dt + 4 * g); S[dt] = S[dt] * dd;
#pragma unroll
            for (int k2 = 0; k2 < 2; ++k2) S[dt] = __builtin_amdgcn_mfma_f32_16x16x32_bf16(kB[dt - 4][k2], vb[k2], S[dt], 0, 0, 0); }
#pragma unroll
        for (int ks = 0; ks < 4; ++ks) Sb[ks] = dn::join8(dn::pack4(S[2 * ks]), dn::pack4(S[2 * ks + 1]));
#undef GLA_LD_Q
#undef GLA_MM_Q
#undef GLA_LD_KE
#undef SB
        const size_t rbase = (size_t)b * SEQ + n * 64;
#pragma unroll
        for (int mt = 0; mt < 4; ++mt)
#pragma unroll
            for (int r = 0; r < 4; ++r) co[(rbase + 16 * mt + 4 * g + r) * D + h * HD + 16 * dvt + fr] = oo[mt][r];
        }
        VM_WAIT();
        __syncthreads();
    }
#undef GLA_STAGE
#undef GLA_PIECE
}

struct Args { const float* in[20]; float* out; unsigned char* ws; };
__global__ void __launch_bounds__(NWAVES * 64, 2) fwd(Args args) {
    extern __shared__ __attribute__((aligned(16))) unsigned char lds[];
    Frame F;
    F.lds = (LAS unsigned char*)lds;
    F.MISC = (volatile LAS unsigned*)(F.lds + MISC_OFF);
    F.tid = threadIdx.x; F.lane = F.tid & 63; F.wave = __builtin_amdgcn_readfirstlane(F.tid >> 6);
    F.G = gridDim.x; F.bx = (int)blockIdx.x;
    GAS unsigned char* ws = (GAS unsigned char*)args.ws; F.ws = ws; F.out = args.out;
    F.ctl = (gu32*)(ws + WS_CTL);
    F.ka = (const __attribute__((address_space(4))) unsigned long long*)__builtin_amdgcn_kernarg_segment_ptr();
    for (int u = F.tid; u < (LDS_BYTES - LDSCTL_OFF) / 4; u += NWAVES * 64) ((LAS unsigned*)(F.lds + LDSCTL_OFF))[u] = 0u;
    __syncthreads();
    XcdBarrier bar = xcd_barrier_post((unsigned*)(F.ctl + CW_BAR), F.MISC + 8);
#define GRID_BAR() xcd_barrier(bar)
    const LAS float* rtab = (const LAS float*)(F.lds + RTAB_OFF);
    bf16* XB; void* XLO; float* ROWSS; bf16* ACT; bf16* Y;
    constexpr bool XF = X_F16 == 1;

    p0_prologue(F);
    GRID_BAR();

    for (int s = 0; s < 2 * DEPTH; ++s) {
        { GAS unsigned char* w_ = F.ws; asm volatile("" : "+s"(w_)); F.ws = w_; ws = w_; auto k_ = F.ka; asm volatile("" : "+s"(k_)); F.ka = k_; int b_ = (int)blockIdx.x; asm volatile("" : "+s"(b_)); F.bx = b_; }
        XB = (bf16*)(ws + WS_XB); XLO = (void*)(ws + WS_X); ROWSS = (float*)(ws + WS_ROWSS); ACT = (bf16*)(ws + WS_ACT); Y = (bf16*)(ws + WS_Y);
        { pg8::EpiSwiGLU E{ACT, DFF, rtab, 0}; run_gemm<pg8::EpiSwiGLU, 0, XF, AIMG_XB != 0>(F, XB, (const bf16*)(ws + WS_W1T) + (size_t)s * NFF * D, M, F.G == 256 ? 40 * 256 : NFF, D, E, true, 0, 0, 1, F.G == 256 ? 5 : -1, 40, 3); }
        if (F.G == 256) { pg8::EpiSwiGLU E{ACT, DFF, rtab + 5 * 256, 1}; run_gemm_half<pg8::EpiSwiGLU, XF, AIMG_XB != 0>(F, XB, (const bf16*)(ws + WS_W1T) + (size_t)s * NFF * D, M, NFF, D, 40, 3, E, false); }
        conv_slot(F, F.G == 256 ? 192 : 0, 3);
        GRID_BAR();
        { pg8::EpiResidual E{s == 0 ? FIN(I_X) : (const float*)nullptr, XB, XLO, ROWSS, 0.5f, D, M}; run_gemm<pg8::EpiResidual, 0, false, AIMG_ACT != 0>(F, ACT, (const bf16*)(ws + WS_W2T) + (size_t)s * D * DFF, M, D, DFF, E, false); }
        if (!(s & 1)) conv_deadline(F, cq_n_mix(s >> 1)); else if (s + 1 < 2 * DEPTH) conv_deadline(F, cq_n_ffn(s + 1));
        GRID_BAR();
        if (!(s & 1)) {
            const int l = s >> 1;
            if (!(l & 1)) {
                const int e = l >> 1;
                { pg8::EpiABin E{(bf16*)(ws + WS_QM), (bf16*)(ws + WS_KM), (bf16*)(ws + WS_VM), (bf16*)(ws + WS_DNPRE), (bf16*)(ws + WS_DNGATE), (float*)(ws + WS_BA), (float*)(ws + WS_KMS), rtab, QK_SCALE_LOG2E};
                  run_gemm<pg8::EpiABin, 0, XF, AIMG_XB != 0>(F, XB, (const bf16*)(ws + WS_WABT) + (size_t)e * AB_PAD * D, M, AB_PAD, D, E, true); }
                conv_slot(F, F.G == 256 ? 160 : F.G, 6);
                GRID_BAR();
                dn_chunk_phase(F, e);
                GRID_BAR();
                dn_scan_phase<0>(F, e);
                moba_phase(F, 4 * BATCH * NH_AB);
                conv_slot(F, 4 * BATCH * NH_AB + BATCH * NH_AB * 8, 18);
                if (DN_TAIL_NORMGATE == 2) ng_help(F, e);
                GRID_BAR();
                if (DN_TAIL_NORMGATE == 0) { normgate(F, (const float*)(ws + WS_DNO), (const bf16*)(ws + WS_DNGATE), NH_AB, FIN(I_AB_ONG) + e * HD, 1024); GRID_BAR(); }
                { pg8::EpiResidual E{nullptr, XB, XLO, ROWSS, 1.0f, D, M}; run_gemm(F, Y, (const bf16*)(ws + WS_WABOT) + (size_t)e * D * D, M, D, D, E, false); }
                conv_deadline(F, cq_n_x(l));
                GRID_BAR();
            } else {
                const int o = l >> 1;
                { pg8::EpiCin E{(bf16*)(ws + WS_CQ), (bf16*)(ws + WS_CK), (bf16*)(ws + WS_CV), (bf16*)(ws + WS_CG), (float*)(ws + WS_CLF), (const float*)(ws + WS_LB) + (size_t)l * D, rtab};
                  run_gemm<pg8::EpiCin, 0, XF, AIMG_XB != 0>(F, XB, (const bf16*)(ws + WS_WCT) + (size_t)o * 4 * D * D, M, 4 * D, D, E, true); }
                GRID_BAR();
                gla_chunk_phase(F);
                GRID_BAR();
                gla_scan_phase<0>(F);
                conv_slot(F, 4 * BATCH * NH_C, 14);
                GRID_BAR();
                normgate(F, (const float*)(ws + WS_CO), (const bf16*)(ws + WS_CG), NH_C, FIN(I_C_ONG) + o * HD, 0);
                GRID_BAR();
                { pg8::EpiResidual E{nullptr, XB, XLO, ROWSS, 1.0f, D, M}; run_gemm(F, Y, (const bf16*)(ws + WS_WCOT) + (size_t)o * D * D, M, D, D, E, false); }
                conv_deadline(F, cq_n_x(l));
                GRID_BAR();
            }
            { pg8::EpiBf16Route E{(bf16*)(ws + WS_XQ), XW, rtab, QK_SCALE_LOG2E, 1}; run_gemm_half<pg8::EpiBf16Route, XF, AIMG_XB != 0>(F, XB, (const bf16*)(ws + WS_WXQT) + (size_t)l * XW * D, M, XW, D, 0, XW / 256, E, true, 0); }
            if (l == 0) { pg8::EpiBf16Route E{(bf16*)(ws + WS_KV), 4096, nullptr, 1.0f, 1}; run_gemm_half(F, (const bf16*)(ws + WS_MEMN), (const bf16*)(ws + WS_WXKVT), BATCH * MEMT, 4096, D, 0, 16, E, false, F.G - 128); }
            conv_slot(F, l == 0 ? 192 : 128, 3);
            GRID_BAR();
            xattn_phase(F, l);
            conv_slot(F, 128, 2);
            GRID_BAR();
            { pg8::EpiResidual E{nullptr, XB, XLO, ROWSS, 1.0f, D, M}; run_gemm(F, (const bf16*)(ws + WS_XO), (const bf16*)(ws + WS_WXOT) + (size_t)l * D * XW, M, D, XW, E, false); }
            conv_deadline(F, cq_n_ffn(s + 1));
            GRID_BAR();
        }
    }
    final_norm(F);
#undef GRID_BAR
}

extern "C" void kernel_launch(void* const* d_in, const int* in_sizes, int n_in, void* d_out, int out_size, void* d_ws, size_t ws_size, hipStream_t stream) {
    static int grid = 0;
    if (grid == 0) {
        if (n_in != 20 || in_sizes[0] != M * D || out_size != M * D || ws_size < WS_END2) { fprintf(stderr, "kernel_launch: unexpected shapes: n_in %d in0 %d out %d ws %zu (need %zu); nothing launched\n", n_in, n_in > 0 ? in_sizes[0] : -1, out_size, ws_size, (size_t)WS_END2); grid = -1; return; }
        int dev = 0, cus = 0, per_cu = 0;
        if (hipGetDevice(&dev) != hipSuccess || hipDeviceGetAttribute(&cus, hipDeviceAttributeMultiprocessorCount, dev) != hipSuccess) { fprintf(stderr, "kernel_launch: device query failed\n"); grid = -1; return; }
        if (hipFuncSetAttribute((const void*)fwd, hipFuncAttributeMaxDynamicSharedMemorySize, LDS_BYTES) != hipSuccess) { fprintf(stderr, "kernel_launch: hipFuncSetAttribute failed\n"); grid = -1; return; }
        if (hipOccupancyMaxActiveBlocksPerMultiprocessor(&per_cu, (const void*)fwd, NWAVES * 64, LDS_BYTES) != hipSuccess || per_cu < 1) fprintf(stderr, "kernel_launch: note: occupancy query reports %d workgroups per CU\n", per_cu);
        (void)hipGetLastError();
        grid = cus;
    }
    if (grid < 0) return;
    if (hipMemsetAsync((char*)d_ws + WS_CTL, 0, CTL_ZERO_BYTES, stream) != hipSuccess) { fprintf(stderr, "kernel_launch: memset failed\n"); return; }
    Args a{};
    for (int i = 0; i < 20; ++i) a.in[i] = (const float*)d_in[i];
    a.out = (float*)d_out; a.ws = (unsigned char*)d_ws;
    hipLaunchKernelGGL(fwd, dim3(grid), dim3(NWAVES * 64), LDS_BYTES, stream, a);
    const hipError_t le = hipPeekAtLastError();
    if (le != hipSuccess) fprintf(stderr, "kernel_launch: launch failed: %s\n", hipGetErrorName(le));
}
```

```cpp
#include <hip/hip_runtime.h>
#include <cstdio>
#include <cstdint>
namespace pg8 {
#define PG8_LAS __attribute__((address_space(3)))
typedef unsigned short bf16_t;
typedef short bf16x8 __attribute__((ext_vector_type(8)));
typedef float f32x4 __attribute__((ext_vector_type(4)));
typedef unsigned u32x4 __attribute__((ext_vector_type(4)));
constexpr int BM = 256, BK = 64, HALF = 128, HTB = HALF * BK * 2  , STAGE_BYTES = 8 * HTB, NXCD = 8, WGM = 4;

__host__ __device__ __forceinline__ int lds_byte(int r, int c) { const int st = (r >> 4) * 2 + (c >> 5), rr = r & 15, cc = c & 31, ob = rr * 64 + cc * 2; return st * 1024 + (ob ^ (((ob >> 9) & 1) << 5)); }
__host__ __device__ __forceinline__ void stage_rc(int b, int& R, int& C) { const int st = b / 1024, sb = b % 1024, swz = sb ^ (((sb >> 9) & 1) << 5); R = (st >> 1) * 16 + swz / 64; C = (st & 1) * 32 + (swz % 64) / 2; }
__host__ __device__ __forceinline__ int perm32(int rho) { const int n = rho >> 4, i = rho & 15; return 8 * (i >> 2) + 4 * n + (i & 3); }

#ifndef BIMG
#define BIMG 1
#endif
__host__ __device__ __forceinline__ int slot32(int c) { const int q = c & 31; return (c & ~31) + 16 * ((q >> 2) & 1) + 4 * (q >> 3) + (q & 3); }
__host__ __device__ __forceinline__ size_t img_off(int r, int k, int K) { return ((size_t)(r >> 4) * (K >> 5) + (k >> 5)) * 1024 + lds_byte(r & 15, k & 31); }
struct Unit { int pm, pn, half; };
struct Gemm { const bf16_t* A; const bf16_t* Bt; int M, N, K, ld, ks; };

struct StaticOrder {
    int nM, nN, nwg, G, c;
    __host__ __device__ void init(int M, int N, int G_, int c_) { nM = M / BM; nN = N / BM; nwg = nM * nN; G = G_; c = c_; }
    __host__ __device__ bool next(int i, Unit& u) const {
        const long L = (long)i * G + c; if (L >= nwg) return false;
        int wgid = (int)L; { const int q = nwg / NXCD, r = nwg % NXCD, xcd = wgid % NXCD, off = wgid / NXCD; wgid = (xcd < r ? xcd * (q + 1) : r * (q + 1) + (xcd - r) * q) + off; }
        const int nig = WGM * nN, gid = wgid / nig, fm = gid * WGM, gsz = (nM - fm) < WGM ? (nM - fm) : WGM;
        u.pm = fm + ((wgid % nig) % gsz); u.pn = (wgid % nig) / gsz; u.half = 0; return true;
    }
    __device__ __forceinline__ void a_ready(const Unit&) const {}
    __device__ __forceinline__ void done(const Unit&) const {}
};

struct HalfOrder {
    int nM, pn0, nhalf, G, c;
    __host__ __device__ void init(int M, int pn0_, int ntile, int G_, int c_) { nM = M / BM; pn0 = pn0_; nhalf = 2 * nM * ntile; G = G_; c = c_; }
    __host__ __device__ bool next(int i, Unit& u) const { const int L = i * G + c; if (L >= nhalf) return false; const int T = L >> 1; u.pm = T % nM; u.pn = pn0 + T / nM; u.half = L & 1; return true; }
    __device__ __forceinline__ void a_ready(const Unit&) const {}
    __device__ __forceinline__ void done(const Unit&) const {}
};

typedef float f32x2_cv __attribute__((ext_vector_type(2))); typedef __bf16 bf16x2_cv __attribute__((ext_vector_type(2)));
__device__ __forceinline__ unsigned cvt_pk_bf16(float lo, float hi) { const f32x2_cv v = {lo, hi}; const bf16x2_cv b = __builtin_convertvector(v, bf16x2_cv); return __builtin_bit_cast(unsigned, b); }
#ifndef X_F16
#define X_F16 2
#endif
typedef _Float16 f16x2_cv __attribute__((ext_vector_type(2))); typedef _Float16 f16x8 __attribute__((ext_vector_type(8)));
__device__ __forceinline__ unsigned cvt_pk_f16(float lo, float hi) { const f32x2_cv v = {lo, hi}; const f16x2_cv b = __builtin_convertvector(v, f16x2_cv); return __builtin_bit_cast(unsigned, b); }
__device__ __forceinline__ float f16_lo(unsigned w) { return (float)__builtin_bit_cast(f16x2_cv, w)[0]; }
__device__ __forceinline__ float f16_hi(unsigned w) { return (float)__builtin_bit_cast(f16x2_cv, w)[1]; }
__device__ __forceinline__ unsigned cvt_pk_x(float lo, float hi) { return X_F16 == 1 ? cvt_pk_f16(lo, hi) : cvt_pk_bf16(lo, hi); }
typedef float f32x2 __attribute__((ext_vector_type(2)));
typedef unsigned u32x2 __attribute__((ext_vector_type(2)));
__device__ __forceinline__ float fast_exp2(float x) { return __builtin_amdgcn_exp2f(x); }
__device__ __forceinline__ float fast_rcp(float x) { return __builtin_amdgcn_rcpf(x); }
__device__ __forceinline__ float silu_f(float a) { return a * fast_rcp(1.0f + fast_exp2(a * -1.44269504089f)); }
__device__ __forceinline__ u32x4 pack8(const f32x4& v0, const f32x4& v1) { u32x4 w; w.x = cvt_pk_bf16(v0[0], v0[1]); w.y = cvt_pk_bf16(v0[2], v0[3]); w.z = cvt_pk_bf16(v1[0], v1[1]); w.w = cvt_pk_bf16(v1[2], v1[3]); return w; }


#ifndef AIMG_ACT
#define AIMG_ACT 1
#endif
#ifndef AIMG_XB
#define AIMG_XB 1
#endif
struct EpiSwiGLU {
    static constexpr bool PERM = true, AFTER_DRAIN = false;
    bf16_t* O; int ldc; const PG8_LAS float* rtab; int hm;
    __device__ __forceinline__ void init(f32x4 (&acc)[2][2][4][2], const Unit&, int, int, int, int) const {
#pragma unroll
        for (int a = 0; a < 2; ++a)
#pragma unroll
            for (int b = 0; b < 2; ++b)
#pragma unroll
                for (int m = 0; m < 4; ++m)
#pragma unroll
                    for (int n = 0; n < 2; ++n) acc[a][b][m][n] = (f32x4){0.f, 0.f, 0.f, 0.f};
    }
    __device__ __forceinline__ void operator()(const f32x4 (&acc)[2][2][4][2], const Unit& u, int ui, int wr, int wc, int fr, int fq) const {
        const PG8_LAS float* rt = rtab + ui * 256;
#pragma unroll
        for (int ai = 0; ai < 2; ++ai)
#pragma unroll
            for (int m = 0; m < 4; ++m) {
                if (hm && ai == 1) continue;
                const int rl = (hm ? u.half : ai) * HALF + wr * 64 + m * 16 + fr; const float rs = rt[rl];
                bf16_t* rowp = AIMG_ACT ? (bf16_t*)((char*)O + img_off(u.pm * BM + rl, u.pn * HALF + wc * 32 + 8 * fq, ldc)) : O + (size_t)(u.pm * BM + rl) * ldc + u.pn * HALF + wc * 32 + 8 * fq;
                f32x4 h[2];
#pragma unroll
                for (int n = 0; n < 2; ++n)
#pragma unroll
                    for (int e = 0; e < 4; ++e) { const float a = acc[ai][0][m][n][e] * rs, b = acc[ai][1][m][n][e] * rs; h[n][e] = silu_f(a) * b; }
                *(u32x4*)rowp = pack8(h[0], h[1]);
            }
    }
};

#ifndef RES_LO
#define RES_LO 1
#endif
constexpr float LO_SCALE = 2048.0f;
__device__ __forceinline__ float bf_lo(unsigned w) { return __builtin_bit_cast(float, w << 16); }
__device__ __forceinline__ float bf_hi(unsigned w) { return __builtin_bit_cast(float, w & 0xffff0000u); }
__device__ __forceinline__ float lo_clamp(float v) { return __builtin_amdgcn_fmed3f(v * LO_SCALE, -448.0f, 448.0f); }
__device__ __forceinline__ unsigned lo_pack4(float a, float b, float c, float d) { int w = __builtin_amdgcn_cvt_pk_fp8_f32(lo_clamp(a), lo_clamp(b), 0, false); return (unsigned)__builtin_amdgcn_cvt_pk_fp8_f32(lo_clamp(c), lo_clamp(d), w, true); }
__device__ __forceinline__ f32x4 hilo4(unsigned h0, unsigned h1, unsigned l) {
    const auto a = __builtin_amdgcn_cvt_pk_f32_fp8((int)l, false), b = __builtin_amdgcn_cvt_pk_f32_fp8((int)l, true); constexpr float r = 1.0f / LO_SCALE;
    return (f32x4){__builtin_fmaf(a[0], r, bf_lo(h0)), __builtin_fmaf(a[1], r, bf_hi(h0)), __builtin_fmaf(b[0], r, bf_lo(h1)), __builtin_fmaf(b[1], r, bf_hi(h1))};
}
__device__ __forceinline__ size_t res_chunk(const Unit& u, int ldx, int wr, int wc, int ai, int m, int bj, int fr, int fq) {
    return (((((size_t)(u.pm * (ldx / BM) + u.pn) * 8 + (wr * 4 + wc)) * 8 + (ai * 4 + m)) * 2 + bj) * 64) + (fq * 16 + fr);
}
struct EpiResidual {
    static constexpr bool PERM = true, AFTER_DRAIN = false;
    const float* xf32; bf16_t* xhi; void* xlo; float* rowss; float scale; int ldx, rsld;
    __device__ __forceinline__ void init(f32x4 (&acc)[2][2][4][2], const Unit& u, int wr, int wc, int fr, int fq) const {
        const float inv = 1.0f / scale;
#pragma unroll
        for (int ai = 0; ai < 2; ++ai)
#pragma unroll
            for (int m = 0; m < 4; ++m) {
                const int row = u.pm * BM + ai * HALF + wr * 64 + m * 16 + fr;
#pragma unroll
                for (int bj = 0; bj < 2; ++bj) { const size_t off = (size_t)row * ldx + u.pn * BM + bj * HALF + wc * 32 + 8 * fq;
                    if (xf32) { acc[ai][bj][m][0] = *(const f32x4*)(xf32 + off) * inv; acc[ai][bj][m][1] = *(const f32x4*)(xf32 + off + 4) * inv; }
                    else { const u32x4 h = X_F16 == 2 ? ((const u32x4*)xlo)[res_chunk(u, ldx, wr, wc, ai, m, bj, fr, fq)] : *(const u32x4*)(xhi + off);
#if X_F16
                        acc[ai][bj][m][0] = (f32x4){f16_lo(h.x), f16_hi(h.x), f16_lo(h.y), f16_hi(h.y)} * inv; acc[ai][bj][m][1] = (f32x4){f16_lo(h.z), f16_hi(h.z), f16_lo(h.w), f16_hi(h.w)} * inv;
#elif RES_LO == 2
                        const u32x2 l = *(const u32x2*)((const unsigned char*)xlo + off);
                        acc[ai][bj][m][0] = hilo4(h.x, h.y, l.x) * inv; acc[ai][bj][m][1] = hilo4(h.z, h.w, l.y) * inv;
#elif RES_LO == 1
                        const u32x4 l = *(const u32x4*)((const bf16_t*)xlo + off);
                        acc[ai][bj][m][0] = (f32x4){bf_lo(h.x) + bf_lo(l.x), bf_hi(h.x) + bf_hi(l.x), bf_lo(h.y) + bf_lo(l.y), bf_hi(h.y) + bf_hi(l.y)} * inv;
                        acc[ai][bj][m][1] = (f32x4){bf_lo(h.z) + bf_lo(l.z), bf_hi(h.z) + bf_hi(l.z), bf_lo(h.w) + bf_lo(l.w), bf_hi(h.w) + bf_hi(l.w)} * inv;
#else
                        acc[ai][bj][m][0] = (f32x4){bf_lo(h.x), bf_hi(h.x), bf_lo(h.y), bf_hi(h.y)} * inv; acc[ai][bj][m][1] = (f32x4){bf_lo(h.z), bf_hi(h.z), bf_lo(h.w), bf_hi(h.w)} * inv;
#endif
                    }
                }
            }
    }
    __device__ __forceinline__ void operator()(const f32x4 (&acc)[2][2][4][2], const Unit& u, int ui, int wr, int wc, int fr, int fq) const {
#pragma unroll
        for (int ai = 0; ai < 2; ++ai)
#pragma unroll
            for (int m = 0; m < 4; ++m) {
                const int row = u.pm * BM + ai * HALF + wr * 64 + m * 16 + fr; float ss = 0.f;
#pragma unroll
                for (int bj = 0; bj < 2; ++bj) {
                    const size_t off = (size_t)row * ldx + u.pn * BM + bj * HALF + wc * 32 + 8 * fq;
                    const f32x4 o0 = acc[ai][bj][m][0] * scale, o1 = acc[ai][bj][m][1] * scale;
#if X_F16
                    *(X_F16 == 2 ? (u32x4*)xlo + res_chunk(u, ldx, wr, wc, ai, m, bj, fr, fq) : (u32x4*)(xhi + off)) = (u32x4){cvt_pk_f16(o0[0], o0[1]), cvt_pk_f16(o0[2], o0[3]), cvt_pk_f16(o1[0], o1[1]), cvt_pk_f16(o1[2], o1[3])};
                    if constexpr (X_F16 == 2) *(u32x4*)(AIMG_XB ? (bf16_t*)((char*)xhi + img_off(row, u.pn * BM + bj * HALF + wc * 32 + 8 * fq, ldx)) : xhi + off) = pack8(o0, o1);
#else
                    const u32x4 h = pack8(o0, o1);
                    *(u32x4*)(xhi + off) = h;
#endif
#if RES_LO && !X_F16
                    const f32x4 r0 = o0 - (f32x4){bf_lo(h.x), bf_hi(h.x), bf_lo(h.y), bf_hi(h.y)}, r1 = o1 - (f32x4){bf_lo(h.z), bf_hi(h.z), bf_lo(h.w), bf_hi(h.w)};
#if RES_LO == 2
                    *(u32x2*)((unsigned char*)xlo + off) = (u32x2){lo_pack4(r0[0], r0[1], r0[2], r0[3]), lo_pack4(r1[0], r1[1], r1[2], r1[3])};
#else
                    *(u32x4*)((bf16_t*)xlo + off) = pack8(r0, r1);
#endif
#endif
                    ss += (o0[0] * o0[0] + o0[1] * o0[1]) + (o0[2] * o0[2] + o0[3] * o0[3]) + (o1[0] * o1[0] + o1[1] * o1[1]) + (o1[2] * o1[2] + o1[3] * o1[3]);
                }
                ss += __shfl_xor(ss, 16); ss += __shfl_xor(ss, 32);
                if (fq == 0) rowss[(size_t)(u.pn * 4 + wc) * rsld + row] = ss;
            }
    }
};

struct EpiBf16Route {
    static constexpr bool PERM = true, AFTER_DRAIN = false;
    bf16_t* O; int ldc; const PG8_LAS float* rtab; float scale; int hm;
    __device__ __forceinline__ void init(f32x4 (&acc)[2][2][4][2], const Unit&, int, int, int, int) const {
#pragma unroll
        for (int a = 0; a < 2; ++a)
#pragma unroll
            for (int b = 0; b < 2; ++b)
#pragma unroll
                for (int m = 0; m < 4; ++m)
#pragma unroll
                    for (int n = 0; n < 2; ++n) acc[a][b][m][n] = (f32x4){0.f, 0.f, 0.f, 0.f};
    }
    __device__ __forceinline__ void operator()(const f32x4 (&acc)[2][2][4][2], const Unit& u, int ui, int wr, int wc, int fr, int fq) const {
#pragma unroll
        for (int ai = 0; ai < 2; ++ai)
#pragma unroll
            for (int m = 0; m < 4; ++m) {
                if (hm && ai == 1) continue;
                const int rl = (hm ? u.half : ai) * HALF + wr * 64 + m * 16 + fr; const float rs = (rtab ? rtab[ui * 256 + rl] : 1.0f) * scale;
                bf16_t* rowp = O + (size_t)(u.pm * BM + rl) * ldc + u.pn * BM + wc * 32 + 8 * fq;
#pragma unroll
                for (int bj = 0; bj < 2; ++bj) *(u32x4*)(rowp + bj * HALF) = pack8(acc[ai][bj][m][0] * rs, acc[ai][bj][m][1] * rs);
            }
    }
};

struct EpiF32Part {
    static constexpr bool PERM = true, AFTER_DRAIN = false;
    float* P; int ldc; int ks; size_t part_stride;
    __device__ __forceinline__ void init(f32x4 (&acc)[2][2][4][2], const Unit&, int, int, int, int) const {
#pragma unroll
        for (int a = 0; a < 2; ++a)
#pragma unroll
            for (int b = 0; b < 2; ++b)
#pragma unroll
                for (int m = 0; m < 4; ++m)
#pragma unroll
                    for (int n = 0; n < 2; ++n) acc[a][b][m][n] = (f32x4){0.f, 0.f, 0.f, 0.f};
    }
    __device__ __forceinline__ void operator()(const f32x4 (&acc)[2][2][4][2], const Unit& u, int ui, int wr, int wc, int fr, int fq) const {
        float* base = P + (size_t)(u.pn % ks) * part_stride + (size_t)(u.pn / ks) * BM + wc * 32 + 8 * fq;
#pragma unroll
        for (int ai = 0; ai < 2; ++ai)
#pragma unroll
            for (int m = 0; m < 4; ++m) {
                float* rowp = base + (size_t)(u.pm * BM + ai * HALF + wr * 64 + m * 16 + fr) * ldc;
#pragma unroll
                for (int bj = 0; bj < 2; ++bj) { *(f32x4*)(rowp + bj * HALF) = acc[ai][bj][m][0]; *(f32x4*)(rowp + bj * HALF + 4) = acc[ai][bj][m][1]; }
            }
    }
};

struct EpiABin {
    static constexpr bool PERM = true, AFTER_DRAIN = false;
    bf16_t *Qm, *Km, *Vm, *DNpre, *DNgate; float* ba; float* kms; const PG8_LAS float* rtab; float qscale;
    __device__ __forceinline__ void init(f32x4 (&acc)[2][2][4][2], const Unit&, int, int, int, int) const {
#pragma unroll
        for (int a = 0; a < 2; ++a)
#pragma unroll
            for (int b = 0; b < 2; ++b)
#pragma unroll
                for (int m = 0; m < 4; ++m)
#pragma unroll
                    for (int n = 0; n < 2; ++n) acc[a][b][m][n] = (f32x4){0.f, 0.f, 0.f, 0.f};
    }
    __device__ __forceinline__ void operator()(const f32x4 (&acc)[2][2][4][2], const Unit& u, int ui, int wr, int wc, int fr, int fq) const {
        const int pn = u.pn; const PG8_LAS float* rt = rtab + ui * 256;
        if (pn < 28) {
            bf16_t* base; int ld = 1024, ct; float sc = 1.0f;
            if (pn < 4) { base = Qm; ct = pn; sc = qscale; } else if (pn < 8) { base = Km; ct = pn - 4; } else if (pn < 12) { base = Vm; ct = pn - 8; }
            else if (pn < 24) { base = DNpre; ld = 3072; ct = pn - 12; } else { base = DNgate; ct = pn - 24; }
            f32x4 cs[2][2];
#pragma unroll
            for (int bj = 0; bj < 2; ++bj)
#pragma unroll
                for (int n = 0; n < 2; ++n) cs[bj][n] = (f32x4){0.f, 0.f, 0.f, 0.f};
#pragma unroll
            for (int ai = 0; ai < 2; ++ai)
#pragma unroll
                for (int m = 0; m < 4; ++m) {
                    const int rl = ai * HALF + wr * 64 + m * 16 + fr; const float rs = rt[rl] * sc;
                    bf16_t* rowp = base + (size_t)(u.pm * BM + rl) * ld + ct * BM + wc * 32 + 8 * fq;
#pragma unroll
                    for (int bj = 0; bj < 2; ++bj) { const f32x4 v0 = acc[ai][bj][m][0] * rs, v1 = acc[ai][bj][m][1] * rs; *(u32x4*)(rowp + bj * HALF) = pack8(v0, v1); cs[bj][0] += v0; cs[bj][1] += v1; }
                }
            if (pn >= 4 && pn < 8) {
#pragma unroll
                for (int bj = 0; bj < 2; ++bj)
#pragma unroll
                    for (int n = 0; n < 2; ++n) {
                        f32x4 s = cs[bj][n];
#pragma unroll
                        for (int o = 1; o < 16; o <<= 1) { s[0] += __shfl_xor(s[0], o); s[1] += __shfl_xor(s[1], o); s[2] += __shfl_xor(s[2], o); s[3] += __shfl_xor(s[3], o); }
                        if (fr == 0) *(f32x4*)(kms + (size_t)(u.pm * 2 + wr) * 1024 + (pn - 4) * BM + bj * HALF + wc * 32 + 8 * fq + 4 * n) = s;
                    }
            }
        } else {
            if (wc == 0 && fq < 2) {
#pragma unroll
                for (int ai = 0; ai < 2; ++ai)
#pragma unroll
                    for (int m = 0; m < 4; ++m) {
                        const int rl = ai * HALF + wr * 64 + m * 16 + fr; const float rs = rt[rl];
                        float* p = ba + (size_t)(u.pm * BM + rl) * 16 + 8 * fq;
                        *(f32x4*)p = acc[ai][0][m][0] * rs; *(f32x4*)(p + 4) = acc[ai][0][m][1] * rs;
                    }
            }
        }
    }
};

struct EpiCin {
    static constexpr bool PERM = true, AFTER_DRAIN = false;
    bf16_t *Cq, *Ck, *Cv, *Cg; float* Clf; const float* lb; const PG8_LAS float* rtab;
    __device__ __forceinline__ void init(f32x4 (&acc)[2][2][4][2], const Unit&, int, int, int, int) const {
#pragma unroll
        for (int a = 0; a < 2; ++a)
#pragma unroll
            for (int b = 0; b < 2; ++b)
#pragma unroll
                for (int m = 0; m < 4; ++m)
#pragma unroll
                    for (int n = 0; n < 2; ++n) acc[a][b][m][n] = (f32x4){0.f, 0.f, 0.f, 0.f};
    }
    __device__ __forceinline__ void operator()(const f32x4 (&acc)[2][2][4][2], const Unit& u, int ui, int wr, int wc, int fr, int fq) const {
        const int pn = u.pn, sec = pn >> 3, ct = pn & 7; const PG8_LAS float* rt = rtab + ui * 256;
        bf16_t* base = sec == 0 ? Cq : (sec == 1 ? Ck : (sec == 2 ? Cv : Cg));
        const int cl = ct * BM + wc * 32 + 8 * fq;
        f32x4 lbv[2][2];
        if (sec == 1) {
#pragma unroll
            for (int bj = 0; bj < 2; ++bj) { lbv[bj][0] = *(const f32x4*)(lb + cl + bj * HALF); lbv[bj][1] = *(const f32x4*)(lb + cl + bj * HALF + 4); }
        }
#pragma unroll
        for (int ai = 0; ai < 2; ++ai)
#pragma unroll
            for (int m = 0; m < 4; ++m) {
                const int rl = ai * HALF + wr * 64 + m * 16 + fr; const float rs = rt[rl];
                const size_t off = (size_t)(u.pm * BM + rl) * 2048 + cl;
#pragma unroll
                for (int bj = 0; bj < 2; ++bj) {
                    f32x4 v[2] = {acc[ai][bj][m][0] * rs, acc[ai][bj][m][1] * rs};
                    if (sec == 0) {
#pragma unroll
                        for (int n = 0; n < 2; ++n)
#pragma unroll
                            for (int e = 0; e < 4; ++e) v[n][e] = silu_f(v[n][e]) * 0.08838834764831845f;
                    } else if (sec == 1) {
                        f32x4 lf[2];
#pragma unroll
                        for (int n = 0; n < 2; ++n)
#pragma unroll
                            for (int e = 0; e < 4; ++e) {
                                const float ex = fast_exp2(v[n][e] * -1.44269504089f), r = fast_rcp(1.0f + ex), l = lbv[bj][n][e];
                                lf[n][e] = __logf(l + (1.0f - l) * r); v[n][e] = (1.0f - l) * ex * r;
                            }
                        *(f32x4*)(Clf + off + bj * HALF) = lf[0]; *(f32x4*)(Clf + off + bj * HALF + 4) = lf[1];
                    }
                    *(u32x4*)(base + off + bj * HALF) = pack8(v[0], v[1]);
                }
            }
    }
};
#ifndef PG8_KROT
#define PG8_KROT 0
#endif
template <class Epi, class Sched, bool ALIGN_EPI = false, bool SP2 = false, int PM = 0, bool HM = false, bool F16 = false, bool AIMG = false>
__device__ __forceinline__ void gemm_phase(PG8_LAS unsigned char* lds, const Gemm g, const Sched& S, const Epi& E) {
    int tid_ = threadIdx.x; asm volatile("" : "+v"(tid_));
    const int tid = tid_, wid = __builtin_amdgcn_readfirstlane(tid >> 6), lane = tid & 63, wr = wid >> 2, wc = wid & 3, fr = lane & 15, fq = lane >> 4;
    const int K = g.K, nt = K / BK, ld = g.ld, ks = g.ks;
    unsigned voffA[2], voffB[2];
#pragma unroll
    for (int i = 0; i < 2; ++i) { int R, C; stage_rc(tid * 16 + i * 8192, R, C); const int Rb = Epi::PERM ? ((R & ~31) + perm32(R & 31)) : R;
        voffA[i] = AIMG ? (unsigned)(((R >> 4) * (ld >> 5) + (C >> 5)) * 1024 + (lds_byte(R, C) & 1023)) : (unsigned)(R * ld + C) * 2u; voffB[i] = BIMG ? (unsigned)(((R >> 4) * (ld >> 5) + (C >> 5)) * 1024 + (lds_byte(R, C) & 1023)) : (unsigned)(Rb * ld + C) * 2u; }
    const size_t kstep = AIMG ? (size_t)2048 : (size_t)(BK * 2), kstepB = BIMG ? (size_t)2048 : (size_t)(BK * 2);
    const size_t hstep = (size_t)HALF * ld * 2;
    const size_t tstep = 2 * hstep;
    const unsigned ldsw = (unsigned)wid * 1024u;
    const int aoff = lds_byte(wr * 64 + fr, fq * 8), boff = lds_byte(wc * 32 + fr, fq * 8);
#define PG8_SA(b, h) (((b) * 2 + (h)) * HTB)
#define PG8_SB(b, h) ((4 + (b) * 2 + (h)) * HTB)
#define PG8_STAGE(bufoff, gbase, voff) do { _Pragma("unroll") for (int _i = 0; _i < 2; ++_i) \
        __builtin_amdgcn_global_load_lds((const unsigned*)((const char*)(gbase) + (voff)[_i]), (PG8_LAS unsigned*)(lds + (bufoff) + ldsw + _i * 8192), 16, 0, 0); } while (0)
#define PG8_LDA(dst, b, h) do { _Pragma("unroll") for (int m = 0; m < 4; ++m) _Pragma("unroll") for (int k = 0; k < 2; ++k) dst[m][k] = *(const PG8_LAS bf16x8*)(lds + PG8_SA(b, h) + aoff + m * 2048 + k * 1024); } while (0)
#define PG8_LDB(dst, b, h) do { _Pragma("unroll") for (int n = 0; n < 2; ++n) _Pragma("unroll") for (int k = 0; k < 2; ++k) dst[n][k] = *(const PG8_LAS bf16x8*)(lds + PG8_SB(b, h) + boff + n * 2048 + k * 1024); } while (0)
#define PG8_MMA(ai, bj, At, Bt) do { __builtin_amdgcn_s_setprio(1); _Pragma("unroll") for (int m = 0; m < 4; ++m) _Pragma("unroll") for (int n = 0; n < 2; ++n) _Pragma("unroll") for (int k = 0; k < 2; ++k) \
        { if constexpr (F16) acc[ai][bj][m][n] = __builtin_amdgcn_mfma_f32_16x16x32_f16(__builtin_bit_cast(f16x8, Bt[n][k]), __builtin_bit_cast(f16x8, At[m][k]), acc[ai][bj][m][n], 0, 0, 0); \
          else acc[ai][bj][m][n] = __builtin_amdgcn_mfma_f32_16x16x32_bf16(Bt[n][k], At[m][k], acc[ai][bj][m][n], 0, 0, 0); } __builtin_amdgcn_s_setprio(0); } while (0)
#define PG8_STAGE_L(bufoff, gbase, voff) do { if constexpr (PM != 1) PG8_STAGE(bufoff, gbase, voff); } while (0)
#define PG8_MMA_L(ai, bj, At, Bt) do { if constexpr (PM != 2) PG8_MMA(ai, bj, At, Bt); } while (0)
#define PG8_WAIT_V(n) asm volatile("s_waitcnt vmcnt(" #n ")" ::: "memory")
#define PG8_WAIT_L(n) asm volatile("s_waitcnt lgkmcnt(" #n ")" ::: "memory")
#define PG8_BAR __builtin_amdgcn_s_barrier()
#define PG8_SCHED __builtin_amdgcn_sched_barrier(0)
    Unit cur, nxt; int ui = 0;
    if (!S.next(0, cur)) return;
    f32x4 acc[2][2][4][2];
    E.init(acc, cur, wr, wc, fr, fq);
    bf16x8 At[4][2], B0[2][2], B1[2][2];
    const char* cA = (const char*)g.A + (size_t)cur.pm * tstep + (size_t)(cur.pn % ks) * K * 2 + (HM ? (size_t)cur.half * hstep : 0); const char* cB = (const char*)g.Bt + (size_t)(cur.pn / ks) * tstep + (size_t)(cur.pn % ks) * K * 2;
    int koff = PG8_KROT ? (PG8_KROT * (cur.pm + cur.pn)) % nt : 0;
    S.a_ready(cur);
    const char* cA0 = cA + (size_t)koff * kstep; const char* cB0 = cB + (size_t)koff * kstepB; const long k1d = (koff + 1 >= nt) ? -(long)koff * (long)kstep : (long)kstep, k1dB = (koff + 1 >= nt) ? -(long)koff * (long)kstepB : (long)kstepB;
    if constexpr (SP2) {
        static_assert(!HM || SP2, "HM needs the SP2 loop");
        PG8_STAGE(PG8_SB(0, 0), cB0, voffB); PG8_STAGE(PG8_SB(0, 1), cB0 + hstep, voffB); PG8_STAGE(PG8_SA(0, 0), cA0, voffA); if constexpr (!HM) PG8_STAGE(PG8_SA(0, 1), cA0 + hstep, voffA);
        if (wr == 1) PG8_BAR;
        if constexpr (HM) PG8_WAIT_V(0); else PG8_WAIT_V(2);
        PG8_BAR;
        PG8_STAGE(PG8_SB(1, 0), cB0 + k1dB, voffB); PG8_STAGE(PG8_SA(1, 0), cA0 + k1d, voffA); PG8_STAGE(PG8_SB(1, 1), cB0 + hstep + k1dB, voffB);
        PG8_WAIT_V(6); PG8_BAR;
    } else {
        PG8_STAGE(PG8_SB(0, 0), cB0, voffB); PG8_STAGE(PG8_SA(0, 0), cA0, voffA); PG8_STAGE(PG8_SB(0, 1), cB0 + hstep, voffB); PG8_STAGE(PG8_SA(0, 1), cA0 + hstep, voffA);
        if (wr == 1) PG8_BAR;
        PG8_WAIT_V(4); PG8_BAR;
        PG8_STAGE(PG8_SB(1, 0), cB0 + k1dB, voffB); PG8_STAGE(PG8_SA(1, 0), cA0 + k1d, voffA); PG8_STAGE(PG8_SB(1, 1), cB0 + hstep + k1dB, voffB);
        PG8_WAIT_V(6); PG8_BAR;
    }
    for (;;) {
        const bool has_next = S.next(ui + 1, nxt);
        const char* nA = has_next ? (const char*)g.A + (size_t)nxt.pm * tstep + (size_t)(nxt.pn % ks) * K * 2 + (HM ? (size_t)nxt.half * hstep : 0) : cA; const char* nB = has_next ? (const char*)g.Bt + (size_t)(nxt.pn / ks) * tstep + (size_t)(nxt.pn % ks) * K * 2 : cB;
        const int koffN = (PG8_KROT && has_next) ? (PG8_KROT * (nxt.pm + nxt.pn)) % nt : koff;
        int e0 = koff;
        for (int t = 0; t < nt; t += 2) {
            const bool last = (t == nt - 2);
            const int e1 = (e0 + 1 >= nt) ? e0 + 1 - nt : e0 + 1, e2 = (e0 + 2 >= nt) ? e0 + 2 - nt : e0 + 2, e3 = (e2 + 1 >= nt) ? 0 : e2 + 1, n1 = (koffN + 1 >= nt) ? 0 : koffN + 1;
            const char* a1 = cA + (size_t)e1 * kstep;
            const char* a2 = last ? nA + (size_t)koffN * kstep : cA + (size_t)e2 * kstep; const char* b2 = last ? nB + (size_t)koffN * kstepB : cB + (size_t)e2 * kstepB;
            const char* a3 = last ? nA + (size_t)n1 * kstep : cA + (size_t)e3 * kstep; const char* b3 = last ? nB + (size_t)n1 * kstepB : cB + (size_t)e3 * kstepB;
            e0 = e2;
            if (last && has_next) S.a_ready(nxt);
            if constexpr (SP2) {
#define PG8_WAIT_VL() do { if constexpr (HM) PG8_WAIT_V(6); else PG8_WAIT_V(8); } while (0)
            PG8_LDB(B0, 0, 0); PG8_LDB(B1, 0, 1); PG8_SCHED; PG8_LDA(At, 0, 0); if constexpr (!HM) PG8_STAGE_L(PG8_SA(1, 1), a1 + hstep, voffA);
            PG8_WAIT_VL(); PG8_WAIT_L(0); PG8_BAR; PG8_MMA_L(0, 0, At, B0); PG8_MMA_L(0, 1, At, B1); PG8_BAR; PG8_SCHED;
            if constexpr (!HM) PG8_LDA(At, 0, 1); PG8_STAGE_L(PG8_SB(0, 0), b2, voffB); PG8_STAGE_L(PG8_SB(0, 1), b2 + hstep, voffB); PG8_STAGE_L(PG8_SA(0, 0), a2, voffA);
            PG8_WAIT_VL(); PG8_WAIT_L(0); PG8_BAR; if constexpr (!HM) { PG8_MMA_L(1, 0, At, B0); PG8_MMA_L(1, 1, At, B1); } PG8_BAR; PG8_SCHED;
            PG8_LDB(B0, 1, 0); PG8_LDB(B1, 1, 1); PG8_SCHED; PG8_LDA(At, 1, 0); if constexpr (!HM) PG8_STAGE_L(PG8_SA(0, 1), a2 + hstep, voffA);
            PG8_WAIT_VL(); PG8_WAIT_L(0); PG8_BAR; PG8_MMA_L(0, 0, At, B0); PG8_MMA_L(0, 1, At, B1); PG8_BAR; PG8_SCHED;
            if constexpr (!HM) PG8_LDA(At, 1, 1); PG8_STAGE_L(PG8_SB(1, 0), b3, voffB); PG8_STAGE_L(PG8_SB(1, 1), b3 + hstep, voffB); PG8_STAGE_L(PG8_SA(1, 0), a3, voffA);
            PG8_WAIT_VL(); PG8_WAIT_L(0); PG8_BAR; if constexpr (!HM) { PG8_MMA_L(1, 0, At, B0); PG8_MMA_L(1, 1, At, B1); } PG8_BAR; PG8_SCHED;
#undef PG8_WAIT_VL
            } else {
            PG8_LDB(B0, 0, 0); PG8_SCHED; PG8_LDA(At, 0, 0); PG8_STAGE_L(PG8_SA(1, 1), a1 + hstep, voffA);
            PG8_WAIT_L(8); PG8_BAR; PG8_WAIT_L(0); PG8_MMA_L(0, 0, At, B0); PG8_BAR; PG8_SCHED;
            PG8_LDB(B1, 0, 1); PG8_STAGE_L(PG8_SB(0, 0), b2, voffB);
            PG8_BAR; PG8_WAIT_L(0); PG8_MMA_L(0, 1, At, B1); PG8_BAR;
            PG8_LDA(At, 0, 1); PG8_STAGE_L(PG8_SA(0, 0), a2, voffA);
            PG8_BAR; PG8_WAIT_L(0); PG8_MMA_L(1, 0, At, B0); PG8_BAR; PG8_SCHED;
            PG8_STAGE_L(PG8_SB(0, 1), b2 + hstep, voffB);
            PG8_WAIT_V(6); PG8_BAR; PG8_MMA_L(1, 1, At, B1); PG8_BAR;
            PG8_LDB(B0, 1, 0); PG8_SCHED; PG8_LDA(At, 1, 0); PG8_STAGE_L(PG8_SA(0, 1), a2 + hstep, voffA);
            PG8_WAIT_L(8); PG8_BAR; PG8_WAIT_L(0); PG8_MMA_L(0, 0, At, B0); PG8_BAR; PG8_SCHED;
            PG8_LDB(B1, 1, 1); PG8_STAGE_L(PG8_SB(1, 0), b3, voffB);
            PG8_BAR; PG8_WAIT_L(0); PG8_MMA_L(0, 1, At, B1); PG8_BAR;
            PG8_LDA(At, 1, 1); PG8_STAGE_L(PG8_SA(1, 0), a3, voffA);
            PG8_BAR; PG8_WAIT_L(0); PG8_MMA_L(1, 0, At, B0); PG8_BAR; PG8_SCHED;
            PG8_STAGE_L(PG8_SB(1, 1), b3 + hstep, voffB);
            PG8_WAIT_V(6); PG8_BAR; PG8_MMA_L(1, 1, At, B1); PG8_BAR;
            }
        }
        if constexpr (ALIGN_EPI) { if (wr == 0) PG8_BAR; }
        if constexpr (!Epi::AFTER_DRAIN) { E(acc, cur, ui, wr, wc, fr, fq); S.done(cur); }
        if (!has_next) break;
        cur = nxt; cA = nA; cB = nB; koff = koffN; ++ui;
        E.init(acc, cur, wr, wc, fr, fq);
        if constexpr (ALIGN_EPI) { if (wr == 1) PG8_BAR; }
    }
    PG8_WAIT_V(0);
    if constexpr (!ALIGN_EPI) { if (wr == 0) PG8_BAR; }
    PG8_BAR;
    if constexpr (Epi::AFTER_DRAIN) { E.fused(acc, cur, wr, wc, fr, fq, lds, wid, lane); S.done(cur); }
#undef PG8_SA
#undef PG8_SB
#undef PG8_STAGE
#undef PG8_STAGE_L
#undef PG8_MMA_L
#undef PG8_LDA
#undef PG8_LDB
#undef PG8_MMA
#undef PG8_WAIT_V
#undef PG8_WAIT_L
#undef PG8_BAR
#undef PG8_SCHED
}
}

constexpr int BATCH = 2, SEQ = 4096, D = 2048, DEPTH = 4, M = BATCH * SEQ;
constexpr int DFF = 5504, NFF = 2 * DFF;
constexpr int AB_IN = 7184, AB_PAD = 7424;
constexpr int HD = 128, NH_AB = 8, NH_C = 16, MEMT = 256, XW = 512, NBLK = SEQ / 256;
constexpr float EPS = 1e-6f;
constexpr float QK_SCALE_LOG2E = 0.08838834764831845f * 1.4426950408889634f;
constexpr int NWAVES = 8;

constexpr size_t MiB = 1u << 20;
constexpr size_t WS_CTL = 0, CTL_ZERO_BYTES = 1 * MiB;
constexpr size_t WS_X = 1 * MiB, WS_XB = 65 * MiB, WS_ROWSS = 97 * MiB, WS_ACT = 98 * MiB;
constexpr size_t WS_W1T = 184 * MiB, WS_W2T = 528 * MiB, WS_WABT = 700 * MiB, WS_WABOT = 758 * MiB, WS_WCT = 774 * MiB, WS_WCOT = 838 * MiB, WS_WXQT = 854 * MiB, WS_WXKVT = 862 * MiB, WS_WXOT = 878 * MiB;
constexpr size_t WS_MIX = 886 * MiB;
constexpr size_t WS_QM = WS_MIX, WS_KM = WS_MIX + 16 * MiB, WS_VM = WS_MIX + 32 * MiB, WS_DNPRE = WS_MIX + 48 * MiB, WS_DNGATE = WS_MIX + 96 * MiB, WS_BA = WS_MIX + 112 * MiB, WS_KMS = WS_MIX + 113 * MiB,
                 WS_DQ = WS_MIX + 114 * MiB, WS_DK = WS_MIX + 146 * MiB, WS_DV = WS_MIX + 178 * MiB, WS_BG = WS_MIX + 210 * MiB, WS_DNO = WS_MIX + 211 * MiB;
constexpr size_t WS_CQ = WS_MIX, WS_CK = WS_MIX + 32 * MiB, WS_CV = WS_MIX + 64 * MiB, WS_CG = WS_MIX + 96 * MiB, WS_CLF = WS_MIX + 128 * MiB, WS_CO = WS_MIX + 192 * MiB;
constexpr size_t WS_Y = WS_MIX + 256 * MiB, WS_XQ = WS_Y + 32 * MiB, WS_XO = WS_XQ + 8 * MiB, WS_MEMN = WS_XO + 8 * MiB, WS_KV = WS_MEMN + 2 * MiB, WS_LB = WS_KV + 4 * MiB, WS_END = WS_LB + 1 * MiB;
static_assert(WS_W1T + (size_t)8 * NFF * D * 2 <= WS_W2T && WS_W2T + (size_t)8 * D * DFF * 2 <= WS_WABT && WS_WABT + (size_t)2 * AB_PAD * D * 2 <= WS_WABOT && WS_ACT + (size_t)M * DFF * 2 <= WS_W1T, "ws map");
constexpr int CW_TMO = 0, CW_CODE = 1, CW_BAR = 4096;

constexpr int RING_OFF = 0, RING_BYTES = 131072;
constexpr int RTAB_OFF = RING_BYTES, RTAB_BYTES = 8 * 1024;
constexpr int LDSCTL_OFF = RTAB_OFF + RTAB_BYTES, MISC_OFF = LDSCTL_OFF + 320;
constexpr int LDS_BYTES = 147456;
static_assert(MISC_OFF + 128 <= LDS_BYTES, "LDS map");
#define GAS __attribute__((address_space(1)))
#define LAS __attribute__((address_space(3)))
typedef unsigned short bf16;
typedef unsigned v4u __attribute__((ext_vector_type(4)));
typedef float f32x4 __attribute__((ext_vector_type(4)));
typedef short bf16x8 __attribute__((ext_vector_type(8)));
typedef GAS unsigned gu32;
typedef GAS unsigned long long gu64;
#define RLX_AGENT __ATOMIC_RELAXED, __HIP_MEMORY_SCOPE_AGENT
#define LDS_WAIT() asm volatile("s_waitcnt lgkmcnt(0)" ::: "memory")
#define VM_WAIT() asm volatile("s_waitcnt vmcnt(0)" ::: "memory")
__device__ __forceinline__ unsigned long long rt() { return __builtin_amdgcn_s_memrealtime(); }
__device__ __forceinline__ unsigned f2bf(float f) { unsigned u = __builtin_bit_cast(unsigned, f); return (u + 0x7fffu + ((u >> 16) & 1u)) >> 16; }
__device__ __forceinline__ unsigned pk2(float lo, float hi) { return f2bf(lo) | (f2bf(hi) << 16); }
#define XB_TMO      128
#define XB_XCNT(j)  (256  + 64 * (j))
#define XB_XSUB(j)  (1280 + 64 * (j))
#define XB_XGEN(j)  (2304 + 64 * (j))
#define XB_TOP      3328
#define XB_TOPGEN   3392
#define XCD_BAR_WORDS 3456
#define XB_SPIN_CAP (1u << 18)

__device__ __forceinline__ unsigned xb_ld(unsigned* p)              { return __hip_atomic_load(p, __ATOMIC_RELAXED, __HIP_MEMORY_SCOPE_AGENT); }
__device__ __forceinline__ unsigned xb_add(unsigned* p, unsigned v) { return __hip_atomic_fetch_add(p, v, __ATOMIC_RELAXED, __HIP_MEMORY_SCOPE_AGENT); }
__device__ __forceinline__ unsigned xb_xcc_id() { return (unsigned)__builtin_amdgcn_s_getreg((3 << 11) | 20) & 0xFu; }
#define XB_SPIN(cond, bar) do { unsigned _sp = 0; while (cond) { __builtin_amdgcn_s_sleep(1); \
    if ((++_sp & 255u) == 0u) { if (xb_ld(&(bar)[XB_TMO])) break; if (_sp > XB_SPIN_CAP) { atomicAdd(&(bar)[XB_TMO], 1u); break; } } } } while (0)

struct XcdBarrier {
    unsigned* bar; unsigned x;
    volatile LAS unsigned* st;
};

__device__ __forceinline__ XcdBarrier xcd_barrier_post(unsigned* bar, volatile LAS unsigned* st) {
    XcdBarrier b; b.bar = bar; b.x = xb_xcc_id(); b.st = st;
    if (threadIdx.x == 0) (void)xb_add(&bar[XB_XCNT(b.x)], 1u);
    return b;
}
__device__ __forceinline__ void xcd_barrier_complete(unsigned* bar, unsigned x, unsigned& nloc, unsigned& nx) {
    const unsigned G = gridDim.x * gridDim.y * gridDim.z;
    unsigned sum, cnt, mine, sp = 0u;
    for (;;) {
        sum = 0u; cnt = 0u; mine = 0u;
#pragma unroll
        for (unsigned j = 0; j < 16; ++j) { const unsigned c = xb_ld(&bar[XB_XCNT(j)]); sum += c; cnt += (c > 0u) ? 1u : 0u; mine = (j == x) ? c : mine; }
        if (sum == G) break;
        __builtin_amdgcn_s_sleep(1);
        if ((++sp & 255u) == 0u) { if (xb_ld(&bar[XB_TMO])) break; if (sp > XB_SPIN_CAP) { atomicAdd(&bar[XB_TMO], 1u); break; } }
    }
    nloc = mine > 0u ? mine : 1u; nx = cnt > 0u ? cnt : 1u;
}

__device__ __forceinline__ void xcd_barrier(const XcdBarrier& b) {
    asm volatile("s_waitcnt vmcnt(0)" ::: "memory");
    __syncthreads();
    if (threadIdx.x == 0) {
        GAS unsigned* bar_g = (GAS unsigned*)b.bar; asm volatile("" : "+s"(bar_g)); unsigned* bar = (unsigned*)bar_g;
        __builtin_amdgcn_s_waitcnt(0);
        unsigned nloc = b.st[0], nx = b.st[1];
        if (nloc == 0u) { xcd_barrier_complete(bar, b.x, nloc, nx); b.st[0] = nloc; b.st[1] = nx; }
        const unsigned old = xb_add(&bar[XB_XSUB(b.x)], 1u);
        const unsigned gen = old / nloc;
        if (old + 1u == (gen + 1u) * nloc) {
            __builtin_amdgcn_fence(__ATOMIC_RELEASE, "agent");
            asm volatile("s_waitcnt vmcnt(0)" ::: "memory");
            const unsigned og = xb_add(&bar[XB_TOP], 1u);
            const unsigned tg = og / nx;
            if (og + 1u == (tg + 1u) * nx) xb_add(&bar[XB_TOPGEN], 1u);
            else XB_SPIN(xb_ld(&bar[XB_TOPGEN]) == tg, bar);
            __builtin_amdgcn_fence(__ATOMIC_ACQUIRE, "agent");
            xb_add(&bar[XB_XGEN(b.x)], 1u);
            asm volatile("s_waitcnt vmcnt(0)" ::: "memory");
        } else {
            XB_SPIN(xb_ld(&bar[XB_XGEN(b.x)]) == gen, bar);
            __builtin_amdgcn_fence(__ATOMIC_ACQUIRE, "agent");
            asm volatile("s_waitcnt vmcnt(0)" ::: "memory");
        }
    }
    __syncthreads();
}

struct Frame {
    LAS unsigned char* lds;
    volatile LAS unsigned* MISC;
    gu32* ctl;
    int tid, lane, wave, G, bx;
    const __attribute__((address_space(4))) unsigned long long* ka;
    float* out; GAS unsigned char* ws;
};
#define FIN(i) ((const float*)(const GAS float*)F.ka[i])
enum { I_X = 0, I_MEM, I_NORMG, I_MEMG, I_FINALG, I_FFN_WIN, I_FFN_WOUT, I_AB_WIN, I_AB_CONVW, I_AB_ALOG, I_AB_DTB, I_AB_ONG, I_AB_WOUT, I_C_WIN, I_C_LBL, I_C_ONG, I_C_WOUT, I_X_WQ, I_X_WKV, I_X_WO };

__device__ __forceinline__ int opaque_i(int v) { asm volatile("" : "+v"(v)); return v; }
#define PHASE_IDS() const int tid = opaque_i(F.tid), lane = tid & 63, wave = __builtin_amdgcn_readfirstlane(tid >> 6); (void)lane; (void)wave
__device__ __forceinline__ float wave_sum(float v) {
#pragma unroll
    for (int o = 1; o < 64; o <<= 1) v += __shfl_xor(v, o);
    return v;
}
__device__ __forceinline__ float wave_max(float v) {
#pragma unroll
    for (int o = 1; o < 64; o <<= 1) v = fmaxf(v, __shfl_xor(v, o));
    return v;
}
__device__ __forceinline__ float bflo(unsigned w) { return __uint_as_float(w << 16); }
__device__ __forceinline__ float bfhi(unsigned w) { return __uint_as_float(w & 0xffff0000u); }
__device__ __forceinline__ float sigmoid_f(float a) { return 1.0f / (1.0f + __expf(-a)); }
__device__ __forceinline__ float silu_acc(float a) { return a / (1.0f + __expf(-a)); }

__device__ __forceinline__ void conv_tile(const float* src, bf16* dst, int K, int N, int mode, const float* gain, int kb, int nb, int wave, int lane) {
    const int k0 = kb * 128 + wave * 16, n = nb * 256 + lane * 4;
    if (n >= N) return;
    const bool xw = X_F16 == 1 && gain != nullptr;
    f32x4 v[16];
#pragma unroll
    for (int r = 0; r < 16; ++r) v[r] = *(const GAS f32x4*)(src + (size_t)(k0 + r) * N + n);
    if (gain) {
#pragma unroll
        for (int r = 0; r < 16; ++r) v[r] = v[r] * gain[k0 + r];
    }
#pragma unroll
    for (int e = 0; e < 4; ++e) {
        const int col = n + e; int drow = col;
        if (mode == 1) { const int half = col >= DFF ? 1 : 0, j = col - half * DFF; drow = (j >> 7) * 256 + half * 128 + (j & 127); }
        v4u w0, w1;
#define CV2(a_, b_) (xw ? pg8::cvt_pk_f16(a_, b_) : pg8::cvt_pk_bf16(a_, b_))
        w0.x = CV2(v[0][e], v[1][e]); w0.y = CV2(v[2][e], v[3][e]); w0.z = CV2(v[4][e], v[5][e]); w0.w = CV2(v[6][e], v[7][e]);
        w1.x = CV2(v[8][e], v[9][e]); w1.y = CV2(v[10][e], v[11][e]); w1.z = CV2(v[12][e], v[13][e]); w1.w = CV2(v[14][e], v[15][e]);
#undef CV2
        GAS v4u* o = BIMG ? (GAS v4u*)((GAS char*)dst + pg8::img_off(pg8::slot32(drow), k0, K)) : (GAS v4u*)(dst + (size_t)drow * K + k0);
        o[0] = w0; o[1] = w1;
    }
}
constexpr int IT_W1M = 16 * 43, IT_W2M = 43 * 8;
__device__ __forceinline__ int conv_family_tiles(int fam) { return fam == 0 ? IT_W1M + IT_W2M : (fam == 1 ? 16 * 29 + 16 * 8 : (fam == 2 ? 16 * 32 + 16 * 8 : (fam == 3 ? 64 : 256))); }
__device__ __forceinline__ void conv_family_item(Frame& F, int fam, int m, int r, int wave, int lane) {
    const float* normg = FIN(I_NORMG); const float* src; bf16* dst; const float* gain = nullptr; int K = D, N = D, mode = 0, kb, nb;
    if (fam == 0) {
        if (r < IT_W1M) { kb = r / 43; nb = r - kb * 43; src = FIN(I_FFN_WIN) + (size_t)m * D * NFF; dst = (bf16*)(F.ws + WS_W1T) + (size_t)m * NFF * D; N = NFF; mode = 1; gain = normg + (size_t)((m >> 1) * 4 + ((m & 1) ? 3 : 0)) * D; }
        else { r -= IT_W1M; kb = r >> 3; nb = r & 7; src = FIN(I_FFN_WOUT) + (size_t)m * DFF * D; dst = (bf16*)(F.ws + WS_W2T) + (size_t)m * D * DFF; K = DFF; }
    } else if (fam == 1) {
        if (r < 16 * 29) { kb = r / 29; nb = r - kb * 29; src = FIN(I_AB_WIN) + (size_t)m * D * AB_IN; dst = (bf16*)(F.ws + WS_WABT) + (size_t)m * AB_PAD * D; N = AB_IN; gain = normg + (size_t)((2 * m) * 4 + 1) * D; }
        else { r -= 16 * 29; kb = r >> 3; nb = r & 7; src = FIN(I_AB_WOUT) + (size_t)m * D * D; dst = (bf16*)(F.ws + WS_WABOT) + (size_t)m * D * D; }
    } else if (fam == 2) {
        if (r < 16 * 32) { kb = r >> 5; nb = r & 31; src = FIN(I_C_WIN) + (size_t)m * D * 4 * D; dst = (bf16*)(F.ws + WS_WCT) + (size_t)m * 4 * D * D; N = 4 * D; gain = normg + (size_t)((2 * m + 1) * 4 + 1) * D; }
        else { r -= 16 * 32; kb = r >> 3; nb = r & 7; src = FIN(I_C_WOUT) + (size_t)m * D * D; dst = (bf16*)(F.ws + WS_WCOT) + (size_t)m * D * D; }
    } else if (fam == 3) {
        if (r < 32) { kb = r >> 1; nb = r & 1; src = FIN(I_X_WQ) + (size_t)m * D * XW; dst = (bf16*)(F.ws + WS_WXQT) + (size_t)m * XW * D; N = XW; gain = normg + (size_t)(m * 4 + 2) * D; }
        else { r -= 32; kb = r >> 3; nb = r & 7; src = FIN(I_X_WO) + (size_t)m * XW * D; dst = (bf16*)(F.ws + WS_WXOT) + (size_t)m * D * XW; K = XW; }
    } else { const int mat = r >> 6, q = r & 63; kb = q >> 2; nb = q & 3; src = FIN(I_X_WKV) + (size_t)mat * D * 2 * XW; dst = (bf16*)(F.ws + WS_WXKVT) + (size_t)mat * 2 * XW * D; N = 2 * XW; }
    conv_tile(src, dst, K, N, mode, gain, kb, nb, wave, lane);
}
__device__ __forceinline__ void conv_family(Frame& F, int fam, int m, int first, int skip_lo = 0, int skip_hi = 0, int part = 0) {
    if (F.bx < first || (F.bx >= skip_lo && F.bx < skip_hi)) return;
    PHASE_IDS();
    const int nall = conv_family_tiles(fam), r0 = part == 2 ? nall / 2 : 0, nt = part == 1 ? nall / 2 : nall, vb = F.bx - first - (F.bx >= skip_hi ? skip_hi - skip_lo : 0), nb = F.G - first - (skip_hi - skip_lo);
    for (int r = r0 + vb; r < nt; r += nb) conv_family_item(F, fam, m, r, wave, lane);
    if (part == 2) return;
    if (fam == 1) {
        constexpr int PADV = (AB_PAD - AB_IN) * (D / 16);
        for (int i = vb * 512 + tid; i < PADV; i += nb * 512) { const int c = AB_IN + i / (D / 16), k0 = (i % (D / 16)) * 16;
            GAS v4u* o = BIMG ? (GAS v4u*)(F.ws + WS_WABT + (size_t)m * AB_PAD * D * 2 + pg8::img_off(pg8::slot32(c), k0, D)) : (GAS v4u*)(F.ws + WS_WABT + ((size_t)m * AB_PAD + c) * D * 2 + k0 * 2); o[0] = (v4u){0u, 0u, 0u, 0u}; o[1] = (v4u){0u, 0u, 0u, 0u}; }
    }
}

constexpr int CQ_NSEG = 17;
__device__ __forceinline__ void conv_queue_tile(Frame& F, int t, int wave, int lane, int tid) {
    int fam = 0, m = 0, base = 0;
#define CQ_SEG(f_, m_, n_) if (t >= base + (n_)) base += (n_); else { fam = (f_); m = (m_); goto found; }
    CQ_SEG(0, 0, 1032) CQ_SEG(1, 0, 592) CQ_SEG(4, 0, 256) CQ_SEG(3, 0, 64) CQ_SEG(0, 1, 1032) CQ_SEG(0, 2, 1032) CQ_SEG(2, 0, 640) CQ_SEG(3, 1, 64) CQ_SEG(0, 3, 1032)
    CQ_SEG(0, 4, 1032) CQ_SEG(1, 1, 592) CQ_SEG(3, 2, 64) CQ_SEG(0, 5, 1032) CQ_SEG(0, 6, 1032) CQ_SEG(2, 1, 640) CQ_SEG(3, 3, 64) CQ_SEG(0, 7, 1032)
    return;
#undef CQ_SEG
found:
    const int r = t - base;
    conv_family_item(F, fam, m, r, wave, lane);
    if (fam == 1 && r == 0) {
        constexpr int PADV = (AB_PAD - AB_IN) * (D / 16);
        for (int i2 = tid; i2 < PADV; i2 += NWAVES * 64) { const int c = AB_IN + i2 / (D / 16), k0 = (i2 % (D / 16)) * 16;
            GAS v4u* o = BIMG ? (GAS v4u*)(F.ws + WS_WABT + (size_t)m * AB_PAD * D * 2 + pg8::img_off(pg8::slot32(c), k0, D)) : (GAS v4u*)(F.ws + WS_WABT + ((size_t)m * AB_PAD + c) * D * 2 + k0 * 2); o[0] = (v4u){0u, 0u, 0u, 0u}; o[1] = (v4u){0u, 0u, 0u, 0u}; }
    }
}
constexpr int CQ_TOTAL = 11232, CW_CONVQ = 2048;
__device__ __forceinline__ int cq_n_ffn(int s) { return s == 0 ? 1032 : s == 1 ? 2976 : s == 2 ? 4008 : s == 3 ? 5744 : s == 4 ? 6776 : s == 5 ? 8464 : s == 6 ? 9496 : 11232; }
__device__ __forceinline__ int cq_n_mix(int l) { return l == 0 ? 1624 : l == 1 ? 4648 : l == 2 ? 7368 : 10136; }
__device__ __forceinline__ int cq_n_x(int l) { return l == 0 ? 1944 : l == 1 ? 4712 : l == 2 ? 7432 : 10200; }
__device__ __forceinline__ unsigned cq_bcast(Frame& F, unsigned v, int tid) { __syncthreads(); if (tid == 0) F.MISC[20] = v; __syncthreads(); return F.MISC[20]; }
__device__ __forceinline__ void conv_slot(Frame& F, int first, int quota, int skip_lo = 0, int skip_hi = 0) {
    if (F.bx < first || (F.bx >= skip_lo && F.bx < skip_hi)) return;
    PHASE_IDS();
    gu32* q = F.ctl + CW_CONVQ;
    unsigned tk = 0u; if (tid == 0) tk = __hip_atomic_fetch_add(q, 1u, RLX_AGENT);
    for (int i = 0; i < quota; ++i) {
        const unsigned t = cq_bcast(F, tk, tid);
        if (t >= (unsigned)CQ_TOTAL) break;
        if (tid == 0 && i + 1 < quota) tk = __hip_atomic_fetch_add(q, 1u, RLX_AGENT);
        conv_queue_tile(F, (int)t, wave, lane, tid);
    }
}
__device__ __forceinline__ void conv_deadline(Frame& F, int need) {
    PHASE_IDS();
    gu32* q = F.ctl + CW_CONVQ;
    for (;;) {
        unsigned cur = 0u; if (tid == 0) cur = __hip_atomic_load(q, RLX_AGENT);
        if (cq_bcast(F, cur, tid) >= (unsigned)need) break;
        unsigned tk = 0u; if (tid == 0) tk = __hip_atomic_fetch_add(q, 1u, RLX_AGENT);
        const unsigned t = cq_bcast(F, tk, tid);
        if (t < (unsigned)CQ_TOTAL) conv_queue_tile(F, (int)t, wave, lane, tid);
    }
}

__device__ __forceinline__ void p0_prologue(Frame& F) {
    PHASE_IDS();
    conv_deadline(F, cq_n_ffn(0));
    const int gw = F.bx * NWAVES + wave, NGW = F.G * NWAVES;
    {
        const float* x = FIN(I_X); bf16* xb = (bf16*)(F.ws + WS_XB); float* rowss = (float*)(F.ws + WS_ROWSS);
        for (int m = gw; m < M; m += NGW) {
            const GAS f32x4* xr = (const GAS f32x4*)(x + (size_t)m * D) + lane; f32x4 v[8]; float ss = 0.f;
#pragma unroll
            for (int j = 0; j < 8; ++j) { v[j] = xr[64 * j]; ss += (v[j][0] * v[j][0] + v[j][1] * v[j][1]) + (v[j][2] * v[j][2] + v[j][3] * v[j][3]); }
            ss = wave_sum(ss);
            GAS pg8::u32x2* o = (GAS pg8::u32x2*)(xb + (size_t)m * D) + lane;
#pragma unroll
            for (int j = 0; j < 8; ++j) { pg8::u32x2 w; w.x = pg8::cvt_pk_x(v[j][0], v[j][1]); w.y = pg8::cvt_pk_x(v[j][2], v[j][3]);
                if (AIMG_XB) *(GAS pg8::u32x2*)((GAS char*)xb + pg8::img_off(m, 4 * lane + 256 * j, D)) = w; else o[64 * j] = w; }
            if (lane < 32) rowss[(size_t)lane * M + m] = lane == 0 ? ss : 0.f;
        }
    }
    {
        const float* mem = FIN(I_MEM); const float* mg = FIN(I_MEMG); bf16* mn = (bf16*)(F.ws + WS_MEMN);
        for (int m = gw; m < BATCH * MEMT; m += NGW) {
            const GAS f32x4* xr = (const GAS f32x4*)(mem + (size_t)m * D) + lane; f32x4 v[8]; float ss = 0.f;
#pragma unroll
            for (int j = 0; j < 8; ++j) { v[j] = xr[64 * j]; ss += (v[j][0] * v[j][0] + v[j][1] * v[j][1]) + (v[j][2] * v[j][2] + v[j][3] * v[j][3]); }
            const float rs = 1.0f / sqrtf(wave_sum(ss) * (1.0f / D) + EPS);
            GAS pg8::u32x2* o = (GAS pg8::u32x2*)(mn + (size_t)m * D) + lane;
#pragma unroll
            for (int j = 0; j < 8; ++j) { const f32x4 g = ((const GAS f32x4*)mg)[lane + 64 * j]; pg8::u32x2 w; w.x = pg8::cvt_pk_bf16(v[j][0] * rs * g[0], v[j][1] * rs * g[1]); w.y = pg8::cvt_pk_bf16(v[j][2] * rs * g[2], v[j][3] * rs * g[3]); o[64 * j] = w; }
        }
    }
    {
        const float* lg = FIN(I_C_LBL); float* lb = (float*)(F.ws + WS_LB);
        for (int c = F.bx * 512 + tid; c < D; c += F.G * 512) {
            const float a0 = lg[c], a1 = lg[D + c], a2 = lg[2 * D + c], a3 = lg[3 * D + c];
            const float mx = fmaxf(fmaxf(a0, a1), fmaxf(a2, a3));
            const float e0 = expf(a0 - mx), e1 = expf(a1 - mx), e2 = expf(a2 - mx), e3 = expf(a3 - mx), inv = 1.0f / (e0 + e1 + e2 + e3);
            const float p1 = e1 * inv, p2 = e2 * inv, p3 = e3 * inv;
            lb[c] = 0.f; lb[D + c] = p1; lb[2 * D + c] = p1 + p2; lb[3 * D + c] = p1 + p2 + p3;
        }
    }
}

template <class Sched> __device__ __forceinline__ void build_rtab(Frame& F, const Sched& S, int xi = -1, int xpn0 = 0, int xnt = 0) {
    PHASE_IDS();
    const float* rowss = (const float*)(F.ws + WS_ROWSS); LAS float* rt = (LAS float*)(F.lds + RTAB_OFF);
    int xpm = -1; if (xi >= 0) { pg8::HalfOrder H; H.init(M, xpn0, xnt, F.G, F.bx); pg8::Unit hu; if (H.next(0, hu)) xpm = hu.pm; xpm = __builtin_amdgcn_readfirstlane(xpm); }
    float v[4][32]; bool ok[4];
#pragma unroll
    for (int it = 0; it < 4; ++it) {
        const int idx = tid + it * NWAVES * 64, i = idx >> 8, r = idx & 255; pg8::Unit u; ok[it] = S.next(i, u);
        if (!ok[it] && i == xi && xpm >= 0) { ok[it] = true; u.pm = xpm; }
        const GAS float* p = (const GAS float*)rowss + (size_t)((ok[it] ? u.pm : 0) * 256 + r);
        if (ok[it]) {
#pragma unroll
            for (int j = 0; j < 32; ++j) v[it][j] = p[(size_t)j * M];
        } else {
#pragma unroll
            for (int j = 0; j < 32; ++j) v[it][j] = 0.f;
        }
    }
#pragma unroll
    for (int it = 0; it < 4; ++it) {
        float s = 0.f;
#pragma unroll
        for (int j = 0; j < 8; ++j) s += (v[it][4 * j] + v[it][4 * j + 1]) + (v[it][4 * j + 2] + v[it][4 * j + 3]);
        if (ok[it]) rt[tid + it * NWAVES * 64] = 1.0f / sqrtf(s * (1.0f / D) + EPS);
    }
    LDS_WAIT(); __syncthreads();
}
template <class Epi, int PM = 0, bool F16 = false, bool AIMG = false> __device__ __forceinline__ void run_gemm(Frame& F, const bf16* A, const bf16* Bt, int Mrows, int N, int K, const Epi& E, bool need_rtab, int rot = 0, int ld = 0, int ks = 1, int xi = -1, int xpn0 = 0, int xnt = 0) {
    pg8::Gemm g{A, Bt, Mrows, N, K, ld ? ld : K, ks}; pg8::StaticOrder S; S.init(Mrows, N, F.G, (int)(((unsigned)F.bx + (unsigned)rot) % (unsigned)F.G));
    if (need_rtab) build_rtab(F, S, xi, xpn0, xnt);
    pg8::gemm_phase<Epi, pg8::StaticOrder, true, true, PM, false, F16, AIMG>(F.lds + RING_OFF, g, S, E);
}

template <class Epi, bool F16 = false, bool AIMG = false> __device__ __forceinline__ void run_gemm_half(Frame& F, const bf16* A, const bf16* Bt, int Mrows, int N, int K, int pn0, int ntile, const Epi& E, bool need_rtab = true, int rot = 0) {
    pg8::Gemm g{A, Bt, Mrows, N, K, K, 1}; pg8::HalfOrder S; S.init(Mrows, pn0, ntile, F.G, (int)(((unsigned)F.bx + (unsigned)rot) % (unsigned)F.G));
    if (need_rtab) build_rtab(F, S);
    pg8::gemm_phase<Epi, pg8::HalfOrder, true, true, 0, true, F16, AIMG>(F.lds + RING_OFF, g, S, E);
}
__device__ __forceinline__ void normgate(Frame& F, const float* o, const bf16* gate, int nheads, const float* gw_, int ycol) {
    PHASE_IDS();
    bf16* Y = (bf16*)(F.ws + WS_Y);
    const int hw = lane >> 5, l32 = lane & 31, ld = nheads * HD, total = M * nheads;
    const int gw = (F.bx * NWAVES + wave) * 2 + hw, NGW = F.G * NWAVES * 2;
    const f32x4 g4 = *(const GAS f32x4*)(gw_ + 4 * l32);
    for (int u0 = gw; u0 < total; u0 += 4 * NGW) {
        f32x4 v[4]; pg8::u32x2 gt[4];
#pragma unroll
        for (int j = 0; j < 4; ++j) { const int un = u0 + j * NGW; if (un < total) { const int row = un / nheads, h = un - row * nheads;
            v[j] = *(const GAS f32x4*)(o + (size_t)row * ld + h * HD + 4 * l32); gt[j] = *(const GAS pg8::u32x2*)(gate + (size_t)row * ld + h * HD + 4 * l32); } else { v[j] = (f32x4){0.f, 0.f, 0.f, 0.f}; gt[j] = (pg8::u32x2){0u, 0u}; } }
#pragma unroll
        for (int j = 0; j < 4; ++j) { const int un = u0 + j * NGW;
            float ss = (v[j][0] * v[j][0] + v[j][1] * v[j][1]) + (v[j][2] * v[j][2] + v[j][3] * v[j][3]);
#pragma unroll
            for (int of = 1; of < 32; of <<= 1) ss += __shfl_xor(ss, of);
            const float rs = 1.0f / sqrtf(ss * (1.0f / HD) + EPS);
            if (un < total) { const int row = un / nheads, h = un - row * nheads; pg8::u32x2 w;
                w.x = pg8::cvt_pk_bf16(v[j][0] * rs * g4[0] * silu_acc(bflo(gt[j].x)), v[j][1] * rs * g4[1] * silu_acc(bfhi(gt[j].x))); w.y = pg8::cvt_pk_bf16(v[j][2] * rs * g4[2] * silu_acc(bflo(gt[j].y)), v[j][3] * rs * g4[3] * silu_acc(bfhi(gt[j].y)));
                *(GAS pg8::u32x2*)(Y + (size_t)row * D + ycol + h * HD + 4 * l32) = w; }
        }
    }
}
__device__ __forceinline__ void final_norm(Frame& F) {
    PHASE_IDS();
    static_assert(X_F16 == 2, "final_norm reads the fragment-ordered f16 residual plane");
    const GAS pg8::u32x4* xn = (const GAS pg8::u32x4*)(F.ws + WS_X); const GAS float* rowss = (const GAS float*)(F.ws + WS_ROWSS); const float* fg = FIN(I_FINALG);
    const int gw = F.bx * NWAVES + wave, NGW = F.G * NWAVES, fr = lane & 15, fq = lane >> 4;
    constexpr int NT = (M / 256) * (D / 256) * 64;
    for (int t0 = gw; t0 < NT; t0 += 2 * NGW) {
        pg8::u32x4 c0[2], c1[2]; float s[2]; int row[2], tt[2];
#pragma unroll
        for (int u = 0; u < 2; ++u) { const int t = t0 + u * NGW < NT ? t0 + u * NGW : t0; tt[u] = t;
            const int am = t & 7, wid = (t >> 3) & 7, U = t >> 6, pm = U / (D / 256), wr = wid >> 2;
            row[u] = pm * 256 + (am >> 2) * 128 + wr * 64 + (am & 3) * 16 + fr;
            c0[u] = xn[((size_t)t * 2 + 0) * 64 + lane]; c1[u] = xn[((size_t)t * 2 + 1) * 64 + lane];
            float a = 0.f;
#pragma unroll
            for (int k = 0; k < 8; ++k) a += rowss[(size_t)(fq * 8 + k) * M + row[u]];
            s[u] = a; }
#pragma unroll
        for (int u = 0; u < 2; ++u) { if (u == 1 && t0 + NGW >= NT) break;
            const int t = tt[u], wid = (t >> 3) & 7, U = t >> 6, pn = U % (D / 256), wc = wid & 3;
            float a = s[u]; a += __shfl_xor(a, 16); a += __shfl_xor(a, 32);
            const float rs = 1.0f / sqrtf(a * (1.0f / D) + EPS);
#pragma unroll
            for (int bj = 0; bj < 2; ++bj) { const pg8::u32x4 c = bj ? c1[u] : c0[u]; const int col = pn * 256 + bj * 128 + wc * 32 + 8 * fq;
                const f32x4 g0 = *(const GAS f32x4*)(fg + col), g1 = *(const GAS f32x4*)(fg + col + 4);
                const f32x4 x0 = {pg8::f16_lo(c.x), pg8::f16_hi(c.x), pg8::f16_lo(c.y), pg8::f16_hi(c.y)}, x1 = {pg8::f16_lo(c.z), pg8::f16_hi(c.z), pg8::f16_lo(c.w), pg8::f16_hi(c.w)};
                GAS f32x4* o = (GAS f32x4*)(F.out + (size_t)row[u] * D + col); o[0] = x0 * rs * g0; o[1] = x1 * rs * g1; }
        }
    }
}

namespace att {
typedef short s16x4 __attribute__((ext_vector_type(4)));
typedef short v4i16_t __attribute__((ext_vector_type(4)));
__device__ __forceinline__ unsigned swz(unsigned row) { return ((row & 3u) << 2) | ((row >> 2) & 3u); }
__device__ __forceinline__ void glds16(const void* gsrc, unsigned lds_dst) { unsigned keep;
    asm volatile("s_mov_b32 %0, m0\n\ts_mov_b32 m0, %2\n\ts_nop 0\n\tglobal_load_lds_dwordx4 %1, off\n\ts_mov_b32 m0, %0" : "=&s"(keep) : "v"(gsrc), "s"(lds_dst) : "memory"); }
__device__ __forceinline__ s16x4 vtr(const LAS char* p) { return __builtin_bit_cast(s16x4, __builtin_amdgcn_ds_read_tr16_b64_v4i16((LAS v4i16_t*)p)); }
__device__ __forceinline__ void stage_half(const char* g, size_t pitch, LAS char* img, int wave, int lane) {
#pragma unroll
    for (int p = 0; p < 4; ++p) {
        const int piece = 4 * wave + p; const unsigned row = 4u * piece + ((unsigned)lane >> 4), ch = ((unsigned)lane & 15u) ^ swz(row);
        glds16(g + (size_t)row * pitch + ch * 16u, (unsigned)__builtin_amdgcn_readfirstlane((unsigned)(size_t)(img + piece * 1024)));
    }
}
struct State { f32x4 o[2][8]; float m[2], l[2]; };
__device__ __forceinline__ void half_step(State& st, const bf16x8 (&qf)[2][4], const LAS char* Kimg, const LAS char* Vimg, int lane, int maskmode, int kbase, const int (&qidx)[2], const bool (&valid)[2]) {
    const unsigned fr = lane & 15, g = lane >> 4, q4 = fr >> 2, p = lane & 3;
    const unsigned fk = swz(fr);
    f32x4 s[2][8];
#pragma unroll
    for (int qt = 0; qt < 2; ++qt)
#pragma unroll
        for (int kt = 0; kt < 8; ++kt) s[qt][kt] = (f32x4){0.f, 0.f, 0.f, 0.f};
#define SB() __builtin_amdgcn_sched_barrier(0)
#define ATT_LDK(kt_, K_) do { _Pragma("unroll") for (int ks_ = 0; ks_ < 4; ++ks_) K_[ks_] = *(const LAS bf16x8*)(Kimg + 256u * (16u * (kt_) + fr) + 16u * ((4u * ks_ + g) ^ fk)); } while (0)
#define ATT_MMK(kt_, K_) do { _Pragma("unroll") for (int ks_ = 0; ks_ < 4; ++ks_) { s[0][kt_] = __builtin_amdgcn_mfma_f32_16x16x32_bf16(K_[ks_], qf[0][ks_], s[0][kt_], 0, 0, 0); s[1][kt_] = __builtin_amdgcn_mfma_f32_16x16x32_bf16(K_[ks_], qf[1][ks_], s[1][kt_], 0, 0, 0); } } while (0)
    {
        bf16x8 kA[4], kB[4];
        ATT_LDK(0, kA); SB();
        ATT_LDK(1, kB); SB(); ATT_MMK(0, kA); SB();
        ATT_LDK(2, kA); SB(); ATT_MMK(1, kB); SB();
        ATT_LDK(3, kB); SB(); ATT_MMK(2, kA); SB();
        ATT_LDK(4, kA); SB(); ATT_MMK(3, kB); SB();
        ATT_LDK(5, kB); SB(); ATT_MMK(4, kA); SB();
        ATT_LDK(6, kA); SB(); ATT_MMK(5, kB); SB();
        ATT_LDK(7, kB); SB(); ATT_MMK(6, kA); SB();
        ATT_MMK(7, kB); SB();
    }
#undef ATT_LDK
#undef ATT_MMK
    bf16x8 pf[2][4];
    if (maskmode == 1) {
#pragma unroll
        for (int qt = 0; qt < 2; ++qt)
#pragma unroll
            for (int kt = 0; kt < 8; ++kt)
#pragma unroll
                for (int r = 0; r < 4; ++r) if (kbase + 16 * kt + 4 * (int)g + r > qidx[qt]) s[qt][kt][r] = -INFINITY;
    }
#pragma unroll
    for (int qt = 0; qt < 2; ++qt) {
        float mx = -INFINITY;
#pragma unroll
        for (int kt = 0; kt < 8; ++kt)
#pragma unroll
            for (int r = 0; r < 4; ++r) mx = fmaxf(mx, s[qt][kt][r]);
        mx = fmaxf(mx, __shfl_xor(mx, 16)); mx = fmaxf(mx, __shfl_xor(mx, 32));
        if (!valid[qt]) mx = -INFINITY;
        const float mn = fmaxf(st.m[qt], mx);
        const float alpha = (st.m[qt] == -INFINITY) ? 0.f : __builtin_amdgcn_exp2f(st.m[qt] - mn);
        const float msub = (!valid[qt] || mn == -INFINITY) ? INFINITY : mn;
        st.m[qt] = mn;
        float sum = 0.f;
#pragma unroll
        for (int kt = 0; kt < 8; ++kt)
#pragma unroll
            for (int r = 0; r < 4; ++r) { const float pv = __builtin_amdgcn_exp2f(s[qt][kt][r] - msub); s[qt][kt][r] = pv; sum += pv; }
        st.l[qt] = st.l[qt] * alpha + sum;
        if (__any(alpha != 1.0f)) {
#pragma unroll
            for (int dt = 0; dt < 8; ++dt) st.o[qt][dt] = st.o[qt][dt] * alpha;
        }
#pragma unroll
        for (int ks = 0; ks < 4; ++ks) {
            pg8::u32x4 w; w.x = pg8::cvt_pk_bf16(s[qt][2 * ks][0], s[qt][2 * ks][1]); w.y = pg8::cvt_pk_bf16(s[qt][2 * ks][2], s[qt][2 * ks][3]);
            w.z = pg8::cvt_pk_bf16(s[qt][2 * ks + 1][0], s[qt][2 * ks + 1][1]); w.w = pg8::cvt_pk_bf16(s[qt][2 * ks + 1][2], s[qt][2 * ks + 1][3]);
            pf[qt][ks] = __builtin_bit_cast(bf16x8, w);
        }
    }
    const unsigned fv = (q4 << 2) | g;
#define ATT_LDV(dt_, V_) do { const unsigned vb_ = 256u * (4u * g + q4) + 16u * ((2u * (dt_) + (p >> 1)) ^ fv) + 8u * (p & 1u); _Pragma("unroll") for (int ks_ = 0; ks_ < 4; ++ks_) { \
        const s16x4 v0_ = vtr(Vimg + vb_ + 256u * (32u * ks_)), v1_ = vtr(Vimg + vb_ + 256u * (32u * ks_ + 16u)); bf16x8 t_; t_[0] = v0_[0]; t_[1] = v0_[1]; t_[2] = v0_[2]; t_[3] = v0_[3]; t_[4] = v1_[0]; t_[5] = v1_[1]; t_[6] = v1_[2]; t_[7] = v1_[3]; V_[ks_] = t_; } } while (0)
#define ATT_MMV(dt_, V_) do { _Pragma("unroll") for (int ks_ = 0; ks_ < 4; ++ks_) { st.o[0][dt_] = __builtin_amdgcn_mfma_f32_16x16x32_bf16(V_[ks_], pf[0][ks_], st.o[0][dt_], 0, 0, 0); st.o[1][dt_] = __builtin_amdgcn_mfma_f32_16x16x32_bf16(V_[ks_], pf[1][ks_], st.o[1][dt_], 0, 0, 0); } } while (0)
    {
        bf16x8 vA[4], vB[4];
        ATT_LDV(0, vA); SB();
        ATT_LDV(1, vB); SB(); ATT_MMV(0, vA); SB();
        ATT_LDV(2, vA); SB(); ATT_MMV(1, vB); SB();
        ATT_LDV(3, vB); SB(); ATT_MMV(2, vA); SB();
        ATT_LDV(4, vA); SB(); ATT_MMV(3, vB); SB();
        ATT_LDV(5, vB); SB(); ATT_MMV(4, vA); SB();
        ATT_LDV(6, vA); SB(); ATT_MMV(5, vB); SB();
        ATT_LDV(7, vB); SB(); ATT_MMV(6, vA); SB();
        ATT_MMV(7, vB); SB();
    }
#undef ATT_LDV
#undef ATT_MMV
#undef SB
}
}

template <int MODE>
__device__ __forceinline__ void attn_unit(Frame& F, int tid_in, int wave, int b, int h, int qblk, int l) {
    const int tid = opaque_i(tid_in), lane = tid & 63;
    LAS char* ring = (LAS char*)(F.lds + RING_OFF);
    LAS unsigned* sel = (LAS unsigned*)(F.lds + RTAB_OFF);
    const bf16* Qp; int ldq; bf16* Op; int ldo;
    if (MODE == 0) { Qp = (const bf16*)(F.ws + WS_XQ); ldq = XW; Op = (bf16*)(F.ws + WS_XO); ldo = XW; }
    else { Qp = (const bf16*)(F.ws + WS_QM); ldq = 1024; Op = (bf16*)(F.ws + WS_Y); ldo = D; }
    const int row0 = b * SEQ + qblk * 256;
    const unsigned fr = lane & 15, g = lane >> 4;
    int nsteps = 2;
    if (MODE == 1) {
        const float* kms = (const float*)(F.ws + WS_KMS);
        LAS float* km = (LAS float*)ring; LAS float* gl = (LAS float*)(ring + 8192);
        __syncthreads();
        for (int i = tid; i < qblk * 128; i += NWAVES * 64) { const int j = i >> 7, d = i & 127; const float* p0 = kms + (size_t)((b * NBLK + j) * 2) * 1024 + h * HD + d; km[i] = p0[0] + p0[1024]; }
        LDS_WAIT(); __syncthreads();
        {
            const int q = tid >> 1, par = tid & 1; float ga[8];
#pragma unroll
            for (int jj = 0; jj < 8; ++jj) ga[jj] = 0.f;
            const GAS v4u* qr = (const GAS v4u*)(Qp + (size_t)(row0 + q) * ldq + h * HD);
            for (int c = 0; c < 16; ++c) {
                const v4u w = qr[c]; const float q0 = bflo(w.x), q1 = bfhi(w.x), q2 = bflo(w.y), q3 = bfhi(w.y), q4 = bflo(w.z), q5 = bfhi(w.z), q6 = bflo(w.w), q7 = bfhi(w.w);
#pragma unroll
                for (int jj = 0; jj < 8; ++jj) { const int j = 2 * jj + par; if (j < qblk) { const f32x4 k0 = *(const LAS f32x4*)(km + j * 128 + 8 * c), k1 = *(const LAS f32x4*)(km + j * 128 + 8 * c + 4);
                    ga[jj] += (q0 * k0[0] + q1 * k0[1]) + (q2 * k0[2] + q3 * k0[3]) + (q4 * k1[0] + q5 * k1[1]) + (q6 * k1[2] + q7 * k1[3]); } }
            }
#pragma unroll
            for (int jj = 0; jj < 8; ++jj) gl[q * 16 + 2 * jj + par] = ga[jj];
        }
        LDS_WAIT(); __syncthreads();
        if (tid < 256) {
            float v1 = -INFINITY, v2 = -INFINITY, v3 = -INFINITY; int i1 = -1, i2 = -1, i3 = -1;
            for (int j = 0; j < qblk; ++j) { const float gj = gl[tid * 16 + j];
                if (gj > v1) { v3 = v2; i3 = i2; v2 = v1; i2 = i1; v1 = gj; i1 = j; } else if (gj > v2) { v3 = v2; i3 = i2; v2 = gj; i2 = j; } else if (gj > v3) { v3 = gj; i3 = j; } }
            unsigned mbits = 1u << qblk; if (i1 >= 0) mbits |= 1u << i1; if (i2 >= 0) mbits |= 1u << i2; if (i3 >= 0) mbits |= 1u << i3;
            sel[tid] = mbits;
        }
        LDS_WAIT(); __syncthreads();
        nsteps = 2 * (qblk + 1);
    } else { __syncthreads(); }
    bf16x8 qf[2][4]; int qidx[2]; unsigned selq[2];
#pragma unroll
    for (int qt = 0; qt < 2; ++qt) {
        qidx[qt] = 32 * wave + 16 * qt + (int)fr; selq[qt] = MODE == 1 ? sel[qidx[qt]] : 0u;
        const bf16* qrow = Qp + (size_t)(row0 + qidx[qt]) * ldq + h * HD;
#pragma unroll
        for (int ks = 0; ks < 4; ++ks) qf[qt][ks] = *(const GAS bf16x8*)(qrow + 32 * ks + 8 * g);
    }
    att::State st;
#pragma unroll
    for (int qt = 0; qt < 2; ++qt) { st.m[qt] = -INFINITY; st.l[qt] = 0.f;
#pragma unroll
        for (int dt = 0; dt < 8; ++dt) st.o[qt][dt] = (f32x4){0.f, 0.f, 0.f, 0.f}; }
    const size_t pitch = MODE == 0 ? (size_t)4096 * 2 : (size_t)1024 * 2;
#define KBASE_OF(i) (MODE == 0 ? (const char*)((const bf16*)(F.ws + WS_KV) + (size_t)(b * MEMT + (i) * 128) * 4096 + l * 1024 + h * HD) \
                               : (const char*)((const bf16*)(F.ws + WS_KM) + (size_t)(b * SEQ + ((i) < 2 ? qblk : (((i) - 2) >> 1)) * 256 + ((i) & 1) * 128) * 1024 + h * HD))
#define VBASE_OF(i) (MODE == 0 ? (const char*)((const bf16*)(F.ws + WS_KV) + (size_t)(b * MEMT + (i) * 128) * 4096 + l * 1024 + 512 + h * HD) \
                               : (const char*)((const bf16*)(F.ws + WS_VM) + (size_t)(b * SEQ + ((i) < 2 ? qblk : (((i) - 2) >> 1)) * 256 + ((i) & 1) * 128) * 1024 + h * HD))
    att::stage_half(KBASE_OF(0), pitch, ring, wave, lane); att::stage_half(VBASE_OF(0), pitch, ring + 32768, wave, lane);
    VM_WAIT(); __syncthreads();
    for (int i = 0; i < nsteps; ++i) {
        LAS char* cur = ring + (i & 1) * 65536; LAS char* nxt = ring + ((i + 1) & 1) * 65536;
        const int ln = opaque_i(lane);
        if (i + 1 < nsteps) { att::stage_half(KBASE_OF(i + 1), pitch, nxt, wave, ln); att::stage_half(VBASE_OF(i + 1), pitch, nxt + 32768, wave, ln); }
        bool valid[2] = {true, true}; int maskmode = 0; bool run = true;
        if (MODE == 1) {
            if (i < 2) { maskmode = 1; if (i == 1 && wave < 4) run = false; }
            else { const int blk = (i - 2) >> 1; valid[0] = (selq[0] >> blk) & 1u; valid[1] = (selq[1] >> blk) & 1u; run = __any((int)(valid[0] || valid[1])) != 0; }
        }
        if (run) att::half_step(st, qf, cur, cur + 32768, opaque_i(ln), maskmode, (i & 1) * 128, qidx, valid);
        VM_WAIT(); __syncthreads();
    }
#pragma unroll
    for (int qt = 0; qt < 2; ++qt) {
        float lt = st.l[qt]; lt += __shfl_xor(lt, 16); lt += __shfl_xor(lt, 32);
        const float inv = 1.0f / lt;
        bf16* orow = Op + (size_t)(row0 + qidx[qt]) * ldo + h * HD + 4 * g;
#pragma unroll
        for (int dt = 0; dt < 8; ++dt) { pg8::u32x2 w; w.x = pg8::cvt_pk_bf16(st.o[qt][dt][0] * inv, st.o[qt][dt][1] * inv); w.y = pg8::cvt_pk_bf16(st.o[qt][dt][2] * inv, st.o[qt][dt][3] * inv); *(GAS pg8::u32x2*)(orow + 16 * dt) = w; }
    }
}
#undef KBASE_OF
#undef VBASE_OF
__device__ __forceinline__ void moba_phase(Frame& F, int blk0) {
    if (F.bx < blk0) return;
    PHASE_IDS();
    const int nb = F.G - blk0;
    for (int pr = F.bx - blk0; pr < BATCH * NH_AB * 8; pr += nb) {
        const int bh = pr >> 3, k = pr & 7, b = bh >> 3, h = bh & 7;
        for (int rep = 0; rep < 2; ++rep) attn_unit<1>(F, tid, wave, b, h, rep ? k : 15 - k, 0);
    }
}
__device__ __forceinline__ void xattn_phase(Frame& F, int l) {
    PHASE_IDS();
    for (int un = F.bx; un < BATCH * 4 * (SEQ / 256); un += F.G) {
        const int qblk = un & 15, bh = un >> 4, b = bh >> 2, h = bh & 3;
        attn_unit<0>(F, tid, wave, b, h, qblk, l);
    }
}

constexpr size_t WS_UT = WS_MIX + 114 * MiB, WS_WT = WS_MIX + 146 * MiB, WS_QDT = WS_MIX + 162 * MiB, WS_KD = WS_MIX + 178 * MiB, WS_AQK = WS_MIX + 194 * MiB, WS_GL = WS_MIX + 202 * MiB;
namespace dn {
typedef short s16x4 __attribute__((ext_vector_type(4)));
__device__ __forceinline__ unsigned swz8(unsigned row) { return (row >> 1) & 7u; }
__device__ __forceinline__ s16x4 pack4(const f32x4& v) { pg8::u32x2 w; w.x = pg8::cvt_pk_bf16(v[0], v[1]); w.y = pg8::cvt_pk_bf16(v[2], v[3]); return __builtin_bit_cast(s16x4, w); }
__device__ __forceinline__ f32x4 unpack4(const s16x4& v) { const pg8::u32x2 w = __builtin_bit_cast(pg8::u32x2, v); return (f32x4){bflo(w.x), bfhi(w.x), bflo(w.y), bfhi(w.y)}; }
__device__ __forceinline__ bf16x8 join8(const s16x4& a, const s16x4& b) { bf16x8 r; r[0] = a[0]; r[1] = a[1]; r[2] = a[2]; r[3] = a[3]; r[4] = b[0]; r[5] = b[1]; r[6] = b[2]; r[7] = b[3]; return r; }
constexpr int MPITCH = 68, DPITCH = 20;
}

__device__ __forceinline__ void dn_chunk_phase(Frame& F, int e) {
    PHASE_IDS();
    LAS char* ring = (LAS char*)(F.lds + RING_OFF);
    LAS char* QI = ring; LAS char* KI = ring + 16384; LAS char* VI = ring + 32768;
    LAS float* MI = (LAS float*)(ring + 49152);
    LAS float* DI = (LAS float*)(ring + 49152 + 64 * dn::MPITCH * 4);
    LAS float* TG = DI + 4 * 16 * dn::DPITCH; LAS float* TB = TG + 64; LAS float* SSQ = (LAS float*)(F.lds + RTAB_OFF);
    LAS char* CWL = ring + 72192;
    LAS char* SLAB = ring + 78848;
#define DN_SLAB(ci_) do { const int n_ = (ci_) & 63, bh_ = (ci_) >> 6, h_ = bh_ & 7, b_ = bh_ >> 3; const long rb_ = (long)b_ * SEQ + n_ * 64; const int ln_ = opaque_i(lane);        \
        _Pragma("unroll") for (int k_ = 0; k_ < 7; ++k_) { const int q_ = wave + 8 * k_; if (q_ < 51) { const int P_ = q_ * 64 + ln_; int rp_ = P_ >> 4; rp_ = rp_ > 200 ? 200 : rp_; const int tok_ = rp_ / 3, sec_ = rp_ - 3 * tok_; \
            const long row_ = (n_ == 0 && tok_ < 3) ? rb_ : rb_ + tok_ - 3; \
            att::glds16(pre + (size_t)row_ * 3072 + sec_ * 1024 + h_ * HD + 8 * (P_ & 15), (unsigned)__builtin_amdgcn_readfirstlane((unsigned)(size_t)(SLAB + q_ * 1024))); } } \
        if (wave < 6) { const int P_ = wave * 64 + ln_, rp_ = P_ >> 5, i_ = rp_ / 3, sec_ = rp_ - 3 * i_;        \
            att::glds16(cw + i_ * 3072 + sec_ * 1024 + h_ * HD + 4 * (P_ & 31), (unsigned)__builtin_amdgcn_readfirstlane((unsigned)(size_t)(CWL + wave * 1024))); } } while (0)
    const bf16* pre = (const bf16*)(F.ws + WS_DNPRE); const float* ba = (const float*)(F.ws + WS_BA); const float* cw = FIN(I_AB_CONVW) + (size_t)e * 4 * 3072;
    const unsigned fr = lane & 15, g = lane >> 4, q4 = fr >> 2, p = lane & 3;
    if (F.bx < BATCH * NH_AB * (SEQ / 64)) DN_SLAB(F.bx);
    for (int ci = F.bx; ci < BATCH * NH_AB * (SEQ / 64); ci += F.G) {
        const int n = ci & 63, bh = ci >> 6, h = bh & 7, b = bh >> 3; const size_t rbase = (size_t)b * SEQ + n * 64;
        float* uT = (float*)(F.ws + WS_UT) + (size_t)ci * 8192; bf16* wT = (bf16*)(F.ws + WS_WT) + (size_t)ci * 8192; bf16* qdT = (bf16*)(F.ws + WS_QDT) + (size_t)ci * 8192;
        bf16* kd = (bf16*)(F.ws + WS_KD) + (size_t)ci * 8192; bf16* aqk = (bf16*)(F.ws + WS_AQK) + (size_t)ci * 4096;
        VM_WAIT(); __syncthreads();
        float braw_ = 0.f, araw_ = 0.f, alog_ = 0.f;
        if (tid < 64) { braw_ = ba[(rbase + tid) * 16 + h]; araw_ = ba[(rbase + tid) * 16 + 8 + h] + FIN(I_AB_DTB)[e * 8 + h]; alog_ = FIN(I_AB_ALOG)[e * 8 + h]; }
        float val[6][8];
        v4u wrow[3][5];
#pragma unroll
        for (int sec = 0; sec < 3; ++sec)
#pragma unroll
            for (int k = 0; k < 5; ++k) wrow[sec][k] = *(const LAS v4u*)(SLAB + (((2 * (tid >> 4) + k) * 3 + sec) * 16 + (tid & 15)) * 16);
#pragma unroll
        for (int sec = 0; sec < 3; ++sec) {
            const int gq = tid & 15;
            f32x4 cwv[4][2];
#pragma unroll
            for (int i = 0; i < 4; ++i) { cwv[i][0] = *(const LAS f32x4*)(CWL + (i * 3 + sec) * 512 + gq * 32); cwv[i][1] = *(const LAS f32x4*)(CWL + (i * 3 + sec) * 512 + gq * 32 + 16); }
            float xr[5][8];
#pragma unroll
            for (int k = 0; k < 5; ++k) { const v4u w = wrow[sec][k]; xr[k][0] = bflo(w.x); xr[k][1] = bfhi(w.x); xr[k][2] = bflo(w.y); xr[k][3] = bfhi(w.y); xr[k][4] = bflo(w.z); xr[k][5] = bfhi(w.z); xr[k][6] = bflo(w.w); xr[k][7] = bfhi(w.w); }
#pragma unroll
            for (int half = 0; half < 2; ++half) {
                const int it = 2 * sec + half, c = 2 * (tid >> 4) + half, t = n * 64 + c;
#pragma unroll
                for (int j = 0; j < 8; ++j) val[it][j] = 0.f;
#pragma unroll
                for (int i = 0; i < 4; ++i) {
                    if (t - 3 + i >= 0) {
#pragma unroll
                        for (int j = 0; j < 4; ++j) { val[it][j] += cwv[i][0][j] * xr[half + i][j]; val[it][4 + j] += cwv[i][1][j] * xr[half + i][4 + j]; }
                    }
                }
                float ss = 0.f;
#pragma unroll
                for (int j = 0; j < 8; ++j) { val[it][j] = pg8::silu_f(val[it][j]); ss += val[it][j] * val[it][j]; }
                if (sec < 2) SSQ[(c * 2 + sec) * 16 + gq] = ss;
            }
        }
        if (tid < 64) {
            const float braw = braw_, araw = araw_;
            const float ea = __expf(araw); const float sp = araw > 20.f ? araw : (ea < 1e-3f ? ea * (1.0f - 0.5f * ea) : __logf(1.0f + ea));
            float gg = -__expf(alog_) * sp;
#pragma unroll
            for (int o = 1; o < 64; o <<= 1) { const float t2 = __shfl_up(gg, o); if (lane >= o) gg += t2; }
            TG[tid] = gg; TB[tid] = sigmoid_f(braw);
        }
        LDS_WAIT(); __syncthreads();
        if (ci + F.G < BATCH * NH_AB * (SEQ / 64)) DN_SLAB(ci + F.G);
#pragma unroll
        for (int it = 0; it < 6; ++it) {
            const int sec = it >> 1, c = 2 * (tid >> 4) + (it & 1), gq = tid & 15; float sc = 1.0f;
            if (sec < 2) { float s = 0.f;
#pragma unroll
                for (int j = 0; j < 4; ++j) { const f32x4 q = *(const LAS f32x4*)(SSQ + (c * 2 + sec) * 16 + 4 * j); s += (q[0] + q[1]) + (q[2] + q[3]); }
                sc = (1.0f / sqrtf(s + EPS)) * (sec == 0 ? 0.08838834764831845f : 1.0f); }
            LAS char* img = sec == 0 ? QI : (sec == 1 ? KI : VI);
            v4u w; w.x = pg8::cvt_pk_bf16(val[it][0] * sc, val[it][1] * sc); w.y = pg8::cvt_pk_bf16(val[it][2] * sc, val[it][3] * sc); w.z = pg8::cvt_pk_bf16(val[it][4] * sc, val[it][5] * sc); w.w = pg8::cvt_pk_bf16(val[it][6] * sc, val[it][7] * sc);
            *(LAS v4u*)(img + 256 * c + 16 * ((unsigned)gq ^ att::swz((unsigned)c))) = w;
        }
        if (tid < 384) { const int pr = tid >> 6, ctz = pr < 3 ? 0 : (pr < 5 ? 1 : 2), stz = pr < 3 ? pr + 1 : (pr < 5 ? pr - 1 : 3), cz = 16 * ctz + ((tid & 63) >> 2), gz = tid & 3;
            *(GAS pg8::u32x2*)(aqk + cz * 64 + 32 * (stz >> 1) + 8 * gz + 4 * (stz & 1)) = (pg8::u32x2){0u, 0u}; }
        LDS_WAIT(); __syncthreads();
        for (int jb = wave; jb < 20; jb += NWAVES) {
            const int ty = jb >= 10 ? 1 : 0, ti = jb - 10 * ty; int ct = 0, st = ti;
            if (ti >= 6) { ct = 3; st = ti - 6; } else if (ti >= 3) { ct = 2; st = ti - 3; } else if (ti >= 1) { ct = 1; st = ti - 1; }
            f32x4 acc = {0.f, 0.f, 0.f, 0.f};
            if (ty == 0) {
#pragma unroll
                for (int ks = 0; ks < 4; ++ks) { const bf16x8 a = *(const LAS bf16x8*)(KI + 256u * (16u * ct + fr) + 16u * ((4u * ks + g) ^ att::swz(fr))), bb = *(const LAS bf16x8*)(KI + 256u * (16u * st + fr) + 16u * ((4u * ks + g) ^ att::swz(fr)));
                    acc = __builtin_amdgcn_mfma_f32_16x16x32_bf16(a, bb, acc, 0, 0, 0); }
                const int s = 16 * st + (int)fr; const float gs = TG[s];
#pragma unroll
                for (int r = 0; r < 4; ++r) { const int c = 16 * ct + 4 * (int)g + r; MI[c * dn::MPITCH + s] = s < c ? acc[r] * TB[c] * __expf(TG[c] - gs) : 0.f; }
            } else {
#pragma unroll
                for (int ks = 0; ks < 4; ++ks) { const bf16x8 a = *(const LAS bf16x8*)(KI + 256u * (16u * st + fr) + 16u * ((4u * ks + g) ^ att::swz(fr))), bb = *(const LAS bf16x8*)(QI + 256u * (16u * ct + fr) + 16u * ((4u * ks + g) ^ att::swz(fr)));
                    acc = __builtin_amdgcn_mfma_f32_16x16x32_bf16(a, bb, acc, 0, 0, 0); }
                const int c = 16 * ct + (int)fr; const float gc = TG[c]; f32x4 o;
#pragma unroll
                for (int r = 0; r < 4; ++r) { const int s = 16 * st + 4 * (int)g + r; o[r] = s <= c ? acc[r] * __expf(gc - TG[s]) : 0.f; }
                *(GAS dn::s16x4*)(aqk + c * 64 + 32 * (st >> 1) + 8 * g + 4 * (st & 1)) = dn::pack4(o);
            }
        }
        LDS_WAIT(); __syncthreads();
        if (wave == 0) {
            const int i = g, j = fr; float dc[16]; f32x4 mr[16][4];
            dc[0] = (j == 0) ? 1.f : 0.f;
#pragma unroll
            for (int r = 1; r < 9; ++r)
#pragma unroll
                for (int q = 0; q < 4; ++q) if (4 * q < r) mr[r][q] = *(const LAS f32x4*)(MI + (16 * i + r) * dn::MPITCH + 16 * i + 4 * q);
#pragma unroll
            for (int r = 1; r < 9; ++r)
#pragma unroll
                for (int q = 0; q < 4; ++q) if (4 * q < r) asm volatile("" : "+v"(mr[r][q]));
#pragma unroll
            for (int r = 1; r < 9; ++r) { float a = (r == j) ? 1.f : 0.f;
#pragma unroll
                for (int s = 0; s < r; ++s) a -= mr[r][s >> 2][s & 3] * dc[s];
                dc[r] = a; }
#pragma unroll
            for (int r = 9; r < 16; ++r)
#pragma unroll
                for (int q = 0; q < 4; ++q) if (4 * q < r) mr[r][q] = *(const LAS f32x4*)(MI + (16 * i + r) * dn::MPITCH + 16 * i + 4 * q);
#pragma unroll
            for (int r = 9; r < 16; ++r)
#pragma unroll
                for (int q = 0; q < 4; ++q) if (4 * q < r) asm volatile("" : "+v"(mr[r][q]));
#pragma unroll
            for (int r = 9; r < 16; ++r) { float a = (r == j) ? 1.f : 0.f;
#pragma unroll
                for (int s = 0; s < r; ++s) a -= mr[r][s >> 2][s & 3] * dc[s];
                dc[r] = a; }
#pragma unroll
            for (int r = 0; r < 16; ++r) DI[(i * 16 + r) * dn::DPITCH + j] = dc[r];
        }
        LDS_WAIT(); __syncthreads();
#pragma unroll
        for (int job = 0; job < 2; ++job) {
            const LAS char* img = job ? KI : VI; dn::s16x4 xb[4];
#pragma unroll
            for (int i = 0; i < 4; ++i) {
                const unsigned row = 16u * i + 4u * g + q4;
                const dn::s16x4 raw = att::vtr(img + 256u * row + 16u * ((2u * wave + (p >> 1)) ^ att::swz(row)) + 8u * (p & 1u));
                f32x4 acc = dn::unpack4(raw);
#pragma unroll
                for (int r = 0; r < 4; ++r) { const int c = 16 * i + 4 * (int)g + r; acc[r] *= job ? TB[c] * __expf(TG[c]) : TB[c]; }
#pragma unroll
                for (int j = 0; j < 4; ++j) { if (j < i) { const f32x4 mm = *(const LAS f32x4*)(MI + (16 * i + (int)fr) * dn::MPITCH + 16 * j + 4 * (int)g);
                    acc = __builtin_amdgcn_mfma_f32_16x16x16bf16_1k(dn::pack4(-mm), xb[j], acc, 0, 0, 0); } }
                const f32x4 dd = *(const LAS f32x4*)(DI + (16 * i + (int)fr) * dn::DPITCH + 4 * (int)g);
                const f32x4 x = __builtin_amdgcn_mfma_f32_16x16x16bf16_1k(dn::pack4(dd), dn::pack4(acc), (f32x4){0.f, 0.f, 0.f, 0.f}, 0, 0, 0);
                xb[i] = dn::pack4(x);
                if (job == 0) *(GAS f32x4*)(uT + (16 * wave + (int)fr) * 64 + 16 * i + 4 * (int)g) = x;
                else *(GAS dn::s16x4*)(wT + (16 * wave + (int)fr) * 64 + 16 * i + 4 * (int)g) = dn::pack4(-x);
            }
        }
#pragma unroll
        for (int i = 0; i < 4; ++i) {
            const unsigned row = 16u * i + 4u * g + q4;
            f32x4 qv = dn::unpack4(att::vtr(QI + 256u * row + 16u * ((2u * wave + (p >> 1)) ^ att::swz(row)) + 8u * (p & 1u)));
#pragma unroll
            for (int r = 0; r < 4; ++r) qv[r] *= __expf(TG[16 * i + 4 * (int)g + r]);
            *(GAS dn::s16x4*)(qdT + (16 * wave + (int)fr) * 64 + 16 * i + 4 * (int)g) = dn::pack4(qv);
        }
        {
            const float glast = TG[63];
#pragma unroll
            for (int it = 0; it < 2; ++it) { const int item = tid + 512 * it, s = item >> 4, ch = item & 15; const float sc = __expf(glast - TG[s]);
                const v4u w = *(const LAS v4u*)(KI + 256 * s + 16 * ((unsigned)ch ^ att::swz((unsigned)s)));
                v4u o; o.x = pg8::cvt_pk_bf16(bflo(w.x) * sc, bfhi(w.x) * sc); o.y = pg8::cvt_pk_bf16(bflo(w.y) * sc, bfhi(w.y) * sc); o.z = pg8::cvt_pk_bf16(bflo(w.z) * sc, bfhi(w.z) * sc); o.w = pg8::cvt_pk_bf16(bflo(w.w) * sc, bfhi(w.w) * sc);
                *(GAS v4u*)(kd + s * 128 + 8 * ch) = o; }
            if (tid == 0) ((float*)(F.ws + WS_GL))[ci] = __expf(glast);
        }
    }
#undef DN_SLAB
    __syncthreads();
}

#ifndef DN_TAIL_NORMGATE
#define DN_TAIL_NORMGATE 1
#endif
constexpr int CW_CHAIN = 8192;
__device__ __forceinline__ void chain_sync(Frame& F, gu32* word, unsigned want) {
    asm volatile("s_waitcnt vmcnt(0)" ::: "memory");
    __syncthreads();
    if (threadIdx.x == 0) {
        __builtin_amdgcn_fence(__ATOMIC_RELEASE, "agent"); asm volatile("s_waitcnt vmcnt(0)" ::: "memory");
        __hip_atomic_fetch_add(word, 1u, RLX_AGENT);
        unsigned sp = 0u;
        while (__hip_atomic_load(word, RLX_AGENT) < want) { __builtin_amdgcn_s_sleep(1); if (++sp > (1u << 22)) break; }
        __builtin_amdgcn_fence(__ATOMIC_ACQUIRE, "agent"); asm volatile("s_waitcnt vmcnt(0)" ::: "memory");
    }
    __syncthreads();
}
constexpr int NG_ = 8;
__device__ __forceinline__ void normgate_rows(Frame& F, const float* o, const bf16* gate, int nheads, const float* gw_, int ycol, int r0, int nr, int h) {
    PHASE_IDS();
    bf16* Y = (bf16*)(F.ws + WS_Y);
    const int hw = lane >> 5, l32 = lane & 31, ld = nheads * HD, hid = wave * 2 + hw;
    const f32x4 g4 = *(const GAS f32x4*)(gw_ + 4 * l32);
    for (int u0 = hid; u0 < nr; u0 += NG_ * 2 * NWAVES) {
        f32x4 v[NG_]; pg8::u32x2 gt[NG_];
#pragma unroll
        for (int j = 0; j < NG_; ++j) { const int un = u0 + j * 2 * NWAVES; if (un < nr) { const size_t row = (size_t)(r0 + un);
            v[j] = *(const GAS f32x4*)(o + row * ld + h * HD + 4 * l32); gt[j] = *(const GAS pg8::u32x2*)(gate + row * ld + h * HD + 4 * l32); } else { v[j] = (f32x4){0.f, 0.f, 0.f, 0.f}; gt[j] = (pg8::u32x2){0u, 0u}; } }
#pragma unroll
        for (int j = 0; j < NG_; ++j) { const int un = u0 + j * 2 * NWAVES;
            float ss = (v[j][0] * v[j][0] + v[j][1] * v[j][1]) + (v[j][2] * v[j][2] + v[j][3] * v[j][3]);
#pragma unroll
            for (int of = 1; of < 32; of <<= 1) ss += __shfl_xor(ss, of);
            const float rs = 1.0f / sqrtf(ss * (1.0f / HD) + EPS);
            if (un < nr) { const size_t row = (size_t)(r0 + un); pg8::u32x2 w;
                w.x = pg8::cvt_pk_bf16(v[j][0] * rs * g4[0] * silu_acc(bflo(gt[j].x)), v[j][1] * rs * g4[1] * silu_acc(bfhi(gt[j].x))); w.y = pg8::cvt_pk_bf16(v[j][2] * rs * g4[2] * silu_acc(bflo(gt[j].y)), v[j][3] * rs * g4[3] * silu_acc(bfhi(gt[j].y)));
                *(GAS pg8::u32x2*)(Y + row * D + ycol + h * HD + 4 * l32) = w; }
        }
    }
}
constexpr int CW_NGQ = 8192 + 128 * 16;
__device__ __forceinline__ void ng_help(Frame& F, int e) {
    PHASE_IDS();
    constexpr int SPL = 4, NCH = BATCH * NH_AB, TPC = 16, ROWS = SEQ / TPC;
    gu32* q = F.ctl + CW_NGQ + e * 16;
    for (;;) {
        unsigned tk = 0u; if (tid == 0) tk = __hip_atomic_fetch_add(q, 1u, RLX_AGENT);
        const unsigned t = cq_bcast(F, tk, tid);
        if (t >= (unsigned)(NCH * TPC)) break;
        const int bh = (int)t / TPC, k = (int)t % TPC, h = bh & 7, b = bh >> 3;
        if (tid == 0) { gu32* w = F.ctl + CW_CHAIN + (e * NCH + bh) * 16; unsigned sp = 0u;
            while (__hip_atomic_load(w, RLX_AGENT) < (unsigned)SPL) { __builtin_amdgcn_s_sleep(1); if (++sp > (1u << 22)) break; }
            __builtin_amdgcn_fence(__ATOMIC_ACQUIRE, "agent"); asm volatile("s_waitcnt vmcnt(0)" ::: "memory"); }
        __syncthreads();
        normgate_rows(F, (const float*)(F.ws + WS_DNO), (const bf16*)(F.ws + WS_DNGATE), NH_AB, FIN(I_AB_ONG) + e * HD, 1024, b * SEQ + k * ROWS, ROWS, h);
    }
}
template <int PM>
__device__ __forceinline__ void dn_scan_phase(Frame& F, int e) {
    constexpr int SPL = 4, NCH = BATCH * NH_AB;
    if (F.bx >= SPL * NCH) return;
    PHASE_IDS();
    const int bh = F.bx % NCH, part = F.bx / NCH, h = bh & 7, b = bh >> 3;
    const int dvt = (8 / SPL) * part + (wave & (8 / SPL - 1)); const bool active = wave < 8 / SPL;
    const int rot = part * (56 / SPL);
    LAS char* ring = (LAS char*)(F.lds + RING_OFF);
    constexpr int STG = 57344;
    const char* gWT = (const char*)(F.ws + WS_WT) + (size_t)bh * 64 * 16384; const char* gQD = (const char*)(F.ws + WS_QDT) + (size_t)bh * 64 * 16384;
    const char* gKD = (const char*)(F.ws + WS_KD) + (size_t)bh * 64 * 16384; const char* gAQ = (const char*)(F.ws + WS_AQK) + (size_t)bh * 64 * 8192;
    const float* gUT = (const float*)(F.ws + WS_UT) + (size_t)bh * 64 * 8192; const float* gGL = (const float*)(F.ws + WS_GL) + bh * 64;
    float* dno = (float*)(F.ws + (PM == 0 ? WS_DNO : WS_ACT));
#define DN_STAGE(n_, stg_) do { _Pragma("unroll") for (int pi_ = 0; pi_ < 7; ++pi_) { int pc_ = 7 * wave + pi_ + rot; pc_ -= pc_ >= 56 ? 56 : 0; const char* src_; \
        if (pc_ < 32 || pc_ >= 48) { const int q_ = pc_ < 16 ? pc_ : (pc_ < 32 ? pc_ - 16 : pc_ - 48); const unsigned row_ = 8u * q_ + ((unsigned)ln >> 3), ch_ = ((unsigned)ln & 7u) ^ dn::swz8(row_); \
            src_ = (pc_ < 16 ? gWT + (size_t)(n_) * 16384 : (pc_ < 32 ? gQD + (size_t)(n_) * 16384 : gAQ + (size_t)(n_) * 8192)) + row_ * 128u + ch_ * 16u; } \
        else { const int q_ = pc_ - 32; const unsigned row_ = 4u * q_ + ((unsigned)ln >> 4), ch_ = ((unsigned)ln & 15u) ^ att::swz(row_); src_ = gKD + (size_t)(n_) * 16384 + row_ * 256u + ch_ * 16u; } \
        att::glds16(src_, (unsigned)__builtin_amdgcn_readfirstlane((unsigned)(size_t)((stg_) + pc_ * 1024))); } } while (0)
    f32x4 S[8]; bf16x8 Sb[4];
#pragma unroll
    for (int dt = 0; dt < 8; ++dt) S[dt] = (f32x4){0.f, 0.f, 0.f, 0.f};
#pragma unroll
    for (int ks = 0; ks < 4; ++ks) Sb[ks] = (bf16x8){0, 0, 0, 0, 0, 0, 0, 0};
    { const int ln = lane; DN_STAGE(0, ring); }
    f32x4 un[4]; const int glbits = __float_as_int(gGL[lane]);
#pragma unroll
    for (int mt = 0; mt < 4; ++mt) un[mt] = *(const GAS f32x4*)(gUT + (16 * dvt + (lane & 15)) * 64 + 16 * mt + 4 * (lane >> 4));
    VM_WAIT(); __syncthreads();
    for (int n = 0; n < SEQ / 64; ++n) {
        LAS char* cur = ring + (n & 1) * STG; LAS char* nxt = ring + ((n + 1) & 1) * STG;
        const int ln = opaque_i(lane);
        asm volatile("" : "+v"(un[0]), "+v"(un[1]), "+v"(un[2]), "+v"(un[3]));
        f32x4 vn[4];
#pragma unroll
        for (int mt = 0; mt < 4; ++mt) vn[mt] = un[mt];
        if (PM != 1 && n + 1 < SEQ / 64) DN_STAGE(n + 1, nxt);
        const unsigned fr = ln & 15, g = (unsigned)ln >> 4, q4 = fr >> 2, p = ln & 3;
        const LAS char* WI = cur; const LAS char* QDI = cur + 16384; const LAS char* KDI = cur + 32768; const LAS char* AQI = cur + 49152;
        if (active && PM != 2) {
        const float gl = __int_as_float(__builtin_amdgcn_readlane(glbits, n));
        f32x4 oo[4];
#pragma unroll
        for (int mt = 0; mt < 4; ++mt) oo[mt] = (f32x4){0.f, 0.f, 0.f, 0.f};
        if (n + 1 < SEQ / 64) {
#pragma unroll
            for (int mt = 0; mt < 4; ++mt) un[mt] = *(const GAS f32x4*)(gUT + (size_t)(n + 1) * 8192 + (16 * dvt + (int)fr) * 64 + 16 * mt + 4 * (int)g);
        }
#define SB() __builtin_amdgcn_sched_barrier(0)
        const unsigned sw8 = (2u * g + (q4 >> 1)) & 7u, fv = (q4 << 2) | g;
#define DN_LD_WQ(mt_, W_, Q_) do { _Pragma("unroll") for (int ks_ = 0; ks_ < 4; ++ks_) { const unsigned r0_ = 32u * ks_ + 4u * g + q4, cb_ = 16u * ((2u * (mt_) + (p >> 1)) ^ sw8) + 8u * (p & 1u); \
            W_[ks_] = dn::join8(att::vtr(WI + 128u * r0_ + cb_), att::vtr(WI + 128u * (r0_ + 16u) + cb_)); Q_[ks_] = dn::join8(att::vtr(QDI + 128u * r0_ + cb_), att::vtr(QDI + 128u * (r0_ + 16u) + cb_)); } } while (0)
#define DN_MM_WQ(mt_, W_, Q_) do { _Pragma("unroll") for (int ks_ = 0; ks_ < 4; ++ks_) { vn[mt_] = __builtin_amdgcn_mfma_f32_16x16x32_bf16(W_[ks_], Sb[ks_], vn[mt_], 0, 0, 0); oo[mt_] = __builtin_amdgcn_mfma_f32_16x16x32_bf16(Q_[ks_], Sb[ks_], oo[mt_], 0, 0, 0); } } while (0)
#define DN_LD_KD(d0_, K_) do { _Pragma("unroll") for (int dd_ = 0; dd_ < 4; ++dd_) _Pragma("unroll") for (int k2_ = 0; k2_ < 2; ++k2_) { const unsigned r0_ = 32u * k2_ + 4u * g + q4, cb_ = 16u * ((2u * ((d0_) + dd_) + (p >> 1)) ^ fv) + 8u * (p & 1u); \
            K_[dd_][k2_] = dn::join8(att::vtr(KDI + 256u * r0_ + cb_), att::vtr(KDI + 256u * (r0_ + 16u) + cb_)); } } while (0)
        bf16x8 wA[4], qA[4], wB[4], qB[4], af[4][2], kA[4][2], kB[4][2];
        DN_LD_WQ(0, wA, qA); SB();
        DN_LD_WQ(1, wB, qB); SB(); DN_MM_WQ(0, wA, qA); SB();
        DN_LD_WQ(2, wA, qA); SB(); DN_MM_WQ(1, wB, qB); SB();
        DN_LD_WQ(3, wB, qB); SB(); DN_MM_WQ(2, wA, qA); SB();
#pragma unroll
        for (int mt = 0; mt < 4; ++mt)
#pragma unroll
            for (int k2 = 0; k2 < 2; ++k2) { const unsigned row = 16u * mt + fr; af[mt][k2] = *(const LAS bf16x8*)(AQI + 128u * row + 16u * ((4u * k2 + g) ^ dn::swz8(row))); }
        SB(); DN_MM_WQ(3, wB, qB); SB();
        DN_LD_KD(0, kA); SB();
        bf16x8 vb[2];
#pragma unroll
        for (int k2 = 0; k2 < 2; ++k2) vb[k2] = dn::join8(dn::pack4(vn[2 * k2]), dn::pack4(vn[2 * k2 + 1]));
#pragma unroll
        for (int mt = 0; mt < 4; ++mt)
#pragma unroll
            for (int k2 = 0; k2 < 2; ++k2) oo[mt] = __builtin_amdgcn_mfma_f32_16x16x32_bf16(af[mt][k2], vb[k2], oo[mt], 0, 0, 0);
        SB(); DN_LD_KD(4, kB); SB();
#pragma unroll
        for (int dt = 0; dt < 4; ++dt) { S[dt] = S[dt] * gl;
#pragma unroll
            for (int k2 = 0; k2 < 2; ++k2) S[dt] = __builtin_amdgcn_mfma_f32_16x16x32_bf16(kA[dt][k2], vb[k2], S[dt], 0, 0, 0); }
        SB();
#pragma unroll
        for (int dt = 4; dt < 8; ++dt) { S[dt] = S[dt] * gl;
#pragma unroll
            for (int k2 = 0; k2 < 2; ++k2) S[dt] = __builtin_amdgcn_mfma_f32_16x16x32_bf16(kB[dt - 4][k2], vb[k2], S[dt], 0, 0, 0); }
#pragma unroll
        for (int ks = 0; ks < 4; ++ks) Sb[ks] = dn::join8(dn::pack4(S[2 * ks]), dn::pack4(S[2 * ks + 1]));
#undef DN_LD_WQ
#undef DN_MM_WQ
#undef DN_LD_KD
#undef SB
        const size_t rbase = (size_t)b * SEQ + n * 64;
#pragma unroll
        for (int mt = 0; mt < 4; ++mt)
#pragma unroll
            for (int r = 0; r < 4; ++r) dno[(rbase + 16 * mt + 4 * g + r) * 1024 + h * HD + 16 * dvt + fr] = oo[mt][r];
        }
        VM_WAIT();
        __syncthreads();
    }
#undef DN_STAGE
    if constexpr (PM == 0 && DN_TAIL_NORMGATE == 2) {
        asm volatile("s_waitcnt vmcnt(0)" ::: "memory");
        __syncthreads();
        if (threadIdx.x == 0) { __builtin_amdgcn_fence(__ATOMIC_RELEASE, "agent"); asm volatile("s_waitcnt vmcnt(0)" ::: "memory"); __hip_atomic_fetch_add(F.ctl + CW_CHAIN + (e * NCH + bh) * 16, 1u, RLX_AGENT); }
    }
    if constexpr (PM == 0 && DN_TAIL_NORMGATE == 1) {
        chain_sync(F, F.ctl + CW_CHAIN + (e * NCH + bh) * 16, SPL);
        normgate_rows(F, (const float*)(F.ws + WS_DNO), (const bf16*)(F.ws + WS_DNGATE), NH_AB, FIN(I_AB_ONG) + e * HD, 1024, b * SEQ + part * (SEQ / SPL), SEQ / SPL, h);
    }
}

constexpr size_t WS_QEP = WS_END, WS_KE = WS_END + 32 * MiB, WS_AINT = WS_END + 64 * MiB, WS_GD = WS_END + 80 * MiB, WS_END2 = WS_END + 82 * MiB;
namespace gla { constexpr int BP = 132; }

__device__ __forceinline__ void gla_chunk_phase(Frame& F) {
    PHASE_IDS();
    LAS char* ring = (LAS char*)(F.lds + RING_OFF);
    LAS float* BI = (LAS float*)ring;
    LAS char* QS = ring + 34816;
    LAS char* KS = ring + 34816 + 16384;
    LAS float* PART = (LAS float*)(ring + 34816 + 16384 + 40960);
    const bf16* Cq = (const bf16*)(F.ws + WS_CQ); const bf16* Ck = (const bf16*)(F.ws + WS_CK); const float* Clf = (const float*)(F.ws + WS_CLF);
    const unsigned fr = lane & 15, g = lane >> 4;
    for (int ci = F.bx; ci < BATCH * NH_C * (SEQ / 64); ci += F.G) {
        const int n = ci & 63, bh = ci >> 6, h = bh & 15, b = bh >> 4; const size_t rbase = (size_t)b * SEQ + n * 64;
        bf16* qep = (bf16*)(F.ws + WS_QEP) + (size_t)ci * 8192; bf16* ke = (bf16*)(F.ws + WS_KE) + (size_t)ci * 8192; bf16* aint = (bf16*)(F.ws + WS_AINT) + (size_t)ci * 4096; float* gd = (float*)(F.ws + WS_GD) + (size_t)ci * 256;
        __syncthreads();
        float lfv[16];
        { const int d = tid & 127, qr = tid >> 7;
#pragma unroll
          for (int r = 0; r < 16; ++r) lfv[r] = Clf[(rbase + 16 * qr + r) * D + h * HD + d]; }
        v4u qwA[2], kwA[2], kwB[5]; pg8::u32x2 q0C[2], q1C[2];
#pragma unroll
        for (int it = 0; it < 2; ++it) { const int item = tid + 512 * it, c = item >> 4, gq = item & 15;
            qwA[it] = *(const GAS v4u*)(Cq + (rbase + c) * D + h * HD + 8 * gq); kwA[it] = *(const GAS v4u*)(Ck + (rbase + c) * D + h * HD + 8 * gq); }
#pragma unroll
        for (int it = 0; it < 5; ++it) { const int item = tid + 512 * it, ri = item >> 4, gq = item & 15; const int s = ri < 16 ? ri : (ri < 48 ? ri - 16 : (ri < 96 ? ri - 48 : ri - 96));
            kwB[it] = *(const GAS v4u*)(Ck + (rbase + s) * D + h * HD + 8 * gq); }
#pragma unroll
        for (int it = 0; it < 2; ++it) { const int item = tid + 512 * it, c = item >> 4, pc = item & 15, dk0 = 32 * (pc >> 2) + 4 * (pc & 3);
            q0C[it] = *(const GAS pg8::u32x2*)(Cq + (rbase + c) * D + h * HD + dk0); q1C[it] = *(const GAS pg8::u32x2*)(Cq + (rbase + c) * D + h * HD + dk0 + 16); }
        if (tid < 192) { const int pr = tid >> 5, ctz = pr < 3 ? 0 : (pr < 5 ? 1 : 2), stz = pr < 3 ? pr + 1 : (pr < 5 ? pr - 1 : 3), cz = 16 * ctz + ((tid & 31) >> 1);
            *(GAS v4u*)(aint + cz * 64 + 16 * stz + 8 * (tid & 1)) = (v4u){0u, 0u, 0u, 0u}; }
        {
            const int d = tid & 127, qr = tid >> 7; float loc[16]; float run = 0.f;
#pragma unroll
            for (int r = 0; r < 16; ++r) { run += lfv[r]; loc[r] = run; }
            PART[qr * 128 + d] = run;
            LDS_WAIT(); __syncthreads();
            float off = 0.f;
#pragma unroll
            for (int q2 = 0; q2 < 3; ++q2) if (q2 < qr) off += PART[q2 * 128 + d];
#pragma unroll
            for (int r = 0; r < 16; ++r) BI[(16 * qr + r) * gla::BP + d] = off + loc[r];
        }
        LDS_WAIT(); __syncthreads();
#pragma unroll
        for (int it = 0; it < 2; ++it) {
            const int item = tid + 512 * it, c = item >> 4, gq = item & 15;
            const v4u qw = qwA[it], kw = kwA[it];
            const LAS float* bc = BI + c * gla::BP + 8 * gq; const LAS float* br = BI + (c & ~15) * gla::BP + 8 * gq; const LAS float* bl = BI + 63 * gla::BP + 8 * gq;
            const f32x4 b0 = *(const LAS f32x4*)bc, b1 = *(const LAS f32x4*)(bc + 4), r0 = *(const LAS f32x4*)br, r1 = *(const LAS f32x4*)(br + 4), l0 = *(const LAS f32x4*)bl, l1 = *(const LAS f32x4*)(bl + 4);
            v4u o;
            o.x = pg8::cvt_pk_bf16(bflo(qw.x) * __expf(b0[0] - r0[0]), bfhi(qw.x) * __expf(b0[1] - r0[1])); o.y = pg8::cvt_pk_bf16(bflo(qw.y) * __expf(b0[2] - r0[2]), bfhi(qw.y) * __expf(b0[3] - r0[3]));
            o.z = pg8::cvt_pk_bf16(bflo(qw.z) * __expf(b1[0] - r1[0]), bfhi(qw.z) * __expf(b1[1] - r1[1])); o.w = pg8::cvt_pk_bf16(bflo(qw.w) * __expf(b1[2] - r1[2]), bfhi(qw.w) * __expf(b1[3] - r1[3]));
            *(LAS v4u*)(QS + 256 * c + 16 * ((unsigned)gq ^ att::swz((unsigned)c))) = o;
            o.x = pg8::cvt_pk_bf16(bflo(kw.x) * __expf(l0[0] - b0[0]), bfhi(kw.x) * __expf(l0[1] - b0[1])); o.y = pg8::cvt_pk_bf16(bflo(kw.y) * __expf(l0[2] - b0[2]), bfhi(kw.y) * __expf(l0[3] - b0[3]));
            o.z = pg8::cvt_pk_bf16(bflo(kw.z) * __expf(l1[0] - b1[0]), bfhi(kw.z) * __expf(l1[1] - b1[1])); o.w = pg8::cvt_pk_bf16(bflo(kw.w) * __expf(l1[2] - b1[2]), bfhi(kw.w) * __expf(l1[3] - b1[3]));
            *(GAS v4u*)(ke + c * 128 + 8 * gq) = o;
        }
#pragma unroll
        for (int it = 0; it < 5; ++it) {
            const int item = tid + 512 * it, ri = item >> 4, gq = item & 15;
            int i, s, base; if (ri < 16) { i = 0; s = ri; base = 0; } else if (ri < 48) { i = 1; s = ri - 16; base = 4096; } else if (ri < 96) { i = 2; s = ri - 48; base = 12288; } else { i = 3; s = ri - 96; base = 24576; }
            const v4u kw = kwB[it];
            const LAS float* bs = BI + s * gla::BP + 8 * gq; const LAS float* br = BI + 16 * i * gla::BP + 8 * gq;
            const f32x4 b0 = *(const LAS f32x4*)bs, b1 = *(const LAS f32x4*)(bs + 4), r0 = *(const LAS f32x4*)br, r1 = *(const LAS f32x4*)(br + 4);
            v4u o;
            o.x = pg8::cvt_pk_bf16(bflo(kw.x) * __expf(r0[0] - b0[0]), bfhi(kw.x) * __expf(r0[1] - b0[1])); o.y = pg8::cvt_pk_bf16(bflo(kw.y) * __expf(r0[2] - b0[2]), bfhi(kw.y) * __expf(r0[3] - b0[3]));
            o.z = pg8::cvt_pk_bf16(bflo(kw.z) * __expf(r1[0] - b1[0]), bfhi(kw.z) * __expf(r1[1] - b1[1])); o.w = pg8::cvt_pk_bf16(bflo(kw.w) * __expf(r1[2] - b1[2]), bfhi(kw.w) * __expf(r1[3] - b1[3]));
            *(LAS v4u*)(KS + base + 256 * s + 16 * ((unsigned)gq ^ att::swz((unsigned)s))) = o;
        }
#pragma unroll
        for (int it = 0; it < 2; ++it) {
            const int item = tid + 512 * it, c = item >> 4, pc = item & 15, ks = pc >> 2, gp = pc & 3, dk0 = 32 * ks + 4 * gp;
            const pg8::u32x2 q0 = q0C[it], q1 = q1C[it];
            const f32x4 b0 = *(const LAS f32x4*)(BI + c * gla::BP + dk0), b1 = *(const LAS f32x4*)(BI + c * gla::BP + dk0 + 16);
            v4u o;
            o.x = pg8::cvt_pk_bf16(bflo(q0.x) * __expf(b0[0]), bfhi(q0.x) * __expf(b0[1])); o.y = pg8::cvt_pk_bf16(bflo(q0.y) * __expf(b0[2]), bfhi(q0.y) * __expf(b0[3]));
            o.z = pg8::cvt_pk_bf16(bflo(q1.x) * __expf(b1[0]), bfhi(q1.x) * __expf(b1[1])); o.w = pg8::cvt_pk_bf16(bflo(q1.y) * __expf(b1[2]), bfhi(q1.y) * __expf(b1[3]));
            *(GAS v4u*)(qep + c * 128 + 8 * pc) = o;
        }
        if (tid < 256) gd[tid] = tid < 128 ? __expf(BI[63 * gla::BP + tid]) : 0.f;
        LDS_WAIT(); __syncthreads();
        for (int jb = wave; jb < 10; jb += NWAVES) {
            int ct = 0, st = jb; if (jb >= 6) { ct = 3; st = jb - 6; } else if (jb >= 3) { ct = 2; st = jb - 3; } else if (jb >= 1) { ct = 1; st = jb - 1; }
            const int base = ct == 0 ? 0 : (ct == 1 ? 4096 : (ct == 2 ? 12288 : 24576));
            f32x4 acc = {0.f, 0.f, 0.f, 0.f};
#pragma unroll
            for (int ks = 0; ks < 4; ++ks) { const bf16x8 a = *(const LAS bf16x8*)(KS + base + 256u * (16u * st + fr) + 16u * ((4u * ks + g) ^ att::swz(fr))), bb = *(const LAS bf16x8*)(QS + 256u * (16u * ct + fr) + 16u * ((4u * ks + g) ^ att::swz(fr)));
                acc = __builtin_amdgcn_mfma_f32_16x16x32_bf16(a, bb, acc, 0, 0, 0); }
            const int c = 16 * ct + (int)fr; f32x4 o;
#pragma unroll
            for (int r = 0; r < 4; ++r) { const int s = 16 * st + 4 * (int)g + r; o[r] = s <= c ? acc[r] : 0.f; }
            *(GAS dn::s16x4*)(aint + c * 64 + 16 * st + 4 * g) = dn::pack4(o);
        }
    }
    __syncthreads();
}

template <int PM>
__device__ __forceinline__ void gla_scan_phase(Frame& F) {
    constexpr int SPL = 4, NCH = BATCH * NH_C;
    if (F.bx >= SPL * NCH) return;
    PHASE_IDS();
    const int bh = F.bx % NCH, part = F.bx / NCH, h = bh & 15, b = bh >> 4;
    const int dvt = (8 / SPL) * part + (wave & (8 / SPL - 1)); const bool active = wave < 8 / SPL;
    const int rot = part * (56 / SPL);
    LAS char* ring = (LAS char*)(F.lds + RING_OFF);
    constexpr int STG = 58368;
    const char* gQE = (const char*)(F.ws + WS_QEP) + (size_t)bh * 64 * 16384; const char* gKE = (const char*)(F.ws + WS_KE) + (size_t)bh * 64 * 16384;
    const char* gA = (const char*)(F.ws + WS_AINT) + (size_t)bh * 64 * 8192; const char* gD = (const char*)(F.ws + WS_GD) + (size_t)bh * 64 * 1024;
    const char* gV = (const char*)((const bf16*)(F.ws + WS_CV) + (size_t)b * SEQ * D + h * HD);
    float* co = (float*)(F.ws + (PM == 0 ? WS_CO : WS_ACT));
#define GLA_PIECE(n_, stg_, pc_) do { const char* src_; \
        if ((pc_) < 48) { const int q_ = (pc_) & 15; const unsigned row_ = 4u * q_ + ((unsigned)ln >> 4), ch_ = ((unsigned)ln & 15u) ^ att::swz(row_); \
            src_ = (pc_) < 16 ? gQE + (size_t)(n_) * 16384 + row_ * 256u + ch_ * 16u : ((pc_) < 32 ? gKE + (size_t)(n_) * 16384 + row_ * 256u + ch_ * 16u : gV + ((size_t)(n_) * 64 + row_) * 4096 + ch_ * 16u); } \
        else if ((pc_) < 56) { const int q_ = (pc_) - 48; const unsigned row_ = 8u * q_ + ((unsigned)ln >> 3), ch_ = ((unsigned)ln & 7u) ^ dn::swz8(row_); src_ = gA + (size_t)(n_) * 8192 + row_ * 128u + ch_ * 16u; } \
        else src_ = gD + (size_t)(n_) * 1024 + (unsigned)ln * 16u; \
        att::glds16(src_, (unsigned)__builtin_amdgcn_readfirstlane((unsigned)(size_t)((stg_) + (pc_) * 1024))); } while (0)
#define GLA_STAGE(n_, stg_) do { _Pragma("unroll") for (int pi_ = 0; pi_ < 7; ++pi_) { int pcc_ = 7 * wave + pi_ + rot; pcc_ -= pcc_ >= 56 ? 56 : 0; GLA_PIECE(n_, stg_, pcc_); } if (wave == 0) { GLA_PIECE(n_, stg_, 56); } } while (0)
    f32x4 S[8]; bf16x8 Sb[4];
#pragma unroll
    for (int dt = 0; dt < 8; ++dt) S[dt] = (f32x4){0.f, 0.f, 0.f, 0.f};
#pragma unroll
    for (int ks = 0; ks < 4; ++ks) Sb[ks] = (bf16x8){0, 0, 0, 0, 0, 0, 0, 0};
    { const int ln = lane; GLA_STAGE(0, ring); }
    VM_WAIT(); __syncthreads();
    for (int n = 0; n < SEQ / 64; ++n) {
        LAS char* cur = ring + (n & 1) * STG; LAS char* nxt = ring + ((n + 1) & 1) * STG;
        const int ln = opaque_i(lane);
        if (PM != 1 && n + 1 < SEQ / 64) GLA_STAGE(n + 1, nxt);
        const unsigned fr = ln & 15, g = (unsigned)ln >> 4, q4 = fr >> 2, p = ln & 3;
        const LAS char* QEI = cur; const LAS char* KEI = cur + 16384; const LAS char* VI = cur + 32768; const LAS char* AI = cur + 49152; const LAS float* DV = (const LAS float*)(cur + 57344);
        if (active && PM != 2) {
        f32x4 oo[4];
#pragma unroll
        for (int mt = 0; mt < 4; ++mt) oo[mt] = (f32x4){0.f, 0.f, 0.f, 0.f};
#define SB() __builtin_amdgcn_sched_barrier(0)
#define GLA_LD_Q(mt_, Q_) do { _Pragma("unroll") for (int ks_ = 0; ks_ < 4; ++ks_) Q_[ks_] = *(const LAS bf16x8*)(QEI + 256u * (16u * (mt_) + fr) + 16u * ((4u * ks_ + g) ^ att::swz(fr))); } while (0)
#define GLA_MM_Q(mt_, Q_) do { _Pragma("unroll") for (int ks_ = 0; ks_ < 4; ++ks_) oo[mt_] = __builtin_amdgcn_mfma_f32_16x16x32_bf16(Q_[ks_], Sb[ks_], oo[mt_], 0, 0, 0); } while (0)
#define GLA_LD_KE(d0_, K_) do { _Pragma("unroll") for (int dd_ = 0; dd_ < 4; ++dd_) _Pragma("unroll") for (int k2_ = 0; k2_ < 2; ++k2_) { const unsigned r0_ = 32u * k2_ + 8u * g + q4, r1_ = r0_ + 4u; \
            K_[dd_][k2_] = dn::join8(att::vtr(KEI + 256u * r0_ + 16u * ((2u * ((d0_) + dd_) + (p >> 1)) ^ att::swz(r0_)) + 8u * (p & 1u)), att::vtr(KEI + 256u * r1_ + 16u * ((2u * ((d0_) + dd_) + (p >> 1)) ^ att::swz(r1_)) + 8u * (p & 1u))); } } while (0)
        bf16x8 qA[4], qB[4], af[4][2], kA[4][2], kB[4][2], vb[2];
        GLA_LD_Q(0, qA);
#pragma unroll
        for (int k2 = 0; k2 < 2; ++k2) {
            const unsigned r0 = 32u * k2 + 8u * g + q4, r1 = r0 + 4u;
            vb[k2] = dn::join8(att::vtr(VI + 256u * r0 + 16u * ((2u * dvt + (p >> 1)) ^ att::swz(r0)) + 8u * (p & 1u)), att::vtr(VI + 256u * r1 + 16u * ((2u * dvt + (p >> 1)) ^ att::swz(r1)) + 8u * (p & 1u)));
        }
        GLA_LD_Q(1, qB); SB(); GLA_MM_Q(0, qA); SB();
        GLA_LD_Q(2, qA);
#pragma unroll
        for (int mt = 0; mt < 4; ++mt)
#pragma unroll
            for (int k2 = 0; k2 < 2; ++k2) { const unsigned row = 16u * mt + fr; af[mt][k2] = *(const LAS bf16x8*)(AI + 128u * row + 16u * ((4u * k2 + g) ^ dn::swz8(row))); }
        SB(); GLA_MM_Q(1, qB); SB();
        GLA_LD_Q(3, qB); SB(); GLA_MM_Q(2, qA); SB();
        GLA_LD_KE(0, kA); SB(); GLA_MM_Q(3, qB);
#pragma unroll
        for (int mt = 0; mt < 4; ++mt)
#pragma unroll
            for (int k2 = 0; k2 < 2; ++k2) oo[mt] = __builtin_amdgcn_mfma_f32_16x16x32_bf16(af[mt][k2], vb[k2], oo[mt], 0, 0, 0);
        SB(); GLA_LD_KE(4, kB); SB();
#pragma unroll
        for (int dt = 0; dt < 4; ++dt) { const f32x4 dd = *(const LAS f32x4*)(DV + 16 * dt + 4 * g); S[dt] = S[dt] * dd;
#pragma unroll
            for (int k2 = 0; k2 < 2; ++k2) S[dt] = __builtin_amdgcn_mfma_f32_16x16x32_bf16(kA[dt][k2], vb[k2], S[dt], 0, 0, 0); }
        SB();
#pragma unroll
        for (int dt = 4; dt < 8; ++dt) { const f32x4 dd = *(const LAS f32x4*)(DV + 16 * dt + 4 * g); S[dt] = S[dt] * dd;
#pragma unroll
            for (int k2 = 0; k2 < 2; ++k2) S[dt] = __builtin_amdgcn_mfma_f32_16x16x32_bf16(kB[dt - 4][k2], vb[k2], S[dt], 0, 0, 0); }
#pragma unroll
        for (int ks = 0; ks < 4; ++ks) Sb[ks] = dn::join8(dn::pack4(S[2 * ks]), dn::pack4(S[2 * ks + 1]));
#undef GLA_LD_Q
#undef GLA_MM_Q
#undef GLA_LD_KE
#undef SB
        const size_t rbase = (size_t)b * SEQ + n * 64;
#pragma unroll
        for (int mt = 0; mt < 4; ++mt)
#pragma unroll
            for (int r = 0; r < 4; ++r) co[(rbase + 16 * mt + 4 * g + r) * D + h * HD + 16 * dvt + fr] = oo[mt][r];
        }
        VM_WAIT();
        __syncthreads();
    }
#undef GLA_STAGE
#undef GLA_PIECE
}

struct Args { const float* in[20]; float* out; unsigned char* ws; };
__global__ void __launch_bounds__(NWAVES * 64, 2) fwd(Args args) {
    extern __shared__ __attribute__((aligned(16))) unsigned char lds[];
    Frame F;
    F.lds = (LAS unsigned char*)lds;
    F.MISC = (volatile LAS unsigned*)(F.lds + MISC_OFF);
    F.tid = threadIdx.x; F.lane = F.tid & 63; F.wave = __builtin_amdgcn_readfirstlane(F.tid >> 6);
    F.G = gridDim.x; F.bx = (int)blockIdx.x;
    GAS unsigned char* ws = (GAS unsigned char*)args.ws; F.ws = ws; F.out = args.out;
    F.ctl = (gu32*)(ws + WS_CTL);
    F.ka = (const __attribute__((address_space(4))) unsigned long long*)__builtin_amdgcn_kernarg_segment_ptr();
    for (int u = F.tid; u < (LDS_BYTES - LDSCTL_OFF) / 4; u += NWAVES * 64) ((LAS unsigned*)(F.lds + LDSCTL_OFF))[u] = 0u;
    __syncthreads();
    XcdBarrier bar = xcd_barrier_post((unsigned*)(F.ctl + CW_BAR), F.MISC + 8);
#define GRID_BAR() xcd_barrier(bar)
    const LAS float* rtab = (const LAS float*)(F.lds + RTAB_OFF);
    bf16* XB; void* XLO; float* ROWSS; bf16* ACT; bf16* Y;
    constexpr bool XF = X_F16 == 1;

    p0_prologue(F);
    GRID_BAR();

    for (int s = 0; s < 2 * DEPTH; ++s) {
        { GAS unsigned char* w_ = F.ws; asm volatile("" : "+s"(w_)); F.ws = w_; ws = w_; auto k_ = F.ka; asm volatile("" : "+s"(k_)); F.ka = k_; int b_ = (int)blockIdx.x; asm volatile("" : "+s"(b_)); F.bx = b_; }
        XB = (bf16*)(ws + WS_XB); XLO = (void*)(ws + WS_X); ROWSS = (float*)(ws + WS_ROWSS); ACT = (bf16*)(ws + WS_ACT); Y = (bf16*)(ws + WS_Y);
        { pg8::EpiSwiGLU E{ACT, DFF, rtab, 0}; run_gemm<pg8::EpiSwiGLU, 0, XF, AIMG_XB != 0>(F, XB, (const bf16*)(ws + WS_W1T) + (size_t)s * NFF * D, M, F.G == 256 ? 40 * 256 : NFF, D, E, true, 0, 0, 1, F.G == 256 ? 5 : -1, 40, 3); }
        if (F.G == 256) { pg8::EpiSwiGLU E{ACT, DFF, rtab + 5 * 256, 1}; run_gemm_half<pg8::EpiSwiGLU, XF, AIMG_XB != 0>(F, XB, (const bf16*)(ws + WS_W1T) + (size_t)s * NFF * D, M, NFF, D, 40, 3, E, false); }
        conv_slot(F, F.G == 256 ? 192 : 0, 3);
        GRID_BAR();
        { pg8::EpiResidual E{s == 0 ? FIN(I_X) : (const float*)nullptr, XB, XLO, ROWSS, 0.5f, D, M}; run_gemm<pg8::EpiResidual, 0, false, AIMG_ACT != 0>(F, ACT, (const bf16*)(ws + WS_W2T) + (size_t)s * D * DFF, M, D, DFF, E, false); }
        if (!(s & 1)) conv_deadline(F, cq_n_mix(s >> 1)); else if (s + 1 < 2 * DEPTH) conv_deadline(F, cq_n_ffn(s + 1));
        GRID_BAR();
        if (!(s & 1)) {
            const int l = s >> 1;
            if (!(l & 1)) {
                const int e = l >> 1;
                { pg8::EpiABin E{(bf16*)(ws + WS_QM), (bf16*)(ws + WS_KM), (bf16*)(ws + WS_VM), (bf16*)(ws + WS_DNPRE), (bf16*)(ws + WS_DNGATE), (float*)(ws + WS_BA), (float*)(ws + WS_KMS), rtab, QK_SCALE_LOG2E};
                  run_gemm<pg8::EpiABin, 0, XF, AIMG_XB != 0>(F, XB, (const bf16*)(ws + WS_WABT) + (size_t)e * AB_PAD * D, M, AB_PAD, D, E, true); }
                conv_slot(F, F.G == 256 ? 160 : F.G, 6);
                GRID_BAR();
                dn_chunk_phase(F, e);
                GRID_BAR();
                dn_scan_phase<0>(F, e);
                moba_phase(F, 4 * BATCH * NH_AB);
                conv_slot(F, 4 * BATCH * NH_AB + BATCH * NH_AB * 8, 18);
                if (DN_TAIL_NORMGATE == 2) ng_help(F, e);
                GRID_BAR();
                if (DN_TAIL_NORMGATE == 0) { normgate(F, (const float*)(ws + WS_DNO), (const bf16*)(ws + WS_DNGATE), NH_AB, FIN(I_AB_ONG) + e * HD, 1024); GRID_BAR(); }
                { pg8::EpiResidual E{nullptr, XB, XLO, ROWSS, 1.0f, D, M}; run_gemm(F, Y, (const bf16*)(ws + WS_WABOT) + (size_t)e * D * D, M, D, D, E, false); }
                conv_deadline(F, cq_n_x(l));
                GRID_BAR();
            } else {
                const int o = l >> 1;
                { pg8::EpiCin E{(bf16*)(ws + WS_CQ), (bf16*)(ws + WS_CK), (bf16*)(ws + WS_CV), (bf16*)(ws + WS_CG), (float*)(ws + WS_CLF), (const float*)(ws + WS_LB) + (size_t)l * D, rtab};
                  run_gemm<pg8::EpiCin, 0, XF, AIMG_XB != 0>(F, XB, (const bf16*)(ws + WS_WCT) + (size_t)o * 4 * D * D, M, 4 * D, D, E, true); }
                GRID_BAR();
                gla_chunk_phase(F);
                GRID_BAR();
                gla_scan_phase<0>(F);
                conv_slot(F, 4 * BATCH * NH_C, 14);
                GRID_BAR();
                normgate(F, (const float*)(ws + WS_CO), (const bf16*)(ws + WS_CG), NH_C, FIN(I_C_ONG) + o * HD, 0);
                GRID_BAR();
                { pg8::EpiResidual E{nullptr, XB, XLO, ROWSS, 1.0f, D, M}; run_gemm(F, Y, (const bf16*)(ws + WS_WCOT) + (size_t)o * D * D, M, D, D, E, false); }
                conv_deadline(F, cq_n_x(l));
                GRID_BAR();
            }
            { pg8::EpiBf16Route E{(bf16*)(ws + WS_XQ), XW, rtab, QK_SCALE_LOG2E, 1}; run_gemm_half<pg8::EpiBf16Route, XF, AIMG_XB != 0>(F, XB, (const bf16*)(ws + WS_WXQT) + (size_t)l * XW * D, M, XW, D, 0, XW / 256, E, true, 0); }
            if (l == 0) { pg8::EpiBf16Route E{(bf16*)(ws + WS_KV), 4096, nullptr, 1.0f, 1}; run_gemm_half(F, (const bf16*)(ws + WS_MEMN), (const bf16*)(ws + WS_WXKVT), BATCH * MEMT, 4096, D, 0, 16, E, false, F.G - 128); }
            conv_slot(F, l == 0 ? 192 : 128, 3);
            GRID_BAR();
            xattn_phase(F, l);
            conv_slot(F, 128, 2);
            GRID_BAR();
            { pg8::EpiResidual E{nullptr, XB, XLO, ROWSS, 1.0f, D, M}; run_gemm(F, (const bf16*)(ws + WS_XO), (const bf16*)(ws + WS_WXOT) + (size_t)l * D * XW, M, D, XW, E, false); }
            conv_deadline(F, cq_n_ffn(s + 1));
            GRID_BAR();
        }
    }
    final_norm(F);
#undef GRID_BAR
}

extern "C" void kernel_launch(void* const* d_in, const int* in_sizes, int n_in, void* d_out, int out_size, void* d_ws, size_t ws_size, hipStream_t stream) {
    static int grid = 0;
    if (grid == 0) {
        if (n_in != 20 || in_sizes[0] != M * D || out_size != M * D || ws_size < WS_END2) { fprintf(stderr, "kernel_launch: unexpected shapes: n_in %d in0 %d out %d ws %zu (need %zu); nothing launched\n", n_in, n_in > 0 ? in_sizes[0] : -1, out_size, ws_size, (size_t)WS_END2); grid = -1; return; }
        int dev = 0, cus = 0, per_cu = 0;
        if (hipGetDevice(&dev) != hipSuccess || hipDeviceGetAttribute(&cus, hipDeviceAttributeMultiprocessorCount, dev) != hipSuccess) { fprintf(stderr, "kernel_launch: device query failed\n"); grid = -1; return; }
        if (hipFuncSetAttribute((const void*)fwd, hipFuncAttributeMaxDynamicSharedMemorySize, LDS_BYTES) != hipSuccess) { fprintf(stderr, "kernel_launch: hipFuncSetAttribute failed\n"); grid = -1; return; }
        if (hipOccupancyMaxActiveBlocksPerMultiprocessor(&per_cu, (const void*)fwd, NWAVES * 64, LDS_BYTES) != hipSuccess || per_cu < 1) fprintf(stderr, "kernel_launch: note: occupancy query reports %d workgroups per CU\n", per_cu);
        (void)hipGetLastError();
        grid = cus;
    }
    if (grid < 0) return;
    if (hipMemsetAsync((char*)d_ws + WS_CTL, 0, CTL_ZERO_BYTES, stream) != hipSuccess) { fprintf(stderr, "kernel_launch: memset failed\n"); return; }
    Args a{};
    for (int i = 0; i < 20; ++i) a.in[i] = (const float*)d_in[i];
    a.out = (float*)d_out; a.ws = (unsigned char*)d_ws;
    hipLaunchKernelGGL(fwd, dim3(grid), dim3(NWAVES * 64), LDS_BYTES, stream, a);
    const hipError_t le = hipPeekAtLastError();
    if (le != hipSuccess) fprintf(stderr, "kernel_launch: launch failed: %s\n", hipGetErrorName(le));
}
```
